# Optimizing an MI355X kernel written in HIP

```python
import math
import jax
import jax.numpy as jnp
from jax import lax
import numpy as np

D_MODEL = 1024
BATCH = 4
SEQ = 8192
DEPTH = 2

GRID_W = 64
CTX_LEN = 256
HEAD_DIM = 64
S5_GROUP_CH = 16
S5_GROUPS = 16
S5_WIDTH = S5_GROUPS * S5_GROUP_CH
S5_STATE = 64
RWKV_HEADS = 8
RWKV_WIDTH = RWKV_HEADS * HEAD_DIM
RWKV_LORA_W = 64
RWKV_LORA_A = 64
RWKV_LORA_G = 128
RWKV_IN = 3 * RWKV_WIDTH + 2 * RWKV_LORA_W + 2 * RWKV_LORA_A + RWKV_LORA_G
RWKV_SPLITS = (RWKV_WIDTH, 2 * RWKV_WIDTH, 3 * RWKV_WIDTH,
               3 * RWKV_WIDTH + 2 * RWKV_LORA_W,
               3 * RWKV_WIDTH + 2 * RWKV_LORA_W + 2 * RWKV_LORA_A)
EVEN_IN = S5_WIDTH + RWKV_IN
EVEN_MIX = S5_WIDTH + RWKV_WIDTH
WIN_HEADS = 8
WIN_KV_HEADS = 2
WINDOW = 128
WIN_BLOCK = 128
NA_HEADS = 8
NA_ROWS = 8
NA_COLS = 16
ODD_SPLITS = (WIN_HEADS * HEAD_DIM, (WIN_HEADS + WIN_KV_HEADS) * HEAD_DIM,
              (WIN_HEADS + 2 * WIN_KV_HEADS) * HEAD_DIM,
              (WIN_HEADS + 2 * WIN_KV_HEADS + NA_HEADS) * HEAD_DIM,
              (WIN_HEADS + 2 * WIN_KV_HEADS + 2 * NA_HEADS) * HEAD_DIM)
ODD_IN = (WIN_HEADS + 2 * WIN_KV_HEADS + 3 * NA_HEADS) * HEAD_DIM
ODD_MIX = (WIN_HEADS + NA_HEADS) * HEAD_DIM
ROPE_BASE = 10000.0
PEER_HEADS = 8
PEER_KEYS = 128
PEER_EXPERTS = PEER_KEYS * PEER_KEYS
PEER_DK = 128
PEER_TOPK = 16
PEER_BLOCK = 128
ALPHA = (2.0 * DEPTH) ** 0.25
BETA = (8.0 * DEPTH) ** -0.25
LN_EPS = 1e-5
GN_EPS = 64e-5

kernel_name = 'hybrid_s5_rwkv7_swa_natten_peer_dit'

F32 = jnp.float32


def _layer_norm(z, g, b):
    zf = z.astype(F32)
    mu = jnp.mean(zf, -1, keepdims=True)
    var = jnp.mean(jnp.square(zf - mu), -1, keepdims=True)
    return ((zf - mu) * lax.rsqrt(var + LN_EPS) * g + b).astype(z.dtype)


def _modulation(cond, w_mod, b_mod):
    m = (jax.nn.silu(cond) @ w_mod + b_mod)[:, None, :]
    return jnp.split(m, 6, axis=-1)


def _modulate(z, shift, scale):
    return z * (1.0 + scale) + shift


def _dir_view(z, n_ctx, d):
    if d == 0:
        return z
    return jnp.concatenate([jnp.flip(z[:, :n_ctx], 1), jnp.flip(z[:, n_ctx:], 1)], 1)


def _axial_rope(z, row, col):
    half = HEAD_DIM // 2
    quarter = half // 2
    freqs = ROPE_BASE ** (-jnp.arange(quarter, dtype=F32) / quarter)

    def rot(za, pos):
        ang = pos[:, None] * freqs[None, :]
        cos = jnp.cos(ang)[None, :, None, :].astype(z.dtype)
        sin = jnp.sin(ang)[None, :, None, :].astype(z.dtype)
        z1, z2 = za[..., :quarter], za[..., quarter:]
        return jnp.concatenate([z1 * cos - z2 * sin, z2 * cos + z1 * sin], -1)

    return jnp.concatenate([rot(z[..., :half], row), rot(z[..., half:], col)], -1)


def _complex_diag_scan(a_re, a_im, b_re, b_im):
    def combine(e1, e2):
        a1r, a1i, b1r, b1i = e1
        a2r, a2i, b2r, b2i = e2
        return (a1r * a2r - a1i * a2i, a1r * a2i + a1i * a2r,
                a2r * b1r - a2i * b1i + b2r, a2r * b1i + a2i * b1r + b2i)

    a_re = jnp.broadcast_to(a_re, b_re.shape)
    a_im = jnp.broadcast_to(a_im, b_re.shape)
    _, _, h_re, h_im = lax.associative_scan(combine, (a_re, a_im, b_re, b_im), axis=1)
    return h_re, h_im


def _s5_mixer(ux, uc, lam_re, lam_im, log_dt, b_re, b_im, c_re, c_im, d_skip, w_glu, b_glu):
    Bt, T, _ = ux.shape
    L = uc.shape[1]
    u = jnp.concatenate([uc, ux], 1).astype(F32).reshape(Bt, L + T, S5_GROUPS, S5_GROUP_CH)
    y = u * d_skip.astype(F32).reshape(S5_GROUPS, S5_GROUP_CH)
    for d in range(2):
        lr, li = lam_re[d].astype(F32), lam_im[d].astype(F32)
        dt = jnp.exp(log_dt[d].astype(F32))[:, None]
        mag = jnp.exp(lr * dt)
        ab_re, ab_im = mag * jnp.cos(li * dt), mag * jnp.sin(li * dt)
        den = lr * lr + li * li
        nr = ab_re - 1.0
        coef_re = (nr * lr + ab_im * li) / den
        coef_im = (ab_im * lr - nr * li) / den
        br, bi = b_re[d].astype(F32), b_im[d].astype(F32)
        bb_re = coef_re[..., None] * br - coef_im[..., None] * bi
        bb_im = coef_re[..., None] * bi + coef_im[..., None] * br
        seq = _dir_view(u, L, d)
        bu_re = jnp.einsum('bsgi,gpi->bsgp', seq, bb_re)
        bu_im = jnp.einsum('bsgi,gpi->bsgp', seq, bb_im)
        h_re, h_im = _complex_diag_scan(ab_re, ab_im, bu_re, bu_im)
        yd = (jnp.einsum('bsgp,gip->bsgi', h_re, c_re[d].astype(F32))
              - jnp.einsum('bsgp,gip->bsgi', h_im, c_im[d].astype(F32)))
        y = y + _dir_view(yd, L, d)
    y = jax.nn.gelu(y.reshape(Bt, L + T, S5_WIDTH), approximate=False)
    y = (y * jax.nn.sigmoid(y @ w_glu.astype(F32) + b_glu.astype(F32))).astype(ux.dtype)
    return y[:, L:], y[:, :L]


def _centred_shift(z, mu):
    prev = jnp.pad(z[:, :-1], ((0, 0), (1, 0), (0, 0)))
    nxt = jnp.pad(z[:, 1:], ((0, 0), (0, 1), (0, 0)))
    return z + mu[0] * (prev - z) + mu[1] * (nxt - z)


def _rwkv_scan(r, w, k, v, a, b):
    Bt, S, H, N = r.shape

    def step(state, inp):
        r_t, w_t, k_t, v_t, a_t, b_t = inp
        sa = jnp.einsum('bhvk,bhk->bhv', state, a_t)
        state = (state * w_t[:, :, None, :] + sa[..., None] * b_t[:, :, None, :]
                 + v_t[..., None] * k_t[:, :, None, :])
        return state, jnp.einsum('bhvk,bhk->bhv', state, r_t)

    xs = tuple(jnp.moveaxis(t, 1, 0) for t in (r, w, k, v, a, b))
    _, ys = lax.scan(step, jnp.zeros((Bt, H, N, N), F32), xs)
    return jnp.moveaxis(ys, 0, 1)


def _rwkv_mixer(zx, zc, shift_mu, w0, w2, a0, a2, g2, k_k, k_a, r_k, gn_w, gn_b):
    Bt, T, _ = zx.shape
    L = zc.shape[1]
    S = L + T
    z = jnp.concatenate([_centred_shift(zc, shift_mu), _centred_shift(zx, shift_mu)], 1).astype(F32)
    r, k, v, w_lo, a_lo, g_lo = jnp.split(z, RWKV_SPLITS, axis=-1)
    w_lo = w_lo.reshape(Bt, S, 2, RWKV_LORA_W)
    a_lo = a_lo.reshape(Bt, S, 2, RWKV_LORA_A)
    g = jax.nn.sigmoid(g_lo) @ g2

    def heads(t):
        return t.reshape(Bt, S, RWKV_HEADS, HEAD_DIM)

    kk = heads(k * k_k)
    kk = kk * lax.rsqrt(jnp.sum(kk * kk, -1, keepdims=True) + 1e-12)
    rh, vh = heads(r), heads(v)
    y = 0.0
    bonus = 0.0
    for d in range(2):
        w_log = -jax.nn.softplus(-(w0[d] + jnp.tanh(w_lo[:, :, d]) @ w2[d])) - 0.5
        decay = jnp.exp(-jnp.exp(w_log))
        a = jax.nn.sigmoid(a0[d] + a_lo[:, :, d] @ a2[d])
        kd = heads(k * (1.0 + (a - 1.0) * k_a))
        ah = heads(a)
        ins = [_dir_view(t, L, d) for t in (rh, heads(decay), kd, vh, -kk, kk * ah)]
        y = y + _dir_view(_rwkv_scan(*ins), L, d)
        bonus = bonus + jnp.sum(rh * kd * r_k, -1, keepdims=True) * vh
    mu = jnp.mean(y, -1, keepdims=True)
    var = jnp.mean(jnp.square(y - mu), -1, keepdims=True)
    y = ((y - mu) * lax.rsqrt(var + GN_EPS)).reshape(Bt, S, RWKV_WIDTH) * gn_w + gn_b
    y = ((y + bonus.reshape(Bt, S, RWKV_WIDTH)) * g).astype(zx.dtype)
    return y[:, L:], y[:, :L]


def _mixer_a_b(hx, hc, p, ctx_out):
    zx, zc = hx @ p['w_in'], hc @ p['w_in']
    ya_x, ya_c = _s5_mixer(zx[..., :S5_WIDTH], zc[..., :S5_WIDTH], p['s5_lam_re'], p['s5_lam_im'],
                           p['s5_log_dt'], p['s5_b_re'], p['s5_b_im'], p['s5_c_re'], p['s5_c_im'],
                           p['s5_d'], p['w_glu'], p['b_glu'])
    yb_x, yb_c = _rwkv_mixer(zx[..., S5_WIDTH:], zc[..., S5_WIDTH:], p['rwkv_shift'], p['rwkv_w0'],
                             p['rwkv_w2'], p['rwkv_a0'], p['rwkv_a2'], p['rwkv_g2'], p['rwkv_k_k'],
                             p['rwkv_k_a'], p['rwkv_r_k'], p['rwkv_gn_w'], p['rwkv_gn_b'])
    out_x = jnp.concatenate([ya_x, yb_x], -1) @ p['w_out']
    out_c = jnp.concatenate([ya_c, yb_c], -1) @ p['w_out'] if ctx_out else None
    return out_x, out_c


def _window_gqa(q, k, v, k_ctx, v_ctx, sink):
    Bt, T, HQ, hd = q.shape
    HK = k.shape[2]
    G = HQ // HK
    nb = T // WIN_BLOCK
    scale = hd ** -0.5

    def band(z):
        zp = jnp.pad(z, ((0, 0), (WIN_BLOCK, WIN_BLOCK), (0, 0), (0, 0))).reshape(Bt, nb + 2, WIN_BLOCK, HK, hd)
        return jnp.concatenate([zp[:, :-2], zp[:, 1:-1], zp[:, 2:]], axis=2)

    kb, vb = band(k), band(v)
    qb = q.reshape(Bt, nb, WIN_BLOCK, HK, G, hd)
    qi = jnp.arange(WIN_BLOCK)[:, None]
    kj = jnp.arange(3 * WIN_BLOCK)[None, :] - WIN_BLOCK
    kabs = jnp.arange(nb)[:, None] * WIN_BLOCK + kj
    valid = (jnp.abs(kj - qi) <= WINDOW)[None] & ((kabs >= 0) & (kabs < T))[:, None, :]
    sink_col = sink.astype(F32).reshape(1, HK, G, 1, 1)
    n_loc = 3 * WIN_BLOCK

    def one_block(args):
        q_i, k_i, v_i, m_i = args
        s_loc = jnp.einsum('bqkgd,bskd->bkgqs', q_i, k_i).astype(F32) * scale
        s_loc = jnp.where(m_i, s_loc, -1e30)
        s_ctx = jnp.einsum('bqkgd,bskd->bkgqs', q_i, k_ctx).astype(F32) * scale
        s_snk = jnp.broadcast_to(sink_col, (Bt, HK, G, WIN_BLOCK, 1))
        p = jax.nn.softmax(jnp.concatenate([s_loc, s_ctx, s_snk], -1), -1).astype(v.dtype)
        return (jnp.einsum('bkgqs,bskd->bqkgd', p[..., :n_loc], v_i)
                + jnp.einsum('bkgqs,bskd->bqkgd', p[..., n_loc:-1], v_ctx))

    o = lax.map(one_block, (jnp.moveaxis(qb, 1, 0), jnp.moveaxis(kb, 1, 0), jnp.moveaxis(vb, 1, 0), valid))
    return jnp.moveaxis(o, 0, 1).reshape(Bt, T, HQ * hd)


def _context_attention(q, k, v, sink):
    Bt, L, HQ, hd = q.shape
    HK = k.shape[2]
    G = HQ // HK
    s = jnp.einsum('bqkgd,bskd->bkgqs', q.reshape(Bt, L, HK, G, hd), k).astype(F32) * hd ** -0.5
    if sink is not None:
        s = jnp.concatenate([s, jnp.broadcast_to(sink.astype(F32).reshape(1, HK, G, 1, 1), (Bt, HK, G, L, 1))], -1)
    p = jax.nn.softmax(s, -1)[..., :L].astype(v.dtype)
    return jnp.einsum('bkgqs,bskd->bqkgd', p, v).reshape(Bt, L, HQ * hd)


def _neighbourhood_attention(q, k, v, k_ctx, v_ctx, rpb):
    Bt, T, H, hd = q.shape
    rows = T // GRID_W
    kh = min(NA_ROWS, rows)
    kw = min(NA_COLS, GRID_W)
    scale = hd ** -0.5

    def grid(z):
        return z.reshape(Bt, rows, GRID_W, H, hd)

    kg, vg = grid(k), grid(v)
    q_rows = jnp.moveaxis(grid(q), 1, 0)
    r_idx = jnp.arange(rows)
    row_start = jnp.clip(r_idx - kh // 2, 0, rows - kh)
    c_idx = jnp.arange(GRID_W)
    col_win = jnp.clip(c_idx - kw // 2, 0, GRID_W - kw)[:, None] + jnp.arange(kw)[None, :]
    col_rel = col_win - c_idx[:, None] + (NA_COLS - 1)
    n_loc = kh * kw

    def one_row(args):
        r, rs, q_r = args
        k_win = lax.dynamic_slice_in_dim(kg, rs, kh, axis=1)[:, :, col_win]
        v_win = lax.dynamic_slice_in_dim(vg, rs, kh, axis=1)[:, :, col_win]
        row_rel = rs + jnp.arange(kh) - r + (NA_ROWS - 1)
        bias = rpb[:, row_rel[:, None, None], col_rel[None, :, :]]
        s_loc = (jnp.einsum('bqhd,brqjhd->bhqrj', q_r, k_win).astype(F32) * scale
                 + jnp.transpose(bias, (0, 2, 1, 3))[None]).reshape(Bt, H, GRID_W, n_loc)
        s_ctx = jnp.einsum('bqhd,bshd->bhqs', q_r, k_ctx).astype(F32) * scale
        p = jax.nn.softmax(jnp.concatenate([s_loc, s_ctx], -1), -1).astype(v.dtype)
        p_loc = p[..., :n_loc].reshape(Bt, H, GRID_W, kh, kw)
        return (jnp.einsum('bhqrj,brqjhd->bqhd', p_loc, v_win)
                + jnp.einsum('bhqs,bshd->bqhd', p[..., n_loc:], v_ctx))

    o = lax.map(one_row, (r_idx, row_start, q_rows))
    return jnp.moveaxis(o, 0, 1).reshape(Bt, T, H * hd)


def _mixer_c_d(hx, hc, p, row, col, ctx_out):
    def heads(z, n):
        return z.reshape(z.shape[0], z.shape[1], n, HEAD_DIM)

    qcx, kcx, vcx, qdx, kdx, vdx = jnp.split(hx @ p['w_in'], ODD_SPLITS, axis=-1)
    qcc, kcc, vcc, qdc, kdc, vdc = jnp.split(hc @ p['w_in'], ODD_SPLITS, axis=-1)
    kcc, vcc = heads(kcc, WIN_KV_HEADS), heads(vcc, WIN_KV_HEADS)
    kdc, vdc = heads(kdc, NA_HEADS), heads(vdc, NA_HEADS)
    oc = _window_gqa(_axial_rope(heads(qcx, WIN_HEADS), row, col), _axial_rope(heads(kcx, WIN_KV_HEADS), row, col),
                     heads(vcx, WIN_KV_HEADS), kcc, vcc, p['sink'])
    od = _neighbourhood_attention(heads(qdx, NA_HEADS), heads(kdx, NA_HEADS), heads(vdx, NA_HEADS), kdc, vdc, p['rpb'])
    out_x = jnp.concatenate([oc, od], -1) @ p['w_out']
    out_c = None
    if ctx_out:
        occ = _context_attention(heads(qcc, WIN_HEADS), kcc, vcc, p['sink'])
        odc = _context_attention(heads(qdc, NA_HEADS), kdc, vdc, None)
        out_c = jnp.concatenate([occ, odc], -1) @ p['w_out']
    return out_x, out_c


def _peer(h, wq, sub_keys, u_tab, v_tab):
    Bt, T, Dm = h.shape
    half = PEER_DK // 2
    n_cand = PEER_TOPK * PEER_TOPK

    def one_block(hb):
        q = (hb @ wq).reshape(PEER_BLOCK, PEER_HEADS, 2, half)
        s = jnp.einsum('nhcd,hckd->nhck', q, sub_keys).astype(F32)
        s1, i1 = lax.top_k(s[:, :, 0], PEER_TOPK)
        s2, i2 = lax.top_k(s[:, :, 1], PEER_TOPK)
        cand = (s1[..., :, None] + s2[..., None, :]).reshape(PEER_BLOCK, PEER_HEADS, n_cand)
        cand_idx = (i1[..., :, None] * PEER_KEYS + i2[..., None, :]).reshape(PEER_BLOCK, PEER_HEADS, n_cand)
        top, pos = lax.top_k(cand, PEER_TOPK)
        idx = jnp.take_along_axis(cand_idx, pos, -1).reshape(PEER_BLOCK, PEER_HEADS * PEER_TOPK)
        gate = jax.nn.softmax(top, -1).reshape(PEER_BLOCK, PEER_HEADS * PEER_TOPK)
        u_e, v_e = u_tab[idx], v_tab[idx]
        act = jax.nn.gelu(jnp.einsum('nd,ned->ne', hb, u_e).astype(F32), approximate=False)
        return jnp.einsum('ne,ned->nd', (gate * act).astype(v_e.dtype), v_e)

    out = lax.map(one_block, h.reshape((Bt * T) // PEER_BLOCK, PEER_BLOCK, Dm))
    return out.reshape(Bt, T, Dm)


def setup_inputs(seed: int = 0) -> dict:
    key = jax.random.key(seed)
    keys = iter(jax.random.split(key, 96))

    def nrm(shape, scale):
        return jax.random.normal(next(keys), shape, F32) * scale

    def unif(shape, lo, hi):
        return jax.random.uniform(next(keys), shape, F32, lo, hi)

    D = D_MODEL
    lam_n = math.pi * jnp.arange(S5_STATE, dtype=F32)
    return {
        'x': nrm((BATCH, SEQ, D), 1.0),
        'c': nrm((BATCH, D), 1.0),
        'ctx': nrm((BATCH, CTX_LEN, D), 1.0),
        'c_ctx': nrm((D,), 1.0),
        'l0_w_mod': nrm((D, 6 * D), 0.5 * D ** -0.5),
        'l0_b_mod': nrm((6 * D,), 0.02),
        'l0_w_in': nrm((D, EVEN_IN), D ** -0.5),
        'l0_s5_lam_re': -0.5 + nrm((2, S5_GROUPS, S5_STATE), 0.01),
        'l0_s5_lam_im': lam_n + nrm((2, S5_GROUPS, S5_STATE), 0.01),
        'l0_s5_log_dt': unif((2, S5_GROUPS), math.log(1e-3), math.log(1e-1)),
        'l0_s5_b_re': nrm((2, S5_GROUPS, S5_STATE, S5_GROUP_CH), (2 * S5_GROUP_CH) ** -0.5),
        'l0_s5_b_im': nrm((2, S5_GROUPS, S5_STATE, S5_GROUP_CH), (2 * S5_GROUP_CH) ** -0.5),
        'l0_s5_c_re': nrm((2, S5_GROUPS, S5_GROUP_CH, S5_STATE), S5_STATE ** -0.5),
        'l0_s5_c_im': nrm((2, S5_GROUPS, S5_GROUP_CH, S5_STATE), S5_STATE ** -0.5),
        'l0_s5_d': nrm((S5_WIDTH,), 1.0),
        'l0_w_glu': nrm((S5_WIDTH, S5_WIDTH), S5_WIDTH ** -0.5),
        'l0_b_glu': nrm((S5_WIDTH,), 0.02),
        'l0_rwkv_shift': unif((2, RWKV_IN), 0.0, 0.5),
        'l0_rwkv_w0': unif((2, RWKV_WIDTH), -6.0, -1.0),
        'l0_rwkv_w2': nrm((2, RWKV_LORA_W, RWKV_WIDTH), 0.1 * RWKV_LORA_W ** -0.5),
        'l0_rwkv_a0': nrm((2, RWKV_WIDTH), 0.1),
        'l0_rwkv_a2': nrm((2, RWKV_LORA_A, RWKV_WIDTH), 0.1 * RWKV_LORA_A ** -0.5),
        'l0_rwkv_g2': nrm((RWKV_LORA_G, RWKV_WIDTH), RWKV_LORA_G ** -0.5),
        'l0_rwkv_k_k': 0.85 + nrm((RWKV_WIDTH,), 0.02),
        'l0_rwkv_k_a': 1.0 + nrm((RWKV_WIDTH,), 0.02),
        'l0_rwkv_r_k': nrm((RWKV_HEADS, HEAD_DIM), 0.1),
        'l0_rwkv_gn_w': 1.0 + nrm((RWKV_WIDTH,), 0.02),
        'l0_rwkv_gn_b': nrm((RWKV_WIDTH,), 0.02),
        'l0_w_out': nrm((EVEN_MIX, D), BETA * EVEN_MIX ** -0.5),
        'l0_ln1_g': 1.0 + nrm((D,), 0.02),
        'l0_ln1_b': nrm((D,), 0.02),
        'l0_peer_wq': nrm((D, PEER_HEADS * PEER_DK), D ** -0.5),
        'l0_peer_keys': nrm((PEER_HEADS, 2, PEER_KEYS, PEER_DK // 2), (PEER_DK // 2) ** -0.5),
        'l0_peer_u': nrm((PEER_EXPERTS, D), D ** -0.5),
        'l0_peer_v': nrm((PEER_EXPERTS, D), BETA),
        'l0_ln2_g': 1.0 + nrm((D,), 0.02),
        'l0_ln2_b': nrm((D,), 0.02),
        'l1_w_mod': nrm((D, 6 * D), 0.5 * D ** -0.5),
        'l1_b_mod': nrm((6 * D,), 0.02),
        'l1_w_in': nrm((D, ODD_IN), D ** -0.5),
        'l1_sink': nrm((WIN_HEADS,), 0.5),
        'l1_rpb': nrm((NA_HEADS, 2 * NA_ROWS - 1, 2 * NA_COLS - 1), 0.1),
        'l1_w_out': nrm((ODD_MIX, D), BETA * ODD_MIX ** -0.5),
        'l1_ln1_g': 1.0 + nrm((D,), 0.02),
        'l1_ln1_b': nrm((D,), 0.02),
        'l1_peer_wq': nrm((D, PEER_HEADS * PEER_DK), D ** -0.5),
        'l1_peer_keys': nrm((PEER_HEADS, 2, PEER_KEYS, PEER_DK // 2), (PEER_DK // 2) ** -0.5),
        'l1_peer_u': nrm((PEER_EXPERTS, D), D ** -0.5),
        'l1_peer_v': nrm((PEER_EXPERTS, D), BETA),
        'l1_ln2_g': 1.0 + nrm((D,), 0.02),
        'l1_ln2_b': nrm((D,), 0.02),
    }


def reference(x, c, ctx, c_ctx,
              l0_w_mod, l0_b_mod, l0_w_in, l0_s5_lam_re, l0_s5_lam_im, l0_s5_log_dt, l0_s5_b_re, l0_s5_b_im,
              l0_s5_c_re, l0_s5_c_im, l0_s5_d, l0_w_glu, l0_b_glu, l0_rwkv_shift, l0_rwkv_w0, l0_rwkv_w2,
              l0_rwkv_a0, l0_rwkv_a2, l0_rwkv_g2, l0_rwkv_k_k, l0_rwkv_k_a, l0_rwkv_r_k, l0_rwkv_gn_w,
              l0_rwkv_gn_b, l0_w_out, l0_ln1_g, l0_ln1_b, l0_peer_wq, l0_peer_keys, l0_peer_u, l0_peer_v,
              l0_ln2_g, l0_ln2_b,
              l1_w_mod, l1_b_mod, l1_w_in, l1_sink, l1_rpb, l1_w_out, l1_ln1_g, l1_ln1_b, l1_peer_wq,
              l1_peer_keys, l1_peer_u, l1_peer_v, l1_ln2_g, l1_ln2_b):
    T = x.shape[1]
    t = jnp.arange(T)
    row = (t // GRID_W).astype(F32)
    col = (t % GRID_W).astype(F32)
    layers = (
        dict(w_mod=l0_w_mod, b_mod=l0_b_mod, w_in=l0_w_in, s5_lam_re=l0_s5_lam_re, s5_lam_im=l0_s5_lam_im,
             s5_log_dt=l0_s5_log_dt, s5_b_re=l0_s5_b_re, s5_b_im=l0_s5_b_im, s5_c_re=l0_s5_c_re,
             s5_c_im=l0_s5_c_im, s5_d=l0_s5_d, w_glu=l0_w_glu, b_glu=l0_b_glu, rwkv_shift=l0_rwkv_shift,
             rwkv_w0=l0_rwkv_w0, rwkv_w2=l0_rwkv_w2, rwkv_a0=l0_rwkv_a0, rwkv_a2=l0_rwkv_a2,
             rwkv_g2=l0_rwkv_g2, rwkv_k_k=l0_rwkv_k_k, rwkv_k_a=l0_rwkv_k_a, rwkv_r_k=l0_rwkv_r_k,
             rwkv_gn_w=l0_rwkv_gn_w, rwkv_gn_b=l0_rwkv_gn_b, w_out=l0_w_out, ln1_g=l0_ln1_g, ln1_b=l0_ln1_b,
             peer_wq=l0_peer_wq, peer_keys=l0_peer_keys, peer_u=l0_peer_u, peer_v=l0_peer_v,
             ln2_g=l0_ln2_g, ln2_b=l0_ln2_b),
        dict(w_mod=l1_w_mod, b_mod=l1_b_mod, w_in=l1_w_in, sink=l1_sink, rpb=l1_rpb, w_out=l1_w_out,
             ln1_g=l1_ln1_g, ln1_b=l1_ln1_b, peer_wq=l1_peer_wq, peer_keys=l1_peer_keys, peer_u=l1_peer_u,
             peer_v=l1_peer_v, ln2_g=l1_ln2_g, ln2_b=l1_ln2_b),
    )
    for i in range(DEPTH):
        p = layers[i]
        last = i == DEPTH - 1
        sx1, cx1, gx1, sx2, cx2, gx2 = _modulation(c, p['w_mod'], p['b_mod'])
        sc1, cc1, gc1, sc2, cc2, gc2 = _modulation(c_ctx[None, :], p['w_mod'], p['b_mod'])
        hx = _modulate(x, sx1, cx1)
        hc = _modulate(ctx, sc1, cc1)
        if i % 2 == 0:
            yx, yc = _mixer_a_b(hx, hc, p, not last)
        else:
            yx, yc = _mixer_c_d(hx, hc, p, row, col, not last)
        x = _layer_norm(ALPHA * x + gx1 * yx, p['ln1_g'], p['ln1_b'])
        x = _layer_norm(ALPHA * x + gx2 * _peer(_modulate(x, sx2, cx2), p['peer_wq'], p['peer_keys'],
                                                p['peer_u'], p['peer_v']), p['ln2_g'], p['ln2_b'])
        if not last:
            ctx = _layer_norm(ALPHA * ctx + gc1 * yc, p['ln1_g'], p['ln1_b'])
            ctx = _layer_norm(ALPHA * ctx + gc2 * _peer(_modulate(ctx, sc2, cc2), p['peer_wq'], p['peer_keys'],
                                                        p['peer_u'], p['peer_v']), p['ln2_g'], p['ln2_b'])
    return x
```

```cpp
#include <hip/hip_runtime.h>
#include <hip/hip_cooperative_groups.h>
#include <stdint.h>
#include <stdio.h>

#define DM      1024
#define NB      4
#define TT      8192
#define LC      256
#define SS      8448
#define NTOK    33792
#define ZW0     2176
#define ZW1     2304
#define ALPHA_F 1.41421356237f
#define NCH     132

typedef unsigned short bf16_t;
using bf16x8 = __attribute__((ext_vector_type(8))) short;
using f32x16 = __attribute__((ext_vector_type(16))) float;
using f32x4  = __attribute__((ext_vector_type(4))) float;
using bf16x2v = __attribute__((ext_vector_type(2))) __bf16;

__device__ __forceinline__ bf16_t f2bf(float f) {
    unsigned u = __float_as_uint(f);
    u += 0x7fffu + ((u >> 16) & 1u);
    return (bf16_t)(u >> 16);
}
__device__ __forceinline__ float bf2f(bf16_t h) { return __uint_as_float(((unsigned)h) << 16); }
__device__ __forceinline__ unsigned pack2(float lo, float hi) { return (unsigned)f2bf(lo) | ((unsigned)f2bf(hi) << 16); }
__device__ __forceinline__ float bflo(unsigned u) { return __uint_as_float(u << 16); }
__device__ __forceinline__ float bfhi(unsigned u) { return __uint_as_float(u & 0xffff0000u); }
__device__ __forceinline__ float sigmoidf_(float x) { return 1.f / (1.f + __expf(-x)); }
__device__ __forceinline__ float siluf_(float x) { return x / (1.f + __expf(-x)); }
__device__ __forceinline__ float geluf_(float x) { return 0.5f * x * (1.f + erff(x * 0.70710678118654752f)); }

template <int CTRL> __device__ __forceinline__ float dppf(float x) {
    return __builtin_bit_cast(float, __builtin_amdgcn_mov_dpp(__builtin_bit_cast(int, x), CTRL, 0xf, 0xf, true));
}
#define DPP_XOR1 0xB1
#define DPP_XOR2 0x4E
#define DPP_ROR4 0x124
#define DPP_ROR8 0x128
__device__ __forceinline__ float row16_sum(float x) {
    x += dppf<DPP_XOR1>(x); x += dppf<DPP_XOR2>(x); x += dppf<DPP_ROR4>(x); x += dppf<DPP_ROR8>(x); return x;
}
__device__ __forceinline__ float row16_max(float x) {
    x = fmaxf(x, dppf<DPP_XOR1>(x)); x = fmaxf(x, dppf<DPP_XOR2>(x)); x = fmaxf(x, dppf<DPP_ROR4>(x)); x = fmaxf(x, dppf<DPP_ROR8>(x)); return x;
}
__device__ __forceinline__ float xrow_sum(float x) {
    auto s = __builtin_amdgcn_permlane16_swap(__float_as_uint(x), __float_as_uint(x), false, false);
    x = __uint_as_float(s[0]) + __uint_as_float(s[1]);
    auto t = __builtin_amdgcn_permlane32_swap(__float_as_uint(x), __float_as_uint(x), false, false);
    return __uint_as_float(t[0]) + __uint_as_float(t[1]);
}
__device__ __forceinline__ float xrow_max(float x) {
    auto s = __builtin_amdgcn_permlane16_swap(__float_as_uint(x), __float_as_uint(x), false, false);
    x = fmaxf(__uint_as_float(s[0]), __uint_as_float(s[1]));
    auto t = __builtin_amdgcn_permlane32_swap(__float_as_uint(x), __float_as_uint(x), false, false);
    return fmaxf(__uint_as_float(t[0]), __uint_as_float(t[1]));
}
__device__ __forceinline__ float wave_sum(float x) { return xrow_sum(row16_sum(x)); }
__device__ __forceinline__ float wave_max(float x) { return xrow_max(row16_max(x)); }
__device__ __forceinline__ float half_swap_sum(float x) {
    auto t = __builtin_amdgcn_permlane32_swap(__float_as_uint(x), __float_as_uint(x), false, false);
    return __uint_as_float(t[0]) + __uint_as_float(t[1]);
}
__device__ __forceinline__ float half_swap_max(float x) {
    auto t = __builtin_amdgcn_permlane32_swap(__float_as_uint(x), __float_as_uint(x), false, false);
    return fmaxf(__uint_as_float(t[0]), __uint_as_float(t[1]));
}

constexpr size_t al256(size_t x) { return (x + 255) & ~(size_t)255; }
constexpr size_t WS_WIN0T  = 0;
constexpr size_t WS_WOUT0T = WS_WIN0T  + al256((size_t)ZW0 * 1024 * 2);
constexpr size_t WS_WQ0T   = WS_WOUT0T + al256((size_t)1024 * 768 * 2);
constexpr size_t WS_KEYS0  = WS_WQ0T   + al256((size_t)1024 * 1024 * 2);
constexpr size_t WS_WIN1T  = WS_KEYS0  + al256((size_t)2048 * 64 * 2);
constexpr size_t WS_WOUT1T = WS_WIN1T  + al256((size_t)ZW1 * 1024 * 2);
constexpr size_t WS_WQ1T   = WS_WOUT1T + al256((size_t)1024 * 1024 * 2);
constexpr size_t WS_KEYS1  = WS_WQ1T   + al256((size_t)1024 * 1024 * 2);
constexpr size_t WS_WGLUT  = WS_KEYS1  + al256((size_t)2048 * 64 * 2);
constexpr size_t WS_W2T    = WS_WGLUT  + al256((size_t)256 * 256 * 2);
constexpr size_t WS_A2T    = WS_W2T    + al256((size_t)2 * 512 * 64 * 2);
constexpr size_t WS_G2T    = WS_A2T    + al256((size_t)2 * 512 * 64 * 2);
constexpr size_t WS_S5POW  = WS_G2T    + al256((size_t)512 * 128 * 2);
constexpr size_t WS_S5K    = WS_S5POW  + al256((size_t)2 * 16 * 64 * 65 * 2 * 4);
constexpr size_t WS_S5W    = WS_S5K    + al256((size_t)2 * 16 * 64 * 256 * 2);
constexpr size_t WS_S5V    = WS_S5W    + al256((size_t)2 * 16 * 128 * 1024 * 2);
constexpr size_t WS_MODP   = WS_S5V    + al256((size_t)2 * 16 * 1024 * 128 * 2);
constexpr size_t WS_MOD    = WS_MODP   + al256((size_t)8 * 2 * 5 * 6144 * 4);
constexpr size_t WS_TABU0  = WS_MOD    + al256((size_t)2 * 5 * 6144 * 4);
constexpr size_t WS_TABV0  = WS_TABU0  + (size_t)16384 * 1024 * 2;
constexpr size_t WS_TABU1  = WS_TABV0  + (size_t)16384 * 1024 * 2;
constexpr size_t WS_TABV1  = WS_TABU1  + (size_t)16384 * 1024 * 2;
constexpr size_t WS_ZX     = WS_TABV1  + (size_t)16384 * 1024 * 2;
constexpr size_t WS_CTX    = WS_ZX     + al256((size_t)NTOK * ZW1 * 2);
constexpr size_t WS_US5    = WS_CTX    + al256((size_t)1024 * 1024 * 4);
constexpr size_t WS_S5E    = WS_US5    + al256((size_t)16 * NTOK * 16 * 2);
constexpr size_t WS_S5H    = WS_S5E    + al256((size_t)2 * 16 * 528 * 128 * 4);
constexpr size_t WS_YA     = WS_S5H    + al256((size_t)2 * 16 * 528 * 128 * 2);
constexpr size_t WS_YB     = WS_YA     + al256((size_t)NTOK * 256 * 2);
constexpr size_t WS_BON    = WS_YB     + al256((size_t)2 * NTOK * 512 * 2);
constexpr size_t WS_MIX    = WS_BON    + al256((size_t)NTOK * 16 * 4);
constexpr size_t WS_END    = WS_MIX    + al256((size_t)NTOK * 1024 * 2);
constexpr size_t WS_VT     = WS_YB;
static_assert((size_t)4 * 10 * 64 * SS * 2 <= (size_t)2 * NTOK * 512 * 2, "VT overlay");
constexpr size_t WS_IDX    = WS_MIX;
constexpr size_t WS_GATE   = WS_MIX + (size_t)NTOK * 128 * 4;
static_assert(WS_GATE + (size_t)NTOK * 128 * 4 <= WS_END, "idx/gate overlay");
static_assert(WS_END <= (size_t)536870912, "workspace budget");

struct P {
    const float* in[51];
    float* out;
    unsigned char* ws;
};
enum {
    I_X = 0, I_C, I_CTX, I_CCTX,
    I0_WMOD, I0_BMOD, I0_WIN, I0_LAMRE, I0_LAMIM, I0_LOGDT, I0_BRE, I0_BIM, I0_CRE, I0_CIM, I0_S5D, I0_WGLU, I0_BGLU,
    I0_SHIFT, I0_W0, I0_W2, I0_A0, I0_A2, I0_G2, I0_KK, I0_KA, I0_RK, I0_GNW, I0_GNB, I0_WOUT, I0_LN1G, I0_LN1B,
    I0_WQ, I0_KEYS, I0_U, I0_V, I0_LN2G, I0_LN2B,
    I1_WMOD, I1_BMOD, I1_WIN, I1_SINK, I1_RPB, I1_WOUT, I1_LN1G, I1_LN1B, I1_WQ, I1_KEYS, I1_U, I1_V, I1_LN2G, I1_LN2B
};
static_assert(I1_LN2B == 50, "51 inputs");

#define WSP(T, off) ((T*)(p.ws + (off)))

__device__ void transpose_cvt_tile(const float* __restrict__ W, int K, int N, bf16_t* __restrict__ Wt, int tile, float* sm) {
    const int tn = N / 64;
    const int k0 = (tile / tn) * 64, n0 = (tile % tn) * 64;
    const int tid = threadIdx.x;
    for (int e = tid; e < 4096; e += 256) { int r = e >> 6, c = e & 63; sm[r * 65 + c] = W[(size_t)(k0 + r) * N + n0 + c]; }
    __syncthreads();
    for (int e = tid; e < 4096; e += 256) { int r = e >> 6, c = e & 63; Wt[(size_t)(n0 + r) * K + k0 + c] = f2bf(sm[c * 65 + r]); }
    __syncthreads();
}

struct TrDesc { int in_idx; size_t in_off; int K, N; size_t out_off; };
#define N_TR 12
__device__ __forceinline__ TrDesc tr_desc(int i) {
    switch (i) {
        case 0:  return {I0_WIN, 0, 1024, ZW0, WS_WIN0T};
        case 1:  return {I0_WOUT, 0, 768, 1024, WS_WOUT0T};
        case 2:  return {I0_WQ, 0, 1024, 1024, WS_WQ0T};
        case 3:  return {I1_WIN, 0, 1024, ZW1, WS_WIN1T};
        case 4:  return {I1_WOUT, 0, 1024, 1024, WS_WOUT1T};
        case 5:  return {I1_WQ, 0, 1024, 1024, WS_WQ1T};
        case 6:  return {I0_WGLU, 0, 256, 256, WS_WGLUT};
        case 7:  return {I0_W2, 0, 64, 512, WS_W2T};
        case 8:  return {I0_W2, (size_t)64 * 512, 64, 512, WS_W2T + (size_t)512 * 64 * 2};
        case 9:  return {I0_A2, 0, 64, 512, WS_A2T};
        case 10: return {I0_A2, (size_t)64 * 512, 64, 512, WS_A2T + (size_t)512 * 64 * 2};
        default: return {I0_G2, 0, 128, 512, WS_G2T};
    }
}
__device__ int tr_total_tiles() { int t = 0; for (int i = 0; i < N_TR; ++i) { TrDesc d = tr_desc(i); t += (d.K / 64) * (d.N / 64); } return t; }

__device__ void phase_transpose(const P& p, float* sm, int bid, int nblk) {
    const int total = tr_total_tiles();
    for (int t = bid; t < total; t += nblk) {
        int rem = t, i = 0;
        for (; i < N_TR; ++i) { TrDesc d = tr_desc(i); int n = (d.K / 64) * (d.N / 64); if (rem < n) break; rem -= n; }
        TrDesc d = tr_desc(i);
        transpose_cvt_tile(p.in[d.in_idx] + d.in_off, d.K, d.N, (bf16_t*)(p.ws + d.out_off), rem, sm);
    }
}

__device__ void cvt_range(const float* __restrict__ src, bf16_t* __restrict__ dst, size_t n, size_t gtid, size_t gthreads) {
    const size_t n8 = n / 8;
    for (size_t i = gtid; i < n8; i += gthreads) {
        float4 a = ((const float4*)src)[2 * i], b = ((const float4*)src)[2 * i + 1];
        uint4 o; o.x = pack2(a.x, a.y); o.y = pack2(a.z, a.w); o.z = pack2(b.x, b.y); o.w = pack2(b.z, b.w);
        ((uint4*)dst)[i] = o;
    }
}
__device__ void phase_convert(const P& p, size_t gtid, size_t gthreads) {
    cvt_range(p.in[I0_KEYS], WSP(bf16_t, WS_KEYS0), (size_t)2048 * 64, gtid, gthreads);
    cvt_range(p.in[I1_KEYS], WSP(bf16_t, WS_KEYS1), (size_t)2048 * 64, gtid, gthreads);
    cvt_range(p.in[I0_U], WSP(bf16_t, WS_TABU0), (size_t)16384 * 1024, gtid, gthreads);
    cvt_range(p.in[I0_V], WSP(bf16_t, WS_TABV0), (size_t)16384 * 1024, gtid, gthreads);
    cvt_range(p.in[I1_U], WSP(bf16_t, WS_TABU1), (size_t)16384 * 1024, gtid, gthreads);
    cvt_range(p.in[I1_V], WSP(bf16_t, WS_TABV1), (size_t)16384 * 1024, gtid, gthreads);
}

__device__ void phase_mod_partial(const P& p, int gwave, int nwaves) {
    const int lane = threadIdx.x & 63;
    for (int it = gwave; it < 2 * 96 * 8; it += nwaves) {
        const int kc = it & 7, ct = (it >> 3) % 96, l = it / (8 * 96);
        const float* wm = p.in[l ? I1_WMOD : I0_WMOD];
        const int col = ct * 64 + lane;
        float acc[5] = {0.f, 0.f, 0.f, 0.f, 0.f};
        for (int i = kc * 128; i < kc * 128 + 128; ++i) {
            const float w = wm[(size_t)i * 6144 + col];
#pragma unroll
            for (int n = 0; n < 4; ++n) acc[n] += siluf_(p.in[I_C][n * 1024 + i]) * w;
            acc[4] += siluf_(p.in[I_CCTX][i]) * w;
        }
        float* mp = WSP(float, WS_MODP);
#pragma unroll
        for (int n = 0; n < 5; ++n) mp[(((size_t)kc * 2 + l) * 5 + n) * 6144 + col] = acc[n];
    }
}
__device__ void phase_mod_reduce(const P& p, size_t gtid, size_t gthreads) {
    const float* mp = WSP(float, WS_MODP);
    float* mo = WSP(float, WS_MOD);
    for (size_t i = gtid; i < (size_t)2 * 5 * 6144; i += gthreads) {
        const int l = (int)(i / (5 * 6144)), col = (int)(i % 6144);
        float s = p.in[l ? I1_BMOD : I0_BMOD][col];
        for (int kc = 0; kc < 8; ++kc) s += mp[(size_t)kc * 2 * 5 * 6144 + i];
        mo[i] = s;
    }
}

__device__ void phase_s5_pow(const P& p, size_t gtid, size_t gthreads) {
    float* pw = WSP(float, WS_S5POW);
    for (size_t i = gtid; i < 2048; i += gthreads) {
        const int dg = (int)(i >> 6);
        const float lr = p.in[I0_LAMRE][i], li = p.in[I0_LAMIM][i];
        const float dt = expf(p.in[I0_LOGDT][dg]);
        const float mag = expf(lr * dt);
        const float ar = mag * cosf(li * dt), ai = mag * sinf(li * dt);
        float cr = 1.f, ci = 0.f;
        for (int j = 0; j <= 64; ++j) {
            pw[(i * 65 + j) * 2] = cr; pw[(i * 65 + j) * 2 + 1] = ci;
            const float nr = cr * ar - ci * ai, ni = cr * ai + ci * ar; cr = nr; ci = ni;
        }
    }
}
__device__ __forceinline__ void s5_bbar(const P& p, int dgp, int i, float& br, float& bi) {
    const float lr = p.in[I0_LAMRE][dgp], li = p.in[I0_LAMIM][dgp];
    const float* pw = WSP(float, WS_S5POW) + ((size_t)dgp * 65 + 1) * 2;
    const float ar = pw[0], ai = pw[1];
    const float den = lr * lr + li * li, nr = ar - 1.f;
    const float cr = (nr * lr + ai * li) / den, ci = (ai * lr - nr * li) / den;
    const float xr = p.in[I0_BRE][(size_t)dgp * 16 + i], xi = p.in[I0_BIM][(size_t)dgp * 16 + i];
    br = cr * xr - ci * xi; bi = cr * xi + ci * xr;
}
__device__ void phase_s5_tables(const P& p, size_t gtid, size_t gthreads) {
    const float* pw = WSP(float, WS_S5POW);
    bf16_t* Kt = WSP(bf16_t, WS_S5K);
    bf16_t* Wt = WSP(bf16_t, WS_S5W);
    bf16_t* Vt = WSP(bf16_t, WS_S5V);
    for (size_t e = gtid; e < (size_t)32 * 64 * 256; e += gthreads) {
        const int ip = (int)(e & 15), i = (int)((e >> 4) & 15), lag = (int)((e >> 8) & 63), dg = (int)(e >> 14);
        float acc = 0.f;
        for (int pp = 0; pp < 64; ++pp) {
            const int dgp = dg * 64 + pp;
            float br, bi; s5_bbar(p, dgp, ip, br, bi);
            const float pr = pw[((size_t)dgp * 65 + lag) * 2], pi = pw[((size_t)dgp * 65 + lag) * 2 + 1];
            const float cr = p.in[I0_CRE][((size_t)dg * 16 + i) * 64 + pp], ci = p.in[I0_CIM][((size_t)dg * 16 + i) * 64 + pp];
            const float tr = pr * br - pi * bi, ti = pr * bi + pi * br;
            acc += cr * tr - ci * ti;
        }
        if (lag == 0 && i == ip && dg < 16) acc += p.in[I0_S5D][(dg & 15) * 16 + i];
        Kt[e] = f2bf(acc);
    }
    for (size_t e = gtid; e < (size_t)32 * 128 * 1024; e += gthreads) {
        const int k = (int)(e & 1023), n = (int)((e >> 10) & 127), dg = (int)(e >> 17);
        const int ip = k & 15, s = k >> 4, pp = n >> 1, ri = n & 1, d = dg >> 4;
        const int dgp = dg * 64 + pp;
        float br, bi; s5_bbar(p, dgp, ip, br, bi);
        const int ex = d ? s : 63 - s;
        const float pr = pw[((size_t)dgp * 65 + ex) * 2], pi = pw[((size_t)dgp * 65 + ex) * 2 + 1];
        const float tr = pr * br - pi * bi, ti = pr * bi + pi * br;
        Wt[e] = f2bf(ri ? ti : tr);
    }
    for (size_t e = gtid; e < (size_t)32 * 1024 * 128; e += gthreads) {
        const int k = (int)(e & 127), n = (int)((e >> 7) & 1023), dg = (int)(e >> 17);
        const int pp = k >> 1, ri = k & 1, i = n & 15, t = n >> 4, d = dg >> 4;
        const int dgp = dg * 64 + pp;
        const int ex = d ? 64 - t : t + 1;
        const float pr = pw[((size_t)dgp * 65 + ex) * 2], pi = pw[((size_t)dgp * 65 + ex) * 2 + 1];
        const float cr = p.in[I0_CRE][((size_t)dg * 16 + i) * 64 + pp], ci = p.in[I0_CIM][((size_t)dg * 16 + i) * 64 + pp];
        Vt[e] = f2bf(ri ? -(cr * pi + ci * pr) : (cr * pr - ci * pi));
    }
}

#define GM_LD 72
#define CS_LD 132
#define GEMM_SMEM_BYTES (2 * 128 * GM_LD * 2)
static_assert(64 * CS_LD * 4 <= GEMM_SMEM_BYTES, "C staging fits");

template <class AL, class BL, class Epi>
__device__ void gemm_tile(const AL& al, const BL& bl, int K, int m0, int n0, Epi& epi, unsigned char* smem) {
    bf16_t* As = (bf16_t*)smem;
    bf16_t* Bs = As + 128 * GM_LD;
    const int tid = threadIdx.x, lane = tid & 63, wave = tid >> 6;
    const int wm = wave >> 1, wn = wave & 1;
    const int lrow = tid >> 3, kc = (tid & 7) * 8;
    typename AL::RowCtx arow[4];
    typename BL::RowCtx brow[4];
#pragma unroll
    for (int i = 0; i < 4; ++i) { arow[i] = al.row(m0 + lrow + 32 * i); brow[i] = bl.row(n0 + lrow + 32 * i); }
    f32x16 acc[2][2];
#pragma unroll
    for (int i = 0; i < 2; ++i)
#pragma unroll
        for (int j = 0; j < 2; ++j)
#pragma unroll
            for (int r = 0; r < 16; ++r) acc[i][j][r] = 0.f;
    uint4 ra[4], rb[4];
#pragma unroll
    for (int i = 0; i < 4; ++i) { ra[i] = al.load8(arow[i], kc); rb[i] = bl.load8(brow[i], kc); }
    for (int k0 = 0; k0 < K; k0 += 64) {
        __syncthreads();
#pragma unroll
        for (int i = 0; i < 4; ++i) {
            *(uint4*)&As[(lrow + 32 * i) * GM_LD + kc] = ra[i];
            *(uint4*)&Bs[(lrow + 32 * i) * GM_LD + kc] = rb[i];
        }
        __syncthreads();
        if (k0 + 64 < K) {
#pragma unroll
            for (int i = 0; i < 4; ++i) { ra[i] = al.load8(arow[i], k0 + 64 + kc); rb[i] = bl.load8(brow[i], k0 + 64 + kc); }
        }
#pragma unroll
        for (int kk = 0; kk < 4; ++kk) {
            bf16x8 a[2], b[2];
#pragma unroll
            for (int i = 0; i < 2; ++i) a[i] = *(const bf16x8*)&As[(wm * 64 + i * 32 + (lane & 31)) * GM_LD + kk * 16 + 8 * (lane >> 5)];
#pragma unroll
            for (int j = 0; j < 2; ++j) b[j] = *(const bf16x8*)&Bs[(wn * 64 + j * 32 + (lane & 31)) * GM_LD + kk * 16 + 8 * (lane >> 5)];
#pragma unroll
            for (int i = 0; i < 2; ++i)
#pragma unroll
                for (int j = 0; j < 2; ++j) acc[i][j] = __builtin_amdgcn_mfma_f32_32x32x16_bf16(a[i], b[j], acc[i][j], 0, 0, 0);
        }
    }
    float* Cs = (float*)smem;
#pragma unroll
    for (int pass = 0; pass < 2; ++pass) {
        __syncthreads();
        if (wm == pass) {
#pragma unroll
            for (int i = 0; i < 2; ++i)
#pragma unroll
                for (int j = 0; j < 2; ++j)
#pragma unroll
                    for (int r = 0; r < 16; ++r) {
                        const int row = i * 32 + (r & 3) + 8 * (r >> 2) + 4 * (lane >> 5);
                        const int col = wn * 64 + j * 32 + (lane & 31);
                        Cs[row * CS_LD + col] = acc[i][j][r];
                    }
        }
        __syncthreads();
        epi(Cs, pass, tid);
    }
    __syncthreads();
}

struct LdBf16 {
    const bf16_t* base; int ld;
    typedef const bf16_t* RowCtx;
    __device__ RowCtx row(int r) const { return base + (size_t)r * ld; }
    __device__ uint4 load8(RowCtx rc, int k) const { return *(const uint4*)(rc + k); }
};
struct LdXMod {
    const float* xlat; const float* xctx; const float* mod; int shift_off, scale_off;
    struct RowCtx { const float* src; const float* m; };
    __device__ RowCtx row(int R) const {
        const int b = R / SS, s = R - b * SS;
        RowCtx rc;
        if (s < LC) { rc.src = xctx + ((size_t)(b * LC + s)) * DM; rc.m = mod + 4 * 6144; }
        else        { rc.src = xlat + ((size_t)(b * TT + s - LC)) * DM; rc.m = mod + b * 6144; }
        return rc;
    }
    __device__ uint4 load8(const RowCtx& rc, int k) const {
        const float4 x0 = *(const float4*)(rc.src + k), x1 = *(const float4*)(rc.src + k + 4);
        const float4 c0 = *(const float4*)(rc.m + scale_off + k), c1 = *(const float4*)(rc.m + scale_off + k + 4);
        const float4 h0 = *(const float4*)(rc.m + shift_off + k), h1 = *(const float4*)(rc.m + shift_off + k + 4);
        uint4 o;
        o.x = pack2(x0.x * (1.f + c0.x) + h0.x, x0.y * (1.f + c0.y) + h0.y);
        o.y = pack2(x0.z * (1.f + c0.z) + h0.z, x0.w * (1.f + c0.w) + h0.w);
        o.z = pack2(x1.x * (1.f + c1.x) + h1.x, x1.y * (1.f + c1.y) + h1.y);
        o.w = pack2(x1.z * (1.f + c1.z) + h1.z, x1.w * (1.f + c1.w) + h1.w);
        return o;
    }
};

struct EpiStoreBf16 {
    bf16_t* out; int ld; int m0, n0; int mmax;
    __device__ void operator()(const float* Cs, int pass, int tid) const {
#pragma unroll
        for (int i = 0; i < 4; ++i) {
            const int c = tid + 256 * i, row = c >> 4, col8 = (c & 15) * 8;
            const int R = m0 + pass * 64 + row;
            if (R >= mmax) continue;
            const float4 a = *(const float4*)&Cs[row * CS_LD + col8], b = *(const float4*)&Cs[row * CS_LD + col8 + 4];
            uint4 o; o.x = pack2(a.x, a.y); o.y = pack2(a.z, a.w); o.z = pack2(b.x, b.y); o.w = pack2(b.z, b.w);
            *(uint4*)&out[(size_t)R * ld + n0 + col8] = o;
        }
    }
};
struct EpiStoreF32 {
    float* out; int ld; int m0, n0; int mmax;
    __device__ void operator()(const float* Cs, int pass, int tid) const {
#pragma unroll
        for (int i = 0; i < 8; ++i) {
            const int c = tid + 256 * i, row = c >> 5, col4 = (c & 31) * 4;
            const int R = m0 + pass * 64 + row;
            if (R >= mmax) continue;
            *(float4*)&out[(size_t)R * ld + n0 + col4] = *(const float4*)&Cs[row * CS_LD + col4];
        }
    }
};

struct EpiZX0 {
    bf16_t* zx; bf16_t* us5; int m0, n0;
    __device__ void operator()(const float* Cs, int pass, int tid) const {
#pragma unroll
        for (int i = 0; i < 4; ++i) {
            const int c = tid + 256 * i, row = c >> 4, col8 = (c & 15) * 8;
            const int R = m0 + pass * 64 + row, col = n0 + col8;
            const float4 a = *(const float4*)&Cs[row * CS_LD + col8], b = *(const float4*)&Cs[row * CS_LD + col8 + 4];
            uint4 o; o.x = pack2(a.x, a.y); o.y = pack2(a.z, a.w); o.z = pack2(b.x, b.y); o.w = pack2(b.z, b.w);
            if (col < 256) *(uint4*)&us5[((size_t)(col >> 4) * NTOK + R) * 16 + (col & 8)] = o;
            else           *(uint4*)&zx[(size_t)R * ZW0 + col] = o;
        }
    }
};
__device__ void phase_gemm_win0(const P& p, unsigned char* smem, int bid, int nblk) {
    LdXMod al{p.in[I_X], p.in[I_CTX], WSP(float, WS_MOD), 0, 1024};
    LdBf16 bl{WSP(bf16_t, WS_WIN0T), 1024};
    const int ntn = ZW0 / 128, total = (NTOK / 128) * ntn;
    for (int t = bid; t < total; t += nblk) {
        const int m0 = (t / ntn) * 128, n0 = (t % ntn) * 128;
        EpiZX0 epi{WSP(bf16_t, WS_ZX), WSP(bf16_t, WS_US5), m0, n0};
        gemm_tile(al, bl, 1024, m0, n0, epi, smem);
    }
}

struct LdBf16Clamp {
    const bf16_t* base; int ld; int rmax;
    typedef const bf16_t* RowCtx;
    __device__ RowCtx row(int r) const { return base + (size_t)(r < rmax ? r : rmax) * ld; }
    __device__ uint4 load8(RowCtx rc, int k) const { return *(const uint4*)(rc + k); }
};
__device__ void phase_s5_E(const P& p, unsigned char* smem, int bid, int nblk) {
    for (int t = bid; t < 32 * 5; t += nblk) {
        const int dg = t / 5, mt = t % 5, g = dg & 15;
        LdBf16Clamp al{WSP(bf16_t, WS_US5) + (size_t)g * NTOK * 16, 1024, 527};
        LdBf16 bl{WSP(bf16_t, WS_S5W) + (size_t)dg * 128 * 1024, 1024};
        EpiStoreF32 epi{WSP(float, WS_S5E) + (size_t)dg * 528 * 128, 128, mt * 128, 0, 528};
        gemm_tile(al, bl, 1024, mt * 128, 0, epi, smem);
    }
}
__device__ void phase_s5_carry(const P& p, size_t gtid, size_t gthreads) {
    const float* pw = WSP(float, WS_S5POW);
    const float* E = WSP(float, WS_S5E);
    bf16_t* H = WSP(bf16_t, WS_S5H);
    for (size_t i = gtid; i < 8192; i += gthreads) {
        const int pp = (int)(i & 63), b = (int)((i >> 6) & 3), dg = (int)(i >> 8), d = dg >> 4;
        const float ar = pw[((size_t)(dg * 64 + pp) * 65 + 64) * 2], ai = pw[((size_t)(dg * 64 + pp) * 65 + 64) * 2 + 1];
        float hr = 0.f, hi = 0.f;
        for (int cc = 0; cc < NCH; ++cc) {
            const int c = d ? (cc < 4 ? 3 - cc : 131 - (cc - 4)) : cc;
            const size_t o = ((size_t)dg * 528 + b * NCH + c) * 128 + pp * 2;
            H[o] = f2bf(hr); H[o + 1] = f2bf(hi);
            const float er = E[o], ei = E[o + 1];
            const float nr = ar * hr - ai * hi + er, ni = ar * hi + ai * hr + ei;
            hr = nr; hi = ni;
        }
    }
}
struct LdS5YA {
    const bf16_t* u; const bf16_t* h0; const bf16_t* h1;
    struct RowCtx { const bf16_t* u; const bf16_t* h0; const bf16_t* h1; };
    __device__ RowCtx row(int r) const { if (r > 527) r = 527; return {u + (size_t)r * 1024, h0 + (size_t)r * 128, h1 + (size_t)r * 128}; }
    __device__ uint4 load8(const RowCtx& rc, int k) const {
        if (k < 1024) return *(const uint4*)(rc.u + k);
        if (k < 1152) return *(const uint4*)(rc.h0 + (k - 1024));
        if (k < 2176) return *(const uint4*)(rc.u + (k - 1152));
        return *(const uint4*)(rc.h1 + (k - 2176));
    }
};
struct LdS5YB {
    const bf16_t* k0; const bf16_t* k1; const bf16_t* v0; const bf16_t* v1;
    struct RowCtx { int t, i; const bf16_t* v0; const bf16_t* v1; };
    __device__ RowCtx row(int n) const { return {n >> 4, n & 15, v0 + (size_t)n * 128, v1 + (size_t)n * 128}; }
    __device__ uint4 load8(const RowCtx& rc, int k) const {
        if (k < 1024) { const int s = k >> 4, lag = rc.t - s; if (lag < 0) return make_uint4(0, 0, 0, 0); return *(const uint4*)(k0 + (lag * 16 + rc.i) * 16 + (k & 8)); }
        if (k < 1152) return *(const uint4*)(rc.v0 + (k - 1024));
        if (k < 2176) { const int kk = k - 1152, s = kk >> 4, lag = s - rc.t; if (lag < 0) return make_uint4(0, 0, 0, 0); return *(const uint4*)(k1 + (lag * 16 + rc.i) * 16 + (kk & 8)); }
        return *(const uint4*)(rc.v1 + (k - 2176));
    }
};
struct EpiS5Y {
    bf16_t* ya; int g; int m0, n0;
    __device__ void operator()(const float* Cs, int pass, int tid) const {
#pragma unroll
        for (int i = 0; i < 4; ++i) {
            const int c = tid + 256 * i, row = c >> 4, col8 = (c & 15) * 8;
            const int r = m0 + pass * 64 + row;
            if (r > 527) continue;
            const int n = n0 + col8, t = n >> 4;
            const float4 a = *(const float4*)&Cs[row * CS_LD + col8], b = *(const float4*)&Cs[row * CS_LD + col8 + 4];
            uint4 o;
            o.x = pack2(geluf_(a.x), geluf_(a.y)); o.y = pack2(geluf_(a.z), geluf_(a.w));
            o.z = pack2(geluf_(b.x), geluf_(b.y)); o.w = pack2(geluf_(b.z), geluf_(b.w));
            *(uint4*)&ya[((size_t)r * 64 + t) * 256 + g * 16 + (n & 8)] = o;
        }
    }
};
__device__ void phase_s5_Y(const P& p, unsigned char* smem, int bid, int nblk) {
    for (int t = bid; t < 16 * 5 * 8; t += nblk) {
        const int g = t / 40, mt = (t % 40) / 8, nt = t % 8;
        LdS5YA al{WSP(bf16_t, WS_US5) + (size_t)g * NTOK * 16, WSP(bf16_t, WS_S5H) + (size_t)g * 528 * 128, WSP(bf16_t, WS_S5H) + (size_t)(16 + g) * 528 * 128};
        LdS5YB bl{WSP(bf16_t, WS_S5K) + (size_t)g * 64 * 256, WSP(bf16_t, WS_S5K) + (size_t)(16 + g) * 64 * 256,
                  WSP(bf16_t, WS_S5V) + (size_t)g * 1024 * 128, WSP(bf16_t, WS_S5V) + (size_t)(16 + g) * 1024 * 128};
        EpiS5Y epi{WSP(bf16_t, WS_YA), g, mt * 128, nt * 128};
        gemm_tile(al, bl, 2304, mt * 128, nt * 128, epi, smem);
    }
}

#define RW_CH 32
struct RwkvSmem {
    bf16_t w2s[64 * GM_LD];
    bf16_t a2s[64 * GM_LD];
    bf16_t raw[5][RW_CH + 2][64];
    bf16_t alo[2][RW_CH * GM_LD];
    float dec[RW_CH][64], aa[RW_CH][64], bb[RW_CH][64], kd[RW_CH][64], rr[RW_CH][64];
    float vv[RW_CH][16];
    float yo[RW_CH][16];
};
__device__ void rwkv_scan_item(const P& p, int item, unsigned char* smem_raw) {
    RwkvSmem& sm = *(RwkvSmem*)smem_raw;
    const int q = item & 3, d = (item >> 2) & 1, h = (item >> 3) & 7, b = item >> 6;
    const int tid = threadIdx.x, lane = tid & 63, wave = tid >> 6;
    const bf16_t* zx = WSP(bf16_t, WS_ZX);
    const float* mu = p.in[I0_SHIFT];
    {
        const bf16_t* w2t = WSP(bf16_t, WS_W2T) + ((size_t)d * 512 + h * 64) * 64;
        const bf16_t* a2t = WSP(bf16_t, WS_A2T) + ((size_t)d * 512 + h * 64) * 64;
        for (int c = tid; c < 512; c += 256) {
            const int n = c >> 3, k8 = (c & 7) * 8;
            *(uint4*)&sm.w2s[n * GM_LD + k8] = *(const uint4*)&w2t[n * 64 + k8];
            *(uint4*)&sm.a2s[n * GM_LD + k8] = *(const uint4*)&a2t[n * 64 + k8];
        }
    }
    const int colr = 256 + h * 64, colk = 768 + h * 64, colv = 1280 + h * 64, colw = 1792 + d * 64, cola = 1920 + d * 64;
    float S0 = 0.f, S1 = 0.f, S2 = 0.f, S3 = 0.f;
    const int kseg = lane & 15, rowl = wave * 4 + (lane >> 4);
    bf16_t* yb = WSP(bf16_t, WS_YB) + (size_t)d * NTOK * 512;
    float* bon = WSP(float, WS_BON);
    for (int cc = 0; cc < SS / RW_CH; ++cc) {
        int s0;
        if (d == 0) s0 = RW_CH * cc;
        else s0 = (cc < LC / RW_CH) ? RW_CH * (LC / RW_CH - 1 - cc) : LC + RW_CH * (TT / RW_CH - 1 - (cc - LC / RW_CH));
        const int seg_lo = (s0 < LC) ? 0 : LC, seg_hi = (s0 < LC) ? LC : SS;
        __syncthreads();
        for (int c = tid; c < 5 * (RW_CH + 2) * 8; c += 256) {
            const int c8 = (c & 7) * 8, rix = (c >> 3) % (RW_CH + 2), sl = c / (8 * (RW_CH + 2));
            const int s = s0 - 1 + rix;
            const int col = (sl == 0 ? colr : sl == 1 ? colk : sl == 2 ? colv : sl == 3 ? colw : cola) + c8;
            uint4 v = make_uint4(0, 0, 0, 0);
            if (s >= seg_lo && s < seg_hi) v = *(const uint4*)&zx[((size_t)b * SS + s) * ZW0 + col];
            *(uint4*)&sm.raw[sl][rix][c8] = v;
        }
        __syncthreads();
        for (int e = tid; e < 5 * RW_CH * 64; e += 256) {
            const int ch = e & 63, j = (e >> 6) % RW_CH, sl = e / (64 * RW_CH);
            const int jj = d ? (RW_CH - 1 - j) : j;
            const float z = bf2f(sm.raw[sl][jj + 1][ch]), zp = bf2f(sm.raw[sl][jj][ch]), zn = bf2f(sm.raw[sl][jj + 2][ch]);
            const int mcol = (sl == 0 ? colr : sl == 1 ? colk : sl == 2 ? colv : sl == 3 ? colw : cola) - 256 + ch;
            const float sh = z + mu[mcol] * (zp - z) + mu[1920 + mcol] * (zn - z);
            if (sl == 0) sm.rr[j][ch] = sh;
            else if (sl == 1) sm.kd[j][ch] = sh;
            else if (sl == 2) { const int cq = ch - q * 16; if (cq >= 0 && cq < 16) sm.vv[j][cq] = sh; }
            else if (sl == 3) sm.alo[0][j * GM_LD + ch] = f2bf(tanhf(sh));
            else sm.alo[1][j * GM_LD + ch] = f2bf(sh);
        }
        __syncthreads();
        {
            const int mat = wave >> 1, ct = wave & 1;
            const bf16_t* Bsm = mat ? sm.a2s : sm.w2s;
            f32x16 acc;
#pragma unroll
            for (int r = 0; r < 16; ++r) acc[r] = 0.f;
#pragma unroll
            for (int kk = 0; kk < 4; ++kk) {
                const bf16x8 a = *(const bf16x8*)&sm.alo[mat][(lane & 31) * GM_LD + kk * 16 + 8 * (lane >> 5)];
                const bf16x8 bq = *(const bf16x8*)&Bsm[(ct * 32 + (lane & 31)) * GM_LD + kk * 16 + 8 * (lane >> 5)];
                acc = __builtin_amdgcn_mfma_f32_32x32x16_bf16(a, bq, acc, 0, 0, 0);
            }
            const int n = ct * 32 + (lane & 31);
            const float bias = mat ? p.in[I0_A0][d * 512 + h * 64 + n] : p.in[I0_W0][d * 512 + h * 64 + n];
#pragma unroll
            for (int r = 0; r < 16; ++r) {
                const int j = (r & 3) + 8 * (r >> 2) + 4 * (lane >> 5);
                const float x = acc[r] + bias;
                if (mat == 0) {
                    const float nx = -x;
                    const float sp = fmaxf(nx, 0.f) + log1pf(__expf(-fabsf(nx)));
                    const float wlog = -sp - 0.5f;
                    sm.dec[j][n] = __expf(-__expf(wlog));
                } else {
                    sm.bb[j][n] = sigmoidf_(x);
                }
            }
        }
        __syncthreads();
        {
            const int j = tid >> 3, c0 = (tid & 7) * 8;
            float kkr[8], ss = 0.f, bsum = 0.f;
#pragma unroll
            for (int u = 0; u < 8; ++u) {
                const int ch = c0 + u, gc = h * 64 + ch;
                const float kt = sm.kd[j][ch];
                kkr[u] = kt * p.in[I0_KK][gc];
                ss += kkr[u] * kkr[u];
                const float a = sm.bb[j][ch];
                const float kdv = kt * (1.f + (a - 1.f) * p.in[I0_KA][gc]);
                sm.kd[j][ch] = kdv;
                bsum += sm.rr[j][ch] * kdv * p.in[I0_RK][gc];
            }
            ss += __shfl_xor(ss, 1); ss += __shfl_xor(ss, 2); ss += __shfl_xor(ss, 4);
            bsum += __shfl_xor(bsum, 1); bsum += __shfl_xor(bsum, 2); bsum += __shfl_xor(bsum, 4);
            const float rn = rsqrtf(ss + 1e-12f);
#pragma unroll
            for (int u = 0; u < 8; ++u) {
                const int ch = c0 + u;
                const float kk = kkr[u] * rn;
                const float a = sm.bb[j][ch];
                sm.aa[j][ch] = -kk;
                sm.bb[j][ch] = kk * a;
            }
            if (q == 0 && (tid & 7) == 0) {
                const int s = d ? (s0 + RW_CH - 1 - j) : (s0 + j);
                bon[((size_t)b * SS + s) * 16 + h * 2 + d] = bsum;
            }
        }
        __syncthreads();
#pragma unroll 4
        for (int j = 0; j < RW_CH; ++j) {
            const float4 w4 = *(const float4*)&sm.dec[j][kseg * 4];
            const float4 a4 = *(const float4*)&sm.aa[j][kseg * 4];
            const float4 b4 = *(const float4*)&sm.bb[j][kseg * 4];
            const float4 k4 = *(const float4*)&sm.kd[j][kseg * 4];
            const float4 r4 = *(const float4*)&sm.rr[j][kseg * 4];
            const float vj = sm.vv[j][rowl];
            float sa = S0 * a4.x + S1 * a4.y + S2 * a4.z + S3 * a4.w;
            sa = row16_sum(sa);
            S0 = S0 * w4.x + sa * b4.x + vj * k4.x;
            S1 = S1 * w4.y + sa * b4.y + vj * k4.y;
            S2 = S2 * w4.z + sa * b4.z + vj * k4.z;
            S3 = S3 * w4.w + sa * b4.w + vj * k4.w;
            float y = S0 * r4.x + S1 * r4.y + S2 * r4.z + S3 * r4.w;
            y = row16_sum(y);
            if (kseg == 0) sm.yo[j][rowl] = y;
        }
        __syncthreads();
        if (tid < RW_CH * 4) {
            const int j = tid >> 2, c4 = (tid & 3) * 4;
            const int s = d ? (s0 + RW_CH - 1 - j) : (s0 + j);
            uint2 o; o.x = pack2(sm.yo[j][c4], sm.yo[j][c4 + 1]); o.y = pack2(sm.yo[j][c4 + 2], sm.yo[j][c4 + 3]);
            *(uint2*)&yb[((size_t)b * SS + s) * 512 + h * 64 + q * 16 + c4] = o;
        }
    }
}

struct EpiGlu {
    const bf16_t* ya; const float* bglu; bf16_t* mix; int m0, n0;
    __device__ void operator()(const float* Cs, int pass, int tid) const {
#pragma unroll
        for (int i = 0; i < 4; ++i) {
            const int c = tid + 256 * i, row = c >> 4, col8 = (c & 15) * 8;
            const int R = m0 + pass * 64 + row, col = n0 + col8;
            const uint4 yv = *(const uint4*)&ya[(size_t)R * 256 + col];
            const unsigned yu[4] = {yv.x, yv.y, yv.z, yv.w};
            unsigned o[4];
#pragma unroll
            for (int u = 0; u < 4; ++u) {
                const float y0 = bflo(yu[u]), y1 = bfhi(yu[u]);
                const float g0 = sigmoidf_(Cs[row * CS_LD + col8 + 2 * u] + bglu[col + 2 * u]);
                const float g1 = sigmoidf_(Cs[row * CS_LD + col8 + 2 * u + 1] + bglu[col + 2 * u + 1]);
                o[u] = pack2(y0 * g0, y1 * g1);
            }
            *(uint4*)&mix[(size_t)R * 768 + col] = make_uint4(o[0], o[1], o[2], o[3]);
        }
    }
};
__device__ void phase_glu(const P& p, unsigned char* smem, int bid, int nblk) {
    LdBf16 al{WSP(bf16_t, WS_YA), 256};
    LdBf16 bl{WSP(bf16_t, WS_WGLUT), 256};
    for (int t = bid; t < (NTOK / 128) * 2; t += nblk) {
        const int m0 = (t >> 1) * 128, n0 = (t & 1) * 128;
        EpiGlu epi{WSP(bf16_t, WS_YA), p.in[I0_BGLU], WSP(bf16_t, WS_MIX), m0, n0};
        gemm_tile(al, bl, 256, m0, n0, epi, smem);
    }
}
__device__ __forceinline__ void zx0_shift8(const bf16_t* zx, const float* mu, int R, int col, float (&o)[8]) {
    const int s = R % SS;
    const bool hp = (s != 0) && (s != LC), hn = (s != LC - 1) && (s != SS - 1);
    const uint4 z = *(const uint4*)&zx[(size_t)R * ZW0 + col];
    uint4 zp = make_uint4(0, 0, 0, 0), zn = make_uint4(0, 0, 0, 0);
    if (hp) zp = *(const uint4*)&zx[(size_t)(R - 1) * ZW0 + col];
    if (hn) zn = *(const uint4*)&zx[(size_t)(R + 1) * ZW0 + col];
    const unsigned zu[4] = {z.x, z.y, z.z, z.w}, pu[4] = {zp.x, zp.y, zp.z, zp.w}, nu[4] = {zn.x, zn.y, zn.z, zn.w};
    const int mc = col - 256;
#pragma unroll
    for (int u = 0; u < 4; ++u) {
        const float a0 = bflo(zu[u]), a1 = bfhi(zu[u]);
        o[2 * u]     = a0 + mu[mc + 2 * u] * (bflo(pu[u]) - a0) + mu[1920 + mc + 2 * u] * (bflo(nu[u]) - a0);
        o[2 * u + 1] = a1 + mu[mc + 2 * u + 1] * (bfhi(pu[u]) - a1) + mu[1920 + mc + 2 * u + 1] * (bfhi(nu[u]) - a1);
    }
}
struct LdGlo {
    const bf16_t* zx; const float* mu;
    typedef int RowCtx;
    __device__ RowCtx row(int R) const { return R; }
    __device__ uint4 load8(RowCtx R, int k) const {
        float v[8]; zx0_shift8(zx, mu, R, 2048 + k, v);
        uint4 o; o.x = pack2(sigmoidf_(v[0]), sigmoidf_(v[1])); o.y = pack2(sigmoidf_(v[2]), sigmoidf_(v[3]));
        o.z = pack2(sigmoidf_(v[4]), sigmoidf_(v[5])); o.w = pack2(sigmoidf_(v[6]), sigmoidf_(v[7]));
        return o;
    }
};
struct EpiRwkvOut {
    const bf16_t* yb0; const bf16_t* yb1; const float* bon; const bf16_t* zx; const float* mu; const float* gnw; const float* gnb; bf16_t* mix; int m0, n0;
    __device__ void operator()(const float* Cs, int pass, int tid) const {
        const int row = tid >> 2, cg = tid & 3;
        const int R = m0 + pass * 64 + row, col0 = n0 + cg * 32, head = col0 >> 6;
        float y[32], sum = 0.f, sq = 0.f;
#pragma unroll
        for (int c8 = 0; c8 < 4; ++c8) {
            const uint4 a = *(const uint4*)&yb0[(size_t)R * 512 + col0 + c8 * 8], b = *(const uint4*)&yb1[(size_t)R * 512 + col0 + c8 * 8];
            const unsigned au[4] = {a.x, a.y, a.z, a.w}, bu[4] = {b.x, b.y, b.z, b.w};
#pragma unroll
            for (int u = 0; u < 4; ++u) {
                y[c8 * 8 + 2 * u] = bflo(au[u]) + bflo(bu[u]);
                y[c8 * 8 + 2 * u + 1] = bfhi(au[u]) + bfhi(bu[u]);
            }
        }
#pragma unroll
        for (int u = 0; u < 32; ++u) sum += y[u];
        sum += __shfl_xor(sum, 1);
        const float mean = sum * (1.f / 64.f);
#pragma unroll
        for (int u = 0; u < 32; ++u) { const float dlt = y[u] - mean; sq += dlt * dlt; }
        sq += __shfl_xor(sq, 1);
        const float rs = rsqrtf(sq * (1.f / 64.f) + 64e-5f);
        const float bc = bon[(size_t)R * 16 + head * 2] + bon[(size_t)R * 16 + head * 2 + 1];
#pragma unroll
        for (int c8 = 0; c8 < 4; ++c8) {
            float v[8]; zx0_shift8(zx, mu, R, 1280 + col0 + c8 * 8, v);
            unsigned o[4];
#pragma unroll
            for (int u = 0; u < 4; ++u) {
                const int c = col0 + c8 * 8 + 2 * u;
                const float g0 = Cs[row * CS_LD + cg * 32 + c8 * 8 + 2 * u], g1 = Cs[row * CS_LD + cg * 32 + c8 * 8 + 2 * u + 1];
                const float o0 = ((y[c8 * 8 + 2 * u] - mean) * rs * gnw[c] + gnb[c] + bc * v[2 * u]) * g0;
                const float o1 = ((y[c8 * 8 + 2 * u + 1] - mean) * rs * gnw[c + 1] + gnb[c + 1] + bc * v[2 * u + 1]) * g1;
                o[u] = pack2(o0, o1);
            }
            *(uint4*)&mix[(size_t)R * 768 + 256 + col0 + c8 * 8] = make_uint4(o[0], o[1], o[2], o[3]);
        }
    }
};
__device__ void phase_rwkv_out(const P& p, unsigned char* smem, int bid, int nblk) {
    LdGlo al{WSP(bf16_t, WS_ZX), p.in[I0_SHIFT]};
    LdBf16 bl{WSP(bf16_t, WS_G2T), 128};
    for (int t = bid; t < (NTOK / 128) * 4; t += nblk) {
        const int m0 = (t >> 2) * 128, n0 = (t & 3) * 128;
        EpiRwkvOut epi{WSP(bf16_t, WS_YB), WSP(bf16_t, WS_YB) + (size_t)NTOK * 512, WSP(float, WS_BON), WSP(bf16_t, WS_ZX), p.in[I0_SHIFT],
                       p.in[I0_GNW], p.in[I0_GNB], WSP(bf16_t, WS_MIX), m0, n0};
        gemm_tile(al, bl, 128, m0, n0, epi, smem);
    }
}

__device__ void phase_gemm_wout(const P& p, unsigned char* smem, int bid, int nblk, int layer) {
    const int K = layer ? 1024 : 768;
    LdBf16 al{WSP(bf16_t, WS_MIX), K};
    LdBf16 bl{WSP(bf16_t, layer ? WS_WOUT1T : WS_WOUT0T), K};
    const int total = (NTOK / 128) * 8;
    for (int t = bid; t < total; t += nblk) {
        const int m0 = (t >> 3) * 128, n0 = (t & 7) * 128;
        if (layer && (m0 % SS) < LC) continue;
        EpiStoreF32 epi{WSP(float, WS_ZX), 1024, m0, n0, NTOK};
        gemm_tile(al, bl, K, m0, n0, epi, smem);
    }
}

__device__ __forceinline__ void ln_row_store(float (&v)[16], const float* g, const float* bta, float* dst, int lane) {
    float s = 0.f;
#pragma unroll
    for (int i = 0; i < 16; ++i) s += v[i];
    const float mean = wave_sum(s) * (1.f / 1024.f);
    float q = 0.f;
#pragma unroll
    for (int i = 0; i < 16; ++i) { const float dl = v[i] - mean; q += dl * dl; }
    const float rs = rsqrtf(wave_sum(q) * (1.f / 1024.f) + 1e-5f);
#pragma unroll
    for (int i = 0; i < 4; ++i) {
        const int k = i * 256 + lane * 4;
        const float4 gg = *(const float4*)&g[k], bb = *(const float4*)&bta[k];
        float4 o;
        o.x = (v[4 * i] - mean) * rs * gg.x + bb.x; o.y = (v[4 * i + 1] - mean) * rs * gg.y + bb.y;
        o.z = (v[4 * i + 2] - mean) * rs * gg.z + bb.z; o.w = (v[4 * i + 3] - mean) * rs * gg.w + bb.w;
        *(float4*)&dst[k] = o;
    }
}
__device__ void phase_ln1(const P& p, int gwave, int nwaves, int layer) {
    const int lane = threadIdx.x & 63;
    const float* yx = WSP(float, WS_ZX);
    const float* mod = WSP(float, WS_MOD) + (size_t)layer * 5 * 6144;
    const float* g = p.in[layer ? I1_LN1G : I0_LN1G];
    const float* bt = p.in[layer ? I1_LN1B : I0_LN1B];
    const float* xlat = layer ? p.out : p.in[I_X];
    const float* xctx = layer ? WSP(float, WS_CTX) : p.in[I_CTX];
    for (int R = gwave; R < NTOK; R += nwaves) {
        const int b = R / SS, s = R - b * SS;
        if (layer && s < LC) continue;
        const float* src; float* dst; const float* m;
        if (s < LC) { src = xctx + ((size_t)(b * LC + s)) * DM; dst = WSP(float, WS_CTX) + ((size_t)(b * LC + s)) * DM; m = mod + 4 * 6144 + 2048; }
        else        { src = xlat + ((size_t)(b * TT + s - LC)) * DM; dst = p.out + ((size_t)(b * TT + s - LC)) * DM; m = mod + b * 6144 + 2048; }
        float v[16];
#pragma unroll
        for (int i = 0; i < 4; ++i) {
            const int k = i * 256 + lane * 4;
            const float4 x4 = *(const float4*)&src[k], y4 = *(const float4*)&yx[(size_t)R * 1024 + k], g4 = *(const float4*)&m[k];
            v[4 * i] = ALPHA_F * x4.x + g4.x * y4.x; v[4 * i + 1] = ALPHA_F * x4.y + g4.y * y4.y;
            v[4 * i + 2] = ALPHA_F * x4.z + g4.z * y4.z; v[4 * i + 3] = ALPHA_F * x4.w + g4.w * y4.w;
        }
        ln_row_store(v, g, bt, dst, lane);
    }
}

__device__ void phase_gemm_q(const P& p, unsigned char* smem, int bid, int nblk, int layer) {
    LdXMod al{p.out, WSP(float, WS_CTX), WSP(float, WS_MOD) + (size_t)layer * 5 * 6144, 3072, 4096};
    LdBf16 bl{WSP(bf16_t, layer ? WS_WQ1T : WS_WQ0T), 1024};
    const int total = (NTOK / 128) * 8;
    for (int t = bid; t < total; t += nblk) {
        const int m0 = (t >> 3) * 128, n0 = (t & 7) * 128;
        if (layer && (m0 % SS) < LC) continue;
        EpiStoreBf16 epi{WSP(bf16_t, WS_YB), 1024, m0, n0, NTOK};
        gemm_tile(al, bl, 1024, m0, n0, epi, smem);
    }
}

#define NEG_BIG (-3.0e38f)
#define TOPK_SMEM_BYTES (4 * (16 * 132 + 16 * 64) * 4)
__device__ void peer_topk_item(const P& p, int item, unsigned char* smem, int layer) {
    const int tile = item >> 3, h = item & 7;
    const int tid = threadIdx.x, lane = tid & 63, wave = tid >> 6;
    const int R0 = tile * 64 + wave * 16;
    const bf16_t* Q = WSP(bf16_t, WS_YB);
    const bf16_t* keys = WSP(bf16_t, layer ? WS_KEYS1 : WS_KEYS0);
    float* sc = (float*)smem + wave * (16 * 132 + 16 * 64);
    float* res = sc + 16 * 132;
    int* idxo = WSP(int, WS_IDX);
    float* gato = WSP(float, WS_GATE);
    for (int c = 0; c < 2; ++c) {
        f32x4 acc[8];
#pragma unroll
        for (int nt = 0; nt < 8; ++nt) acc[nt] = (f32x4){0.f, 0.f, 0.f, 0.f};
#pragma unroll
        for (int kk = 0; kk < 2; ++kk) {
            const bf16x8 a = *(const bf16x8*)&Q[(size_t)(R0 + (lane & 15)) * 1024 + h * 128 + c * 64 + kk * 32 + 8 * (lane >> 4)];
#pragma unroll
            for (int nt = 0; nt < 8; ++nt) {
                const bf16x8 bq = *(const bf16x8*)&keys[(size_t)((h * 2 + c) * 128 + nt * 16 + (lane & 15)) * 64 + kk * 32 + 8 * (lane >> 4)];
                acc[nt] = __builtin_amdgcn_mfma_f32_16x16x32_bf16(a, bq, acc[nt], 0, 0, 0);
            }
        }
#pragma unroll
        for (int nt = 0; nt < 8; ++nt)
#pragma unroll
            for (int r = 0; r < 4; ++r) sc[((lane >> 4) * 4 + r) * 132 + nt * 16 + (lane & 15)] = acc[nt][r];
        for (int t = 0; t < 16; ++t) {
            float v0 = sc[t * 132 + lane], v1 = sc[t * 132 + 64 + lane];
            float tv = 0.f; int ti = 0;
            for (int it = 0; it < 16; ++it) {
                const float m = wave_max(fmaxf(v0, v1));
                const unsigned long long bal = __ballot(v0 == m || v1 == m);
                const int wl = __ffsll((long long)bal) - 1;
                const int myidx = (v0 == m) ? lane : lane + 64;
                const int widx = __builtin_amdgcn_readlane(myidx, wl);
                if (lane == wl) { if (v0 == m) v0 = NEG_BIG; else v1 = NEG_BIG; }
                if (lane == it) { tv = m; ti = widx; }
            }
            if (lane < 16) { res[t * 64 + c * 32 + lane] = tv; ((int*)res)[t * 64 + c * 32 + 16 + lane] = ti; }
        }
    }
    for (int t = 0; t < 16; ++t) {
        const int R = R0 + t;
        const float a1 = res[t * 64 + (lane & 15)];
        const int   j1 = ((const int*)res)[t * 64 + 16 + (lane & 15)];
        const float a2 = res[t * 64 + 32 + (lane & 15)];
        const int   j2 = ((const int*)res)[t * 64 + 48 + (lane & 15)];
        float cv[4];
#pragma unroll
        for (int mm = 0; mm < 4; ++mm) cv[mm] = __shfl(a1, (lane >> 4) + 4 * mm) + a2;
        float tv = 0.f; int tn = 0;
        for (int it = 0; it < 16; ++it) {
            const float lm = fmaxf(fmaxf(cv[0], cv[1]), fmaxf(cv[2], cv[3]));
            const float m = wave_max(lm);
            const unsigned long long bal = __ballot(lm == m);
            const int wl = __ffsll((long long)bal) - 1;
            const int mysel = (cv[0] == m) ? 0 : (cv[1] == m) ? 1 : (cv[2] == m) ? 2 : 3;
            const int wsel = __builtin_amdgcn_readlane(mysel, wl);
            if (lane == wl) { if (wsel == 0) cv[0] = NEG_BIG; else if (wsel == 1) cv[1] = NEG_BIG; else if (wsel == 2) cv[2] = NEG_BIG; else cv[3] = NEG_BIG; }
            if (lane == it) { tv = m; tn = wl + 64 * wsel; }
        }
        const int e1 = __shfl(j1, tn >> 4), e2 = __shfl(j2, tn & 15);
        const float mx = __shfl(tv, 0);
        const float ex = (lane < 16) ? __expf(tv - mx) : 0.f;
        const float den = row16_sum(ex);
        if (lane < 16) {
            idxo[(size_t)R * 128 + h * 16 + lane] = e1 * 128 + e2;
            gato[(size_t)R * 128 + h * 16 + lane] = ex / den;
        }
    }
}

__device__ void phase_peer_gather(const P& p, int gwave, int nwaves, int layer) {
    const int lane = threadIdx.x & 63;
    const float* mod = WSP(float, WS_MOD) + (size_t)layer * 5 * 6144;
    const bf16_t* U = WSP(bf16_t, layer ? WS_TABU1 : WS_TABU0);
    const bf16_t* V = WSP(bf16_t, layer ? WS_TABV1 : WS_TABV0);
    const int* idxo = WSP(int, WS_IDX);
    const float* gato = WSP(float, WS_GATE);
    const float* g = p.in[layer ? I1_LN2G : I0_LN2G];
    const float* bt = p.in[layer ? I1_LN2B : I0_LN2B];
    for (int R = gwave; R < NTOK; R += nwaves) {
        const int b = R / SS, s = R - b * SS;
        if (layer && s < LC) continue;
        float* xrow; const float* m;
        if (s < LC) { xrow = WSP(float, WS_CTX) + ((size_t)(b * LC + s)) * DM; m = mod + 4 * 6144; }
        else        { xrow = p.out + ((size_t)(b * TT + s - LC)) * DM; m = mod + b * 6144; }
        float x[16], hh[16], o[16];
#pragma unroll
        for (int i = 0; i < 2; ++i)
#pragma unroll
            for (int q4 = 0; q4 < 2; ++q4) {
                const int k = i * 512 + lane * 8 + q4 * 4;
                const float4 xv = *(const float4*)&xrow[k], sc = *(const float4*)&m[4096 + k], sh = *(const float4*)&m[3072 + k];
                x[i * 8 + q4 * 4 + 0] = xv.x; x[i * 8 + q4 * 4 + 1] = xv.y; x[i * 8 + q4 * 4 + 2] = xv.z; x[i * 8 + q4 * 4 + 3] = xv.w;
                hh[i * 8 + q4 * 4 + 0] = xv.x * (1.f + sc.x) + sh.x; hh[i * 8 + q4 * 4 + 1] = xv.y * (1.f + sc.y) + sh.y;
                hh[i * 8 + q4 * 4 + 2] = xv.z * (1.f + sc.z) + sh.z; hh[i * 8 + q4 * 4 + 3] = xv.w * (1.f + sc.w) + sh.w;
            }
#pragma unroll
        for (int i = 0; i < 16; ++i) o[i] = 0.f;
        const int ia = idxo[(size_t)R * 128 + lane], ib = idxo[(size_t)R * 128 + 64 + lane];
        const float ga = gato[(size_t)R * 128 + lane], gb = gato[(size_t)R * 128 + 64 + lane];
#pragma unroll 4
        for (int e = 0; e < 128; ++e) {
            const int id = (e < 64) ? __builtin_amdgcn_readlane(ia, e & 63) : __builtin_amdgcn_readlane(ib, e & 63);
            const float gt = __builtin_bit_cast(float, (e < 64) ? __builtin_amdgcn_readlane(__builtin_bit_cast(int, ga), e & 63)
                                                                : __builtin_amdgcn_readlane(__builtin_bit_cast(int, gb), e & 63));
            const uint4 u0 = *(const uint4*)&U[(size_t)id * 1024 + lane * 8], u1 = *(const uint4*)&U[(size_t)id * 1024 + 512 + lane * 8];
            const uint4 v0 = *(const uint4*)&V[(size_t)id * 1024 + lane * 8], v1 = *(const uint4*)&V[(size_t)id * 1024 + 512 + lane * 8];
            float d = 0.f;
            d += hh[0] * bflo(u0.x) + hh[1] * bfhi(u0.x) + hh[2] * bflo(u0.y) + hh[3] * bfhi(u0.y);
            d += hh[4] * bflo(u0.z) + hh[5] * bfhi(u0.z) + hh[6] * bflo(u0.w) + hh[7] * bfhi(u0.w);
            d += hh[8] * bflo(u1.x) + hh[9] * bfhi(u1.x) + hh[10] * bflo(u1.y) + hh[11] * bfhi(u1.y);
            d += hh[12] * bflo(u1.z) + hh[13] * bfhi(u1.z) + hh[14] * bflo(u1.w) + hh[15] * bfhi(u1.w);
            d = wave_sum(d);
            const float w = gt * geluf_(d);
            o[0] += w * bflo(v0.x); o[1] += w * bfhi(v0.x); o[2] += w * bflo(v0.y); o[3] += w * bfhi(v0.y);
            o[4] += w * bflo(v0.z); o[5] += w * bfhi(v0.z); o[6] += w * bflo(v0.w); o[7] += w * bfhi(v0.w);
            o[8] += w * bflo(v1.x); o[9] += w * bfhi(v1.x); o[10] += w * bflo(v1.y); o[11] += w * bfhi(v1.y);
            o[12] += w * bflo(v1.z); o[13] += w * bfhi(v1.z); o[14] += w * bflo(v1.w); o[15] += w * bfhi(v1.w);
        }
        float vsum = 0.f;
#pragma unroll
        for (int i = 0; i < 2; ++i)
#pragma unroll
            for (int q4 = 0; q4 < 2; ++q4) {
                const int k = i * 512 + lane * 8 + q4 * 4;
                const float4 g2 = *(const float4*)&m[5120 + k];
                o[i * 8 + q4 * 4 + 0] = ALPHA_F * x[i * 8 + q4 * 4 + 0] + g2.x * o[i * 8 + q4 * 4 + 0];
                o[i * 8 + q4 * 4 + 1] = ALPHA_F * x[i * 8 + q4 * 4 + 1] + g2.y * o[i * 8 + q4 * 4 + 1];
                o[i * 8 + q4 * 4 + 2] = ALPHA_F * x[i * 8 + q4 * 4 + 2] + g2.z * o[i * 8 + q4 * 4 + 2];
                o[i * 8 + q4 * 4 + 3] = ALPHA_F * x[i * 8 + q4 * 4 + 3] + g2.w * o[i * 8 + q4 * 4 + 3];
            }
#pragma unroll
        for (int i = 0; i < 16; ++i) vsum += o[i];
        const float mean = wave_sum(vsum) * (1.f / 1024.f);
        float vq = 0.f;
#pragma unroll
        for (int i = 0; i < 16; ++i) { const float dl = o[i] - mean; vq += dl * dl; }
        const float rs = rsqrtf(wave_sum(vq) * (1.f / 1024.f) + 1e-5f);
#pragma unroll
        for (int i = 0; i < 2; ++i)
#pragma unroll
            for (int q4 = 0; q4 < 2; ++q4) {
                const int k = i * 512 + lane * 8 + q4 * 4;
                const float4 gg = *(const float4*)&g[k], bb = *(const float4*)&bt[k];
                float4 r;
                r.x = (o[i * 8 + q4 * 4 + 0] - mean) * rs * gg.x + bb.x; r.y = (o[i * 8 + q4 * 4 + 1] - mean) * rs * gg.y + bb.y;
                r.z = (o[i * 8 + q4 * 4 + 2] - mean) * rs * gg.z + bb.z; r.w = (o[i * 8 + q4 * 4 + 3] - mean) * rs * gg.w + bb.w;
                *(float4*)&xrow[k] = r;
            }
    }
}

constexpr size_t WS_ROPE = WS_END;
static_assert(WS_ROPE + 16384 <= (size_t)536870912, "rope table fits");
__device__ void phase_rope_table(const P& p, size_t gtid, size_t gthreads) {
    float* rt = WSP(float, WS_ROPE);
    for (size_t e = gtid; e < 128 * 16; e += gthreads) {
        const int i = (int)(e & 15), pos = (int)(e >> 4);
        const float freq = powf(10000.f, -(float)i / 16.f);
        const float ang = (float)pos * freq;
        rt[e * 2] = cosf(ang); rt[e * 2 + 1] = sinf(ang);
    }
}
struct EpiZX1 {
    bf16_t* zx; bf16_t* vt; const float* rope; int m0, n0;
    __device__ void operator()(const float* Cs, int pass, int tid) const {
        const int Rb = m0 + pass * 64;
        const int b = Rb / SS, sb = Rb - b * SS;
        const bool isv = (n0 == 640) || (n0 >= 1792);
        if (isv) {
            const int hv0 = (n0 == 640) ? 0 : 2 + (n0 - 1792) / 64;
#pragma unroll
            for (int i = 0; i < 4; ++i) {
                const int c = tid + 256 * i, col = c >> 3, r8 = (c & 7) * 8;
                float v[8];
#pragma unroll
                for (int u = 0; u < 8; ++u) v[u] = Cs[(r8 + u) * CS_LD + col];
                uint4 o; o.x = pack2(v[0], v[1]); o.y = pack2(v[2], v[3]); o.z = pack2(v[4], v[5]); o.w = pack2(v[6], v[7]);
                *(uint4*)&vt[((size_t)(b * 10 + hv0 + (col >> 6)) * 64 + (col & 63)) * SS + sb + r8] = o;
            }
            return;
        }
        const bool dorope = (n0 < 640) && (sb >= LC);
#pragma unroll
        for (int i = 0; i < 4; ++i) {
            const int c = tid + 256 * i, row = c >> 4, col8 = (c & 15) * 8;
            const int R = Rb + row;
            float v[8];
            const float4 a = *(const float4*)&Cs[row * CS_LD + col8], bq = *(const float4*)&Cs[row * CS_LD + col8 + 4];
            v[0] = a.x; v[1] = a.y; v[2] = a.z; v[3] = a.w; v[4] = bq.x; v[5] = bq.y; v[6] = bq.z; v[7] = bq.w;
            if (dorope) {
                const int t = sb + row - LC;
                const int e0 = col8 & 31, half = (col8 >> 5) & 1;
                const int pos = half ? (t & 63) : (t >> 6);
                const bool lo = e0 < 16;
                const int pc = lo ? col8 + 16 : col8 - 16;
                const float4 pa = *(const float4*)&Cs[row * CS_LD + pc], pb = *(const float4*)&Cs[row * CS_LD + pc + 4];
                const float pv[8] = {pa.x, pa.y, pa.z, pa.w, pb.x, pb.y, pb.z, pb.w};
#pragma unroll
                for (int u = 0; u < 8; ++u) {
                    const int fi = (e0 & 15) + u;
                    const float cs = rope[(pos * 16 + fi) * 2], sn = rope[(pos * 16 + fi) * 2 + 1];
                    v[u] = lo ? (v[u] * cs - pv[u] * sn) : (v[u] * cs + pv[u] * sn);
                }
            }
            uint4 o; o.x = pack2(v[0], v[1]); o.y = pack2(v[2], v[3]); o.z = pack2(v[4], v[5]); o.w = pack2(v[6], v[7]);
            *(uint4*)&zx[(size_t)R * ZW1 + n0 + col8] = o;
        }
    }
};
__device__ void phase_gemm_win1(const P& p, unsigned char* smem, int bid, int nblk) {
    LdXMod al{p.out, WSP(float, WS_CTX), WSP(float, WS_MOD) + (size_t)5 * 6144, 0, 1024};
    LdBf16 bl{WSP(bf16_t, WS_WIN1T), 1024};
    const int ntn = ZW1 / 128, total = (NTOK / 128) * ntn;
    for (int t = bid; t < total; t += nblk) {
        const int m0 = (t / ntn) * 128, n0 = (t % ntn) * 128;
        EpiZX1 epi{WSP(bf16_t, WS_ZX), WSP(bf16_t, WS_VT), WSP(float, WS_ROPE), m0, n0};
        gemm_tile(al, bl, 1024, m0, n0, epi, smem);
    }
}

#define AT_LD 72
#define ATTN_SMEM_BYTES (2 * 64 * AT_LD * 2)
#define MASK_NEG (-1.0e30f)
__device__ void attn_item(const P& p, int item, unsigned char* smem) {
    const int qt = item & 63, hq = (item >> 6) & 7, b = (item >> 9) & 3, kind = item >> 11;
    const int tid = threadIdx.x, lane = tid & 63, wave = tid >> 6, hh = lane >> 5, ql = lane & 31;
    bf16_t* Ks = (bf16_t*)smem;
    bf16_t* Vs = Ks + 64 * AT_LD;
    const bf16_t* zx = WSP(bf16_t, WS_ZX);
    const int t0 = qt * 128;
    const int qcol = kind ? 768 + hq * 64 : hq * 64;
    const int kcol = kind ? 1280 + hq * 64 : 512 + (hq >> 2) * 64;
    const bf16_t* vt = WSP(bf16_t, WS_VT) + ((size_t)(b * 10 + (kind ? 2 + hq : (hq >> 2))) * 64) * SS;
    const int ocol = kind ? 512 + hq * 64 : hq * 64;
    const int tq = t0 + wave * 32 + ql;
    const size_t Rq = (size_t)b * SS + LC + tq;
    bf16x8 qf[4];
#pragma unroll
    for (int st = 0; st < 4; ++st) qf[st] = *(const bf16x8*)&zx[Rq * ZW1 + qcol + st * 16 + 8 * hh];
    int lk0, lk1;
    const int r0 = t0 >> 6;
    if (kind == 0) { lk0 = t0 - 128 < 0 ? 0 : t0 - 128; lk1 = t0 + 256 > TT ? TT : t0 + 256; }
    else {
        int rs0 = r0 - 4; rs0 = rs0 < 0 ? 0 : (rs0 > 120 ? 120 : rs0);
        int rs1 = r0 + 1 - 4; rs1 = rs1 < 0 ? 0 : (rs1 > 120 ? 120 : rs1);
        lk0 = rs0 * 64; lk1 = (rs1 + 8) * 64;
    }
    const int nloc = (lk1 - lk0) >> 6;
    const int rq = tq >> 6, cq = tq & 63;
    int rsq = rq - 4; rsq = rsq < 0 ? 0 : (rsq > 120 ? 120 : rsq);
    int csq = cq - 8; csq = csq < 0 ? 0 : (csq > 48 ? 48 : csq);
    const float* rpb = p.in[I1_RPB] + (size_t)hq * 15 * 31;
    float m = MASK_NEG, l = 0.f;
    f32x16 oacc[2];
#pragma unroll
    for (int r = 0; r < 16; ++r) { oacc[0][r] = 0.f; oacc[1][r] = 0.f; }
    for (int ti = 0; ti < 4 + nloc; ++ti) {
        const bool isctx = ti < 4;
        const int sbase = isctx ? ti * 64 : LC + lk0 + (ti - 4) * 64;
        __syncthreads();
        for (int c = tid; c < 512; c += 256) {
            const int rr = c >> 3, c8 = (c & 7) * 8;
            *(uint4*)&Ks[rr * AT_LD + c8] = *(const uint4*)&zx[((size_t)b * SS + sbase + rr) * ZW1 + kcol + c8];
            *(uint4*)&Vs[rr * AT_LD + c8] = *(const uint4*)&vt[(size_t)rr * SS + sbase + c8];
        }
        __syncthreads();
        const int tk0 = sbase - LC;
        const int kr = tk0 >> 6;
        if (!isctx && kind == 1) {
            const int rqw = (t0 + wave * 32) >> 6;
            int rsw = rqw - 4; rsw = rsw < 0 ? 0 : (rsw > 120 ? 120 : rsw);
            if (kr < rsw || kr >= rsw + 8) continue;
        }
#pragma unroll
        for (int sub = 0; sub < 2; ++sub) {
            f32x16 sacc;
#pragma unroll
            for (int r = 0; r < 16; ++r) sacc[r] = 0.f;
#pragma unroll
            for (int st = 0; st < 4; ++st) {
                const bf16x8 kf = *(const bf16x8*)&Ks[(sub * 32 + ql) * AT_LD + st * 16 + 8 * hh];
                sacc = __builtin_amdgcn_mfma_f32_32x32x16_bf16(kf, qf[st], sacc, 0, 0, 0);
            }
            float sv[16], smax = MASK_NEG;
#pragma unroll
            for (int r = 0; r < 16; ++r) {
                const int key = sub * 32 + (r & 3) + 8 * (r >> 2) + 4 * hh;
                float x = sacc[r] * 0.125f;
                if (!isctx) {
                    if (kind == 0) { const int dlt = tk0 + key - tq; if (dlt > 128 || dlt < -128) x = MASK_NEG; }
                    else {
                        if (key < csq || key >= csq + 16) x = MASK_NEG;
                        else x += rpb[(kr - rq + 7) * 31 + (key - cq + 15)];
                    }
                }
                sv[r] = x; smax = fmaxf(smax, x);
            }
            smax = half_swap_max(smax);
            const float mn = fmaxf(m, smax);
            const float alpha = __expf(m - mn);
            m = mn;
            float ps = 0.f;
#pragma unroll
            for (int r = 0; r < 16; ++r) { sv[r] = __expf(sv[r] - mn); ps += sv[r]; }
            l = l * alpha + ps;
#pragma unroll
            for (int r = 0; r < 16; ++r) { oacc[0][r] *= alpha; oacc[1][r] *= alpha; }
#pragma unroll
            for (int s2 = 0; s2 < 2; ++s2) {
                union { bf16x8 v; unsigned u[4]; } pb;
#pragma unroll
                for (int u = 0; u < 4; ++u) pb.u[u] = pack2(sv[8 * s2 + 2 * u], sv[8 * s2 + 2 * u + 1]);
#pragma unroll
                for (int db = 0; db < 2; ++db) {
                    union { bf16x8 v; uint2 h[2]; } vf;
                    const bf16_t* vrow = &Vs[(db * 32 + ql) * AT_LD + sub * 32 + 16 * s2 + 4 * hh];
                    vf.h[0] = *(const uint2*)vrow;
                    vf.h[1] = *(const uint2*)(vrow + 8);
                    oacc[db] = __builtin_amdgcn_mfma_f32_32x32x16_bf16(vf.v, pb.v, oacc[db], 0, 0, 0);
                }
            }
        }
    }
    float lt = half_swap_sum(l);
    if (kind == 0) lt += __expf(p.in[I1_SINK][hq] - m);
    const float inv = 1.f / lt;
    bf16_t* mix = WSP(bf16_t, WS_MIX);
#pragma unroll
    for (int db = 0; db < 2; ++db)
#pragma unroll
        for (int g4 = 0; g4 < 4; ++g4) {
            const int dd = db * 32 + 8 * g4 + 4 * hh;
            uint2 o; o.x = pack2(oacc[db][4 * g4] * inv, oacc[db][4 * g4 + 1] * inv); o.y = pack2(oacc[db][4 * g4 + 2] * inv, oacc[db][4 * g4 + 3] * inv);
            *(uint2*)&mix[Rq * 1024 + ocol + dd] = o;
        }
}

enum { PH_TRANSPOSE = 0, PH_CONVERT, PH_MODP, PH_MISC, PH_S5TAB, PH_WIN0, PH_S5E, PH_S5CARRY, PH_S5Y, PH_RWKV, PH_GLU, PH_RWKVOUT,
       PH_WOUT, PH_LN1, PH_QGEMM, PH_TOPK, PH_GATHER, PH_WIN1, PH_ATTN, PH_COUNT };
template <int PH> struct PhaseSmem { static constexpr int bytes = 1024; };
template <> struct PhaseSmem<PH_TRANSPOSE> { static constexpr int bytes = 64 * 65 * 4; };
template <> struct PhaseSmem<PH_WIN0>    { static constexpr int bytes = GEMM_SMEM_BYTES; };
template <> struct PhaseSmem<PH_S5E>     { static constexpr int bytes = GEMM_SMEM_BYTES; };
template <> struct PhaseSmem<PH_S5Y>     { static constexpr int bytes = GEMM_SMEM_BYTES; };
template <> struct PhaseSmem<PH_RWKV>    { static constexpr int bytes = (int)sizeof(RwkvSmem); };
template <> struct PhaseSmem<PH_GLU>     { static constexpr int bytes = GEMM_SMEM_BYTES; };
template <> struct PhaseSmem<PH_RWKVOUT> { static constexpr int bytes = GEMM_SMEM_BYTES; };
template <> struct PhaseSmem<PH_WOUT>    { static constexpr int bytes = GEMM_SMEM_BYTES; };
template <> struct PhaseSmem<PH_QGEMM>   { static constexpr int bytes = GEMM_SMEM_BYTES; };
template <> struct PhaseSmem<PH_TOPK>    { static constexpr int bytes = TOPK_SMEM_BYTES; };
template <> struct PhaseSmem<PH_WIN1>    { static constexpr int bytes = GEMM_SMEM_BYTES; };
template <> struct PhaseSmem<PH_ATTN>    { static constexpr int bytes = ATTN_SMEM_BYTES; };

template <int PH>
__device__ __forceinline__ void run_phase(const P& p, int layer, unsigned char* smem) {
    const int bid = blockIdx.x, nblk = gridDim.x;
    const size_t gtid = (size_t)bid * 256 + threadIdx.x, gthreads = (size_t)nblk * 256;
    const int gwave = bid * 4 + (threadIdx.x >> 6), nwaves = nblk * 4;
    if constexpr (PH == PH_TRANSPOSE) phase_transpose(p, (float*)smem, bid, nblk);
    else if constexpr (PH == PH_CONVERT) phase_convert(p, gtid, gthreads);
    else if constexpr (PH == PH_MODP) phase_mod_partial(p, gwave, nwaves);
    else if constexpr (PH == PH_MISC) { phase_mod_reduce(p, gtid, gthreads); phase_s5_pow(p, gtid, gthreads); phase_rope_table(p, gtid, gthreads); }
    else if constexpr (PH == PH_S5TAB) phase_s5_tables(p, gtid, gthreads);
    else if constexpr (PH == PH_WIN0) phase_gemm_win0(p, smem, bid, nblk);
    else if constexpr (PH == PH_S5E) phase_s5_E(p, smem, bid, nblk);
    else if constexpr (PH == PH_S5CARRY) phase_s5_carry(p, gtid, gthreads);
    else if constexpr (PH == PH_S5Y) phase_s5_Y(p, smem, bid, nblk);
    else if constexpr (PH == PH_RWKV) { for (int it = bid; it < 256; it += nblk) rwkv_scan_item(p, it, smem); }
    else if constexpr (PH == PH_GLU) phase_glu(p, smem, bid, nblk);
    else if constexpr (PH == PH_RWKVOUT) phase_rwkv_out(p, smem, bid, nblk);
    else if constexpr (PH == PH_WOUT) phase_gemm_wout(p, smem, bid, nblk, layer);
    else if constexpr (PH == PH_LN1) phase_ln1(p, gwave, nwaves, layer);
    else if constexpr (PH == PH_QGEMM) phase_gemm_q(p, smem, bid, nblk, layer);
    else if constexpr (PH == PH_TOPK) {
        for (int it = bid; it < (NTOK / 64) * 8; it += nblk) { if (layer && ((it >> 3) * 64) % SS < LC) continue; peer_topk_item(p, it, smem, layer); }
    }
    else if constexpr (PH == PH_GATHER) phase_peer_gather(p, gwave, nwaves, layer);
    else if constexpr (PH == PH_WIN1) phase_gemm_win1(p, smem, bid, nblk);
    else if constexpr (PH == PH_ATTN) { for (int it = bid; it < 4096; it += nblk) attn_item(p, it, smem); }
}

template <int PH>
__global__ void __launch_bounds__(256) k_phase(P p, int layer) {
    __shared__ __attribute__((aligned(16))) unsigned char smem[PhaseSmem<PH>::bytes];
    run_phase<PH>(p, layer, smem);
}

template <int PH> static void launch_phase(const P& p, int layer, int grid, hipStream_t stream) {
    hipLaunchKernelGGL(k_phase<PH>, dim3(grid), dim3(256), 0, stream, p, layer);
}

extern "C" void kernel_launch(void* const* d_in, const int* in_sizes, int n_in, void* d_out, int out_size, void* d_ws, size_t ws_size,
                              hipStream_t stream) {
    (void)in_sizes; (void)n_in; (void)out_size; (void)ws_size;
    P p{};
    for (int i = 0; i < 51; ++i) p.in[i] = (const float*)d_in[i];
    p.out = (float*)d_out; p.ws = (unsigned char*)d_ws;
    const int G = 2048;
    launch_phase<PH_TRANSPOSE>(p, 0, G, stream);
    launch_phase<PH_CONVERT>(p, 0, G, stream);
    launch_phase<PH_MODP>(p, 0, 384, stream);
    launch_phase<PH_MISC>(p, 0, 256, stream);
    launch_phase<PH_S5TAB>(p, 0, G, stream);
    launch_phase<PH_WIN0>(p, 0, G, stream);
    launch_phase<PH_S5E>(p, 0, 160, stream);
    launch_phase<PH_S5CARRY>(p, 0, 32, stream);
    launch_phase<PH_S5Y>(p, 0, 640, stream);
    launch_phase<PH_RWKV>(p, 0, 256, stream);
    launch_phase<PH_GLU>(p, 0, 528, stream);
    launch_phase<PH_RWKVOUT>(p, 0, 1056, stream);
    launch_phase<PH_WOUT>(p, 0, G, stream);
    launch_phase<PH_LN1>(p, 0, G, stream);
    launch_phase<PH_QGEMM>(p, 0, G, stream);
    launch_phase<PH_TOPK>(p, 0, G, stream);
    launch_phase<PH_GATHER>(p, 0, G, stream);
    launch_phase<PH_WIN1>(p, 1, G, stream);
    launch_phase<PH_ATTN>(p, 1, G, stream);
    launch_phase<PH_WOUT>(p, 1, G, stream);
    launch_phase<PH_LN1>(p, 1, G, stream);
    launch_phase<PH_QGEMM>(p, 1, G, stream);
    launch_phase<PH_TOPK>(p, 1, G, stream);
    launch_phase<PH_GATHER>(p, 1, G, stream);
}
```

```cpp
#include <hip/hip_runtime.h>
#include <hip/hip_cooperative_groups.h>
#include <stdint.h>
#include <stdio.h>

#define DM      1024
#define NB      4
#define TT      8192
#define LC      256
#define SS      8448
#define NTOK    33792
#define ZW0     2176
#define ZW1     2304
#define ALPHA_F 1.41421356237f
#define NCH     132

typedef unsigned short bf16_t;
using bf16x8 = __attribute__((ext_vector_type(8))) short;
using f32x16 = __attribute__((ext_vector_type(16))) float;
using f32x4  = __attribute__((ext_vector_type(4))) float;
using bf16x2v = __attribute__((ext_vector_type(2))) __bf16;

__device__ __forceinline__ bf16_t f2bf(float f) {
    unsigned u = __float_as_uint(f);
    u += 0x7fffu + ((u >> 16) & 1u);
    return (bf16_t)(u >> 16);
}
__device__ __forceinline__ float bf2f(bf16_t h) { return __uint_as_float(((unsigned)h) << 16); }
__device__ __forceinline__ unsigned pack2(float lo, float hi) { return (unsigned)f2bf(lo) | ((unsigned)f2bf(hi) << 16); }
__device__ __forceinline__ float bflo(unsigned u) { return __uint_as_float(u << 16); }
__device__ __forceinline__ float bfhi(unsigned u) { return __uint_as_float(u & 0xffff0000u); }
__device__ __forceinline__ float sigmoidf_(float x) { return 1.f / (1.f + __expf(-x)); }
__device__ __forceinline__ float siluf_(float x) { return x / (1.f + __expf(-x)); }
__device__ __forceinline__ float geluf_(float x) { return 0.5f * x * (1.f + erff(x * 0.70710678118654752f)); }

template <int CTRL> __device__ __forceinline__ float dppf(float x) {
    return __builtin_bit_cast(float, __builtin_amdgcn_mov_dpp(__builtin_bit_cast(int, x), CTRL, 0xf, 0xf, true));
}
#define DPP_XOR1 0xB1
#define DPP_XOR2 0x4E
#define DPP_ROR4 0x124
#define DPP_ROR8 0x128
__device__ __forceinline__ float row16_sum(float x) {
    x += dppf<DPP_XOR1>(x); x += dppf<DPP_XOR2>(x); x += dppf<DPP_ROR4>(x); x += dppf<DPP_ROR8>(x); return x;
}
__device__ __forceinline__ float row16_max(float x) {
    x = fmaxf(x, dppf<DPP_XOR1>(x)); x = fmaxf(x, dppf<DPP_XOR2>(x)); x = fmaxf(x, dppf<DPP_ROR4>(x)); x = fmaxf(x, dppf<DPP_ROR8>(x)); return x;
}
__device__ __forceinline__ float xrow_sum(float x) {
    auto s = __builtin_amdgcn_permlane16_swap(__float_as_uint(x), __float_as_uint(x), false, false);
    x = __uint_as_float(s[0]) + __uint_as_float(s[1]);
    auto t = __builtin_amdgcn_permlane32_swap(__float_as_uint(x), __float_as_uint(x), false, false);
    return __uint_as_float(t[0]) + __uint_as_float(t[1]);
}
__device__ __forceinline__ float xrow_max(float x) {
    auto s = __builtin_amdgcn_permlane16_swap(__float_as_uint(x), __float_as_uint(x), false, false);
    x = fmaxf(__uint_as_float(s[0]), __uint_as_float(s[1]));
    auto t = __builtin_amdgcn_permlane32_swap(__float_as_uint(x), __float_as_uint(x), false, false);
    return fmaxf(__uint_as_float(t[0]), __uint_as_float(t[1]));
}
__device__ __forceinline__ float wave_sum(float x) { return xrow_sum(row16_sum(x)); }
__device__ __forceinline__ float wave_max(float x) { return xrow_max(row16_max(x)); }
__device__ __forceinline__ float half_swap_sum(float x) {
    auto t = __builtin_amdgcn_permlane32_swap(__float_as_uint(x), __float_as_uint(x), false, false);
    return __uint_as_float(t[0]) + __uint_as_float(t[1]);
}
__device__ __forceinline__ float half_swap_max(float x) {
    auto t = __builtin_amdgcn_permlane32_swap(__float_as_uint(x), __float_as_uint(x), false, false);
    return fmaxf(__uint_as_float(t[0]), __uint_as_float(t[1]));
}

constexpr size_t al256(size_t x) { return (x + 255) & ~(size_t)255; }
constexpr size_t WS_WIN0T  = 0;
constexpr size_t WS_WOUT0T = WS_WIN0T  + al256((size_t)ZW0 * 1024 * 2);
constexpr size_t WS_WQ0T   = WS_WOUT0T + al256((size_t)1024 * 768 * 2);
constexpr size_t WS_KEYS0  = WS_WQ0T   + al256((size_t)1024 * 1024 * 2);
constexpr size_t WS_WIN1T  = WS_KEYS0  + al256((size_t)2048 * 64 * 2);
constexpr size_t WS_WOUT1T = WS_WIN1T  + al256((size_t)ZW1 * 1024 * 2);
constexpr size_t WS_WQ1T   = WS_WOUT1T + al256((size_t)1024 * 1024 * 2);
constexpr size_t WS_KEYS1  = WS_WQ1T   + al256((size_t)1024 * 1024 * 2);
constexpr size_t WS_WGLUT  = WS_KEYS1  + al256((size_t)2048 * 64 * 2);
constexpr size_t WS_W2T    = WS_WGLUT  + al256((size_t)256 * 256 * 2);
constexpr size_t WS_A2T    = WS_W2T    + al256((size_t)2 * 512 * 64 * 2);
constexpr size_t WS_G2T    = WS_A2T    + al256((size_t)2 * 512 * 64 * 2);
constexpr size_t WS_S5POW  = WS_G2T    + al256((size_t)512 * 128 * 2);
constexpr size_t WS_S5K    = WS_S5POW  + al256((size_t)2 * 16 * 64 * 65 * 2 * 4);
constexpr size_t WS_S5W    = WS_S5K    + al256((size_t)2 * 16 * 64 * 256 * 2);
constexpr size_t WS_S5V    = WS_S5W    + al256((size_t)2 * 16 * 128 * 1024 * 2);
constexpr size_t WS_MODP   = WS_S5V    + al256((size_t)2 * 16 * 1024 * 128 * 2);
constexpr size_t WS_MOD    = WS_MODP   + al256((size_t)8 * 2 * 5 * 6144 * 4);
constexpr size_t WS_TABU0  = WS_MOD    + al256((size_t)2 * 5 * 6144 * 4);
constexpr size_t WS_TABV0  = WS_TABU0  + (size_t)16384 * 1024 * 2;
constexpr size_t WS_TABU1  = WS_TABV0  + (size_t)16384 * 1024 * 2;
constexpr size_t WS_TABV1  = WS_TABU1  + (size_t)16384 * 1024 * 2;
constexpr size_t WS_ZX     = WS_TABV1  + (size_t)16384 * 1024 * 2;
constexpr size_t WS_CTX    = WS_ZX     + al256((size_t)NTOK * ZW1 * 2);
constexpr size_t WS_US5    = WS_CTX    + al256((size_t)1024 * 1024 * 4);
constexpr size_t WS_S5E    = WS_US5    + al256((size_t)16 * NTOK * 16 * 2);
constexpr size_t WS_S5H    = WS_S5E    + al256((size_t)2 * 16 * 528 * 128 * 4);
constexpr size_t WS_YA     = WS_S5H    + al256((size_t)2 * 16 * 528 * 128 * 2);
constexpr size_t WS_YB     = WS_YA     + al256((size_t)NTOK * 256 * 2);
constexpr size_t WS_BON    = WS_YB     + al256((size_t)2 * NTOK * 512 * 2);
constexpr size_t WS_MIX    = WS_BON    + al256((size_t)NTOK * 16 * 4);
constexpr size_t WS_END    = WS_MIX    + al256((size_t)NTOK * 1024 * 2);
constexpr size_t WS_VT     = WS_YB;
static_assert((size_t)4 * 10 * 64 * SS * 2 <= (size_t)2 * NTOK * 512 * 2, "VT overlay");
constexpr int PAR_SHIFT = 0, PAR_A0 = 3840, PAR_W0 = 4864, PAR_KK = 5888, PAR_KA = 6400, PAR_RK = 6912, PAR_BGLU = 7424, PAR_GNW = 7680, PAR_GNB = 8192,
              PAR_LN1G0 = 8704, PAR_LN1B0 = 9728, PAR_LN2G0 = 10752, PAR_LN2B0 = 11776, PAR_LN1G1 = 12800, PAR_LN1B1 = 13824, PAR_LN2G1 = 14848, PAR_LN2B1 = 15872,
              PAR_RPB = 16896, PAR_SINK = 20736, PAR_TOTAL = 20800;
constexpr size_t WS_PAR    = WS_END + 16384;
static_assert(WS_PAR + (size_t)PAR_TOTAL * 4 <= (size_t)536870912, "param pack fits");
constexpr size_t WS_IDX    = WS_MIX;
constexpr size_t WS_GATE   = WS_MIX + (size_t)NTOK * 128 * 4;
static_assert(WS_GATE + (size_t)NTOK * 128 * 4 <= WS_END, "idx/gate overlay");
static_assert(WS_END <= (size_t)536870912, "workspace budget");

struct P {
    const float* in[51];
    float* out;
    unsigned char* ws;
};
struct W { const float* x; const float* ctx; float* out; unsigned char* ws; };
enum {
    I_X = 0, I_C, I_CTX, I_CCTX,
    I0_WMOD, I0_BMOD, I0_WIN, I0_LAMRE, I0_LAMIM, I0_LOGDT, I0_BRE, I0_BIM, I0_CRE, I0_CIM, I0_S5D, I0_WGLU, I0_BGLU,
    I0_SHIFT, I0_W0, I0_W2, I0_A0, I0_A2, I0_G2, I0_KK, I0_KA, I0_RK, I0_GNW, I0_GNB, I0_WOUT, I0_LN1G, I0_LN1B,
    I0_WQ, I0_KEYS, I0_U, I0_V, I0_LN2G, I0_LN2B,
    I1_WMOD, I1_BMOD, I1_WIN, I1_SINK, I1_RPB, I1_WOUT, I1_LN1G, I1_LN1B, I1_WQ, I1_KEYS, I1_U, I1_V, I1_LN2G, I1_LN2B
};
static_assert(I1_LN2B == 50, "51 inputs");

#define WSP(T, off) ((T*)(p.ws + (off)))
#define PAR(off) (((const float*)(p.ws + WS_PAR)) + (off))

__device__ void transpose_cvt_tile(const float* __restrict__ W, int K, int N, bf16_t* __restrict__ Wt, int tile, float* sm) {
    const int tn = N / 64;
    const int k0 = (tile / tn) * 64, n0 = (tile % tn) * 64;
    const int tid = threadIdx.x;
    for (int e = tid; e < 4096; e += 256) { int r = e >> 6, c = e & 63; sm[r * 65 + c] = W[(size_t)(k0 + r) * N + n0 + c]; }
    __syncthreads();
    for (int e = tid; e < 4096; e += 256) { int r = e >> 6, c = e & 63; Wt[(size_t)(n0 + r) * K + k0 + c] = f2bf(sm[c * 65 + r]); }
    __syncthreads();
}

struct TrDesc { int in_idx; size_t in_off; int K, N; size_t out_off; };
#define N_TR 12
__device__ __forceinline__ TrDesc tr_desc(int i) {
    switch (i) {
        case 0:  return {I0_WIN, 0, 1024, ZW0, WS_WIN0T};
        case 1:  return {I0_WOUT, 0, 768, 1024, WS_WOUT0T};
        case 2:  return {I0_WQ, 0, 1024, 1024, WS_WQ0T};
        case 3:  return {I1_WIN, 0, 1024, ZW1, WS_WIN1T};
        case 4:  return {I1_WOUT, 0, 1024, 1024, WS_WOUT1T};
        case 5:  return {I1_WQ, 0, 1024, 1024, WS_WQ1T};
        case 6:  return {I0_WGLU, 0, 256, 256, WS_WGLUT};
        case 7:  return {I0_W2, 0, 64, 512, WS_W2T};
        case 8:  return {I0_W2, (size_t)64 * 512, 64, 512, WS_W2T + (size_t)512 * 64 * 2};
        case 9:  return {I0_A2, 0, 64, 512, WS_A2T};
        case 10: return {I0_A2, (size_t)64 * 512, 64, 512, WS_A2T + (size_t)512 * 64 * 2};
        default: return {I0_G2, 0, 128, 512, WS_G2T};
    }
}
__device__ int tr_total_tiles() { int t = 0; for (int i = 0; i < N_TR; ++i) { TrDesc d = tr_desc(i); t += (d.K / 64) * (d.N / 64); } return t; }

__device__ void phase_transpose(const P& p, float* sm, int bid, int nblk) {
    const int total = tr_total_tiles();
    for (int t = bid; t < total; t += nblk) {
        int rem = t, i = 0;
        for (; i < N_TR; ++i) { TrDesc d = tr_desc(i); int n = (d.K / 64) * (d.N / 64); if (rem < n) break; rem -= n; }
        TrDesc d = tr_desc(i);
        transpose_cvt_tile(p.in[d.in_idx] + d.in_off, d.K, d.N, (bf16_t*)(p.ws + d.out_off), rem, sm);
    }
}

__device__ void cvt_range(const float* __restrict__ src, bf16_t* __restrict__ dst, size_t n, size_t gtid, size_t gthreads) {
    const size_t n8 = n / 8;
    for (size_t i = gtid; i < n8; i += gthreads) {
        float4 a = ((const float4*)src)[2 * i], b = ((const float4*)src)[2 * i + 1];
        uint4 o; o.x = pack2(a.x, a.y); o.y = pack2(a.z, a.w); o.z = pack2(b.x, b.y); o.w = pack2(b.z, b.w);
        ((uint4*)dst)[i] = o;
    }
}
__device__ void phase_convert(const P& p, size_t gtid, size_t gthreads) {
    cvt_range(p.in[I0_KEYS], WSP(bf16_t, WS_KEYS0), (size_t)2048 * 64, gtid, gthreads);
    cvt_range(p.in[I1_KEYS], WSP(bf16_t, WS_KEYS1), (size_t)2048 * 64, gtid, gthreads);
    cvt_range(p.in[I0_U], WSP(bf16_t, WS_TABU0), (size_t)16384 * 1024, gtid, gthreads);
    cvt_range(p.in[I0_V], WSP(bf16_t, WS_TABV0), (size_t)16384 * 1024, gtid, gthreads);
    cvt_range(p.in[I1_U], WSP(bf16_t, WS_TABU1), (size_t)16384 * 1024, gtid, gthreads);
    cvt_range(p.in[I1_V], WSP(bf16_t, WS_TABV1), (size_t)16384 * 1024, gtid, gthreads);
}

#define PACK1(IDX, OFF, CNT) { const float* src = p.in[IDX]; for (size_t i = gtid; i < (size_t)(CNT); i += gthreads) dst[(OFF) + i] = src[i]; }
__device__ void phase_pack_params(const P& p, size_t gtid, size_t gthreads) {
    float* dst = (float*)(p.ws + WS_PAR);
    PACK1(I0_SHIFT, PAR_SHIFT, 3840) PACK1(I0_A0, PAR_A0, 1024) PACK1(I0_W0, PAR_W0, 1024) PACK1(I0_KK, PAR_KK, 512) PACK1(I0_KA, PAR_KA, 512)
    PACK1(I0_RK, PAR_RK, 512) PACK1(I0_BGLU, PAR_BGLU, 256) PACK1(I0_GNW, PAR_GNW, 512) PACK1(I0_GNB, PAR_GNB, 512)
    PACK1(I0_LN1G, PAR_LN1G0, 1024) PACK1(I0_LN1B, PAR_LN1B0, 1024) PACK1(I0_LN2G, PAR_LN2G0, 1024) PACK1(I0_LN2B, PAR_LN2B0, 1024)
    PACK1(I1_LN1G, PAR_LN1G1, 1024) PACK1(I1_LN1B, PAR_LN1B1, 1024) PACK1(I1_LN2G, PAR_LN2G1, 1024) PACK1(I1_LN2B, PAR_LN2B1, 1024)
    PACK1(I1_RPB, PAR_RPB, 3720) PACK1(I1_SINK, PAR_SINK, 8)
}
__device__ void phase_mod_partial(const P& p, int gwave, int nwaves) {
    const int lane = threadIdx.x & 63;
    for (int it = gwave; it < 2 * 96 * 8; it += nwaves) {
        const int kc = it & 7, ct = (it >> 3) % 96, l = it / (8 * 96);
        const float* wm = p.in[l ? I1_WMOD : I0_WMOD];
        const int col = ct * 64 + lane;
        float acc[5] = {0.f, 0.f, 0.f, 0.f, 0.f};
        for (int i = kc * 128; i < kc * 128 + 128; ++i) {
            const float w = wm[(size_t)i * 6144 + col];
#pragma unroll
            for (int n = 0; n < 4; ++n) acc[n] += siluf_(p.in[I_C][n * 1024 + i]) * w;
            acc[4] += siluf_(p.in[I_CCTX][i]) * w;
        }
        float* mp = WSP(float, WS_MODP);
#pragma unroll
        for (int n = 0; n < 5; ++n) mp[(((size_t)kc * 2 + l) * 5 + n) * 6144 + col] = acc[n];
    }
}
__device__ void phase_mod_reduce(const P& p, size_t gtid, size_t gthreads) {
    const float* mp = WSP(float, WS_MODP);
    float* mo = WSP(float, WS_MOD);
    for (size_t i = gtid; i < (size_t)2 * 5 * 6144; i += gthreads) {
        const int l = (int)(i / (5 * 6144)), col = (int)(i % 6144);
        float s = p.in[l ? I1_BMOD : I0_BMOD][col];
        for (int kc = 0; kc < 8; ++kc) s += mp[(size_t)kc * 2 * 5 * 6144 + i];
        mo[i] = s;
    }
}

__device__ void phase_s5_pow(const P& p, size_t gtid, size_t gthreads) {
    float* pw = WSP(float, WS_S5POW);
    for (size_t i = gtid; i < 2048; i += gthreads) {
        const int dg = (int)(i >> 6);
        const float lr = p.in[I0_LAMRE][i], li = p.in[I0_LAMIM][i];
        const float dt = expf(p.in[I0_LOGDT][dg]);
        const float mag = expf(lr * dt);
        const float ar = mag * cosf(li * dt), ai = mag * sinf(li * dt);
        float cr = 1.f, ci = 0.f;
        for (int j = 0; j <= 64; ++j) {
            pw[(i * 65 + j) * 2] = cr; pw[(i * 65 + j) * 2 + 1] = ci;
            const float nr = cr * ar - ci * ai, ni = cr * ai + ci * ar; cr = nr; ci = ni;
        }
    }
}
__device__ __forceinline__ void s5_bbar(const P& p, int dgp, int i, float& br, float& bi) {
    const float lr = p.in[I0_LAMRE][dgp], li = p.in[I0_LAMIM][dgp];
    const float* pw = WSP(float, WS_S5POW) + ((size_t)dgp * 65 + 1) * 2;
    const float ar = pw[0], ai = pw[1];
    const float den = lr * lr + li * li, nr = ar - 1.f;
    const float cr = (nr * lr + ai * li) / den, ci = (ai * lr - nr * li) / den;
    const float xr = p.in[I0_BRE][(size_t)dgp * 16 + i], xi = p.in[I0_BIM][(size_t)dgp * 16 + i];
    br = cr * xr - ci * xi; bi = cr * xi + ci * xr;
}
__device__ void phase_s5_tables(const P& p, size_t gtid, size_t gthreads) {
    const float* pw = WSP(float, WS_S5POW);
    bf16_t* Kt = WSP(bf16_t, WS_S5K);
    bf16_t* Wt = WSP(bf16_t, WS_S5W);
    bf16_t* Vt = WSP(bf16_t, WS_S5V);
    for (size_t e = gtid; e < (size_t)32 * 64 * 256; e += gthreads) {
        const int ip = (int)(e & 15), i = (int)((e >> 4) & 15), lag = (int)((e >> 8) & 63), dg = (int)(e >> 14);
        float acc = 0.f;
        for (int pp = 0; pp < 64; ++pp) {
            const int dgp = dg * 64 + pp;
            float br, bi; s5_bbar(p, dgp, ip, br, bi);
            const float pr = pw[((size_t)dgp * 65 + lag) * 2], pi = pw[((size_t)dgp * 65 + lag) * 2 + 1];
            const float cr = p.in[I0_CRE][((size_t)dg * 16 + i) * 64 + pp], ci = p.in[I0_CIM][((size_t)dg * 16 + i) * 64 + pp];
            const float tr = pr * br - pi * bi, ti = pr * bi + pi * br;
            acc += cr * tr - ci * ti;
        }
        if (lag == 0 && i == ip && dg < 16) acc += p.in[I0_S5D][(dg & 15) * 16 + i];
        Kt[e] = f2bf(acc);
    }
    for (size_t e = gtid; e < (size_t)32 * 128 * 1024; e += gthreads) {
        const int k = (int)(e & 1023), n = (int)((e >> 10) & 127), dg = (int)(e >> 17);
        const int ip = k & 15, s = k >> 4, pp = n >> 1, ri = n & 1, d = dg >> 4;
        const int dgp = dg * 64 + pp;
        float br, bi; s5_bbar(p, dgp, ip, br, bi);
        const int ex = d ? s : 63 - s;
        const float pr = pw[((size_t)dgp * 65 + ex) * 2], pi = pw[((size_t)dgp * 65 + ex) * 2 + 1];
        const float tr = pr * br - pi * bi, ti = pr * bi + pi * br;
        Wt[e] = f2bf(ri ? ti : tr);
    }
    for (size_t e = gtid; e < (size_t)32 * 1024 * 128; e += gthreads) {
        const int k = (int)(e & 127), n = (int)((e >> 7) & 1023), dg = (int)(e >> 17);
        const int pp = k >> 1, ri = k & 1, i = n & 15, t = n >> 4, d = dg >> 4;
        const int dgp = dg * 64 + pp;
        const int ex = d ? 64 - t : t + 1;
        const float pr = pw[((size_t)dgp * 65 + ex) * 2], pi = pw[((size_t)dgp * 65 + ex) * 2 + 1];
        const float cr = p.in[I0_CRE][((size_t)dg * 16 + i) * 64 + pp], ci = p.in[I0_CIM][((size_t)dg * 16 + i) * 64 + pp];
        Vt[e] = f2bf(ri ? -(cr * pi + ci * pr) : (cr * pr - ci * pi));
    }
}

#define GM_LD 72
#define CS_LD 132
#define GEMM_SMEM_BYTES (2 * 128 * GM_LD * 2)
static_assert(64 * CS_LD * 4 <= GEMM_SMEM_BYTES, "C staging fits");

template <class AL, class BL, class Epi>
__device__ void gemm_tile(const AL& al, const BL& bl, int K, int m0, int n0, Epi& epi, unsigned char* smem) {
    bf16_t* As = (bf16_t*)smem;
    bf16_t* Bs = As + 128 * GM_LD;
    const int tid = threadIdx.x, lane = tid & 63, wave = tid >> 6;
    const int wm = wave >> 1, wn = wave & 1;
    const int lrow = tid >> 3, kc = (tid & 7) * 8;
    typename AL::RowCtx arow[4];
    typename BL::RowCtx brow[4];
#pragma unroll
    for (int i = 0; i < 4; ++i) { arow[i] = al.row(m0 + lrow + 32 * i); brow[i] = bl.row(n0 + lrow + 32 * i); }
    f32x16 acc[2][2];
#pragma unroll
    for (int i = 0; i < 2; ++i)
#pragma unroll
        for (int j = 0; j < 2; ++j)
#pragma unroll
            for (int r = 0; r < 16; ++r) acc[i][j][r] = 0.f;
    uint4 ra[4], rb[4];
#pragma unroll
    for (int i = 0; i < 4; ++i) { ra[i] = al.load8(arow[i], kc); rb[i] = bl.load8(brow[i], kc); }
    for (int k0 = 0; k0 < K; k0 += 64) {
        __syncthreads();
#pragma unroll
        for (int i = 0; i < 4; ++i) {
            *(uint4*)&As[(lrow + 32 * i) * GM_LD + kc] = ra[i];
            *(uint4*)&Bs[(lrow + 32 * i) * GM_LD + kc] = rb[i];
        }
        __syncthreads();
        if (k0 + 64 < K) {
#pragma unroll
            for (int i = 0; i < 4; ++i) { ra[i] = al.load8(arow[i], k0 + 64 + kc); rb[i] = bl.load8(brow[i], k0 + 64 + kc); }
        }
#pragma unroll
        for (int kk = 0; kk < 4; ++kk) {
            bf16x8 a[2], b[2];
#pragma unroll
            for (int i = 0; i < 2; ++i) a[i] = *(const bf16x8*)&As[(wm * 64 + i * 32 + (lane & 31)) * GM_LD + kk * 16 + 8 * (lane >> 5)];
#pragma unroll
            for (int j = 0; j < 2; ++j) b[j] = *(const bf16x8*)&Bs[(wn * 64 + j * 32 + (lane & 31)) * GM_LD + kk * 16 + 8 * (lane >> 5)];
#pragma unroll
            for (int i = 0; i < 2; ++i)
#pragma unroll
                for (int j = 0; j < 2; ++j) acc[i][j] = __builtin_amdgcn_mfma_f32_32x32x16_bf16(a[i], b[j], acc[i][j], 0, 0, 0);
        }
    }
    float* Cs = (float*)smem;
#pragma unroll
    for (int pass = 0; pass < 2; ++pass) {
        __syncthreads();
        if (wm == pass) {
#pragma unroll
            for (int i = 0; i < 2; ++i)
#pragma unroll
                for (int j = 0; j < 2; ++j)
#pragma unroll
                    for (int r = 0; r < 16; ++r) {
                        const int row = i * 32 + (r & 3) + 8 * (r >> 2) + 4 * (lane >> 5);
                        const int col = wn * 64 + j * 32 + (lane & 31);
                        Cs[row * CS_LD + col] = acc[i][j][r];
                    }
        }
        __syncthreads();
        epi(Cs, pass, tid);
    }
    __syncthreads();
}

struct LdBf16 {
    const bf16_t* base; int ld;
    typedef const bf16_t* RowCtx;
    __device__ RowCtx row(int r) const { return base + (size_t)r * ld; }
    __device__ uint4 load8(RowCtx rc, int k) const { return *(const uint4*)(rc + k); }
};
struct LdXMod {
    const float* xlat; const float* xctx; const float* mod; int shift_off, scale_off;
    struct RowCtx { const float* src; const float* m; };
    __device__ RowCtx row(int R) const {
        const int b = R / SS, s = R - b * SS;
        RowCtx rc;
        if (s < LC) { rc.src = xctx + ((size_t)(b * LC + s)) * DM; rc.m = mod + 4 * 6144; }
        else        { rc.src = xlat + ((size_t)(b * TT + s - LC)) * DM; rc.m = mod + b * 6144; }
        return rc;
    }
    __device__ uint4 load8(const RowCtx& rc, int k) const {
        const float4 x0 = *(const float4*)(rc.src + k), x1 = *(const float4*)(rc.src + k + 4);
        const float4 c0 = *(const float4*)(rc.m + scale_off + k), c1 = *(const float4*)(rc.m + scale_off + k + 4);
        const float4 h0 = *(const float4*)(rc.m + shift_off + k), h1 = *(const float4*)(rc.m + shift_off + k + 4);
        uint4 o;
        o.x = pack2(x0.x * (1.f + c0.x) + h0.x, x0.y * (1.f + c0.y) + h0.y);
        o.y = pack2(x0.z * (1.f + c0.z) + h0.z, x0.w * (1.f + c0.w) + h0.w);
        o.z = pack2(x1.x * (1.f + c1.x) + h1.x, x1.y * (1.f + c1.y) + h1.y);
        o.w = pack2(x1.z * (1.f + c1.z) + h1.z, x1.w * (1.f + c1.w) + h1.w);
        return o;
    }
};

struct EpiStoreBf16 {
    bf16_t* out; int ld; int m0, n0; int mmax;
    __device__ void operator()(const float* Cs, int pass, int tid) const {
#pragma unroll
        for (int i = 0; i < 4; ++i) {
            const int c = tid + 256 * i, row = c >> 4, col8 = (c & 15) * 8;
            const int R = m0 + pass * 64 + row;
            if (R >= mmax) continue;
            const float4 a = *(const float4*)&Cs[row * CS_LD + col8], b = *(const float4*)&Cs[row * CS_LD + col8 + 4];
            uint4 o; o.x = pack2(a.x, a.y); o.y = pack2(a.z, a.w); o.z = pack2(b.x, b.y); o.w = pack2(b.z, b.w);
            *(uint4*)&out[(size_t)R * ld + n0 + col8] = o;
        }
    }
};
struct EpiStoreF32 {
    float* out; int ld; int m0, n0; int mmax;
    __device__ void operator()(const float* Cs, int pass, int tid) const {
#pragma unroll
        for (int i = 0; i < 8; ++i) {
            const int c = tid + 256 * i, row = c >> 5, col4 = (c & 31) * 4;
            const int R = m0 + pass * 64 + row;
            if (R >= mmax) continue;
            *(float4*)&out[(size_t)R * ld + n0 + col4] = *(const float4*)&Cs[row * CS_LD + col4];
        }
    }
};

struct EpiZX0 {
    bf16_t* zx; bf16_t* us5; int m0, n0;
    __device__ void operator()(const float* Cs, int pass, int tid) const {
#pragma unroll
        for (int i = 0; i < 4; ++i) {
            const int c = tid + 256 * i, row = c >> 4, col8 = (c & 15) * 8;
            const int R = m0 + pass * 64 + row, col = n0 + col8;
            const float4 a = *(const float4*)&Cs[row * CS_LD + col8], b = *(const float4*)&Cs[row * CS_LD + col8 + 4];
            uint4 o; o.x = pack2(a.x, a.y); o.y = pack2(a.z, a.w); o.z = pack2(b.x, b.y); o.w = pack2(b.z, b.w);
            if (col < 256) *(uint4*)&us5[((size_t)(col >> 4) * NTOK + R) * 16 + (col & 8)] = o;
            else           *(uint4*)&zx[(size_t)R * ZW0 + col] = o;
        }
    }
};
__device__ void phase_gemm_win0(const W p, unsigned char* smem, int bid, int nblk) {
    LdXMod al{p.x, p.ctx, WSP(float, WS_MOD), 0, 1024};
    LdBf16 bl{WSP(bf16_t, WS_WIN0T), 1024};
    const int ntn = ZW0 / 128, total = (NTOK / 128) * ntn;
    for (int t = bid; t < total; t += nblk) {
        const int m0 = (t / ntn) * 128, n0 = (t % ntn) * 128;
        EpiZX0 epi{WSP(bf16_t, WS_ZX), WSP(bf16_t, WS_US5), m0, n0};
        gemm_tile(al, bl, 1024, m0, n0, epi, smem);
    }
}

struct LdBf16Clamp {
    const bf16_t* base; int ld; int rmax;
    typedef const bf16_t* RowCtx;
    __device__ RowCtx row(int r) const { return base + (size_t)(r < rmax ? r : rmax) * ld; }
    __device__ uint4 load8(RowCtx rc, int k) const { return *(const uint4*)(rc + k); }
};
__device__ void phase_s5_E(const W p, unsigned char* smem, int bid, int nblk) {
    for (int t = bid; t < 32 * 5; t += nblk) {
        const int dg = t / 5, mt = t % 5, g = dg & 15;
        LdBf16Clamp al{WSP(bf16_t, WS_US5) + (size_t)g * NTOK * 16, 1024, 527};
        LdBf16 bl{WSP(bf16_t, WS_S5W) + (size_t)dg * 128 * 1024, 1024};
        EpiStoreF32 epi{WSP(float, WS_S5E) + (size_t)dg * 528 * 128, 128, mt * 128, 0, 528};
        gemm_tile(al, bl, 1024, mt * 128, 0, epi, smem);
    }
}
__device__ void phase_s5_carry(const W p, size_t gtid, size_t gthreads) {
    const float* pw = WSP(float, WS_S5POW);
    const float* E = WSP(float, WS_S5E);
    bf16_t* H = WSP(bf16_t, WS_S5H);
    for (size_t i = gtid; i < 8192; i += gthreads) {
        const int pp = (int)(i & 63), b = (int)((i >> 6) & 3), dg = (int)(i >> 8), d = dg >> 4;
        const float ar = pw[((size_t)(dg * 64 + pp) * 65 + 64) * 2], ai = pw[((size_t)(dg * 64 + pp) * 65 + 64) * 2 + 1];
        float hr = 0.f, hi = 0.f;
        for (int cc = 0; cc < NCH; ++cc) {
            const int c = d ? (cc < 4 ? 3 - cc : 131 - (cc - 4)) : cc;
            const size_t o = ((size_t)dg * 528 + b * NCH + c) * 128 + pp * 2;
            H[o] = f2bf(hr); H[o + 1] = f2bf(hi);
            const float er = E[o], ei = E[o + 1];
            const float nr = ar * hr - ai * hi + er, ni = ar * hi + ai * hr + ei;
            hr = nr; hi = ni;
        }
    }
}
struct LdS5YA {
    const bf16_t* u; const bf16_t* h0; const bf16_t* h1;
    struct RowCtx { const bf16_t* u; const bf16_t* h0; const bf16_t* h1; };
    __device__ RowCtx row(int r) const { if (r > 527) r = 527; return {u + (size_t)r * 1024, h0 + (size_t)r * 128, h1 + (size_t)r * 128}; }
    __device__ uint4 load8(const RowCtx& rc, int k) const {
        if (k < 1024) return *(const uint4*)(rc.u + k);
        if (k < 1152) return *(const uint4*)(rc.h0 + (k - 1024));
        if (k < 2176) return *(const uint4*)(rc.u + (k - 1152));
        return *(const uint4*)(rc.h1 + (k - 2176));
    }
};
struct LdS5YB {
    const bf16_t* k0; const bf16_t* k1; const bf16_t* v0; const bf16_t* v1;
    struct RowCtx { int t, i; const bf16_t* v0; const bf16_t* v1; };
    __device__ RowCtx row(int n) const { return {n >> 4, n & 15, v0 + (size_t)n * 128, v1 + (size_t)n * 128}; }
    __device__ uint4 load8(const RowCtx& rc, int k) const {
        if (k < 1024) { const int s = k >> 4, lag = rc.t - s; if (lag < 0) return make_uint4(0, 0, 0, 0); return *(const uint4*)(k0 + (lag * 16 + rc.i) * 16 + (k & 8)); }
        if (k < 1152) return *(const uint4*)(rc.v0 + (k - 1024));
        if (k < 2176) { const int kk = k - 1152, s = kk >> 4, lag = s - rc.t; if (lag < 0) return make_uint4(0, 0, 0, 0); return *(const uint4*)(k1 + (lag * 16 + rc.i) * 16 + (kk & 8)); }
        return *(const uint4*)(rc.v1 + (k - 2176));
    }
};
struct EpiS5Y {
    bf16_t* ya; int g; int m0, n0;
    __device__ void operator()(const float* Cs, int pass, int tid) const {
#pragma unroll
        for (int i = 0; i < 4; ++i) {
            const int c = tid + 256 * i, row = c >> 4, col8 = (c & 15) * 8;
            const int r = m0 + pass * 64 + row;
            if (r > 527) continue;
            const int n = n0 + col8, t = n >> 4;
            const float4 a = *(const float4*)&Cs[row * CS_LD + col8], b = *(const float4*)&Cs[row * CS_LD + col8 + 4];
            uint4 o;
            o.x = pack2(geluf_(a.x), geluf_(a.y)); o.y = pack2(geluf_(a.z), geluf_(a.w));
            o.z = pack2(geluf_(b.x), geluf_(b.y)); o.w = pack2(geluf_(b.z), geluf_(b.w));
            *(uint4*)&ya[((size_t)r * 64 + t) * 256 + g * 16 + (n & 8)] = o;
        }
    }
};
__device__ void phase_s5_Y(const W p, unsigned char* smem, int bid, int nblk) {
    for (int t = bid; t < 16 * 5 * 8; t += nblk) {
        const int g = t / 40, mt = (t % 40) / 8, nt = t % 8;
        LdS5YA al{WSP(bf16_t, WS_US5) + (size_t)g * NTOK * 16, WSP(bf16_t, WS_S5H) + (size_t)g * 528 * 128, WSP(bf16_t, WS_S5H) + (size_t)(16 + g) * 528 * 128};
        LdS5YB bl{WSP(bf16_t, WS_S5K) + (size_t)g * 64 * 256, WSP(bf16_t, WS_S5K) + (size_t)(16 + g) * 64 * 256,
                  WSP(bf16_t, WS_S5V) + (size_t)g * 1024 * 128, WSP(bf16_t, WS_S5V) + (size_t)(16 + g) * 1024 * 128};
        EpiS5Y epi{WSP(bf16_t, WS_YA), g, mt * 128, nt * 128};
        gemm_tile(al, bl, 2304, mt * 128, nt * 128, epi, smem);
    }
}

#define RW_CH 32
struct RwkvSmem {
    bf16_t raw[5][RW_CH + 2][64];
    bf16_t alo[2][RW_CH * GM_LD];
    float dec[RW_CH][64], aa[RW_CH][64], bb[RW_CH][64], kd[RW_CH][64], rr[RW_CH][64];
    float vv[RW_CH][16];
    float yo[RW_CH][16];
};
__device__ void rwkv_scan_item(const W p, int item, unsigned char* smem_raw) {
    RwkvSmem& sm = *(RwkvSmem*)smem_raw;
    const int q = item & 3, d = (item >> 2) & 1, h = (item >> 3) & 7, b = item >> 6;
    const int tid = threadIdx.x, lane = tid & 63, wave = tid >> 6;
    const bf16_t* zx = WSP(bf16_t, WS_ZX);
    const float* mu = PAR(PAR_SHIFT);
    bf16x8 bfrag[4];
    {
        const int mat = wave >> 1, ct = wave & 1;
        const bf16_t* wt = WSP(bf16_t, mat ? WS_A2T : WS_W2T) + ((size_t)d * 512 + h * 64 + ct * 32 + (lane & 31)) * 64 + 8 * (lane >> 5);
#pragma unroll
        for (int kk = 0; kk < 4; ++kk) bfrag[kk] = *(const bf16x8*)(wt + kk * 16);
    }
    const int colr = 256 + h * 64, colk = 768 + h * 64, colv = 1280 + h * 64, colw = 1792 + d * 64, cola = 1920 + d * 64;
    float S0 = 0.f, S1 = 0.f, S2 = 0.f, S3 = 0.f;
    const int kseg = lane & 15, rowl = wave * 4 + (lane >> 4);
    bf16_t* yb = WSP(bf16_t, WS_YB) + (size_t)d * NTOK * 512;
    float* bon = WSP(float, WS_BON);
    for (int cc = 0; cc < SS / RW_CH; ++cc) {
        int s0;
        if (d == 0) s0 = RW_CH * cc;
        else s0 = (cc < LC / RW_CH) ? RW_CH * (LC / RW_CH - 1 - cc) : LC + RW_CH * (TT / RW_CH - 1 - (cc - LC / RW_CH));
        const int seg_lo = (s0 < LC) ? 0 : LC, seg_hi = (s0 < LC) ? LC : SS;
        __syncthreads();
        for (int c = tid; c < 5 * (RW_CH + 2) * 8; c += 256) {
            const int c8 = (c & 7) * 8, rix = (c >> 3) % (RW_CH + 2), sl = c / (8 * (RW_CH + 2));
            const int s = s0 - 1 + rix;
            const int col = (sl == 0 ? colr : sl == 1 ? colk : sl == 2 ? colv : sl == 3 ? colw : cola) + c8;
            uint4 v = make_uint4(0, 0, 0, 0);
            if (s >= seg_lo && s < seg_hi) v = *(const uint4*)&zx[((size_t)b * SS + s) * ZW0 + col];
            *(uint4*)&sm.raw[sl][rix][c8] = v;
        }
        __syncthreads();
        for (int e = tid; e < 5 * RW_CH * 64; e += 256) {
            const int ch = e & 63, j = (e >> 6) % RW_CH, sl = e / (64 * RW_CH);
            const int jj = d ? (RW_CH - 1 - j) : j;
            const float z = bf2f(sm.raw[sl][jj + 1][ch]), zp = bf2f(sm.raw[sl][jj][ch]), zn = bf2f(sm.raw[sl][jj + 2][ch]);
            const int mcol = (sl == 0 ? colr : sl == 1 ? colk : sl == 2 ? colv : sl == 3 ? colw : cola) - 256 + ch;
            const float sh = z + mu[mcol] * (zp - z) + mu[1920 + mcol] * (zn - z);
            if (sl == 0) sm.rr[j][ch] = sh;
            else if (sl == 1) sm.kd[j][ch] = sh;
            else if (sl == 2) { const int cq = ch - q * 16; if (cq >= 0 && cq < 16) sm.vv[j][cq] = sh; }
            else if (sl == 3) sm.alo[0][j * GM_LD + ch] = f2bf(tanhf(sh));
            else sm.alo[1][j * GM_LD + ch] = f2bf(sh);
        }
        __syncthreads();
        {
            const int mat = wave >> 1, ct = wave & 1;
            f32x16 acc;
#pragma unroll
            for (int r = 0; r < 16; ++r) acc[r] = 0.f;
#pragma unroll
            for (int kk = 0; kk < 4; ++kk) {
                const bf16x8 a = *(const bf16x8*)&sm.alo[mat][(lane & 31) * GM_LD + kk * 16 + 8 * (lane >> 5)];
                acc = __builtin_amdgcn_mfma_f32_32x32x16_bf16(a, bfrag[kk], acc, 0, 0, 0);
            }
            const int n = ct * 32 + (lane & 31);
            const float bias = mat ? PAR(PAR_A0)[d * 512 + h * 64 + n] : PAR(PAR_W0)[d * 512 + h * 64 + n];
#pragma unroll
            for (int r = 0; r < 16; ++r) {
                const int j = (r & 3) + 8 * (r >> 2) + 4 * (lane >> 5);
                const float x = acc[r] + bias;
                if (mat == 0) {
                    const float nx = -x;
                    const float sp = fmaxf(nx, 0.f) + log1pf(__expf(-fabsf(nx)));
                    const float wlog = -sp - 0.5f;
                    sm.dec[j][n] = __expf(-__expf(wlog));
                } else {
                    sm.bb[j][n] = sigmoidf_(x);
                }
            }
        }
        __syncthreads();
        {
            const int j = tid >> 3, c0 = (tid & 7) * 8;
            float kkr[8], ss = 0.f, bsum = 0.f;
#pragma unroll
            for (int u = 0; u < 8; ++u) {
                const int ch = c0 + u, gc = h * 64 + ch;
                const float kt = sm.kd[j][ch];
                kkr[u] = kt * PAR(PAR_KK)[gc];
                ss += kkr[u] * kkr[u];
                const float a = sm.bb[j][ch];
                const float kdv = kt * (1.f + (a - 1.f) * PAR(PAR_KA)[gc]);
                sm.kd[j][ch] = kdv;
                bsum += sm.rr[j][ch] * kdv * PAR(PAR_RK)[gc];
            }
            ss += __shfl_xor(ss, 1); ss += __shfl_xor(ss, 2); ss += __shfl_xor(ss, 4);
            bsum += __shfl_xor(bsum, 1); bsum += __shfl_xor(bsum, 2); bsum += __shfl_xor(bsum, 4);
            const float rn = rsqrtf(ss + 1e-12f);
#pragma unroll
            for (int u = 0; u < 8; ++u) {
                const int ch = c0 + u;
                const float kk = kkr[u] * rn;
                const float a = sm.bb[j][ch];
                sm.aa[j][ch] = -kk;
                sm.bb[j][ch] = kk * a;
            }
            if (q == 0 && (tid & 7) == 0) {
                const int s = d ? (s0 + RW_CH - 1 - j) : (s0 + j);
                bon[((size_t)b * SS + s) * 16 + h * 2 + d] = bsum;
            }
        }
        __syncthreads();
#pragma unroll 4
        for (int j = 0; j < RW_CH; ++j) {
            const float4 w4 = *(const float4*)&sm.dec[j][kseg * 4];
            const float4 a4 = *(const float4*)&sm.aa[j][kseg * 4];
            const float4 b4 = *(const float4*)&sm.bb[j][kseg * 4];
            const float4 k4 = *(const float4*)&sm.kd[j][kseg * 4];
            const float4 r4 = *(const float4*)&sm.rr[j][kseg * 4];
            const float vj = sm.vv[j][rowl];
            float sa = S0 * a4.x + S1 * a4.y + S2 * a4.z + S3 * a4.w;
            sa = row16_sum(sa);
            S0 = S0 * w4.x + sa * b4.x + vj * k4.x;
            S1 = S1 * w4.y + sa * b4.y + vj * k4.y;
            S2 = S2 * w4.z + sa * b4.z + vj * k4.z;
            S3 = S3 * w4.w + sa * b4.w + vj * k4.w;
            float y = S0 * r4.x + S1 * r4.y + S2 * r4.z + S3 * r4.w;
            y = row16_sum(y);
            if (kseg == 0) sm.yo[j][rowl] = y;
        }
        __syncthreads();
        if (tid < RW_CH * 4) {
            const int j = tid >> 2, c4 = (tid & 3) * 4;
            const int s = d ? (s0 + RW_CH - 1 - j) : (s0 + j);
            uint2 o; o.x = pack2(sm.yo[j][c4], sm.yo[j][c4 + 1]); o.y = pack2(sm.yo[j][c4 + 2], sm.yo[j][c4 + 3]);
            *(uint2*)&yb[((size_t)b * SS + s) * 512 + h * 64 + q * 16 + c4] = o;
        }
    }
}

struct EpiGlu {
    const bf16_t* ya; const float* bglu; bf16_t* mix; int m0, n0;
    __device__ void operator()(const float* Cs, int pass, int tid) const {
#pragma unroll
        for (int i = 0; i < 4; ++i) {
            const int c = tid + 256 * i, row = c >> 4, col8 = (c & 15) * 8;
            const int R = m0 + pass * 64 + row, col = n0 + col8;
            const uint4 yv = *(const uint4*)&ya[(size_t)R * 256 + col];
            const unsigned yu[4] = {yv.x, yv.y, yv.z, yv.w};
            unsigned o[4];
#pragma unroll
            for (int u = 0; u < 4; ++u) {
                const float y0 = bflo(yu[u]), y1 = bfhi(yu[u]);
                const float g0 = sigmoidf_(Cs[row * CS_LD + col8 + 2 * u] + bglu[col + 2 * u]);
                const float g1 = sigmoidf_(Cs[row * CS_LD + col8 + 2 * u + 1] + bglu[col + 2 * u + 1]);
                o[u] = pack2(y0 * g0, y1 * g1);
            }
            *(uint4*)&mix[(size_t)R * 768 + col] = make_uint4(o[0], o[1], o[2], o[3]);
        }
    }
};
__device__ void phase_glu(const W p, unsigned char* smem, int bid, int nblk) {
    LdBf16 al{WSP(bf16_t, WS_YA), 256};
    LdBf16 bl{WSP(bf16_t, WS_WGLUT), 256};
    for (int t = bid; t < (NTOK / 128) * 2; t += nblk) {
        const int m0 = (t >> 1) * 128, n0 = (t & 1) * 128;
        EpiGlu epi{WSP(bf16_t, WS_YA), PAR(PAR_BGLU), WSP(bf16_t, WS_MIX), m0, n0};
        gemm_tile(al, bl, 256, m0, n0, epi, smem);
    }
}
__device__ __forceinline__ void zx0_shift8(const bf16_t* zx, const float* mu, int R, int col, float (&o)[8]) {
    const int s = R % SS;
    const bool hp = (s != 0) && (s != LC), hn = (s != LC - 1) && (s != SS - 1);
    const uint4 z = *(const uint4*)&zx[(size_t)R * ZW0 + col];
    uint4 zp = make_uint4(0, 0, 0, 0), zn = make_uint4(0, 0, 0, 0);
    if (hp) zp = *(const uint4*)&zx[(size_t)(R - 1) * ZW0 + col];
    if (hn) zn = *(const uint4*)&zx[(size_t)(R + 1) * ZW0 + col];
    const unsigned zu[4] = {z.x, z.y, z.z, z.w}, pu[4] = {zp.x, zp.y, zp.z, zp.w}, nu[4] = {zn.x, zn.y, zn.z, zn.w};
    const int mc = col - 256;
#pragma unroll
    for (int u = 0; u < 4; ++u) {
        const float a0 = bflo(zu[u]), a1 = bfhi(zu[u]);
        o[2 * u]     = a0 + mu[mc + 2 * u] * (bflo(pu[u]) - a0) + mu[1920 + mc + 2 * u] * (bflo(nu[u]) - a0);
        o[2 * u + 1] = a1 + mu[mc + 2 * u + 1] * (bfhi(pu[u]) - a1) + mu[1920 + mc + 2 * u + 1] * (bfhi(nu[u]) - a1);
    }
}
struct LdGlo {
    const bf16_t* zx; const float* mu;
    typedef int RowCtx;
    __device__ RowCtx row(int R) const { return R; }
    __device__ uint4 load8(RowCtx R, int k) const {
        float v[8]; zx0_shift8(zx, mu, R, 2048 + k, v);
        uint4 o; o.x = pack2(sigmoidf_(v[0]), sigmoidf_(v[1])); o.y = pack2(sigmoidf_(v[2]), sigmoidf_(v[3]));
        o.z = pack2(sigmoidf_(v[4]), sigmoidf_(v[5])); o.w = pack2(sigmoidf_(v[6]), sigmoidf_(v[7]));
        return o;
    }
};
struct EpiRwkvOut {
    const bf16_t* yb0; const bf16_t* yb1; const float* bon; const bf16_t* zx; const float* mu; const float* gnw; const float* gnb; bf16_t* mix; int m0, n0;
    __device__ void operator()(const float* Cs, int pass, int tid) const {
        const int row = tid >> 2, cg = tid & 3;
        const int R = m0 + pass * 64 + row, col0 = n0 + cg * 32, head = col0 >> 6;
        float y[32], sum = 0.f, sq = 0.f;
#pragma unroll
        for (int c8 = 0; c8 < 4; ++c8) {
            const uint4 a = *(const uint4*)&yb0[(size_t)R * 512 + col0 + c8 * 8], b = *(const uint4*)&yb1[(size_t)R * 512 + col0 + c8 * 8];
            const unsigned au[4] = {a.x, a.y, a.z, a.w}, bu[4] = {b.x, b.y, b.z, b.w};
#pragma unroll
            for (int u = 0; u < 4; ++u) {
                y[c8 * 8 + 2 * u] = bflo(au[u]) + bflo(bu[u]);
                y[c8 * 8 + 2 * u + 1] = bfhi(au[u]) + bfhi(bu[u]);
            }
        }
#pragma unroll
        for (int u = 0; u < 32; ++u) sum += y[u];
        sum += __shfl_xor(sum, 1);
        const float mean = sum * (1.f / 64.f);
#pragma unroll
        for (int u = 0; u < 32; ++u) { const float dlt = y[u] - mean; sq += dlt * dlt; }
        sq += __shfl_xor(sq, 1);
        const float rs = rsqrtf(sq * (1.f / 64.f) + 64e-5f);
        const float bc = bon[(size_t)R * 16 + head * 2] + bon[(size_t)R * 16 + head * 2 + 1];
#pragma unroll
        for (int c8 = 0; c8 < 4; ++c8) {
            float v[8]; zx0_shift8(zx, mu, R, 1280 + col0 + c8 * 8, v);
            unsigned o[4];
#pragma unroll
            for (int u = 0; u < 4; ++u) {
                const int c = col0 + c8 * 8 + 2 * u;
                const float g0 = Cs[row * CS_LD + cg * 32 + c8 * 8 + 2 * u], g1 = Cs[row * CS_LD + cg * 32 + c8 * 8 + 2 * u + 1];
                const float o0 = ((y[c8 * 8 + 2 * u] - mean) * rs * gnw[c] + gnb[c] + bc * v[2 * u]) * g0;
                const float o1 = ((y[c8 * 8 + 2 * u + 1] - mean) * rs * gnw[c + 1] + gnb[c + 1] + bc * v[2 * u + 1]) * g1;
                o[u] = pack2(o0, o1);
            }
            *(uint4*)&mix[(size_t)R * 768 + 256 + col0 + c8 * 8] = make_uint4(o[0], o[1], o[2], o[3]);
        }
    }
};
__device__ void phase_rwkv_out(const W p, unsigned char* smem, int bid, int nblk) {
    LdGlo al{WSP(bf16_t, WS_ZX), PAR(PAR_SHIFT)};
    LdBf16 bl{WSP(bf16_t, WS_G2T), 128};
    for (int t = bid; t < (NTOK / 128) * 4; t += nblk) {
        const int m0 = (t >> 2) * 128, n0 = (t & 3) * 128;
        EpiRwkvOut epi{WSP(bf16_t, WS_YB), WSP(bf16_t, WS_YB) + (size_t)NTOK * 512, WSP(float, WS_BON), WSP(bf16_t, WS_ZX), PAR(PAR_SHIFT),
                       PAR(PAR_GNW), PAR(PAR_GNB), WSP(bf16_t, WS_MIX), m0, n0};
        gemm_tile(al, bl, 128, m0, n0, epi, smem);
    }
}

__device__ void phase_gemm_wout(const W p, unsigned char* smem, int bid, int nblk, int layer) {
    const int K = layer ? 1024 : 768;
    LdBf16 al{WSP(bf16_t, WS_MIX), K};
    LdBf16 bl{WSP(bf16_t, layer ? WS_WOUT1T : WS_WOUT0T), K};
    const int total = (NTOK / 128) * 8;
    for (int t = bid; t < total; t += nblk) {
        const int m0 = (t >> 3) * 128, n0 = (t & 7) * 128;
        if (layer && (m0 % SS) < LC) continue;
        EpiStoreF32 epi{WSP(float, WS_ZX), 1024, m0, n0, NTOK};
        gemm_tile(al, bl, K, m0, n0, epi, smem);
    }
}

__device__ __forceinline__ void ln_row_store(float (&v)[16], const float* g, const float* bta, float* dst, int lane) {
    float s = 0.f;
#pragma unroll
    for (int i = 0; i < 16; ++i) s += v[i];
    const float mean = wave_sum(s) * (1.f / 1024.f);
    float q = 0.f;
#pragma unroll
    for (int i = 0; i < 16; ++i) { const float dl = v[i] - mean; q += dl * dl; }
    const float rs = rsqrtf(wave_sum(q) * (1.f / 1024.f) + 1e-5f);
#pragma unroll
    for (int i = 0; i < 4; ++i) {
        const int k = i * 256 + lane * 4;
        const float4 gg = *(const float4*)&g[k], bb = *(const float4*)&bta[k];
        float4 o;
        o.x = (v[4 * i] - mean) * rs * gg.x + bb.x; o.y = (v[4 * i + 1] - mean) * rs * gg.y + bb.y;
        o.z = (v[4 * i + 2] - mean) * rs * gg.z + bb.z; o.w = (v[4 * i + 3] - mean) * rs * gg.w + bb.w;
        *(float4*)&dst[k] = o;
    }
}
__device__ void phase_ln1(const W p, int gwave, int nwaves, int layer) {
    const int lane = threadIdx.x & 63;
    const float* yx = WSP(float, WS_ZX);
    const float* mod = WSP(float, WS_MOD) + (size_t)layer * 5 * 6144;
    const float* g = PAR(layer ? PAR_LN1G1 : PAR_LN1G0);
    const float* bt = PAR(layer ? PAR_LN1B1 : PAR_LN1B0);
    const float* xlat = layer ? p.out : p.x;
    const float* xctx = layer ? WSP(float, WS_CTX) : p.ctx;
    for (int R = gwave; R < NTOK; R += nwaves) {
        const int b = R / SS, s = R - b * SS;
        if (layer && s < LC) continue;
        const float* src; float* dst; const float* m;
        if (s < LC) { src = xctx + ((size_t)(b * LC + s)) * DM; dst = WSP(float, WS_CTX) + ((size_t)(b * LC + s)) * DM; m = mod + 4 * 6144 + 2048; }
        else        { src = xlat + ((size_t)(b * TT + s - LC)) * DM; dst = p.out + ((size_t)(b * TT + s - LC)) * DM; m = mod + b * 6144 + 2048; }
        float v[16];
#pragma unroll
        for (int i = 0; i < 4; ++i) {
            const int k = i * 256 + lane * 4;
            const float4 x4 = *(const float4*)&src[k], y4 = *(const float4*)&yx[(size_t)R * 1024 + k], g4 = *(const float4*)&m[k];
            v[4 * i] = ALPHA_F * x4.x + g4.x * y4.x; v[4 * i + 1] = ALPHA_F * x4.y + g4.y * y4.y;
            v[4 * i + 2] = ALPHA_F * x4.z + g4.z * y4.z; v[4 * i + 3] = ALPHA_F * x4.w + g4.w * y4.w;
        }
        ln_row_store(v, g, bt, dst, lane);
    }
}

__device__ void phase_gemm_q(const W p, unsigned char* smem, int bid, int nblk, int layer) {
    LdXMod al{p.out, WSP(float, WS_CTX), WSP(float, WS_MOD) + (size_t)layer * 5 * 6144, 3072, 4096};
    LdBf16 bl{WSP(bf16_t, layer ? WS_WQ1T : WS_WQ0T), 1024};
    const int total = (NTOK / 128) * 8;
    for (int t = bid; t < total; t += nblk) {
        const int m0 = (t >> 3) * 128, n0 = (t & 7) * 128;
        if (layer && (m0 % SS) < LC) continue;
        EpiStoreBf16 epi{WSP(bf16_t, WS_YB), 1024, m0, n0, NTOK};
        gemm_tile(al, bl, 1024, m0, n0, epi, smem);
    }
}

#define NEG_BIG (-3.0e38f)
#define TOPK_SMEM_BYTES (4 * (16 * 132 + 16 * 64) * 4)
__device__ void peer_topk_item(const W p, int item, unsigned char* smem, int layer) {
    const int tile = item >> 3, h = item & 7;
    const int tid = threadIdx.x, lane = tid & 63, wave = tid >> 6;
    const int R0 = tile * 64 + wave * 16;
    const bf16_t* Q = WSP(bf16_t, WS_YB);
    const bf16_t* keys = WSP(bf16_t, layer ? WS_KEYS1 : WS_KEYS0);
    float* sc = (float*)smem + wave * (16 * 132 + 16 * 64);
    float* res = sc + 16 * 132;
    int* idxo = WSP(int, WS_IDX);
    float* gato = WSP(float, WS_GATE);
    for (int c = 0; c < 2; ++c) {
        f32x4 acc[8];
#pragma unroll
        for (int nt = 0; nt < 8; ++nt) acc[nt] = (f32x4){0.f, 0.f, 0.f, 0.f};
#pragma unroll
        for (int kk = 0; kk < 2; ++kk) {
            const bf16x8 a = *(const bf16x8*)&Q[(size_t)(R0 + (lane & 15)) * 1024 + h * 128 + c * 64 + kk * 32 + 8 * (lane >> 4)];
#pragma unroll
            for (int nt = 0; nt < 8; ++nt) {
                const bf16x8 bq = *(const bf16x8*)&keys[(size_t)((h * 2 + c) * 128 + nt * 16 + (lane & 15)) * 64 + kk * 32 + 8 * (lane >> 4)];
                acc[nt] = __builtin_amdgcn_mfma_f32_16x16x32_bf16(a, bq, acc[nt], 0, 0, 0);
            }
        }
#pragma unroll
        for (int nt = 0; nt < 8; ++nt)
#pragma unroll
            for (int r = 0; r < 4; ++r) sc[((lane >> 4) * 4 + r) * 132 + nt * 16 + (lane & 15)] = acc[nt][r];
        for (int t = 0; t < 16; ++t) {
            float v0 = sc[t * 132 + lane], v1 = sc[t * 132 + 64 + lane];
            float tv = 0.f; int ti = 0;
            for (int it = 0; it < 16; ++it) {
                const float m = wave_max(fmaxf(v0, v1));
                const unsigned long long bal = __ballot(v0 == m || v1 == m);
                const int wl = __ffsll((long long)bal) - 1;
                const int myidx = (v0 == m) ? lane : lane + 64;
                const int widx = __builtin_amdgcn_readlane(myidx, wl);
                if (lane == wl) { if (v0 == m) v0 = NEG_BIG; else v1 = NEG_BIG; }
                if (lane == it) { tv = m; ti = widx; }
            }
            if (lane < 16) { res[t * 64 + c * 32 + lane] = tv; ((int*)res)[t * 64 + c * 32 + 16 + lane] = ti; }
        }
    }
    for (int t = 0; t < 16; ++t) {
        const int R = R0 + t;
        const float a1 = res[t * 64 + (lane & 15)];
        const int   j1 = ((const int*)res)[t * 64 + 16 + (lane & 15)];
        const float a2 = res[t * 64 + 32 + (lane & 15)];
        const int   j2 = ((const int*)res)[t * 64 + 48 + (lane & 15)];
        float cv[4];
#pragma unroll
        for (int mm = 0; mm < 4; ++mm) cv[mm] = __shfl(a1, (lane >> 4) + 4 * mm) + a2;
        float tv = 0.f; int tn = 0;
        for (int it = 0; it < 16; ++it) {
            const float lm = fmaxf(fmaxf(cv[0], cv[1]), fmaxf(cv[2], cv[3]));
            const float m = wave_max(lm);
            const unsigned long long bal = __ballot(lm == m);
            const int wl = __ffsll((long long)bal) - 1;
            const int mysel = (cv[0] == m) ? 0 : (cv[1] == m) ? 1 : (cv[2] == m) ? 2 : 3;
            const int wsel = __builtin_amdgcn_readlane(mysel, wl);
            if (lane == wl) { if (wsel == 0) cv[0] = NEG_BIG; else if (wsel == 1) cv[1] = NEG_BIG; else if (wsel == 2) cv[2] = NEG_BIG; else cv[3] = NEG_BIG; }
            if (lane == it) { tv = m; tn = wl + 64 * wsel; }
        }
        const int e1 = __shfl(j1, tn >> 4), e2 = __shfl(j2, tn & 15);
        const float mx = __shfl(tv, 0);
        const float ex = (lane < 16) ? __expf(tv - mx) : 0.f;
        const float den = row16_sum(ex);
        if (lane < 16) {
            idxo[(size_t)R * 128 + h * 16 + lane] = e1 * 128 + e2;
            gato[(size_t)R * 128 + h * 16 + lane] = ex / den;
        }
    }
}

__device__ void phase_peer_gather(const W p, int gwave, int nwaves, int layer) {
    const int lane = threadIdx.x & 63;
    const float* mod = WSP(float, WS_MOD) + (size_t)layer * 5 * 6144;
    const bf16_t* U = WSP(bf16_t, layer ? WS_TABU1 : WS_TABU0);
    const bf16_t* V = WSP(bf16_t, layer ? WS_TABV1 : WS_TABV0);
    const int* idxo = WSP(int, WS_IDX);
    const float* gato = WSP(float, WS_GATE);
    const float* g = PAR(layer ? PAR_LN2G1 : PAR_LN2G0);
    const float* bt = PAR(layer ? PAR_LN2B1 : PAR_LN2B0);
    for (int R = gwave; R < NTOK; R += nwaves) {
        const int b = R / SS, s = R - b * SS;
        if (layer && s < LC) continue;
        float* xrow; const float* m;
        if (s < LC) { xrow = WSP(float, WS_CTX) + ((size_t)(b * LC + s)) * DM; m = mod + 4 * 6144; }
        else        { xrow = p.out + ((size_t)(b * TT + s - LC)) * DM; m = mod + b * 6144; }
        float x[16], hh[16], o[16];
#pragma unroll
        for (int i = 0; i < 2; ++i)
#pragma unroll
            for (int q4 = 0; q4 < 2; ++q4) {
                const int k = i * 512 + lane * 8 + q4 * 4;
                const float4 xv = *(const float4*)&xrow[k], sc = *(const float4*)&m[4096 + k], sh = *(const float4*)&m[3072 + k];
                x[i * 8 + q4 * 4 + 0] = xv.x; x[i * 8 + q4 * 4 + 1] = xv.y; x[i * 8 + q4 * 4 + 2] = xv.z; x[i * 8 + q4 * 4 + 3] = xv.w;
                hh[i * 8 + q4 * 4 + 0] = xv.x * (1.f + sc.x) + sh.x; hh[i * 8 + q4 * 4 + 1] = xv.y * (1.f + sc.y) + sh.y;
                hh[i * 8 + q4 * 4 + 2] = xv.z * (1.f + sc.z) + sh.z; hh[i * 8 + q4 * 4 + 3] = xv.w * (1.f + sc.w) + sh.w;
            }
#pragma unroll
        for (int i = 0; i < 16; ++i) o[i] = 0.f;
        const int ia = idxo[(size_t)R * 128 + lane], ib = idxo[(size_t)R * 128 + 64 + lane];
        const float ga = gato[(size_t)R * 128 + lane], gb = gato[(size_t)R * 128 + 64 + lane];
#pragma unroll 4
        for (int e = 0; e < 128; ++e) {
            const int id = (e < 64) ? __builtin_amdgcn_readlane(ia, e & 63) : __builtin_amdgcn_readlane(ib, e & 63);
            const float gt = __builtin_bit_cast(float, (e < 64) ? __builtin_amdgcn_readlane(__builtin_bit_cast(int, ga), e & 63)
                                                                : __builtin_amdgcn_readlane(__builtin_bit_cast(int, gb), e & 63));
            const uint4 u0 = *(const uint4*)&U[(size_t)id * 1024 + lane * 8], u1 = *(const uint4*)&U[(size_t)id * 1024 + 512 + lane * 8];
            const uint4 v0 = *(const uint4*)&V[(size_t)id * 1024 + lane * 8], v1 = *(const uint4*)&V[(size_t)id * 1024 + 512 + lane * 8];
            float d = 0.f;
            d += hh[0] * bflo(u0.x) + hh[1] * bfhi(u0.x) + hh[2] * bflo(u0.y) + hh[3] * bfhi(u0.y);
            d += hh[4] * bflo(u0.z) + hh[5] * bfhi(u0.z) + hh[6] * bflo(u0.w) + hh[7] * bfhi(u0.w);
            d += hh[8] * bflo(u1.x) + hh[9] * bfhi(u1.x) + hh[10] * bflo(u1.y) + hh[11] * bfhi(u1.y);
            d += hh[12] * bflo(u1.z) + hh[13] * bfhi(u1.z) + hh[14] * bflo(u1.w) + hh[15] * bfhi(u1.w);
            d = wave_sum(d);
            const float w = gt * geluf_(d);
            o[0] += w * bflo(v0.x); o[1] += w * bfhi(v0.x); o[2] += w * bflo(v0.y); o[3] += w * bfhi(v0.y);
            o[4] += w * bflo(v0.z); o[5] += w * bfhi(v0.z); o[6] += w * bflo(v0.w); o[7] += w * bfhi(v0.w);
            o[8] += w * bflo(v1.x); o[9] += w * bfhi(v1.x); o[10] += w * bflo(v1.y); o[11] += w * bfhi(v1.y);
            o[12] += w * bflo(v1.z); o[13] += w * bfhi(v1.z); o[14] += w * bflo(v1.w); o[15] += w * bfhi(v1.w);
        }
        float vsum = 0.f;
#pragma unroll
        for (int i = 0; i < 2; ++i)
#pragma unroll
            for (int q4 = 0; q4 < 2; ++q4) {
                const int k = i * 512 + lane * 8 + q4 * 4;
                const float4 g2 = *(const float4*)&m[5120 + k];
                o[i * 8 + q4 * 4 + 0] = ALPHA_F * x[i * 8 + q4 * 4 + 0] + g2.x * o[i * 8 + q4 * 4 + 0];
                o[i * 8 + q4 * 4 + 1] = ALPHA_F * x[i * 8 + q4 * 4 + 1] + g2.y * o[i * 8 + q4 * 4 + 1];
                o[i * 8 + q4 * 4 + 2] = ALPHA_F * x[i * 8 + q4 * 4 + 2] + g2.z * o[i * 8 + q4 * 4 + 2];
                o[i * 8 + q4 * 4 + 3] = ALPHA_F * x[i * 8 + q4 * 4 + 3] + g2.w * o[i * 8 + q4 * 4 + 3];
            }
#pragma unroll
        for (int i = 0; i < 16; ++i) vsum += o[i];
        const float mean = wave_sum(vsum) * (1.f / 1024.f);
        float vq = 0.f;
#pragma unroll
        for (int i = 0; i < 16; ++i) { const float dl = o[i] - mean; vq += dl * dl; }
        const float rs = rsqrtf(wave_sum(vq) * (1.f / 1024.f) + 1e-5f);
#pragma unroll
        for (int i = 0; i < 2; ++i)
#pragma unroll
            for (int q4 = 0; q4 < 2; ++q4) {
                const int k = i * 512 + lane * 8 + q4 * 4;
                const float4 gg = *(const float4*)&g[k], bb = *(const float4*)&bt[k];
                float4 r;
                r.x = (o[i * 8 + q4 * 4 + 0] - mean) * rs * gg.x + bb.x; r.y = (o[i * 8 + q4 * 4 + 1] - mean) * rs * gg.y + bb.y;
                r.z = (o[i * 8 + q4 * 4 + 2] - mean) * rs * gg.z + bb.z; r.w = (o[i * 8 + q4 * 4 + 3] - mean) * rs * gg.w + bb.w;
                *(float4*)&xrow[k] = r;
            }
    }
}

constexpr size_t WS_ROPE = WS_END;
static_assert(WS_ROPE + 16384 <= (size_t)536870912, "rope table fits");
__device__ void phase_rope_table(const P& p, size_t gtid, size_t gthreads) {
    float* rt = WSP(float, WS_ROPE);
    for (size_t e = gtid; e < 128 * 16; e += gthreads) {
        const int i = (int)(e & 15), pos = (int)(e >> 4);
        const float freq = powf(10000.f, -(float)i / 16.f);
        const float ang = (float)pos * freq;
        rt[e * 2] = cosf(ang); rt[e * 2 + 1] = sinf(ang);
    }
}
struct EpiZX1 {
    bf16_t* zx; bf16_t* vt; const float* rope; int m0, n0;
    __device__ void operator()(const float* Cs, int pass, int tid) const {
        const int Rb = m0 + pass * 64;
        const int b = Rb / SS, sb = Rb - b * SS;
        const bool isv = (n0 == 640) || (n0 >= 1792);
        if (isv) {
            const int hv0 = (n0 == 640) ? 0 : 2 + (n0 - 1792) / 64;
#pragma unroll
            for (int i = 0; i < 4; ++i) {
                const int c = tid + 256 * i, col = c >> 3, r8 = (c & 7) * 8;
                float v[8];
#pragma unroll
                for (int u = 0; u < 8; ++u) v[u] = Cs[(r8 + u) * CS_LD + col];
                uint4 o; o.x = pack2(v[0], v[1]); o.y = pack2(v[2], v[3]); o.z = pack2(v[4], v[5]); o.w = pack2(v[6], v[7]);
                *(uint4*)&vt[((size_t)(b * 10 + hv0 + (col >> 6)) * 64 + (col & 63)) * SS + sb + r8] = o;
            }
            return;
        }
        const bool dorope = (n0 < 640) && (sb >= LC);
#pragma unroll
        for (int i = 0; i < 4; ++i) {
            const int c = tid + 256 * i, row = c >> 4, col8 = (c & 15) * 8;
            const int R = Rb + row;
            float v[8];
            const float4 a = *(const float4*)&Cs[row * CS_LD + col8], bq = *(const float4*)&Cs[row * CS_LD + col8 + 4];
            v[0] = a.x; v[1] = a.y; v[2] = a.z; v[3] = a.w; v[4] = bq.x; v[5] = bq.y; v[6] = bq.z; v[7] = bq.w;
            if (dorope) {
                const int t = sb + row - LC;
                const int e0 = col8 & 31, half = (col8 >> 5) & 1;
                const int pos = half ? (t & 63) : (t >> 6);
                const bool lo = e0 < 16;
                const int pc = lo ? col8 + 16 : col8 - 16;
                const float4 pa = *(const float4*)&Cs[row * CS_LD + pc], pb = *(const float4*)&Cs[row * CS_LD + pc + 4];
                const float pv[8] = {pa.x, pa.y, pa.z, pa.w, pb.x, pb.y, pb.z, pb.w};
#pragma unroll
                for (int u = 0; u < 8; ++u) {
                    const int fi = (e0 & 15) + u;
                    const float cs = rope[(pos * 16 + fi) * 2], sn = rope[(pos * 16 + fi) * 2 + 1];
                    v[u] = lo ? (v[u] * cs - pv[u] * sn) : (v[u] * cs + pv[u] * sn);
                }
            }
            uint4 o; o.x = pack2(v[0], v[1]); o.y = pack2(v[2], v[3]); o.z = pack2(v[4], v[5]); o.w = pack2(v[6], v[7]);
            *(uint4*)&zx[(size_t)R * ZW1 + n0 + col8] = o;
        }
    }
};
__device__ void phase_gemm_win1(const W p, unsigned char* smem, int bid, int nblk) {
    LdXMod al{p.out, WSP(float, WS_CTX), WSP(float, WS_MOD) + (size_t)5 * 6144, 0, 1024};
    LdBf16 bl{WSP(bf16_t, WS_WIN1T), 1024};
    const int ntn = ZW1 / 128, total = (NTOK / 128) * ntn;
    for (int t = bid; t < total; t += nblk) {
        const int m0 = (t / ntn) * 128, n0 = (t % ntn) * 128;
        EpiZX1 epi{WSP(bf16_t, WS_ZX), WSP(bf16_t, WS_VT), WSP(float, WS_ROPE), m0, n0};
        gemm_tile(al, bl, 1024, m0, n0, epi, smem);
    }
}

#define AT_LD 72
#define ATTN_SMEM_BYTES (2 * 64 * AT_LD * 2)
#define MASK_NEG (-1.0e30f)
__device__ void attn_item(const W p, int item, unsigned char* smem) {
    const int qt = item & 63, hq = (item >> 6) & 7, b = (item >> 9) & 3, kind = item >> 11;
    const int tid = threadIdx.x, lane = tid & 63, wave = tid >> 6, hh = lane >> 5, ql = lane & 31;
    bf16_t* Ks = (bf16_t*)smem;
    bf16_t* Vs = Ks + 64 * AT_LD;
    const bf16_t* zx = WSP(bf16_t, WS_ZX);
    const int t0 = qt * 128;
    const int qcol = kind ? 768 + hq * 64 : hq * 64;
    const int kcol = kind ? 1280 + hq * 64 : 512 + (hq >> 2) * 64;
    const bf16_t* vt = WSP(bf16_t, WS_VT) + ((size_t)(b * 10 + (kind ? 2 + hq : (hq >> 2))) * 64) * SS;
    const int ocol = kind ? 512 + hq * 64 : hq * 64;
    const int tq = t0 + wave * 32 + ql;
    const size_t Rq = (size_t)b * SS + LC + tq;
    bf16x8 qf[4];
#pragma unroll
    for (int st = 0; st < 4; ++st) qf[st] = *(const bf16x8*)&zx[Rq * ZW1 + qcol + st * 16 + 8 * hh];
    int lk0, lk1;
    const int r0 = t0 >> 6;
    if (kind == 0) { lk0 = t0 - 128 < 0 ? 0 : t0 - 128; lk1 = t0 + 256 > TT ? TT : t0 + 256; }
    else {
        int rs0 = r0 - 4; rs0 = rs0 < 0 ? 0 : (rs0 > 120 ? 120 : rs0);
        int rs1 = r0 + 1 - 4; rs1 = rs1 < 0 ? 0 : (rs1 > 120 ? 120 : rs1);
        lk0 = rs0 * 64; lk1 = (rs1 + 8) * 64;
    }
    const int nloc = (lk1 - lk0) >> 6;
    const int rq = tq >> 6, cq = tq & 63;
    int rsq = rq - 4; rsq = rsq < 0 ? 0 : (rsq > 120 ? 120 : rsq);
    int csq = cq - 8; csq = csq < 0 ? 0 : (csq > 48 ? 48 : csq);
    const float* rpb = PAR(PAR_RPB) + (size_t)hq * 15 * 31;
    float m = MASK_NEG, l = 0.f;
    f32x16 oacc[2];
#pragma unroll
    for (int r = 0; r < 16; ++r) { oacc[0][r] = 0.f; oacc[1][r] = 0.f; }
    for (int ti = 0; ti < 4 + nloc; ++ti) {
        const bool isctx = ti < 4;
        const int sbase = isctx ? ti * 64 : LC + lk0 + (ti - 4) * 64;
        __syncthreads();
        for (int c = tid; c < 512; c += 256) {
            const int rr = c >> 3, c8 = (c & 7) * 8;
            *(uint4*)&Ks[rr * AT_LD + c8] = *(const uint4*)&zx[((size_t)b * SS + sbase + rr) * ZW1 + kcol + c8];
            *(uint4*)&Vs[rr * AT_LD + c8] = *(const uint4*)&vt[(size_t)rr * SS + sbase + c8];
        }
        __syncthreads();
        const int tk0 = sbase - LC;
        const int kr = tk0 >> 6;
        if (!isctx && kind == 1) {
            const int rqw = (t0 + wave * 32) >> 6;
            int rsw = rqw - 4; rsw = rsw < 0 ? 0 : (rsw > 120 ? 120 : rsw);
            if (kr < rsw || kr >= rsw + 8) continue;
        }
#pragma unroll
        for (int sub = 0; sub < 2; ++sub) {
            f32x16 sacc;
#pragma unroll
            for (int r = 0; r < 16; ++r) sacc[r] = 0.f;
#pragma unroll
            for (int st = 0; st < 4; ++st) {
                const bf16x8 kf = *(const bf16x8*)&Ks[(sub * 32 + ql) * AT_LD + st * 16 + 8 * hh];
                sacc = __builtin_amdgcn_mfma_f32_32x32x16_bf16(kf, qf[st], sacc, 0, 0, 0);
            }
            float sv[16], smax = MASK_NEG;
#pragma unroll
            for (int r = 0; r < 16; ++r) {
                const int key = sub * 32 + (r & 3) + 8 * (r >> 2) + 4 * hh;
                float x = sacc[r] * 0.125f;
                if (!isctx) {
                    if (kind == 0) { const int dlt = tk0 + key - tq; if (dlt > 128 || dlt < -128) x = MASK_NEG; }
                    else {
                        if (key < csq || key >= csq + 16) x = MASK_NEG;
                        else x += rpb[(kr - rq + 7) * 31 + (key - cq + 15)];
                    }
                }
                sv[r] = x; smax = fmaxf(smax, x);
            }
            smax = half_swap_max(smax);
            const float mn = fmaxf(m, smax);
            const float alpha = __expf(m - mn);
            m = mn;
            float ps = 0.f;
#pragma unroll
            for (int r = 0; r < 16; ++r) { sv[r] = __expf(sv[r] - mn); ps += sv[r]; }
            l = l * alpha + ps;
#pragma unroll
            for (int r = 0; r < 16; ++r) { oacc[0][r] *= alpha; oacc[1][r] *= alpha; }
#pragma unroll
            for (int s2 = 0; s2 < 2; ++s2) {
                union { bf16x8 v; unsigned u[4]; } pb;
#pragma unroll
                for (int u = 0; u < 4; ++u) pb.u[u] = pack2(sv[8 * s2 + 2 * u], sv[8 * s2 + 2 * u + 1]);
#pragma unroll
                for (int db = 0; db < 2; ++db) {
                    union { bf16x8 v; uint2 h[2]; } vf;
                    const bf16_t* vrow = &Vs[(db * 32 + ql) * AT_LD + sub * 32 + 16 * s2 + 4 * hh];
                    vf.h[0] = *(const uint2*)vrow;
                    vf.h[1] = *(const uint2*)(vrow + 8);
                    oacc[db] = __builtin_amdgcn_mfma_f32_32x32x16_bf16(vf.v, pb.v, oacc[db], 0, 0, 0);
                }
            }
        }
    }
    float lt = half_swap_sum(l);
    if (kind == 0) lt += __expf(PAR(PAR_SINK)[hq] - m);
    const float inv = 1.f / lt;
    bf16_t* mix = WSP(bf16_t, WS_MIX);
#pragma unroll
    for (int db = 0; db < 2; ++db)
#pragma unroll
        for (int g4 = 0; g4 < 4; ++g4) {
            const int dd = db * 32 + 8 * g4 + 4 * hh;
            uint2 o; o.x = pack2(oacc[db][4 * g4] * inv, oacc[db][4 * g4 + 1] * inv); o.y = pack2(oacc[db][4 * g4 + 2] * inv, oacc[db][4 * g4 + 3] * inv);
            *(uint2*)&mix[Rq * 1024 + ocol + dd] = o;
        }
}

enum { PH_TRANSPOSE = 0, PH_CONVERT, PH_MODP, PH_MISC, PH_S5TAB, PH_WIN0, PH_S5E, PH_S5CARRY, PH_S5Y, PH_RWKV, PH_GLU, PH_RWKVOUT,
       PH_WOUT, PH_LN1, PH_QGEMM, PH_TOPK, PH_GATHER, PH_WIN1, PH_ATTN, PH_COUNT };
template <int PH> struct PhaseSmem { static constexpr int bytes = 1024; };
template <> struct PhaseSmem<PH_TRANSPOSE> { static constexpr int bytes = 64 * 65 * 4; };
template <> struct PhaseSmem<PH_WIN0>    { static constexpr int bytes = GEMM_SMEM_BYTES; };
template <> struct PhaseSmem<PH_S5E>     { static constexpr int bytes = GEMM_SMEM_BYTES; };
template <> struct PhaseSmem<PH_S5Y>     { static constexpr int bytes = GEMM_SMEM_BYTES; };
template <> struct PhaseSmem<PH_RWKV>    { static constexpr int bytes = (int)sizeof(RwkvSmem); };
template <> struct PhaseSmem<PH_GLU>     { static constexpr int bytes = GEMM_SMEM_BYTES; };
template <> struct PhaseSmem<PH_RWKVOUT> { static constexpr int bytes = GEMM_SMEM_BYTES; };
template <> struct PhaseSmem<PH_WOUT>    { static constexpr int bytes = GEMM_SMEM_BYTES; };
template <> struct PhaseSmem<PH_QGEMM>   { static constexpr int bytes = GEMM_SMEM_BYTES; };
template <> struct PhaseSmem<PH_TOPK>    { static constexpr int bytes = TOPK_SMEM_BYTES; };
template <> struct PhaseSmem<PH_WIN1>    { static constexpr int bytes = GEMM_SMEM_BYTES; };
template <> struct PhaseSmem<PH_ATTN>    { static constexpr int bytes = ATTN_SMEM_BYTES; };

template <int PH>
__device__ __forceinline__ void run_early(const P& p, unsigned char* smem) {
    const int bid = blockIdx.x, nblk = gridDim.x;
    const size_t gtid = (size_t)bid * 256 + threadIdx.x, gthreads = (size_t)nblk * 256;
    const int gwave = bid * 4 + (threadIdx.x >> 6), nwaves = nblk * 4;
    if constexpr (PH == PH_TRANSPOSE) phase_transpose(p, (float*)smem, bid, nblk);
    else if constexpr (PH == PH_CONVERT) phase_convert(p, gtid, gthreads);
    else if constexpr (PH == PH_MODP) phase_mod_partial(p, gwave, nwaves);
    else if constexpr (PH == PH_MISC) { phase_s5_pow(p, gtid, gthreads); phase_rope_table(p, gtid, gthreads); phase_pack_params(p, gtid, gthreads); }
    else if constexpr (PH == PH_S5TAB) { phase_mod_reduce(p, gtid, gthreads); phase_s5_tables(p, gtid, gthreads); }
}
template <int PH>
__device__ __forceinline__ void run_phase(const W p, int layer, unsigned char* smem) {
    const int bid = blockIdx.x, nblk = gridDim.x;
    const size_t gtid = (size_t)bid * 256 + threadIdx.x, gthreads = (size_t)nblk * 256;
    const int gwave = bid * 4 + (threadIdx.x >> 6), nwaves = nblk * 4;
    if constexpr (PH == PH_WIN0) phase_gemm_win0(p, smem, bid, nblk);
    else if constexpr (PH == PH_S5E) phase_s5_E(p, smem, bid, nblk);
    else if constexpr (PH == PH_S5CARRY) phase_s5_carry(p, gtid, gthreads);
    else if constexpr (PH == PH_S5Y) phase_s5_Y(p, smem, bid, nblk);
    else if constexpr (PH == PH_RWKV) { for (int it = bid; it < 256; it += nblk) rwkv_scan_item(p, it, smem); }
    else if constexpr (PH == PH_GLU) phase_glu(p, smem, bid, nblk);
    else if constexpr (PH == PH_RWKVOUT) phase_rwkv_out(p, smem, bid, nblk);
    else if constexpr (PH == PH_WOUT) phase_gemm_wout(p, smem, bid, nblk, layer);
    else if constexpr (PH == PH_LN1) phase_ln1(p, gwave, nwaves, layer);
    else if constexpr (PH == PH_QGEMM) phase_gemm_q(p, smem, bid, nblk, layer);
    else if constexpr (PH == PH_TOPK) {
        for (int it = bid; it < (NTOK / 64) * 8; it += nblk) { if (layer && ((it >> 3) * 64) % SS < LC) continue; peer_topk_item(p, it, smem, layer); }
    }
    else if constexpr (PH == PH_GATHER) phase_peer_gather(p, gwave, nwaves, layer);
    else if constexpr (PH == PH_WIN1) phase_gemm_win1(p, smem, bid, nblk);
    else if constexpr (PH == PH_ATTN) { for (int it = bid; it < 4096; it += nblk) attn_item(p, it, smem); }
}

namespace cg = cooperative_groups;
constexpr int cmax(int a, int b) { return a > b ? a : b; }
constexpr int MEGA_SMEM = cmax(cmax(GEMM_SMEM_BYTES, (int)sizeof(RwkvSmem)), cmax(TOPK_SMEM_BYTES, ATTN_SMEM_BYTES));

__global__ void __launch_bounds__(256, 2) mega_kernel(P p) {
    __shared__ __attribute__((aligned(16))) unsigned char smem[MEGA_SMEM];
    cg::grid_group grid = cg::this_grid();
    run_early<PH_TRANSPOSE>(p, smem);
    run_early<PH_CONVERT>(p, smem);
    run_early<PH_MODP>(p, smem);
    run_early<PH_MISC>(p, smem);
    grid.sync();
    run_early<PH_S5TAB>(p, smem);
    grid.sync();
    const W w{p.in[I_X], p.in[I_CTX], p.out, p.ws};
    run_phase<PH_WIN0>(w, 0, smem);
    grid.sync();
    run_phase<PH_S5E>(w, 0, smem);
    grid.sync();
    run_phase<PH_RWKV>(w, 0, smem);
    run_phase<PH_S5CARRY>(w, 0, smem);
    grid.sync();
    run_phase<PH_S5Y>(w, 0, smem);
    grid.sync();
    run_phase<PH_GLU>(w, 0, smem);
    run_phase<PH_RWKVOUT>(w, 0, smem);
    grid.sync();
    run_phase<PH_WOUT>(w, 0, smem);   grid.sync();
    run_phase<PH_LN1>(w, 0, smem);    grid.sync();
    run_phase<PH_QGEMM>(w, 0, smem);  grid.sync();
    run_phase<PH_TOPK>(w, 0, smem);   grid.sync();
    run_phase<PH_GATHER>(w, 0, smem); grid.sync();
    run_phase<PH_WIN1>(w, 1, smem);   grid.sync();
    run_phase<PH_ATTN>(w, 1, smem);   grid.sync();
    run_phase<PH_WOUT>(w, 1, smem);   grid.sync();
    run_phase<PH_LN1>(w, 1, smem);    grid.sync();
    run_phase<PH_QGEMM>(w, 1, smem);  grid.sync();
    run_phase<PH_TOPK>(w, 1, smem);   grid.sync();
    run_phase<PH_GATHER>(w, 1, smem);
}

extern "C" void kernel_launch(void* const* d_in, const int* in_sizes, int n_in, void* d_out, int out_size, void* d_ws, size_t ws_size,
                              hipStream_t stream) {
    (void)in_sizes; (void)n_in; (void)out_size; (void)ws_size;
    static int grid_blocks = 0;
    if (!grid_blocks) {
        int dev = 0, cus = 0, per_cu = 0;
        hipGetDevice(&dev);
        hipDeviceGetAttribute(&cus, hipDeviceAttributeMultiprocessorCount, dev);
        hipOccupancyMaxActiveBlocksPerMultiprocessor(&per_cu, mega_kernel, 256, 0);
        if (per_cu > 2) per_cu = 2;
        if (per_cu < 1) per_cu = 1;
        grid_blocks = cus * per_cu;
    }
    P p{};
    for (int i = 0; i < 51; ++i) p.in[i] = (const float*)d_in[i];
    p.out = (float*)d_out; p.ws = (unsigned char*)d_ws;
    void* args[] = {&p};
    hipError_t e = hipLaunchCooperativeKernel((void*)mega_kernel, dim3(grid_blocks), dim3(256), args, 0, stream);
    if (e != hipSuccess) fprintf(stderr, "cooperative launch failed: %s (grid %d)\n", hipGetErrorString(e), grid_blocks);
}
```

```cpp
#include <hip/hip_runtime.h>
#include <hip/hip_cooperative_groups.h>
#include <stdint.h>
#include <stdio.h>
#define DIAGX 0

#define DM      1024
#define NB      4
#define TT      8192
#define LC      256
#define SS      8448
#define NTOK    33792
#define ZW0     2176
#define ZW1     2304
#define ALPHA_F 1.41421356237f
#define NCH     132

typedef unsigned short bf16_t;
using bf16x8 = __attribute__((ext_vector_type(8))) short;
using f32x16 = __attribute__((ext_vector_type(16))) float;
using f32x4  = __attribute__((ext_vector_type(4))) float;
using bf16x2v = __attribute__((ext_vector_type(2))) __bf16;
using u32x4v = __attribute__((ext_vector_type(4))) unsigned;


__device__ __forceinline__ int tidx() { int t = (int)threadIdx.x; asm volatile("" : "+v"(t)); return t; }
__device__ __forceinline__ int bidx() { int t = (int)blockIdx.x; asm volatile("" : "+s"(t)); return t; }
typedef __bf16 hwbf16x2_t __attribute__((ext_vector_type(2)));
typedef float hwf32x2_t __attribute__((ext_vector_type(2)));
__device__ __forceinline__ bf16_t f2bf(float f) { return (bf16_t)__builtin_bit_cast(unsigned short, (__bf16)f); }
__device__ __forceinline__ float bf2f(bf16_t h) { return __uint_as_float(((unsigned)h) << 16); }
__device__ __forceinline__ unsigned pack2(float lo, float hi) { const hwf32x2_t f = {lo, hi}; return __builtin_bit_cast(unsigned, __builtin_convertvector(f, hwbf16x2_t)); }
__device__ __forceinline__ float bflo(unsigned u) { return __uint_as_float(u << 16); }
__device__ __forceinline__ float bfhi(unsigned u) { return __uint_as_float(u & 0xffff0000u); }
__device__ __forceinline__ float sigmoidf_(float x) { return 1.f / (1.f + __expf(-x)); }
__device__ __forceinline__ float siluf_(float x) { return x / (1.f + __expf(-x)); }
__device__ __forceinline__ float geluf_(float x) { return 0.5f * x * (1.f + erff(x * 0.70710678118654752f)); }

template <int CTRL> __device__ __forceinline__ float dppf(float x) {
    return __builtin_bit_cast(float, __builtin_amdgcn_mov_dpp(__builtin_bit_cast(int, x), CTRL, 0xf, 0xf, true));
}
#define DPP_XOR1 0xB1
#define DPP_XOR2 0x4E
#define DPP_ROR4 0x124
#define DPP_ROR8 0x128
__device__ __forceinline__ float row16_sum(float x) {
    x += dppf<DPP_XOR1>(x); x += dppf<DPP_XOR2>(x); x += dppf<DPP_ROR4>(x); x += dppf<DPP_ROR8>(x); return x;
}
__device__ __forceinline__ float row16_max(float x) {
    x = fmaxf(x, dppf<DPP_XOR1>(x)); x = fmaxf(x, dppf<DPP_XOR2>(x)); x = fmaxf(x, dppf<DPP_ROR4>(x)); x = fmaxf(x, dppf<DPP_ROR8>(x)); return x;
}
__device__ __forceinline__ float xrow_sum(float x) {
    auto s = __builtin_amdgcn_permlane16_swap(__float_as_uint(x), __float_as_uint(x), false, false);
    x = __uint_as_float(s[0]) + __uint_as_float(s[1]);
    auto t = __builtin_amdgcn_permlane32_swap(__float_as_uint(x), __float_as_uint(x), false, false);
    return __uint_as_float(t[0]) + __uint_as_float(t[1]);
}
__device__ __forceinline__ float xrow_max(float x) {
    auto s = __builtin_amdgcn_permlane16_swap(__float_as_uint(x), __float_as_uint(x), false, false);
    x = fmaxf(__uint_as_float(s[0]), __uint_as_float(s[1]));
    auto t = __builtin_amdgcn_permlane32_swap(__float_as_uint(x), __float_as_uint(x), false, false);
    return fmaxf(__uint_as_float(t[0]), __uint_as_float(t[1]));
}
__device__ __forceinline__ float wave_sum(float x) { return xrow_sum(row16_sum(x)); }
__device__ __forceinline__ float wave_max(float x) { return xrow_max(row16_max(x)); }
__device__ __forceinline__ float half_swap_sum(float x) {
    auto t = __builtin_amdgcn_permlane32_swap(__float_as_uint(x), __float_as_uint(x), false, false);
    return __uint_as_float(t[0]) + __uint_as_float(t[1]);
}
__device__ __forceinline__ float half_swap_max(float x) {
    auto t = __builtin_amdgcn_permlane32_swap(__float_as_uint(x), __float_as_uint(x), false, false);
    return fmaxf(__uint_as_float(t[0]), __uint_as_float(t[1]));
}

constexpr size_t al256(size_t x) { return (x + 255) & ~(size_t)255; }
constexpr size_t WS_WIN0T  = 0;
constexpr size_t WS_WOUT0T = WS_WIN0T  + al256((size_t)ZW0 * 1024 * 2);
constexpr size_t WS_WQ0T   = WS_WOUT0T + al256((size_t)1024 * 768 * 2);
constexpr size_t WS_KEYS0  = WS_WQ0T   + al256((size_t)1024 * 1024 * 2);
constexpr size_t WS_WIN1T  = WS_KEYS0  + al256((size_t)2048 * 64 * 2);
constexpr size_t WS_WOUT1T = WS_WIN1T  + al256((size_t)ZW1 * 1024 * 2);
constexpr size_t WS_WQ1T   = WS_WOUT1T + al256((size_t)1024 * 1024 * 2);
constexpr size_t WS_KEYS1  = WS_WQ1T   + al256((size_t)1024 * 1024 * 2);
constexpr size_t WS_WGLUT  = WS_KEYS1  + al256((size_t)2048 * 64 * 2);
constexpr size_t WS_W2T    = WS_WGLUT  + al256((size_t)256 * 256 * 2);
constexpr size_t WS_A2T    = WS_W2T    + al256((size_t)2 * 512 * 64 * 2);
constexpr size_t WS_G2T    = WS_A2T    + al256((size_t)2 * 512 * 64 * 2);
constexpr size_t WS_S5POW  = WS_G2T    + al256((size_t)512 * 128 * 2);
constexpr size_t WS_S5K    = WS_S5POW  + al256((size_t)2 * 16 * 64 * 65 * 2 * 4);
constexpr size_t WS_S5W    = WS_S5K    + al256((size_t)2 * 16 * 64 * 256 * 2);
constexpr size_t WS_S5V    = WS_S5W    + al256((size_t)2 * 16 * 128 * 1024 * 2);
constexpr size_t WS_MODP   = WS_S5V    + al256((size_t)2 * 16 * 1024 * 128 * 2);
constexpr size_t WS_MOD    = WS_MODP   + al256((size_t)8 * 2 * 5 * 6144 * 4);
constexpr size_t WS_TABU0  = WS_MOD    + al256((size_t)2 * 5 * 6144 * 4);
constexpr size_t WS_TABV0  = WS_TABU0  + (size_t)16384 * 1024;
constexpr size_t WS_TABU1  = WS_TABV0  + (size_t)16384 * 1024;
constexpr size_t WS_TABV1  = WS_TABU1  + (size_t)16384 * 1024;
constexpr size_t WS_TABSC  = WS_TABV1  + (size_t)16384 * 1024;
constexpr size_t WS_ZX     = WS_TABU0  + (size_t)4 * 16384 * 1024 * 2;
constexpr size_t WS_CTX    = WS_ZX     + al256((size_t)NTOK * ZW1 * 2);
constexpr size_t WS_US5    = WS_CTX    + al256((size_t)1024 * 1024 * 4);
constexpr size_t WS_S5E    = WS_US5    + al256((size_t)16 * NTOK * 16 * 2);
constexpr size_t WS_S5H    = WS_S5E    + al256((size_t)2 * 16 * 528 * 128 * 4);
constexpr size_t WS_YA     = WS_S5H    + al256((size_t)2 * 16 * 528 * 128 * 2);
constexpr size_t WS_YB     = WS_YA     + al256((size_t)NTOK * 256 * 2);
constexpr size_t WS_BON    = WS_YB     + al256((size_t)2 * NTOK * 512 * 2);
constexpr size_t WS_MIX    = WS_BON    + al256((size_t)NTOK * 16 * 4);
constexpr size_t WS_END    = WS_MIX    + al256((size_t)NTOK * 1024 * 2);
constexpr size_t WS_VT     = WS_TABSC + (size_t)4 * 16384 * 4;
static_assert(WS_VT + (size_t)4 * 10 * 64 * SS * 2 <= WS_ZX, "VT fits behind the fp8 tables");
constexpr size_t WS_HB     = WS_MIX;
constexpr size_t WS_HB2    = WS_YB;
constexpr int PAR_SHIFT = 0, PAR_A0 = 3840, PAR_W0 = 4864, PAR_KK = 5888, PAR_KA = 6400, PAR_RK = 6912, PAR_BGLU = 7424, PAR_GNW = 7680, PAR_GNB = 8192,
              PAR_LN1G0 = 8704, PAR_LN1B0 = 9728, PAR_LN2G0 = 10752, PAR_LN2B0 = 11776, PAR_LN1G1 = 12800, PAR_LN1B1 = 13824, PAR_LN2G1 = 14848, PAR_LN2B1 = 15872,
              PAR_RPB = 16896, PAR_SINK = 20736, PAR_TOTAL = 20800;
constexpr size_t WS_PAR    = WS_END + 16384;
static_assert(WS_PAR + (size_t)PAR_TOTAL * 4 <= (size_t)536870912, "param pack fits");
constexpr size_t WS_TS     = WS_PAR + (size_t)PAR_TOTAL * 4 + 256;
static_assert(WS_TS + 512 <= (size_t)536870912, "ts fits");
constexpr size_t WS_RWR    = WS_TABU0;
constexpr size_t WS_RWK    = WS_RWR + (size_t)NTOK * 512 * 2;
constexpr size_t WS_RWAS   = WS_RWK + (size_t)NTOK * 512 * 2;
constexpr size_t WS_RWNRM  = WS_RWAS + (size_t)2 * NTOK * 512;
static_assert(WS_RWNRM + (size_t)NTOK * 8 * 4 <= WS_ZX, "rwkv hand-off fits in the table region");
constexpr size_t WS_RWLW   = WS_MIX;
constexpr size_t WS_IDX    = WS_US5;
constexpr size_t WS_GATE   = WS_YA;
static_assert((size_t)NTOK * 128 * 4 <= (size_t)16 * NTOK * 16 * 2 && (size_t)NTOK * 128 * 4 <= (size_t)NTOK * 256 * 2, "idx/gate overlays");
static_assert(WS_END <= (size_t)536870912, "workspace budget");

struct P {
    const float* in[51];
    float* out;
    unsigned char* ws;
};
struct W { const float* x; const float* ctx; float* out; unsigned char* ws; };
enum {
    I_X = 0, I_C, I_CTX, I_CCTX,
    I0_WMOD, I0_BMOD, I0_WIN, I0_LAMRE, I0_LAMIM, I0_LOGDT, I0_BRE, I0_BIM, I0_CRE, I0_CIM, I0_S5D, I0_WGLU, I0_BGLU,
    I0_SHIFT, I0_W0, I0_W2, I0_A0, I0_A2, I0_G2, I0_KK, I0_KA, I0_RK, I0_GNW, I0_GNB, I0_WOUT, I0_LN1G, I0_LN1B,
    I0_WQ, I0_KEYS, I0_U, I0_V, I0_LN2G, I0_LN2B,
    I1_WMOD, I1_BMOD, I1_WIN, I1_SINK, I1_RPB, I1_WOUT, I1_LN1G, I1_LN1B, I1_WQ, I1_KEYS, I1_U, I1_V, I1_LN2G, I1_LN2B
};
static_assert(I1_LN2B == 50, "51 inputs");

#define WSP(T, off) ((T*)(p.ws + (off)))
#define PAR(off) (((const float*)(p.ws + WS_PAR)) + (off))

constexpr size_t WS_CTL = WS_TS + 512;
#define CTL_WORDS 8192
constexpr size_t WS_S5BB = WS_CTL + CTL_WORDS * 4;
static_assert(WS_S5BB + (size_t)2048 * 32 * 4 <= (size_t)536870912, "ctl + bbar fit");
#define XB_TMO      128
#define XB_XCNT(j)  (256  + 64 * (j))
#define XB_XSUB(j)  (1280 + 64 * (j))
#define XB_XGEN(j)  (2304 + 64 * (j))
#define XB_TOP      3328
#define XB_TOPGEN   3392
#define CT_ELECT    4096
#define CT_NEXT     6144
#define CT_CARRYT   6208
#define CT_CARRYD   6272
#define CT_S5YT     6336
#define CT_S5YD     6400
#define CT_CONVT    6464
#define CT_GLUT     6528
#define CT_S5ED     6592
#define XB_SPIN_CAP (1u << 22)
#define LAS __attribute__((address_space(3)))
__device__ __forceinline__ unsigned xb_ld(unsigned* p)              { return __hip_atomic_load(p, __ATOMIC_RELAXED, __HIP_MEMORY_SCOPE_AGENT); }
__device__ __forceinline__ unsigned xb_add(unsigned* p, unsigned v) { return __hip_atomic_fetch_add(p, v, __ATOMIC_RELAXED, __HIP_MEMORY_SCOPE_AGENT); }
__device__ __forceinline__ unsigned xb_xcc_id() { return (unsigned)__builtin_amdgcn_s_getreg((3 << 11) | 20) & 0xFu; }
__device__ __forceinline__ unsigned cu_key() { return ((unsigned)__builtin_amdgcn_s_getreg(63492) >> 8) & 0xffu; }
#define XB_SPIN(cond, bar) do { unsigned _sp = 0; while (cond) { __builtin_amdgcn_s_sleep(1); \
    if ((++_sp & 255u) == 0u) { if (xb_ld(&(bar)[XB_TMO])) break; if (_sp > XB_SPIN_CAP) { atomicAdd(&(bar)[XB_TMO], 1u); break; } } } } while (0)
struct XcdBarrier { unsigned* bar; unsigned x; volatile LAS unsigned* st; };
__device__ __forceinline__ XcdBarrier xcd_barrier_post(unsigned* bar, volatile LAS unsigned* st) {
    XcdBarrier b; b.bar = bar; b.x = xb_xcc_id(); b.st = st;
    if (tidx() == 0) (void)xb_add(&bar[XB_XCNT(b.x)], 1u);
    return b;
}
__device__ __forceinline__ void xcd_barrier_complete(unsigned* bar, unsigned x, unsigned& nloc, unsigned& nx) {
    const unsigned G = gridDim.x;
    unsigned sum, cnt, mine, sp = 0u;
    for (;;) {
        sum = 0u; cnt = 0u; mine = 0u;
#pragma unroll
        for (unsigned j = 0; j < 16; ++j) { const unsigned c = xb_ld(&bar[XB_XCNT(j)]); sum += c; cnt += (c > 0u) ? 1u : 0u; mine = (j == x) ? c : mine; }
        if (sum == G) break;
        __builtin_amdgcn_s_sleep(1);
        if ((++sp & 255u) == 0u) { if (xb_ld(&bar[XB_TMO])) break; if (sp > XB_SPIN_CAP) { atomicAdd(&bar[XB_TMO], 1u); break; } }
    }
    nloc = mine > 0u ? mine : 1u; nx = cnt > 0u ? cnt : 1u;
}
__device__ __forceinline__ void xcd_barrier(const XcdBarrier& b) {
    asm volatile("s_waitcnt vmcnt(0)" ::: "memory");
    __syncthreads();
    if (tidx() == 0) {
        unsigned* bar = b.bar;
        __builtin_amdgcn_s_waitcnt(0);
        unsigned nloc = b.st[0], nx = b.st[1];
        if (nloc == 0u) { xcd_barrier_complete(bar, b.x, nloc, nx); b.st[0] = nloc; b.st[1] = nx; }
        const unsigned old = xb_add(&bar[XB_XSUB(b.x)], 1u);
        const unsigned gen = old / nloc;
        if (old + 1u == (gen + 1u) * nloc) {
            __builtin_amdgcn_fence(__ATOMIC_RELEASE, "agent");
            asm volatile("s_waitcnt vmcnt(0)" ::: "memory");
            const unsigned og = xb_add(&bar[XB_TOP], 1u);
            const unsigned tg = og / nx;
            if (og + 1u == (tg + 1u) * nx) xb_add(&bar[XB_TOPGEN], 1u);
            else XB_SPIN(xb_ld(&bar[XB_TOPGEN]) == tg, bar);
            __builtin_amdgcn_fence(__ATOMIC_ACQUIRE, "agent");
            xb_add(&bar[XB_XGEN(b.x)], 1u);
            asm volatile("s_waitcnt vmcnt(0)" ::: "memory");
        } else {
            XB_SPIN(xb_ld(&bar[XB_XGEN(b.x)]) == gen, bar);
            __builtin_amdgcn_fence(__ATOMIC_ACQUIRE, "agent");
            asm volatile("s_waitcnt vmcnt(0)" ::: "memory");
        }
    }
    __syncthreads();
}
__device__ __forceinline__ int take_ticket(unsigned* ctr, volatile LAS unsigned* bc) {
    __syncthreads();
    if (tidx() == 0) bc[0] = xb_add(ctr, 1u);
    __syncthreads();
    return (int)bc[0];
}
__device__ __forceinline__ void signal_done(unsigned* ctr) {
    asm volatile("s_waitcnt vmcnt(0)" ::: "memory");
    __syncthreads();
    if (tidx() == 0) {
        __builtin_amdgcn_fence(__ATOMIC_RELEASE, "agent");
        asm volatile("s_waitcnt vmcnt(0)" ::: "memory");
        xb_add(ctr, 1u);
    }
}
__device__ __forceinline__ void wait_count(unsigned* ctl, int word, unsigned target) {
    if (tidx() == 0) {
        XB_SPIN(xb_ld(&ctl[word]) < target, ctl);
        __builtin_amdgcn_fence(__ATOMIC_ACQUIRE, "agent");
        asm volatile("s_waitcnt vmcnt(0)" ::: "memory");
    }
    __syncthreads();
}

__device__ void transpose_cvt_tile(const float* __restrict__ W, int K, int N, bf16_t* __restrict__ Wt, int tile, float* sm) {
    const int tn = N / 64;
    const int k0 = (tile / tn) * 64, n0 = (tile % tn) * 64;
    const int tid = tidx();
    for (int e = tid; e < 4096; e += 256) { int r = e >> 6, c = e & 63; sm[r * 65 + c] = W[(size_t)(k0 + r) * N + n0 + c]; }
    __syncthreads();
    for (int e = tid; e < 4096; e += 256) { int r = e >> 6, c = e & 63; Wt[(size_t)(n0 + r) * K + k0 + c] = f2bf(sm[c * 65 + r]); }
    __syncthreads();
}

struct TrDesc { int in_idx; size_t in_off; int K, N; size_t out_off; };
#define N_TR 12
__device__ __forceinline__ TrDesc tr_desc(int i) {
    switch (i) {
        case 0:  return {I0_WIN, 0, 1024, ZW0, WS_WIN0T};
        case 1:  return {I0_WOUT, 0, 768, 1024, WS_WOUT0T};
        case 2:  return {I0_WQ, 0, 1024, 1024, WS_WQ0T};
        case 3:  return {I1_WIN, 0, 1024, ZW1, WS_WIN1T};
        case 4:  return {I1_WOUT, 0, 1024, 1024, WS_WOUT1T};
        case 5:  return {I1_WQ, 0, 1024, 1024, WS_WQ1T};
        case 6:  return {I0_WGLU, 0, 256, 256, WS_WGLUT};
        case 7:  return {I0_W2, 0, 64, 512, WS_W2T};
        case 8:  return {I0_W2, (size_t)64 * 512, 64, 512, WS_W2T + (size_t)512 * 64 * 2};
        case 9:  return {I0_A2, 0, 64, 512, WS_A2T};
        case 10: return {I0_A2, (size_t)64 * 512, 64, 512, WS_A2T + (size_t)512 * 64 * 2};
        default: return {I0_G2, 0, 128, 512, WS_G2T};
    }
}
__device__ int tr_total_tiles() { int t = 0; for (int i = 0; i < N_TR; ++i) { TrDesc d = tr_desc(i); t += (d.K / 64) * (d.N / 64); } return t; }

__device__ void phase_transpose(const P& p, float* sm, int bid, int nblk) {
    const int total = tr_total_tiles();
    for (int t = bid; t < total; t += nblk) {
        int rem = t, i = 0;
        for (; i < N_TR; ++i) { TrDesc d = tr_desc(i); int n = (d.K / 64) * (d.N / 64); if (rem < n) break; rem -= n; }
        TrDesc d = tr_desc(i);
        transpose_cvt_tile(p.in[d.in_idx] + d.in_off, d.K, d.N, (bf16_t*)(p.ws + d.out_off), rem, sm);
    }
}

__device__ void cvt_range(const float* __restrict__ src, bf16_t* __restrict__ dst, size_t n, size_t gtid, size_t gthreads) {
    const size_t n8 = n / 8;
    for (size_t i = gtid; i < n8; i += gthreads) {
        float4 a = ((const float4*)src)[2 * i], b = ((const float4*)src)[2 * i + 1];
        uint4 o; o.x = pack2(a.x, a.y); o.y = pack2(a.z, a.w); o.z = pack2(b.x, b.y); o.w = pack2(b.z, b.w);
        ((uint4*)dst)[i] = o;
    }
}
struct __attribute__((aligned(4))) U3 { unsigned x, y, z; };
__device__ __forceinline__ unsigned e2m3_code(float v) {
    const float a = fabsf(v);
    const float c = a < 2.f ? rintf(a * 8.f) : (a < 4.f ? 16.f + rintf((a - 2.f) * 4.f) : 24.f + rintf((a - 4.f) * 2.f));
    return (unsigned)fminf(c, 31.f) | (v < 0.f ? 32u : 0u);
}
__device__ void phase_convert(const P& p, size_t gtid, size_t gthreads) {
    cvt_range(p.in[I0_KEYS], WSP(bf16_t, WS_KEYS0), (size_t)2048 * 64, gtid, gthreads);
    cvt_range(p.in[I1_KEYS], WSP(bf16_t, WS_KEYS1), (size_t)2048 * 64, gtid, gthreads);
    const int lane = (int)(gtid & 63);
    const size_t gwave = gtid >> 6, nwaves = gthreads >> 6;
    float* scl = WSP(float, WS_TABSC);
    const float* t0 = p.in[I0_U]; const float* t1 = p.in[I0_V]; const float* t2 = p.in[I1_U]; const float* t3 = p.in[I1_V];
#define CV_SRC(R_) ((((R_) >> 14) == 0 ? t0 : ((R_) >> 14) == 1 ? t1 : ((R_) >> 14) == 2 ? t2 : t3) + (size_t)((R_) & 16383) * 1024 + lane * 16)
#define CV_LOAD(DST, R_) { const size_t rr_ = (R_) < (size_t)4 * 16384 ? (R_) : (size_t)4 * 16384 - 1; const float4* s_ = (const float4*)CV_SRC(rr_); \
        _Pragma("unroll") for (int q_ = 0; q_ < 4; ++q_) { const float4 t_ = s_[q_]; DST[4 * q_] = t_.x; DST[4 * q_ + 1] = t_.y; DST[4 * q_ + 2] = t_.z; DST[4 * q_ + 3] = t_.w; } }
    float pa[16], pb[16];
    CV_LOAD(pa, gwave) CV_LOAD(pb, gwave + nwaves)
    for (size_t r = gwave; r < (size_t)4 * 16384; r += nwaves) {
        const int tb = (int)(r >> 14), row = (int)(r & 16383);
        unsigned char* dst = p.ws + (tb == 0 ? WS_TABU0 : tb == 1 ? WS_TABV0 : tb == 2 ? WS_TABU1 : WS_TABV1) + (size_t)row * 768 + lane * 12;
        float v[16];
#pragma unroll
        for (int u = 0; u < 16; ++u) { v[u] = pa[u]; pa[u] = pb[u]; }
        CV_LOAD(pb, r + 2 * nwaves)
        float mx = 0.f;
#pragma unroll
        for (int u = 0; u < 16; ++u) mx = fmaxf(mx, fabsf(v[u]));
        mx = wave_max(mx);
        const float sc = mx > 0.f ? 7.5f / mx : 1.f;
        unsigned c[16];
#pragma unroll
        for (int u = 0; u < 16; ++u) c[u] = e2m3_code(v[u] * sc);
        unsigned long long lo = 0ull;
#pragma unroll
        for (int u = 0; u < 10; ++u) lo |= (unsigned long long)c[u] << (6 * u);
        lo |= (unsigned long long)(c[10] & 15u) << 60;
        U3 o3;
        o3.x = (unsigned)lo; o3.y = (unsigned)(lo >> 32);
        o3.z = (c[10] >> 4) | (c[11] << 2) | (c[12] << 8) | (c[13] << 14) | (c[14] << 20) | (c[15] << 26);
        *(U3*)dst = o3;
        if (lane == 0) scl[r] = mx > 0.f ? mx / 7.5f : 1.f;
    }
#undef CV_LOAD
#undef CV_SRC
}
#define PSEG(IDX, OFF, CNT) if (r < (CNT)) { dst[(OFF) + r] = p.in[IDX][r]; continue; } r -= (CNT);
__device__ void phase_pack_params(const P& p, size_t gtid, size_t gthreads) {
    float* dst = (float*)(p.ws + WS_PAR);
    for (size_t i = gtid; i < 20624; i += gthreads) {
        int r = (int)i;
        PSEG(I0_SHIFT, PAR_SHIFT, 3840) PSEG(I0_A0, PAR_A0, 1024) PSEG(I0_W0, PAR_W0, 1024) PSEG(I0_KK, PAR_KK, 512) PSEG(I0_KA, PAR_KA, 512)
        PSEG(I0_RK, PAR_RK, 512) PSEG(I0_BGLU, PAR_BGLU, 256) PSEG(I0_GNW, PAR_GNW, 512) PSEG(I0_GNB, PAR_GNB, 512)
        PSEG(I0_LN1G, PAR_LN1G0, 1024) PSEG(I0_LN1B, PAR_LN1B0, 1024) PSEG(I0_LN2G, PAR_LN2G0, 1024) PSEG(I0_LN2B, PAR_LN2B0, 1024)
        PSEG(I1_LN1G, PAR_LN1G1, 1024) PSEG(I1_LN1B, PAR_LN1B1, 1024) PSEG(I1_LN2G, PAR_LN2G1, 1024) PSEG(I1_LN2B, PAR_LN2B1, 1024)
        PSEG(I1_RPB, PAR_RPB, 3720) PSEG(I1_SINK, PAR_SINK, 8)
    }
}
#undef PSEG
__device__ void phase_mod_partial(const P& p, int gwave, int nwaves) {
    const int lane = tidx() & 63;
    for (int it = gwave; it < 2 * 96 * 8; it += nwaves) {
        const int kc = it & 7, ct = (it >> 3) % 96, l = it / (8 * 96);
        const float* wm = p.in[l ? I1_WMOD : I0_WMOD];
        const int col = ct * 64 + lane;
        float sa[5], sb[5];
#pragma unroll
        for (int n = 0; n < 5; ++n) {
            const float* cv = n < 4 ? p.in[I_C] + n * 1024 : p.in[I_CCTX];
            sa[n] = siluf_(cv[kc * 128 + lane]); sb[n] = siluf_(cv[kc * 128 + 64 + lane]);
        }
        float acc[5] = {0.f, 0.f, 0.f, 0.f, 0.f};
        const float* wp = wm + (size_t)(kc * 128) * 6144 + col;
#pragma unroll 1
        for (int i0 = 0; i0 < 64; i0 += 32) {
            float w0[32], w1[32];
#pragma unroll
            for (int j = 0; j < 32; ++j) { w0[j] = wp[(size_t)(i0 + j) * 6144]; w1[j] = wp[(size_t)(64 + i0 + j) * 6144]; }
#pragma unroll
            for (int j = 0; j < 32; ++j)
#pragma unroll
                for (int n = 0; n < 5; ++n) {
                    const float s0 = __builtin_bit_cast(float, __builtin_amdgcn_readlane(__builtin_bit_cast(int, sa[n]), i0 + j));
                    const float s1 = __builtin_bit_cast(float, __builtin_amdgcn_readlane(__builtin_bit_cast(int, sb[n]), i0 + j));
                    acc[n] += s0 * w0[j] + s1 * w1[j];
                }
        }
        float* mp = WSP(float, WS_MODP);
#pragma unroll
        for (int n = 0; n < 5; ++n) mp[(((size_t)kc * 2 + l) * 5 + n) * 6144 + col] = acc[n];
    }
}
__device__ void phase_mod_reduce(const P& p, size_t gtid, size_t gthreads) {
    const float* mp = WSP(float, WS_MODP);
    float* mo = WSP(float, WS_MOD);
    for (size_t i = gtid; i < (size_t)2 * 5 * 6144; i += gthreads) {
        const int l = (int)(i / (5 * 6144)), col = (int)(i % 6144);
        float s = p.in[l ? I1_BMOD : I0_BMOD][col];
        for (int kc = 0; kc < 8; ++kc) s += mp[(size_t)kc * 2 * 5 * 6144 + i];
        mo[i] = s;
    }
}

__device__ void phase_s5_pow(const P& p, size_t gtid, size_t gthreads) {
    float* pw = WSP(float, WS_S5POW);
    for (size_t e = gtid; e < (size_t)2048 * 65; e += gthreads) {
        const int i = (int)(e / 65), j = (int)(e - (size_t)i * 65);
        const float lr = p.in[I0_LAMRE][i], li = p.in[I0_LAMIM][i];
        const float dt = expf(p.in[I0_LOGDT][i >> 6]);
        const float mag = expf(lr * dt * (float)j), ang = li * dt * (float)j;
        pw[e * 2] = mag * cosf(ang); pw[e * 2 + 1] = mag * sinf(ang);
    }
    for (size_t e = gtid; e < (size_t)2048 * 16; e += gthreads) {
        const int i = (int)(e >> 4), q = (int)(e & 15);
        const float lr = p.in[I0_LAMRE][i], li = p.in[I0_LAMIM][i];
        const float dt = expf(p.in[I0_LOGDT][i >> 6]);
        const float mag = expf(lr * dt);
        const float ar = mag * cosf(li * dt), ai = mag * sinf(li * dt);
        const float den = lr * lr + li * li, nr1 = ar - 1.f;
        const float kr = (nr1 * lr + ai * li) / den, ki = (ai * lr - nr1 * li) / den;
        const float xr = p.in[I0_BRE][e], xi = p.in[I0_BIM][e];
        float* bbt = (float*)(p.ws + WS_S5BB) + (size_t)i * 32 + 2 * q;
        bbt[0] = kr * xr - ki * xi; bbt[1] = kr * xi + ki * xr;
    }
}
__device__ __forceinline__ void s5_bbar(const P& p, int dgp, int i, float& br, float& bi) {
    const float* bbt = (const float*)(p.ws + WS_S5BB) + (size_t)dgp * 32 + 2 * i;
    br = bbt[0]; bi = bbt[1];
}
#define TSTAMP(k) do { if (DIAGX && bidx() == 0 && tidx() == 0) ((volatile unsigned long long*)(p.ws + WS_TS))[k] = __builtin_amdgcn_s_memrealtime(); } while (0)
__device__ void phase_s5_tables(const P& p, size_t gtid, size_t gthreads) {
    const float* pw = WSP(float, WS_S5POW);
    const float* bbt = (const float*)(p.ws + WS_S5BB);
    bf16_t* Kt = WSP(bf16_t, WS_S5K);
    bf16_t* Wt = WSP(bf16_t, WS_S5W);
    bf16_t* Vt = WSP(bf16_t, WS_S5V);
    for (size_t e = gtid; e < (size_t)32 * 64 * 64; e += gthreads) {
        const int ipq = (int)(e & 3), i = (int)((e >> 2) & 15), lag = (int)((e >> 6) & 63), dg = (int)(e >> 12);
        float acc[4] = {0.f, 0.f, 0.f, 0.f};
        const float* crp = p.in[I0_CRE] + ((size_t)dg * 16 + i) * 64;
        const float* cip = p.in[I0_CIM] + ((size_t)dg * 16 + i) * 64;
#pragma unroll 8
        for (int pp = 0; pp < 64; ++pp) {
            const int dgp = dg * 64 + pp;
            const float2 a = *(const float2*)&pw[((size_t)dgp * 65 + lag) * 2];
            const float cr = crp[pp], ci = cip[pp];
            const float tr = cr * a.x - ci * a.y, ti = cr * a.y + ci * a.x;
            const float4 b0 = *(const float4*)&bbt[(size_t)dgp * 32 + ipq * 8], b1 = *(const float4*)&bbt[(size_t)dgp * 32 + ipq * 8 + 4];
            acc[0] += tr * b0.x - ti * b0.y; acc[1] += tr * b0.z - ti * b0.w;
            acc[2] += tr * b1.x - ti * b1.y; acc[3] += tr * b1.z - ti * b1.w;
        }
        if (lag == 0 && dg < 16 && (i >> 2) == ipq) acc[i & 3] += p.in[I0_S5D][(dg & 15) * 16 + i];
        *(uint2*)&Kt[e * 4] = make_uint2(pack2(acc[0], acc[1]), pack2(acc[2], acc[3]));
    }
    for (size_t e = gtid; e < (size_t)32 * 64 * 64; e += gthreads) {
        const int s_ = (int)(e & 63), pp = (int)((e >> 6) & 63), dg = (int)(e >> 12), d = dg >> 4;
        const int dgp = dg * 64 + pp;
        const int ex = d ? s_ : 63 - s_;
        const float2 a = *(const float2*)&pw[((size_t)dgp * 65 + ex) * 2];
        float tr[16], ti[16];
#pragma unroll
        for (int q = 0; q < 8; ++q) {
            const float4 b = *(const float4*)&bbt[(size_t)dgp * 32 + q * 4];
            tr[2 * q] = a.x * b.x - a.y * b.y; ti[2 * q] = a.x * b.y + a.y * b.x;
            tr[2 * q + 1] = a.x * b.z - a.y * b.w; ti[2 * q + 1] = a.x * b.w + a.y * b.z;
        }
        bf16_t* w0 = Wt + ((size_t)dg * 128 + pp * 2) * 1024 + s_ * 16;
        *(uint4*)&w0[0] = make_uint4(pack2(tr[0], tr[1]), pack2(tr[2], tr[3]), pack2(tr[4], tr[5]), pack2(tr[6], tr[7]));
        *(uint4*)&w0[8] = make_uint4(pack2(tr[8], tr[9]), pack2(tr[10], tr[11]), pack2(tr[12], tr[13]), pack2(tr[14], tr[15]));
        *(uint4*)&w0[1024] = make_uint4(pack2(ti[0], ti[1]), pack2(ti[2], ti[3]), pack2(ti[4], ti[5]), pack2(ti[6], ti[7]));
        *(uint4*)&w0[1032] = make_uint4(pack2(ti[8], ti[9]), pack2(ti[10], ti[11]), pack2(ti[12], ti[13]), pack2(ti[14], ti[15]));
    }
    for (size_t e = gtid; e < (size_t)32 * 64 * 64; e += gthreads) {
        const int pp = (int)(e & 63), t = (int)((e >> 6) & 63), dg = (int)(e >> 12), d = dg >> 4;
        const int dgp = dg * 64 + pp;
        const int ex = d ? 64 - t : t + 1;
        const float2 a = *(const float2*)&pw[((size_t)dgp * 65 + ex) * 2];
        bf16_t* v0 = Vt + ((size_t)dg * 1024 + t * 16) * 128 + pp * 2;
#pragma unroll
        for (int i = 0; i < 16; ++i) {
            const float cr = p.in[I0_CRE][((size_t)dg * 16 + i) * 64 + pp], ci = p.in[I0_CIM][((size_t)dg * 16 + i) * 64 + pp];
            *(unsigned*)&v0[(size_t)i * 128] = pack2(cr * a.x - ci * a.y, -(cr * a.y + ci * a.x));
        }
    }
}

#define GM_LD 72
#define CS_LD 132
#define GEMM_SMEM_BYTES (2 * 128 * (128 + 8) * 2)
static_assert(64 * CS_LD * 4 <= 2 * 128 * GM_LD * 2, "C staging fits");

template <int BK, class AL, class BL, class Epi>
__device__ void gemm_tile(const AL& al, const BL& bl, int K, int m0, int n0, Epi& epi, unsigned char* smem) {
    constexpr int LD = BK + 8;
    constexpr int NC = BK / 64;
    bf16_t* As = (bf16_t*)smem;
    bf16_t* Bs = As + 128 * LD;
    const int tid = tidx(), lane = tid & 63, wave = tid >> 6;
    const int wm = wave >> 1, wn = wave & 1;
    const int lrow = tid >> 3, kc = (tid & 7) * 8;
    typename AL::RowCtx arow[4];
    typename BL::RowCtx brow[4];
#pragma unroll
    for (int i = 0; i < 4; ++i) { arow[i] = al.row(m0 + lrow + 32 * i); brow[i] = bl.row(n0 + lrow + 32 * i); }
    f32x16 acc[2][2];
#pragma unroll
    for (int i = 0; i < 2; ++i)
#pragma unroll
        for (int j = 0; j < 2; ++j)
#pragma unroll
            for (int r = 0; r < 16; ++r) acc[i][j][r] = 0.f;
    uint4 ra[4 * NC], rb[4 * NC];
#pragma unroll
    for (int c = 0; c < NC; ++c)
#pragma unroll
        for (int i = 0; i < 4; ++i) { ra[c * 4 + i] = al.load8(arow[i], c * 64 + kc); rb[c * 4 + i] = bl.load8(brow[i], c * 64 + kc); }
    for (int k0 = 0; k0 < K; k0 += BK) {
        __syncthreads();
#pragma unroll
        for (int c = 0; c < NC; ++c)
#pragma unroll
            for (int i = 0; i < 4; ++i) {
                *(uint4*)&As[(lrow + 32 * i) * LD + c * 64 + kc] = ra[c * 4 + i];
                *(uint4*)&Bs[(lrow + 32 * i) * LD + c * 64 + kc] = rb[c * 4 + i];
            }
        __syncthreads();
        if (k0 + BK < K) {
#pragma unroll
            for (int c = 0; c < NC; ++c)
#pragma unroll
                for (int i = 0; i < 4; ++i) { ra[c * 4 + i] = al.load8(arow[i], k0 + BK + c * 64 + kc); rb[c * 4 + i] = bl.load8(brow[i], k0 + BK + c * 64 + kc); }
        }
#pragma unroll
        for (int kk = 0; kk < BK / 16; ++kk) {
            bf16x8 a[2], b[2];
#pragma unroll
            for (int i = 0; i < 2; ++i) a[i] = *(const bf16x8*)&As[(wm * 64 + i * 32 + (lane & 31)) * LD + kk * 16 + 8 * (lane >> 5)];
#pragma unroll
            for (int j = 0; j < 2; ++j) b[j] = *(const bf16x8*)&Bs[(wn * 64 + j * 32 + (lane & 31)) * LD + kk * 16 + 8 * (lane >> 5)];
#pragma unroll
            for (int i = 0; i < 2; ++i)
#pragma unroll
                for (int j = 0; j < 2; ++j) acc[i][j] = __builtin_amdgcn_mfma_f32_32x32x16_bf16(a[i], b[j], acc[i][j], 0, 0, 0);
        }
    }
    float* Cs = (float*)smem;
#pragma unroll
    for (int pass = 0; pass < 2; ++pass) {
        __syncthreads();
        if (wm == pass) {
#pragma unroll
            for (int i = 0; i < 2; ++i)
#pragma unroll
                for (int j = 0; j < 2; ++j)
#pragma unroll
                    for (int r = 0; r < 16; ++r) {
                        const int row = i * 32 + (r & 3) + 8 * (r >> 2) + 4 * (lane >> 5);
                        const int col = wn * 64 + j * 32 + (lane & 31);
                        Cs[row * CS_LD + col] = acc[i][j][r];
                    }
        }
        __syncthreads();
        epi(Cs, pass, tid);
    }
    __syncthreads();
}

template <int MODE = 0, class Epi>
__device__ void gemm_tile_dma(const bf16_t* __restrict__ A, int lda, const bf16_t* __restrict__ Bt, int ldb, int K, int m0, int n0, Epi& epi, unsigned char* smem) {
    const int tid = tidx(), lane = tid & 63, wave = tid >> 6, wm = wave >> 1, wn = wave & 1, l31 = lane & 31, hh = lane >> 5;
    const int prow = lane >> 3, pchunk = (lane & 7) ^ prow;
    const bf16_t* ga = A + (size_t)(m0 + wave * 32 + prow) * lda + pchunk * 8;
    const bf16_t* gb = Bt + (size_t)(n0 + wave * 32 + prow) * ldb + pchunk * 8;
    f32x16 acc[2][2];
#pragma unroll
    for (int i = 0; i < 2; ++i)
#pragma unroll
        for (int j = 0; j < 2; ++j)
#pragma unroll
            for (int r = 0; r < 16; ++r) acc[i][j][r] = 0.f;
    const int wbase = __builtin_amdgcn_readfirstlane(wave) * (32 * 128);
#define DMA_ISSUE(k0_, buf_) { unsigned char* ab_ = smem + (buf_) * 32768 + wbase; unsigned char* bb_ = ab_ + 16384; \
        _Pragma("unroll") for (int j_ = 0; j_ < 4; ++j_) { \
            __builtin_amdgcn_global_load_lds((const unsigned*)(ga + (size_t)(8 * j_) * lda + (k0_)), (unsigned*)(ab_ + j_ * 1024), 16, 0, 0); \
            __builtin_amdgcn_global_load_lds((const unsigned*)(gb + (size_t)(8 * j_) * ldb + (k0_)), (unsigned*)(bb_ + j_ * 1024), 16, 0, 0); } }
    __syncthreads();
    DMA_ISSUE(0, 0)
    asm volatile("s_waitcnt vmcnt(0)" ::: "memory");
    asm volatile("s_waitcnt lgkmcnt(0)" ::: "memory"); __builtin_amdgcn_s_barrier();
    const int nk = K / 64;
    for (int kt = 0; kt < nk; ++kt) {
        const int buf = kt & 1;
        if (kt + 1 < nk) DMA_ISSUE((kt + 1) * 64, buf ^ 1)
        const bf16_t* As = (const bf16_t*)(smem + buf * 32768);
        const bf16_t* Bs = As + 8192;
#pragma unroll
        for (int kk = 0; kk < 4; ++kk) {
            bf16x8 a[2], b[2];
            const int cc = ((kk * 2 + hh) ^ (l31 & 7)) * 8;
#pragma unroll
            for (int i = 0; i < 2; ++i) a[i] = *(const bf16x8*)&As[(wm * 64 + i * 32 + l31) * 64 + cc];
#pragma unroll
            for (int j = 0; j < 2; ++j) b[j] = *(const bf16x8*)&Bs[(wn * 64 + j * 32 + l31) * 64 + cc];
#pragma unroll
            for (int i = 0; i < 2; ++i)
#pragma unroll
                for (int j = 0; j < 2; ++j) acc[i][j] = __builtin_amdgcn_mfma_f32_32x32x16_bf16(a[i], b[j], acc[i][j], 0, 0, 0);
        }
        asm volatile("s_waitcnt vmcnt(0)" ::: "memory");
        asm volatile("s_waitcnt lgkmcnt(0)" ::: "memory"); __builtin_amdgcn_s_barrier();
    }
#undef DMA_ISSUE
    float* Cs = (float*)smem;
    if constexpr (MODE == 2) {
        __syncthreads();
#pragma unroll
        for (int i = 0; i < 2; ++i)
#pragma unroll
            for (int j = 0; j < 2; ++j)
#pragma unroll
                for (int r = 0; r < 16; ++r) {
                    const int row = wm * 64 + i * 32 + (r & 3) + 8 * (r >> 2) + 4 * (lane >> 5);
                    const int col = wn * 64 + j * 32 + (lane & 31);
                    Cs[row * CS_LD + col] = acc[i][j][r];
                }
        __syncthreads();
        epi.run128(Cs, tid);
    } else {
#pragma unroll
    for (int pass = 0; pass < 2; ++pass) {
        __syncthreads();
        if (wm == pass) {
#pragma unroll
            for (int i = 0; i < 2; ++i)
#pragma unroll
                for (int j = 0; j < 2; ++j)
#pragma unroll
                    for (int r = 0; r < 16; ++r) {
                        const int row = i * 32 + (r & 3) + 8 * (r >> 2) + 4 * (lane >> 5);
                        const int col = wn * 64 + j * 32 + (lane & 31);
                        Cs[row * CS_LD + col] = acc[i][j][r];
                    }
        }
        __syncthreads();
        epi(Cs, pass, tid);
    }
    __syncthreads();
    }
}

__device__ __forceinline__ int xcd_swz(int bid, int nblk) { return (nblk & 7) ? bid : (bid & 7) * (nblk >> 3) + (bid >> 3); }

struct LdBf16 {
    const bf16_t* base; int ld;
    typedef const bf16_t* RowCtx;
    __device__ RowCtx row(int r) const { return base + (size_t)r * ld; }
    __device__ uint4 load8(RowCtx rc, int k) const { return *(const uint4*)(rc + k); }
};
struct LdXMod {
    const float* xlat; const float* xctx; const float* mod; int shift_off, scale_off;
    struct RowCtx { const float* src; const float* m; };
    __device__ RowCtx row(int R) const {
        const int b = R / SS, s = R - b * SS;
        RowCtx rc;
        if (s < LC) { rc.src = xctx + ((size_t)(b * LC + s)) * DM; rc.m = mod + 4 * 6144; }
        else        { rc.src = xlat + ((size_t)(b * TT + s - LC)) * DM; rc.m = mod + b * 6144; }
        return rc;
    }
    __device__ uint4 load8(const RowCtx& rc, int k) const {
        const float4 x0 = *(const float4*)(rc.src + k), x1 = *(const float4*)(rc.src + k + 4);
        const float4 c0 = *(const float4*)(rc.m + scale_off + k), c1 = *(const float4*)(rc.m + scale_off + k + 4);
        const float4 h0 = *(const float4*)(rc.m + shift_off + k), h1 = *(const float4*)(rc.m + shift_off + k + 4);
        uint4 o;
        o.x = pack2(x0.x * (1.f + c0.x) + h0.x, x0.y * (1.f + c0.y) + h0.y);
        o.y = pack2(x0.z * (1.f + c0.z) + h0.z, x0.w * (1.f + c0.w) + h0.w);
        o.z = pack2(x1.x * (1.f + c1.x) + h1.x, x1.y * (1.f + c1.y) + h1.y);
        o.w = pack2(x1.z * (1.f + c1.z) + h1.z, x1.w * (1.f + c1.w) + h1.w);
        return o;
    }
};

struct EpiStoreBf16 {
    bf16_t* out; int ld; int m0, n0; int mmax;
    __device__ void operator()(const float* Cs, int pass, int tid) const {
#pragma unroll
        for (int i = 0; i < 4; ++i) {
            const int c = tid + 256 * i, row = c >> 4, col8 = (c & 15) * 8;
            const int R = m0 + pass * 64 + row;
            if (R >= mmax) continue;
            const float4 a = *(const float4*)&Cs[row * CS_LD + col8], b = *(const float4*)&Cs[row * CS_LD + col8 + 4];
            uint4 o; o.x = pack2(a.x, a.y); o.y = pack2(a.z, a.w); o.z = pack2(b.x, b.y); o.w = pack2(b.z, b.w);
            *(uint4*)&out[(size_t)R * ld + n0 + col8] = o;
        }
    }
};
struct EpiStoreF32 {
    float* out; int ld; int m0, n0; int mmax;
    __device__ void operator()(const float* Cs, int pass, int tid) const {
#pragma unroll
        for (int i = 0; i < 8; ++i) {
            const int c = tid + 256 * i, row = c >> 5, col4 = (c & 31) * 4;
            const int R = m0 + pass * 64 + row;
            if (R >= mmax) continue;
            *(float4*)&out[(size_t)R * ld + n0 + col4] = *(const float4*)&Cs[row * CS_LD + col4];
        }
    }
};

__device__ __forceinline__ void phase_xcvt(const W p, unsigned char* smem) {
    const int gwave = __builtin_amdgcn_readfirstlane((int)bidx() * 4 + (tidx() >> 6)), nwaves = (int)gridDim.x * 4;
    const float* mod = WSP(float, WS_MOD);
    bf16_t* hb = WSP(bf16_t, WS_HB);
    float* sp = (float*)smem;
    for (int i = tidx(); i < 1024; i += 256) {
#pragma unroll
        for (int v = 0; v < 5; ++v) { sp[v * 1024 + i] = mod[v * 6144 + i]; sp[5120 + v * 1024 + i] = mod[v * 6144 + 1024 + i]; }
    }
    __syncthreads();
    if (gwave >= NTOK) return;
#define XC_SRC(R_) ((R_) % SS < LC ? p.ctx + ((size_t)(((R_) / SS) * LC + (R_) % SS)) * DM : p.x + ((size_t)(((R_) / SS) * TT + (R_) % SS - LC)) * DM)
#define XC_LOAD(XD, R_) { const float* s_ = XC_SRC(R_); const int l4_ = (tidx() & 63) * 4; \
        _Pragma("unroll") for (int i_ = 0; i_ < 4; ++i_) { const float4 x4_ = *(const float4*)&s_[i_ * 256 + l4_]; \
            XD[4 * i_] = x4_.x; XD[4 * i_ + 1] = x4_.y; XD[4 * i_ + 2] = x4_.z; XD[4 * i_ + 3] = x4_.w; } }
    float xa[16], xb[16];
    XC_LOAD(xa, gwave)
    { const int r1 = gwave + nwaves < NTOK ? gwave + nwaves : gwave; XC_LOAD(xb, r1) }
    for (int R = gwave; R < NTOK; R += nwaves) {
        const int var = (R % SS) < LC ? 4 : R / SS;
        float xc[16];
        { const int r2 = R + 2 * nwaves < NTOK ? R + 2 * nwaves : R; XC_LOAD(xc, r2) }
        const int l4 = (tidx() & 63) * 4;
#pragma unroll
        for (int i = 0; i < 4; ++i) {
            const int k = i * 256 + l4;
            const float4 sh = *(const float4*)&sp[var * 1024 + k], sc = *(const float4*)&sp[5120 + var * 1024 + k];
            *(uint2*)&hb[(size_t)R * 1024 + k] = make_uint2(pack2(xa[4 * i] * (1.f + sc.x) + sh.x, xa[4 * i + 1] * (1.f + sc.y) + sh.y),
                                                            pack2(xa[4 * i + 2] * (1.f + sc.z) + sh.z, xa[4 * i + 3] * (1.f + sc.w) + sh.w));
        }
#pragma unroll
        for (int i = 0; i < 16; ++i) { xa[i] = xb[i]; xb[i] = xc[i]; }
    }
#undef XC_LOAD
#undef XC_SRC
}
struct EpiZX0 {
    bf16_t* zx; bf16_t* us5; int m0, n0;
    __device__ void operator()(const float* Cs, int pass, int tid) const {
#pragma unroll
        for (int i = 0; i < 4; ++i) {
            const int c = tid + 256 * i, row = c >> 4, col8 = (c & 15) * 8;
            const int R = m0 + pass * 64 + row, col = n0 + col8;
            const float4 a = *(const float4*)&Cs[row * CS_LD + col8], b = *(const float4*)&Cs[row * CS_LD + col8 + 4];
            uint4 o; o.x = pack2(a.x, a.y); o.y = pack2(a.z, a.w); o.z = pack2(b.x, b.y); o.w = pack2(b.z, b.w);
            if (col < 256) *(uint4*)&us5[((size_t)(col >> 4) * NTOK + R) * 16 + (col & 8)] = o;
            else           *(uint4*)&zx[(size_t)R * ZW0 + col] = o;
        }
    }
};
__device__ void phase_gemm_win0(const W p, unsigned char* smem, int bid, int nblk) {
    LdBf16 al{WSP(bf16_t, WS_HB), 1024};
    LdBf16 bl{WSP(bf16_t, WS_WIN0T), 1024};
    const int ntn = ZW0 / 128, total = (NTOK / 128) * ntn;
    for (int t = xcd_swz(bid, nblk); t < total; t += nblk) {
        const int m0 = (t / ntn) * 128, n0 = (t % ntn) * 128;
        EpiZX0 epi{WSP(bf16_t, WS_ZX), WSP(bf16_t, WS_US5), m0, n0};
        gemm_tile_dma(al.base, al.ld, bl.base, bl.ld, 1024, m0, n0, epi, smem);
    }
}

struct LdBf16Clamp {
    const bf16_t* base; int ld; int rmax;
    typedef const bf16_t* RowCtx;
    __device__ RowCtx row(int r) const { return base + (size_t)(r < rmax ? r : rmax) * ld; }
    __device__ uint4 load8(RowCtx rc, int k) const { return *(const uint4*)(rc + k); }
};
__device__ void phase_s5_E(const W p, unsigned char* smem, int bid, int nblk) {
    for (int t = bid; t < 32 * 5; t += nblk) {
        const int dg = t / 5, mt = t % 5, g = dg & 15;
        LdBf16Clamp al{WSP(bf16_t, WS_US5) + (size_t)g * NTOK * 16, 1024, 527};
        LdBf16 bl{WSP(bf16_t, WS_S5W) + (size_t)dg * 128 * 1024, 1024};
        EpiStoreF32 epi{WSP(float, WS_S5E) + (size_t)dg * 528 * 128, 128, mt * 128, 0, 528};
        gemm_tile<128>(al, bl, 1024, mt * 128, 0, epi, smem);
        signal_done((unsigned*)(p.ws + WS_CTL) + CT_S5ED);
    }
}
__device__ void phase_s5_carry(const W p, size_t gtid, size_t gthreads) {
    const float* pw = WSP(float, WS_S5POW);
    const float* E = WSP(float, WS_S5E);
    bf16_t* H = WSP(bf16_t, WS_S5H);
    for (size_t i = gtid; i < 8192; i += gthreads) {
        const int pp = (int)(i & 63), b = (int)((i >> 6) & 3), dg = (int)(i >> 8), d = dg >> 4;
        const float ar = pw[((size_t)(dg * 64 + pp) * 65 + 64) * 2], ai = pw[((size_t)(dg * 64 + pp) * 65 + 64) * 2 + 1];
        float hr = 0.f, hi = 0.f;
        for (int cc0 = 0; cc0 < NCH; cc0 += 4) {
            size_t o[4]; float er[4], ei[4];
#pragma unroll
            for (int j = 0; j < 4; ++j) {
                const int cc = cc0 + j;
                const int c = d ? (cc < 4 ? 3 - cc : 131 - (cc - 4)) : cc;
                o[j] = ((size_t)dg * 528 + b * NCH + c) * 128 + pp * 2;
                er[j] = E[o[j]]; ei[j] = E[o[j] + 1];
            }
#pragma unroll
            for (int j = 0; j < 4; ++j) {
                H[o[j]] = f2bf(hr); H[o[j] + 1] = f2bf(hi);
                const float nr = ar * hr - ai * hi + er[j], ni = ar * hi + ai * hr + ei[j];
                hr = nr; hi = ni;
            }
        }
    }
}
struct LdS5YA {
    const bf16_t* u; const bf16_t* h0; const bf16_t* h1;
    struct RowCtx { const bf16_t* u; const bf16_t* h0; const bf16_t* h1; };
    __device__ RowCtx row(int r) const { if (r > 527) r = 527; return {u + (size_t)r * 1024, h0 + (size_t)r * 128, h1 + (size_t)r * 128}; }
    __device__ uint4 load8(const RowCtx& rc, int k) const {
        if (k < 1024) return *(const uint4*)(rc.u + k);
        if (k < 1152) return *(const uint4*)(rc.h0 + (k - 1024));
        if (k < 2176) return *(const uint4*)(rc.u + (k - 1152));
        return *(const uint4*)(rc.h1 + (k - 2176));
    }
};
struct LdS5YB {
    const bf16_t* k0; const bf16_t* k1; const bf16_t* v0; const bf16_t* v1;
    struct RowCtx { int t, i; const bf16_t* v0; const bf16_t* v1; };
    __device__ RowCtx row(int n) const { return {n >> 4, n & 15, v0 + (size_t)n * 128, v1 + (size_t)n * 128}; }
    __device__ uint4 load8(const RowCtx& rc, int k) const {
        if (k < 1024) { const int s = k >> 4, lag = rc.t - s; if (lag < 0) return make_uint4(0, 0, 0, 0); return *(const uint4*)(k0 + (lag * 16 + rc.i) * 16 + (k & 8)); }
        if (k < 1152) return *(const uint4*)(rc.v0 + (k - 1024));
        if (k < 2176) { const int kk = k - 1152, s = kk >> 4, lag = s - rc.t; if (lag < 0) return make_uint4(0, 0, 0, 0); return *(const uint4*)(k1 + (lag * 16 + rc.i) * 16 + (kk & 8)); }
        return *(const uint4*)(rc.v1 + (k - 2176));
    }
};
struct EpiS5Y {
    bf16_t* ya; int g; int m0, n0;
    __device__ void operator()(const float* Cs, int pass, int tid) const {
#pragma unroll
        for (int i = 0; i < 4; ++i) {
            const int c = tid + 256 * i, row = c >> 4, col8 = (c & 15) * 8;
            const int r = m0 + pass * 64 + row;
            if (r > 527) continue;
            const int n = n0 + col8, t = n >> 4;
            const float4 a = *(const float4*)&Cs[row * CS_LD + col8], b = *(const float4*)&Cs[row * CS_LD + col8 + 4];
            uint4 o;
            o.x = pack2(geluf_(a.x), geluf_(a.y)); o.y = pack2(geluf_(a.z), geluf_(a.w));
            o.z = pack2(geluf_(b.x), geluf_(b.y)); o.w = pack2(geluf_(b.z), geluf_(b.w));
            *(uint4*)&ya[((size_t)r * 64 + t) * 256 + g * 16 + (n & 8)] = o;
        }
    }
};
__device__ void phase_s5_Y(const W p, unsigned char* smem, int bid, int nblk) {
    for (int t = bid; t < 16 * 5 * 8; t += nblk) {
        if (t < 0) continue;
        const int g = t / 40, mt = (t % 40) / 8, nt = t % 8;
        LdS5YA al{WSP(bf16_t, WS_US5) + (size_t)g * NTOK * 16, WSP(bf16_t, WS_S5H) + (size_t)g * 528 * 128, WSP(bf16_t, WS_S5H) + (size_t)(16 + g) * 528 * 128};
        LdS5YB bl{WSP(bf16_t, WS_S5K) + (size_t)g * 64 * 256, WSP(bf16_t, WS_S5K) + (size_t)(16 + g) * 64 * 256,
                  WSP(bf16_t, WS_S5V) + (size_t)g * 1024 * 128, WSP(bf16_t, WS_S5V) + (size_t)(16 + g) * 1024 * 128};
        EpiS5Y epi{WSP(bf16_t, WS_YA), g, mt * 128, nt * 128};
        gemm_tile<128>(al, bl, 2304, mt * 128, nt * 128, epi, smem);
    }
}

__device__ __forceinline__ void zx0_shift8(const bf16_t* zx, const float* mu, int R, int col, float (&o)[8]) {
    const int s = R % SS;
    const bool hp = (s != 0) && (s != LC), hn = (s != LC - 1) && (s != SS - 1);
    const uint4 z = *(const uint4*)&zx[(size_t)R * ZW0 + col];
    uint4 zp = make_uint4(0, 0, 0, 0), zn = make_uint4(0, 0, 0, 0);
    if (hp) zp = *(const uint4*)&zx[(size_t)(R - 1) * ZW0 + col];
    if (hn) zn = *(const uint4*)&zx[(size_t)(R + 1) * ZW0 + col];
    const unsigned zu[4] = {z.x, z.y, z.z, z.w}, pu[4] = {zp.x, zp.y, zp.z, zp.w}, nu[4] = {zn.x, zn.y, zn.z, zn.w};
    const int mc = col - 256;
#pragma unroll
    for (int u = 0; u < 4; ++u) {
        const float a0 = bflo(zu[u]), a1 = bfhi(zu[u]);
        o[2 * u]     = a0 + mu[mc + 2 * u] * (bflo(pu[u]) - a0) + mu[1920 + mc + 2 * u] * (bflo(nu[u]) - a0);
        o[2 * u + 1] = a1 + mu[mc + 2 * u + 1] * (bfhi(pu[u]) - a1) + mu[1920 + mc + 2 * u + 1] * (bfhi(nu[u]) - a1);
    }
}

__device__ __forceinline__ float tanh_fast(float x) { const float e = __expf(2.f * fminf(fmaxf(x, -15.f), 15.f)); return 1.f - 2.f / (e + 1.f); }
__device__ __forceinline__ float softplus_fast(float x) { return fmaxf(x, 0.f) + __logf(1.f + __expf(-fabsf(x))); }

__device__ void phase_rw_shift(const W p, int gwave, int nwaves) {
    const int lane = tidx() & 63;
    const bf16_t* zx = WSP(bf16_t, WS_ZX);
    const float* mu = PAR(PAR_SHIFT);
    bf16_t* Rr = WSP(bf16_t, WS_RWR);
    bf16_t* Kk = WSP(bf16_t, WS_RWK);
    float* nrm = WSP(float, WS_RWNRM);
    for (int R = gwave; R < NTOK; R += nwaves) {
        const int b = R / SS, s = R - b * SS, h = lane >> 3, c8 = (lane & 7) * 8;
        float r8[8], k8[8];
        zx0_shift8(zx, mu, R, 256 + lane * 8, r8);
        zx0_shift8(zx, mu, R, 768 + lane * 8, k8);
        float ss = 0.f;
#pragma unroll
        for (int u = 0; u < 8; ++u) { const float kk = k8[u] * PAR(PAR_KK)[lane * 8 + u]; ss += kk * kk; }
        ss += __shfl_xor(ss, 1); ss += __shfl_xor(ss, 2); ss += __shfl_xor(ss, 4);
        const size_t o = (((size_t)(b * 8 + h)) * SS + s) * 64 + c8;
        *(uint4*)&Rr[o] = make_uint4(pack2(r8[0], r8[1]), pack2(r8[2], r8[3]), pack2(r8[4], r8[5]), pack2(r8[6], r8[7]));
        *(uint4*)&Kk[o] = make_uint4(pack2(k8[0], k8[1]), pack2(k8[2], k8[3]), pack2(k8[4], k8[5]), pack2(k8[6], k8[7]));
        if ((lane & 7) == 0) nrm[((size_t)(b * 8 + h)) * SS + s] = rsqrtf(ss + 1e-12f);
    }
}
struct LdLora {
    const bf16_t* zx; const float* mu; int col0; int dotanh;
    typedef int RowCtx;
    __device__ RowCtx row(int R) const { return R; }
    __device__ uint4 load8(RowCtx R, int k) const {
        float v[8]; zx0_shift8(zx, mu, R, col0 + k, v);
        if (dotanh) {
#pragma unroll
            for (int u = 0; u < 8; ++u) v[u] = tanh_fast(v[u]);
        }
        return make_uint4(pack2(v[0], v[1]), pack2(v[2], v[3]), pack2(v[4], v[5]), pack2(v[6], v[7]));
    }
};
template <int MAT>
struct EpiLora {
    int d; const float* bias; bf16_t* lw; unsigned char* as; float* bon; const bf16_t* zx; const float* mu; const float* ka; const float* rk; int m0, n0;
    __device__ void operator()(const float* Cs, int pass, int tid) const {
#pragma unroll 1
        for (int i = 0; i < 4; ++i) {
            const int c = tid + 256 * i, row = c >> 4, col8 = (c & 15) * 8;
            const int R = m0 + pass * 64 + row, col = n0 + col8;
            const float4 a = *(const float4*)&Cs[row * CS_LD + col8], bq = *(const float4*)&Cs[row * CS_LD + col8 + 4];
            const float x[8] = {a.x, a.y, a.z, a.w, bq.x, bq.y, bq.z, bq.w};
            if constexpr (MAT == 0) {
                float o[8];
#pragma unroll
                for (int u = 0; u < 8; ++u) o[u] = -__expf(-softplus_fast(-(x[u] + bias[col + u])) - 0.5f);
                *(uint4*)&lw[(size_t)R * 512 + col] = make_uint4(pack2(o[0], o[1]), pack2(o[2], o[3]), pack2(o[4], o[5]), pack2(o[6], o[7]));
            } else {
                float r8[8], k8[8], bsum = 0.f;
                zx0_shift8(zx, mu, R, 256 + col, r8);
                zx0_shift8(zx, mu, R, 768 + col, k8);
                unsigned q0 = 0u, q1 = 0u;
#pragma unroll
                for (int u = 0; u < 8; ++u) {
                    const float sg = sigmoidf_(x[u] + bias[col + u]);
                    const float kd = k8[u] * (1.f + (sg - 1.f) * ka[col + u]);
                    bsum += r8[u] * kd * rk[col + u];
                    const unsigned qq = ((unsigned)(sg * 255.f + 0.5f)) << (8 * (u & 3));
                    if (u < 4) q0 |= qq; else q1 |= qq;
                }
                *(uint2*)&as[(size_t)R * 512 + col] = make_uint2(q0, q1);
                bsum += __shfl_xor(bsum, 1); bsum += __shfl_xor(bsum, 2); bsum += __shfl_xor(bsum, 4);
                if ((c & 7) == 0) bon[(size_t)R * 16 + (col >> 6) * 2 + d] = bsum;
            }
        }
    }
};
template <int MAT>
__device__ void phase_rw_lora_mat(const W p, unsigned char* smem, int bid, int nblk) {
    const int total = (NTOK / 128) * 4 * 2;
    for (int t = bid; t < total; t += nblk) {
        const int d = t & 1, nt = (t >> 1) & 3, mt = t >> 3;
        LdLora al{WSP(bf16_t, WS_ZX), PAR(PAR_SHIFT), (MAT ? 1920 : 1792) + d * 64, MAT == 0};
        LdBf16 bl{WSP(bf16_t, MAT ? WS_A2T : WS_W2T) + (size_t)d * 512 * 64, 64};
        EpiLora<MAT> epi{d, PAR(MAT ? PAR_A0 : PAR_W0) + d * 512, WSP(bf16_t, WS_RWLW) + (size_t)d * NTOK * 512, WSP(unsigned char, WS_RWAS) + (size_t)d * NTOK * 512,
                         WSP(float, WS_BON), WSP(bf16_t, WS_ZX), PAR(PAR_SHIFT), PAR(PAR_KA), PAR(PAR_RK), mt * 128, nt * 128};
        gemm_tile<64>(al, bl, 64, mt * 128, nt * 128, epi, smem);
    }
}
__device__ void phase_rw_lora(const W p, unsigned char* smem, int bid, int nblk) {
    phase_rw_lora_mat<0>(p, smem, bid, nblk);
    phase_rw_lora_mat<1>(p, smem, bid, nblk);
}

#define RW_CH 32
struct RwkvSmem {
    float dec[RW_CH][64], aa[RW_CH][64], bb[RW_CH][64], kd[RW_CH][64], rr[RW_CH][64];
    float vv[RW_CH][16];
    float yo[RW_CH][16];
};
struct RwStage { uint4 r8, k8, lw8; uint2 as8; float nrm; float v[8]; };
__device__ __forceinline__ int rw_chunk_s0(int d, int cc) {
    if (d == 0) return RW_CH * cc;
    return (cc < LC / RW_CH) ? RW_CH * (LC / RW_CH - 1 - cc) : LC + RW_CH * (TT / RW_CH - 1 - (cc - LC / RW_CH));
}
__device__ __forceinline__ void rw_stage_load(const W p, RwStage& st, int b, int h, int d, int q, int cc, int tid) {
    const int s0 = rw_chunk_s0(d, cc);
    const int j = tid >> 3, c8 = (tid & 7) * 8;
    const int s = d ? (s0 + RW_CH - 1 - j) : (s0 + j);
    const size_t R = (size_t)b * SS + s;
    const size_t o = (((size_t)(b * 8 + h)) * SS + s) * 64 + c8;
    st.r8 = *(const uint4*)(WSP(bf16_t, WS_RWR) + o);
    st.k8 = *(const uint4*)(WSP(bf16_t, WS_RWK) + o);
    st.lw8 = *(const uint4*)(WSP(bf16_t, WS_RWLW) + ((size_t)d * NTOK + R) * 512 + h * 64 + c8);
    st.as8 = *(const uint2*)(WSP(unsigned char, WS_RWAS) + ((size_t)d * NTOK + R) * 512 + h * 64 + c8);
    st.nrm = WSP(float, WS_RWNRM)[((size_t)(b * 8 + h)) * SS + s];
    if ((tid & 7) < 2) zx0_shift8(WSP(bf16_t, WS_ZX), PAR(PAR_SHIFT), (int)R, 1280 + h * 64 + q * 16 + (tid & 7) * 8, st.v);
}
__device__ __forceinline__ void rw_stage_store(const RwStage& st, RwkvSmem& sm, const float (&kkc)[8], const float (&kac)[8], int tid) {
    const int j = tid >> 3, c8 = (tid & 7) * 8;
    const unsigned ru[4] = {st.r8.x, st.r8.y, st.r8.z, st.r8.w}, ku[4] = {st.k8.x, st.k8.y, st.k8.z, st.k8.w}, lu[4] = {st.lw8.x, st.lw8.y, st.lw8.z, st.lw8.w};
    const unsigned au[2] = {st.as8.x, st.as8.y};
    float dec[8], aa[8], bb[8], kd[8], rr[8];
#pragma unroll
    for (int u = 0; u < 8; ++u) {
        const float kt = (u & 1) ? bfhi(ku[u >> 1]) : bflo(ku[u >> 1]);
        const float rt = (u & 1) ? bfhi(ru[u >> 1]) : bflo(ru[u >> 1]);
        const float lw = (u & 1) ? bfhi(lu[u >> 1]) : bflo(lu[u >> 1]);
        const float a = (float)((au[u >> 2] >> (8 * (u & 3))) & 255u) * (1.f / 255.f);
        const float kk = kt * kkc[u] * st.nrm;
        dec[u] = __expf(lw); aa[u] = -kk; bb[u] = kk * a; kd[u] = kt * (1.f + (a - 1.f) * kac[u]); rr[u] = rt;
    }
    *(float4*)&sm.dec[j][c8] = make_float4(dec[0], dec[1], dec[2], dec[3]); *(float4*)&sm.dec[j][c8 + 4] = make_float4(dec[4], dec[5], dec[6], dec[7]);
    *(float4*)&sm.aa[j][c8] = make_float4(aa[0], aa[1], aa[2], aa[3]);     *(float4*)&sm.aa[j][c8 + 4] = make_float4(aa[4], aa[5], aa[6], aa[7]);
    *(float4*)&sm.bb[j][c8] = make_float4(bb[0], bb[1], bb[2], bb[3]);     *(float4*)&sm.bb[j][c8 + 4] = make_float4(bb[4], bb[5], bb[6], bb[7]);
    *(float4*)&sm.kd[j][c8] = make_float4(kd[0], kd[1], kd[2], kd[3]);     *(float4*)&sm.kd[j][c8 + 4] = make_float4(kd[4], kd[5], kd[6], kd[7]);
    *(float4*)&sm.rr[j][c8] = make_float4(rr[0], rr[1], rr[2], rr[3]);     *(float4*)&sm.rr[j][c8 + 4] = make_float4(rr[4], rr[5], rr[6], rr[7]);
    if ((tid & 7) < 2) {
        *(float4*)&sm.vv[j][(tid & 7) * 8] = make_float4(st.v[0], st.v[1], st.v[2], st.v[3]);
        *(float4*)&sm.vv[j][(tid & 7) * 8 + 4] = make_float4(st.v[4], st.v[5], st.v[6], st.v[7]);
    }
}
__device__ void rwkv_scan_item(const W p, int item, unsigned char* smem_raw) {
    RwkvSmem& sm = *(RwkvSmem*)smem_raw;
    const int q = item & 3, d = (item >> 2) & 1, h = (item >> 3) & 7, b = item >> 6;
    const int tid = tidx(), lane = tid & 63, wave = tid >> 6;
    float S0 = 0.f, S1 = 0.f, S2 = 0.f, S3 = 0.f;
    const int kseg = lane & 15, rowl = wave * 4 + (lane >> 4);
    bf16_t* yb = WSP(bf16_t, WS_YB) + (size_t)d * NTOK * 512;
    float kkc[8], kac[8];
#pragma unroll
    for (int u = 0; u < 8; ++u) { kkc[u] = PAR(PAR_KK)[h * 64 + (tid & 7) * 8 + u]; kac[u] = PAR(PAR_KA)[h * 64 + (tid & 7) * 8 + u]; }
    RwStage st;
    rw_stage_load(p, st, b, h, d, q, 0, tid);
    for (int cc = 0; cc < SS / RW_CH; ++cc) {
        const int s0 = rw_chunk_s0(d, cc);
        __syncthreads();
        rw_stage_store(st, sm, kkc, kac, tid);
        __syncthreads();
        if (cc + 1 < SS / RW_CH) rw_stage_load(p, st, b, h, d, q, cc + 1, tid);
        float yk0 = 0.f, yk1 = 0.f;
#pragma unroll
        for (int j = 0; j < RW_CH; ++j) {
            const float4 w4 = *(const float4*)&sm.dec[j][kseg * 4];
            const float4 a4 = *(const float4*)&sm.aa[j][kseg * 4];
            const float4 b4 = *(const float4*)&sm.bb[j][kseg * 4];
            const float4 k4 = *(const float4*)&sm.kd[j][kseg * 4];
            const float4 r4 = *(const float4*)&sm.rr[j][kseg * 4];
            const float vj = sm.vv[j][rowl];
            float sa = (S0 * a4.x + S1 * a4.y) + (S2 * a4.z + S3 * a4.w);
            sa = row16_sum(sa);
            S0 = S0 * w4.x + sa * b4.x + vj * k4.x;
            S1 = S1 * w4.y + sa * b4.y + vj * k4.y;
            S2 = S2 * w4.z + sa * b4.z + vj * k4.z;
            S3 = S3 * w4.w + sa * b4.w + vj * k4.w;
            float y = (S0 * r4.x + S1 * r4.y) + (S2 * r4.z + S3 * r4.w);
            y = row16_sum(y);
            if (j < 16) yk0 = (kseg == j) ? y : yk0; else yk1 = (kseg == j - 16) ? y : yk1;
        }
        {
            const int sA = d ? (s0 + RW_CH - 1 - kseg) : (s0 + kseg), sB = d ? (s0 + RW_CH - 17 - kseg) : (s0 + 16 + kseg);
            yb[((size_t)b * SS + sA) * 512 + h * 64 + q * 16 + rowl] = f2bf(yk0);
            yb[((size_t)b * SS + sB) * 512 + h * 64 + q * 16 + rowl] = f2bf(yk1);
        }
    }
}

#define RLD 72
constexpr size_t WS_RWPHI = WS_TABU0;
constexpr size_t WS_RWG5  = WS_TABU0 + (size_t)8448 * 8192;
constexpr size_t WS_RWG5B = WS_ZX + (size_t)NTOK * ZW0 * 2;
constexpr size_t WS_RWR2  = WS_MIX;
static_assert(WS_RWG5 + (size_t)7936 * 8192 <= WS_ZX, "G5 part A fits");
static_assert(WS_RWG5B + (size_t)512 * 8192 <= WS_ZX + (size_t)NTOK * ZW1 * 2, "G5 part B fits");
__device__ __forceinline__ bf16_t* rw_g5_ptr(const W p, int item) {
    return item < 7936 ? WSP(bf16_t, WS_RWG5) + (size_t)item * 4096 : WSP(bf16_t, WS_RWG5B) + (size_t)(item - 7936) * 4096;
}
__device__ __forceinline__ int rw_chunk64_s0(int d, int cc) { return d == 0 ? 64 * cc : (cc < 4 ? 64 * (3 - cc) : LC + 64 * (127 - (cc - 4))); }
__device__ __forceinline__ void mmq64(const bf16_t* A, const bf16_t* Bt, int qi, int qj, int l31, int hh, f32x16& acc) {
#pragma unroll
    for (int kk = 0; kk < 4; ++kk) {
        const bf16x8 a = *(const bf16x8*)&A[(32 * qi + l31) * RLD + 16 * kk + 8 * hh];
        const bf16x8 b = *(const bf16x8*)&Bt[(32 * qj + l31) * RLD + 16 * kk + 8 * hh];
        acc = __builtin_amdgcn_mfma_f32_32x32x16_bf16(a, b, acc, 0, 0, 0);
    }
}
#define ACC_ROW(r, qi, hh) (32 * (qi) + ((r) & 3) + 8 * ((r) >> 2) + 4 * (hh))
__device__ __forceinline__ void acc_zero(f32x16& a) {
#pragma unroll
    for (int r = 0; r < 16; ++r) a[r] = 0.f;
}
__device__ __forceinline__ void st_rm(bf16_t* D, const f32x16& acc, int qi, int qj, int l31, int hh) {
#pragma unroll
    for (int r = 0; r < 16; ++r) D[ACC_ROW(r, qi, hh) * RLD + 32 * qj + l31] = f2bf(acc[r]);
}
__device__ __forceinline__ float rcp_fast(float x) { return __builtin_amdgcn_rcpf(x); }
__device__ __forceinline__ void rw1_item(const W p, int item, unsigned char* smem) {
    const int chain = item / 132, cc = item - chain * 132;
    const int d = chain & 1, h = (chain >> 1) & 7, b = chain >> 4;
    const int s0 = rw_chunk64_s0(d, cc);
    const int seg_lo = (s0 < LC) ? 0 : LC, seg_hi = (s0 < LC) ? LC : SS;
    const int tid = tidx(), lane = tid & 63, wave = tid >> 6, l31 = lane & 31, hh = lane >> 5, qi = wave >> 1, qj = wave & 1;
    const int tau = tid >> 2, kq = tid & 3, k0 = kq * 16;
    bf16_t* M0 = (bf16_t*)smem;            bf16_t* M1 = M0 + 64 * RLD; bf16_t* M2 = M1 + 64 * RLD; bf16_t* M3 = M2 + 64 * RLD;
    bf16_t* M4 = M3 + 64 * RLD;            bf16_t* M5 = M4 + 64 * RLD; bf16_t* M6 = M5 + 64 * RLD;
    float* gam = (float*)(smem + 7 * 64 * RLD * 2);
    bf16_t* T11 = (bf16_t*)(gam + 64);
    bf16_t* Wrm = T11 + 32 * 40;
    float* muS = gam + 64;
    float* hcS = muS + 640;
    float* LW = (float*)smem;
    bf16_t* AS = (bf16_t*)(LW + 64 * 64);
    float* tot = (float*)(AS + 64 * 64);
    const bf16_t* zx = WSP(bf16_t, WS_ZX);
    const float* mu = PAR(PAR_SHIFT);
    unsigned* scr = (unsigned*)(WSP(bf16_t, WS_YA) + (size_t)bidx() * 4 * 4096 + tau * 64 + k0);
    const int colr = 256 + h * 64, colk = 768 + h * 64, colv = 1280 + h * 64, colw = 1792 + d * 64, cola = 1920 + d * 64;
    __syncthreads();
    {
        bf16_t* raw = (bf16_t*)smem;
        u32x4v rv[11];
#pragma unroll
        for (int q = 0; q < 11; ++q) {
            const int c = tid + 256 * q;
            const int cc = c < 5 * 66 * 8 ? c : 5 * 66 * 8 - 1;
            const int c8 = (cc & 7) * 8, rix = (cc >> 3) % 66, sl = cc / (8 * 66);
            int s = s0 - 1 + rix;
            const bool inr = s >= seg_lo && s < seg_hi;
            s = inr ? s : seg_lo;
            const int col = (sl == 0 ? colr : sl == 1 ? colk : sl == 2 ? colv : sl == 3 ? colw : cola) + c8;
            const u32x4v v = *(const u32x4v*)&zx[((size_t)b * SS + s) * ZW0 + col];
            rv[q] = inr ? v : (u32x4v){0u, 0u, 0u, 0u};
        }
        float m0v[2], m1v[2];
#pragma unroll
        for (int q = 0; q < 2; ++q) {
            const int e = tid + 256 * q, ee = e < 320 ? e : 319;
            const int sl = ee >> 6, ch = ee & 63;
            const int mc = (sl == 0 ? colr : sl == 1 ? colk : sl == 2 ? colv : sl == 3 ? colw : cola) - 256 + ch;
            m0v[q] = mu[mc]; m1v[q] = mu[1920 + mc];
        }
        const float hcv = PAR(tid < 64 ? PAR_KK : tid < 128 ? PAR_KA : PAR_RK)[h * 64 + (tid & 63)];
#pragma unroll
        for (int q = 0; q < 11; ++q) {
            const int c = tid + 256 * q;
            if (c < 5 * 66 * 8) { const int c8 = (c & 7) * 8, rix = (c >> 3) % 66, sl = c / (8 * 66); *(u32x4v*)&raw[(sl * 66 + rix) * 64 + c8] = rv[q]; }
        }
#pragma unroll
        for (int q = 0; q < 2; ++q) { const int e = tid + 256 * q; if (e < 320) { muS[e * 2] = m0v[q]; muS[e * 2 + 1] = m1v[q]; } }
        if (tid < 192) hcS[tid] = hcv;
    }
    __syncthreads();
    unsigned rpa[8], kpa[8], vpa[8], atp[8], rtp[8], btp[8], ktp[8];
    {
        const bf16_t* raw = (const bf16_t*)smem;
        const int jj = d ? (63 - tau) : tau;
#pragma unroll
        for (int sl = 0; sl < 5; ++sl) {
            const uint4* rp_ = (const uint4*)&raw[(sl * 66 + jj) * 64 + k0];
            const uint4 p0 = rp_[0], p1 = rp_[1], z0 = rp_[8], z1 = rp_[9], n0 = rp_[16], n1 = rp_[17];
            const unsigned pu[8] = {p0.x, p0.y, p0.z, p0.w, p1.x, p1.y, p1.z, p1.w}, zu[8] = {z0.x, z0.y, z0.z, z0.w, z1.x, z1.y, z1.z, z1.w},
                           nu[8] = {n0.x, n0.y, n0.z, n0.w, n1.x, n1.y, n1.z, n1.w};
            unsigned o[8];
#pragma unroll
            for (int u2 = 0; u2 < 8; ++u2) {
                const float4 mw = *(const float4*)&muS[(sl * 64 + k0 + 2 * u2) * 2];
                const float za = bflo(zu[u2]), zb = bfhi(zu[u2]);
                float oa = za + mw.x * (bflo(pu[u2]) - za) + mw.y * (bflo(nu[u2]) - za);
                float ob = zb + mw.z * (bfhi(pu[u2]) - zb) + mw.w * (bfhi(nu[u2]) - zb);
                if (sl == 3) { oa = tanh_fast(oa); ob = tanh_fast(ob); }
                o[u2] = pack2(oa, ob);
            }
            if (sl < 3) {
#pragma unroll
                for (int u2 = 0; u2 < 8; ++u2) { if (sl == 0) rpa[u2] = o[u2]; else if (sl == 1) kpa[u2] = o[u2]; else vpa[u2] = o[u2]; }
            }
            else { bf16_t* Dm = (sl == 3 ? M5 : M6); *(uint4*)&Dm[tau * RLD + k0] = make_uint4(o[0], o[1], o[2], o[3]); *(uint4*)&Dm[tau * RLD + k0 + 8] = make_uint4(o[4], o[5], o[6], o[7]); }
        }
    }
    __syncthreads();
    {
        f32x16 aw, aa; acc_zero(aw); acc_zero(aa);
        const bf16_t* w2t = WSP(bf16_t, WS_W2T) + ((size_t)d * 512 + h * 64 + 32 * qj + l31) * 64 + 8 * hh;
        const bf16_t* a2t = WSP(bf16_t, WS_A2T) + ((size_t)d * 512 + h * 64 + 32 * qj + l31) * 64 + 8 * hh;
#pragma unroll
        for (int kk = 0; kk < 4; ++kk) {
            const bf16x8 xa = *(const bf16x8*)&M5[(32 * qi + l31) * RLD + 16 * kk + 8 * hh];
            const bf16x8 xb = *(const bf16x8*)&M6[(32 * qi + l31) * RLD + 16 * kk + 8 * hh];
            aw = __builtin_amdgcn_mfma_f32_32x32x16_bf16(xa, *(const bf16x8*)(w2t + 16 * kk), aw, 0, 0, 0);
            aa = __builtin_amdgcn_mfma_f32_32x32x16_bf16(xb, *(const bf16x8*)(a2t + 16 * kk), aa, 0, 0, 0);
        }
        const int n = 32 * qj + l31;
        const float w0 = PAR(PAR_W0)[d * 512 + h * 64 + n], a0 = PAR(PAR_A0)[d * 512 + h * 64 + n];
#pragma unroll
        for (int r = 0; r < 16; ++r) {
            const int t = ACC_ROW(r, qi, hh);
            LW[t * 64 + n] = -0.60653065971f * rcp_fast(1.f + __expf(-(aw[r] + w0)));
            AS[t * 64 + n] = f2bf(rcp_fast(1.f + __expf(-(aa[r] + a0))));
        }
    }
    __syncthreads();
    {
        const int k = tid & 63, part = tid >> 6;
        float run = 0.f;
#pragma unroll 4
        for (int i = 0; i < 16; ++i) { run += LW[(16 * part + i) * 64 + k]; LW[(16 * part + i) * 64 + k] = run; }
        tot[part * 64 + k] = run;
        __syncthreads();
        float off = 0.f;
        for (int pp = 0; pp < part; ++pp) off += tot[pp * 64 + k];
#pragma unroll 4
        for (int i = 0; i < 16; ++i) LW[(16 * part + i) * 64 + k] = __expf(LW[(16 * part + i) * 64 + k] + off);
    }
    __syncthreads();
    {
        float ss = 0.f;
#pragma unroll
        for (int u2 = 0; u2 < 8; ++u2) { const unsigned kp = kpa[u2]; const float a = bflo(kp) * hcS[k0 + 2 * u2], c = bfhi(kp) * hcS[k0 + 2 * u2 + 1]; ss += a * a + c * c; }
        ss += dppf<DPP_XOR1>(ss); ss += dppf<DPP_XOR2>(ss);
        const float nrm = rsqrtf(ss + 1e-12f);
        float bsum = 0.f;
#pragma unroll
        for (int u2 = 0; u2 < 8; ++u2) {
            const unsigned kp = kpa[u2], rp = rpa[u2], vp = vpa[u2];
            float fa[2], fr[2], fb[2], fk[2];
#pragma unroll
            for (int e = 0; e < 2; ++e) {
                const int k = k0 + 2 * u2 + e;
                const float kv = e ? bfhi(kp) : bflo(kp), rv = e ? bfhi(rp) : bflo(rp);
                const float eL = LW[tau * 64 + k], eLp = tau ? LW[(tau - 1) * 64 + k] : 1.f, sg = bf2f(AS[tau * 64 + k]);
                const float kk = kv * hcS[k] * nrm;
                const float kd = kv * (1.f + (sg - 1.f) * hcS[64 + k]);
                bsum += rv * kd * hcS[128 + k];
                const float eNL = rcp_fast(eL);
                fa[e] = -kk * eLp; fr[e] = rv * eL; fb[e] = kk * sg * eNL; fk[e] = kd * eNL;
                if (tau == 63) gam[k] = eL;
            }
            const unsigned pa = pack2(fa[0], fa[1]), pr = pack2(fr[0], fr[1]), pb = pack2(fb[0], fb[1]), pk = pack2(fk[0], fk[1]);
            *(unsigned*)&M4[tau * RLD + k0 + 2 * u2] = pa; *(unsigned*)&M5[tau * RLD + k0 + 2 * u2] = pb; *(unsigned*)&M6[tau * RLD + k0 + 2 * u2] = pk;
            atp[u2] = pa; rtp[u2] = pr; btp[u2] = pb; ktp[u2] = pk;
            M3[(k0 + 2 * u2) * RLD + tau] = (bf16_t)(vp & 0xffffu); M3[(k0 + 2 * u2 + 1) * RLD + tau] = (bf16_t)(vp >> 16);
        }
        bsum += dppf<DPP_XOR1>(bsum); bsum += dppf<DPP_XOR2>(bsum);
        if (kq == 0) { const int s = d ? (s0 + 63 - tau) : (s0 + tau); WSP(float, WS_BON)[((size_t)b * SS + s) * 16 + h * 2 + d] = bsum; }
    }
    __syncthreads();
#define CP_TM(D, a) { *(uint4*)&(D)[tau * RLD + k0] = make_uint4(a[0], a[1], a[2], a[3]); *(uint4*)&(D)[tau * RLD + k0 + 8] = make_uint4(a[4], a[5], a[6], a[7]); }
#define CP_KM(D, a, USEG) { _Pragma("unroll") for (int u2 = 0; u2 < 8; ++u2) { const unsigned q_ = a[u2]; const int kx_ = k0 + 2 * u2; \
        (D)[kx_ * RLD + tau] = f2bf(bflo(q_) * ((USEG) ? gam[kx_] : 1.f)); (D)[(kx_ + 1) * RLD + tau] = f2bf(bfhi(q_) * ((USEG) ? gam[kx_ + 1] : 1.f)); } }
    {
        const int sc = 32 * qj + l31;
        f32x16 x0, x1; acc_zero(x0); acc_zero(x1);
        mmq64(M4, M5, qi, qj, l31, hh, x0);
        mmq64(M4, M6, qi, qj, l31, hh, x1);
#pragma unroll
        for (int r = 0; r < 16; ++r) { const bool z = !(sc < ACC_ROW(r, qi, hh)); x0[r] = z ? 0.f : x0[r]; x1[r] = z ? 0.f : x1[r]; }
        st_rm(M0, x0, qi, qj, l31, hh);
        st_rm(M1, x1, qi, qj, l31, hh);
    }
    __syncthreads();
    CP_TM(M4, rtp)
    __syncthreads();
    {
        const int sc = 32 * qj + l31;
        f32x16 x0, x1; acc_zero(x0); acc_zero(x1);
        mmq64(M4, M5, qi, qj, l31, hh, x0);
        mmq64(M4, M6, qi, qj, l31, hh, x1);
#pragma unroll
        for (int r = 0; r < 16; ++r) { const bool z = !(sc <= ACC_ROW(r, qi, hh)); x0[r] = z ? 0.f : x0[r]; x1[r] = z ? 0.f : x1[r]; }
        st_rm(M2, x0, qi, qj, l31, hh);
        __syncthreads();
        st_rm(M6, x1, qi, qj, l31, hh);
    }
    __syncthreads();
    if (wave == 0) {
        const int blk = lane >> 5, rr = lane & 31;
        float Tr[32];
        u32x4v rq0 = {0u, 0u, 0u, 0u}, rq1 = rq0, rq2 = rq0, rq3 = rq0;
#pragma unroll
        for (int t = 0; t < 32; ++t) {
            u32x4v nq0 = rq0, nq1 = rq1, nq2 = rq2, nq3 = rq3;
            if (t + 1 < 32) {
                const bf16_t* nrow = &M0[(32 * blk + t + 1) * RLD + 32 * blk];
                nq0 = *(const u32x4v*)&nrow[0];
                if (t + 1 > 8)  nq1 = *(const u32x4v*)&nrow[8];
                if (t + 1 > 16) nq2 = *(const u32x4v*)&nrow[16];
                if (t + 1 > 24) nq3 = *(const u32x4v*)&nrow[24];
            }
            float ac4[4] = {(t == rr) ? 1.f : 0.f, 0.f, 0.f, 0.f};
#pragma unroll
            for (int c8 = 0; c8 * 8 < t; ++c8) {
                const u32x4v q = c8 == 0 ? rq0 : c8 == 1 ? rq1 : c8 == 2 ? rq2 : rq3;
#pragma unroll
                for (int e = 0; e < 8; ++e) if (8 * c8 + e < t) ac4[e & 3] += Tr[8 * c8 + e] * ((e & 1) ? bfhi(q[e >> 1]) : bflo(q[e >> 1]));
            }
            const float acc = (ac4[0] + ac4[1]) + (ac4[2] + ac4[3]);
            Tr[t] = acc;
            M5[(32 * blk + t) * RLD + 32 * blk + rr] = f2bf(acc);
            if (blk == 0) { T11[rr * 40 + t] = f2bf(acc); M5[t * RLD + 32 + rr] = 0; }
            rq0 = nq0; rq1 = nq1; rq2 = nq2; rq3 = nq3;
        }
        f32x16 wv; acc_zero(wv);
#pragma unroll
        for (int kk = 0; kk < 2; ++kk) {
            const bf16x8 a = *(const bf16x8*)&T11[l31 * 40 + 16 * kk + 8 * hh];
            const bf16x8 bq = *(const bf16x8*)&M0[(32 + l31) * RLD + 16 * kk + 8 * hh];
            wv = __builtin_amdgcn_mfma_f32_32x32x16_bf16(a, bq, wv, 0, 0, 0);
        }
#pragma unroll
        for (int r = 0; r < 16; ++r) Wrm[ACC_ROW(r, 0, hh) * 40 + l31] = f2bf(wv[r]);
        f32x16 t12; acc_zero(t12);
#pragma unroll
        for (int kk = 0; kk < 2; ++kk) {
            const bf16x8 a = *(const bf16x8*)&Wrm[l31 * 40 + 16 * kk + 8 * hh];
            const bf16x8 bq = *(const bf16x8*)&M5[(32 + l31) * RLD + 32 + 16 * kk + 8 * hh];
            t12 = __builtin_amdgcn_mfma_f32_32x32x16_bf16(a, bq, t12, 0, 0, 0);
        }
#pragma unroll
        for (int g4 = 0; g4 < 4; ++g4)
            *(uint2*)&M5[(32 + l31) * RLD + 8 * g4 + 4 * hh] = make_uint2(pack2(t12[4 * g4], t12[4 * g4 + 1]), pack2(t12[4 * g4 + 2], t12[4 * g4 + 3]));
    }
    __syncthreads();
    { f32x16 x; acc_zero(x); mmq64(M3, M1, qi, qj, l31, hh, x); __syncthreads(); st_rm(M0, x, qi, qj, l31, hh); }
    CP_KM(M1, atp, false)
    __syncthreads();
    { f32x16 xa, xg; acc_zero(xa); acc_zero(xg);
      mmq64(M1, M5, qi, qj, l31, hh, xa);
      mmq64(M0, M5, qi, qj, l31, hh, xg);
      st_rm(M4, xa, qi, qj, l31, hh);
      __syncthreads();
      st_rm(M1, xg, qi, qj, l31, hh); }
    __syncthreads();
    CP_TM(M0, rtp)
    CP_KM(M5, btp, true)
    __syncthreads();
    {
        const int cix = 32 * qj + l31;
        f32x16 xr, xp; acc_zero(xr); acc_zero(xp);
        mmq64(M2, M4, qi, qj, l31, hh, xr);
        mmq64(M5, M4, qi, qj, l31, hh, xp);
        const float gc = gam[cix];
#pragma unroll
        for (int r = 0; r < 16; ++r) { xr[r] += bf2f(M0[ACC_ROW(r, qi, hh) * RLD + cix]); xp[r] += (ACC_ROW(r, qi, hh) == cix) ? gc : 0.f; }
        __syncthreads();
        st_rm(M0, xr, qi, qj, l31, hh); st_rm(M4, xp, qi, qj, l31, hh);
    }
    __syncthreads();
    {
        bf16_t* r2g = WSP(bf16_t, WS_RWR2) + (size_t)item * 4096;
        bf16_t* phg = WSP(bf16_t, WS_RWPHI) + (size_t)item * 4096;
        for (int c = tid; c < 512; c += 256) {
            const int row = c >> 3, c8 = (c & 7) * 8;
            *(uint4*)&r2g[row * 64 + c8] = *(const uint4*)&M0[row * RLD + c8];
            *(uint4*)&phg[row * 64 + c8] = *(const uint4*)&M4[row * RLD + c8];
        }
    }
    f32x16 xo; acc_zero(xo);
    {
        f32x16 x; acc_zero(x);
        mmq64(M1, M2, qi, qj, l31, hh, x); mmq64(M3, M6, qi, qj, l31, hh, x);
        mmq64(M1, M5, qi, qj, l31, hh, xo);
        const int t = 32 * qj + l31;
        const int s = d ? (s0 + 63 - t) : (s0 + t);
        bf16_t* yrow = WSP(bf16_t, WS_YB) + (size_t)d * NTOK * 512 + ((size_t)b * SS + s) * 512 + h * 64;
#pragma unroll
        for (int g4 = 0; g4 < 4; ++g4)
            *(uint2*)&yrow[32 * qi + 8 * g4 + 4 * hh] = make_uint2(pack2(x[4 * g4], x[4 * g4 + 1]), pack2(x[4 * g4 + 2], x[4 * g4 + 3]));
    }
    __syncthreads();
    CP_KM(M0, ktp, true)
    __syncthreads();
    { mmq64(M3, M0, qi, qj, l31, hh, xo); st_rm(M4, xo, qi, qj, l31, hh); }
    __syncthreads();
    {
        bf16_t* g5g = rw_g5_ptr(p, item);
        for (int c = tid; c < 512; c += 256) { const int row = c >> 3, c8 = (c & 7) * 8; *(uint4*)&g5g[row * 64 + c8] = *(const uint4*)&M4[row * RLD + c8]; }
    }
#undef CP_TM
#undef CP_KM
}
#define RW1_SMEM_BYTES (7 * 64 * RLD * 2 + 256 + 2 * 32 * 40 * 2)
static_assert(256 + 640 * 4 + 192 * 4 <= 256 + 2 * 32 * 40 * 2, "stage A..E tables fit in the scratch tail");

#define RW2_BUF_BYTES (3 * 64 * RLD * 2)
struct Rw2Stage { u32x4v q0, q1, q2, q3, q4, q5; };
__device__ __forceinline__ void rw2_issue(const W p, int item, int tid, Rw2Stage& st) {
    const bf16_t* s0_ = WSP(bf16_t, WS_RWPHI) + (size_t)item * 4096; const bf16_t* s1_ = WSP(bf16_t, WS_RWR2) + (size_t)item * 4096; const bf16_t* s2_ = rw_g5_ptr(p, item);
    const int o0 = (tid >> 3) * 64 + (tid & 7) * 8, o1 = o0 + 32 * 64;
    st.q0 = *(const u32x4v*)&s0_[o0]; st.q1 = *(const u32x4v*)&s0_[o1];
    st.q2 = *(const u32x4v*)&s1_[o0]; st.q3 = *(const u32x4v*)&s1_[o1];
    st.q4 = *(const u32x4v*)&s2_[o0]; st.q5 = *(const u32x4v*)&s2_[o1];
}
__device__ __forceinline__ void rw2_commit(unsigned char* buf, int tid, const Rw2Stage& st) {
    bf16_t* bb = (bf16_t*)buf;
    const int o0 = (tid >> 3) * RLD + (tid & 7) * 8, o1 = o0 + 32 * RLD;
    *(u32x4v*)&bb[o0] = st.q0; *(u32x4v*)&bb[o1] = st.q1;
    *(u32x4v*)&bb[64 * RLD + o0] = st.q2; *(u32x4v*)&bb[64 * RLD + o1] = st.q3;
    *(u32x4v*)&bb[128 * RLD + o0] = st.q4; *(u32x4v*)&bb[128 * RLD + o1] = st.q5;
}
__device__ __forceinline__ void rw2_step(const unsigned char* bufc, f32x4 (&st)[4], bf16_t* Yt, int wave, int l15, int g) {
    const bf16_t* PH = (const bf16_t*)bufc; const bf16_t* R2 = PH + 64 * RLD; const bf16_t* G5 = R2 + 64 * RLD;
    bf16x8 sb[2];
#pragma unroll
    for (int s2 = 0; s2 < 2; ++s2) {
        union { bf16x8 v; unsigned u[4]; } pk;
        pk.u[0] = pack2(st[2 * s2][0], st[2 * s2][1]); pk.u[1] = pack2(st[2 * s2][2], st[2 * s2][3]);
        pk.u[2] = pack2(st[2 * s2 + 1][0], st[2 * s2 + 1][1]); pk.u[3] = pack2(st[2 * s2 + 1][2], st[2 * s2 + 1][3]);
        sb[s2] = pk.v;
    }
    f32x4 yn[4], sn[4];
#pragma unroll
    for (int mt = 0; mt < 4; ++mt) {
        yn[mt] = (f32x4){0.f, 0.f, 0.f, 0.f};
        const uint2 gq = *(const uint2*)&G5[(16 * wave + l15) * RLD + 16 * mt + 4 * g];
        sn[mt] = (f32x4){bflo(gq.x), bfhi(gq.x), bflo(gq.y), bfhi(gq.y)};
#pragma unroll
        for (int s2 = 0; s2 < 2; ++s2) {
            union { bf16x8 v; uint2 hq[2]; } fa, fb;
            fa.hq[0] = *(const uint2*)&R2[(16 * mt + l15) * RLD + 32 * s2 + 4 * g]; fa.hq[1] = *(const uint2*)&R2[(16 * mt + l15) * RLD + 32 * s2 + 16 + 4 * g];
            fb.hq[0] = *(const uint2*)&PH[(16 * mt + l15) * RLD + 32 * s2 + 4 * g]; fb.hq[1] = *(const uint2*)&PH[(16 * mt + l15) * RLD + 32 * s2 + 16 + 4 * g];
            yn[mt] = __builtin_amdgcn_mfma_f32_16x16x32_bf16(fa.v, sb[s2], yn[mt], 0, 0, 0);
            sn[mt] = __builtin_amdgcn_mfma_f32_16x16x32_bf16(fb.v, sb[s2], sn[mt], 0, 0, 0);
        }
    }
#pragma unroll
    for (int mt = 0; mt < 4; ++mt)
#pragma unroll
        for (int r = 0; r < 4; ++r) Yt[(16 * mt + 4 * g + r) * RLD + 16 * wave + l15] = f2bf(yn[mt][r]);
#pragma unroll
    for (int mt = 0; mt < 4; ++mt) st[mt] = sn[mt];
}
__device__ __forceinline__ void rw2_yaddr(int d, int cc, int tid, size_t& off) {
    const int s0 = rw_chunk64_s0(d, cc < 132 ? cc : 131);
    const int t = tid >> 2; const int s = d ? (s0 + 63 - t) : (s0 + t);
    off = (size_t)s * 512 + (tid & 3) * 16;
}
__device__ __forceinline__ void rw2_yout(bf16_t* ybase, size_t off, const bf16_t* Yt, int tid, const u32x4v& o0, const u32x4v& o1) {
    const int t = tid >> 2, c0 = (tid & 3) * 16;
    const u32x4v a0 = *(const u32x4v*)&Yt[t * RLD + c0], a1 = *(const u32x4v*)&Yt[t * RLD + c0 + 8];
    u32x4v r0, r1;
#pragma unroll
    for (int i = 0; i < 4; ++i) {
        r0[i] = pack2(bflo(o0[i]) + bflo(a0[i]), bfhi(o0[i]) + bfhi(a0[i]));
        r1[i] = pack2(bflo(o1[i]) + bflo(a1[i]), bfhi(o1[i]) + bfhi(a1[i]));
    }
    *(u32x4v*)&ybase[off] = r0; *(u32x4v*)&ybase[off + 8] = r1;
}
__device__ __forceinline__ void rw2_chain(const W p, int chain, unsigned char* smem) {
    const int d = chain & 1, h = (chain >> 1) & 7, b = chain >> 4;
    const int tid = tidx(), lane = tid & 63, wave = tid >> 6, l15 = lane & 15, g = lane >> 4;
    f32x4 st[4];
#pragma unroll
    for (int mt = 0; mt < 4; ++mt) st[mt] = (f32x4){0.f, 0.f, 0.f, 0.f};
    bf16_t* ybase = WSP(bf16_t, WS_YB) + (size_t)d * NTOK * 512 + (size_t)b * SS * 512 + h * 64;
    unsigned char* buf0 = smem; unsigned char* buf1 = smem + RW2_BUF_BYTES;
    bf16_t* Yt = (bf16_t*)(smem + 2 * RW2_BUF_BYTES);
    const int it0 = chain * 132;
    Rw2Stage ra, rb;
    u32x4v oa0, oa1, ob0, ob1; size_t offa, offb;
    __syncthreads();
    rw2_issue(p, it0, tid, ra); rw2_issue(p, it0 + 1, tid, rb);
    rw2_commit(buf0, tid, ra); rw2_issue(p, it0 + 2, tid, ra);
    rw2_commit(buf1, tid, rb); rw2_issue(p, it0 + 3, tid, rb);
    rw2_yaddr(d, 0, tid, offa); oa0 = *(const u32x4v*)&ybase[offa]; oa1 = *(const u32x4v*)&ybase[offa + 8];
#pragma unroll 1
    for (int cc = 0; cc < 132; cc += 2) {
        rw2_yaddr(d, cc + 1, tid, offb); ob0 = *(const u32x4v*)&ybase[offb]; ob1 = *(const u32x4v*)&ybase[offb + 8];
        __syncthreads();
        rw2_step(buf0, st, Yt, wave, l15, g);
        __syncthreads();
        rw2_yout(ybase, offa, Yt, tid, oa0, oa1);
        rw2_commit(buf0, tid, ra);
        rw2_issue(p, it0 + (cc + 4 < 132 ? cc + 4 : 131), tid, ra);
        rw2_yaddr(d, cc + 2, tid, offa); oa0 = *(const u32x4v*)&ybase[offa]; oa1 = *(const u32x4v*)&ybase[offa + 8];
        __syncthreads();
        rw2_step(buf1, st, Yt, wave, l15, g);
        __syncthreads();
        rw2_yout(ybase, offb, Yt, tid, ob0, ob1);
        rw2_commit(buf1, tid, rb);
        rw2_issue(p, it0 + (cc + 5 < 132 ? cc + 5 : 131), tid, rb);
    }
    __syncthreads();
}
static_assert(2 * RW2_BUF_BYTES + 64 * RLD * 2 <= RW1_SMEM_BYTES, "RW2 ring + y tile fit");

struct EpiGlu {
    const bf16_t* ya; const float* bglu; bf16_t* mix; int m0, n0;
    __device__ void operator()(const float* Cs, int pass, int tid) const {
#pragma unroll
        for (int i = 0; i < 4; ++i) {
            const int c = tid + 256 * i, row = c >> 4, col8 = (c & 15) * 8;
            const int R = m0 + pass * 64 + row, col = n0 + col8;
            const uint4 yv = *(const uint4*)&ya[(size_t)R * 256 + col];
            const unsigned yu[4] = {yv.x, yv.y, yv.z, yv.w};
            unsigned o[4];
#pragma unroll
            for (int u = 0; u < 4; ++u) {
                const float y0 = bflo(yu[u]), y1 = bfhi(yu[u]);
                const float g0 = sigmoidf_(Cs[row * CS_LD + col8 + 2 * u] + bglu[col + 2 * u]);
                const float g1 = sigmoidf_(Cs[row * CS_LD + col8 + 2 * u + 1] + bglu[col + 2 * u + 1]);
                o[u] = pack2(y0 * g0, y1 * g1);
            }
            *(uint4*)&mix[(size_t)R * 768 + col] = make_uint4(o[0], o[1], o[2], o[3]);
        }
    }
};
__device__ void phase_glu(const W p, unsigned char* smem, int bid, int nblk) {
    LdBf16 al{WSP(bf16_t, WS_YA), 256};
    LdBf16 bl{WSP(bf16_t, WS_WGLUT), 256};
    for (int t = bid; t < (NTOK / 128) * 2; t += nblk) {
        const int m0 = (t >> 1) * 128, n0 = (t & 1) * 128;
        EpiGlu epi{WSP(bf16_t, WS_YA), PAR(PAR_BGLU), WSP(bf16_t, WS_MIX), m0, n0};
        gemm_tile<128>(al, bl, 256, m0, n0, epi, smem);
    }
}
struct LdGlo {
    const bf16_t* zx; const float* mu;
    typedef int RowCtx;
    __device__ RowCtx row(int R) const { return R; }
    __device__ uint4 load8(RowCtx R, int k) const {
        float v[8]; zx0_shift8(zx, mu, R, 2048 + k, v);
        uint4 o; o.x = pack2(sigmoidf_(v[0]), sigmoidf_(v[1])); o.y = pack2(sigmoidf_(v[2]), sigmoidf_(v[3]));
        o.z = pack2(sigmoidf_(v[4]), sigmoidf_(v[5])); o.w = pack2(sigmoidf_(v[6]), sigmoidf_(v[7]));
        return o;
    }
};
struct EpiRwkvOut {
    const bf16_t* yb0; const bf16_t* yb1; const float* bon; const bf16_t* zx; const float* mu; const float* gnw; const float* gnb; bf16_t* mix; int m0, n0;
    __device__ void operator()(const float* Cs, int pass, int tid) const {
#pragma unroll 1
        for (int i = 0; i < 4; ++i) {
            const int c = tid + 256 * i, row = c >> 4, col8 = (c & 15) * 8;
            const int R = m0 + pass * 64 + row, col = n0 + col8, head = col >> 6;
            const uint4 a = *(const uint4*)&yb0[(size_t)R * 512 + col], b = *(const uint4*)&yb1[(size_t)R * 512 + col];
            const unsigned au[4] = {a.x, a.y, a.z, a.w}, bu[4] = {b.x, b.y, b.z, b.w};
            float y[8], sum = 0.f, sq = 0.f;
#pragma unroll
            for (int u = 0; u < 4; ++u) { y[2 * u] = bflo(au[u]) + bflo(bu[u]); y[2 * u + 1] = bfhi(au[u]) + bfhi(bu[u]); }
#pragma unroll
            for (int u = 0; u < 8; ++u) sum += y[u];
            sum += __shfl_xor(sum, 1); sum += __shfl_xor(sum, 2); sum += __shfl_xor(sum, 4);
            const float mean = sum * (1.f / 64.f);
#pragma unroll
            for (int u = 0; u < 8; ++u) { const float dl = y[u] - mean; sq += dl * dl; }
            sq += __shfl_xor(sq, 1); sq += __shfl_xor(sq, 2); sq += __shfl_xor(sq, 4);
            const float rs = rsqrtf(sq * (1.f / 64.f) + 64e-5f);
            const float bc = bon[(size_t)R * 16 + head * 2] + bon[(size_t)R * 16 + head * 2 + 1];
            float v[8]; zx0_shift8(zx, mu, R, 1280 + col, v);
            const float4 g0 = *(const float4*)&Cs[row * CS_LD + col8], g1 = *(const float4*)&Cs[row * CS_LD + col8 + 4];
            const float gg[8] = {g0.x, g0.y, g0.z, g0.w, g1.x, g1.y, g1.z, g1.w};
            float o[8];
#pragma unroll
            for (int u = 0; u < 8; ++u) o[u] = ((y[u] - mean) * rs * gnw[col + u] + gnb[col + u] + bc * v[u]) * gg[u];
            *(uint4*)&mix[(size_t)R * 768 + 256 + col] = make_uint4(pack2(o[0], o[1]), pack2(o[2], o[3]), pack2(o[4], o[5]), pack2(o[6], o[7]));
        }
    }
};
__device__ void phase_rwkv_out(const W p, unsigned char* smem, int bid, int nblk) {
    LdGlo al{WSP(bf16_t, WS_ZX), PAR(PAR_SHIFT)};
    LdBf16 bl{WSP(bf16_t, WS_G2T), 128};
    for (int t = bid; t < (NTOK / 128) * 4; t += nblk) {
        const int m0 = (t >> 2) * 128, n0 = (t & 3) * 128;
        EpiRwkvOut epi{WSP(bf16_t, WS_YB), WSP(bf16_t, WS_YB) + (size_t)NTOK * 512, WSP(float, WS_BON), WSP(bf16_t, WS_ZX), PAR(PAR_SHIFT),
                       PAR(PAR_GNW), PAR(PAR_GNB), WSP(bf16_t, WS_MIX), m0, n0};
        gemm_tile<128>(al, bl, 128, m0, n0, epi, smem);
    }
}

__device__ void phase_gemm_wout(const W p, unsigned char* smem, int bid, int nblk, int layer) {
    const int K = layer ? 1024 : 768;
    LdBf16 al{WSP(bf16_t, WS_MIX), K};
    LdBf16 bl{WSP(bf16_t, layer ? WS_WOUT1T : WS_WOUT0T), K};
    const int total = (NTOK / 128) * 8;
    for (int t = xcd_swz(bid, nblk); t < total; t += nblk) {
        const int m0 = (t >> 3) * 128, n0 = (t & 7) * 128;
        if (layer && (m0 % SS) < LC) continue;
        EpiStoreBf16 epi{WSP(bf16_t, WS_ZX), 1024, m0, n0, NTOK};
        gemm_tile_dma(al.base, al.ld, bl.base, bl.ld, K, m0, n0, epi, smem);
    }
}

__device__ __forceinline__ void ln_row_store(float (&v)[16], const float* g, const float* bta, float* dst, int lane, const float* m2, bf16_t* hb) {
    float s = 0.f;
#pragma unroll
    for (int i = 0; i < 16; ++i) s += v[i];
    const float mean = wave_sum(s) * (1.f / 1024.f);
    float q = 0.f;
#pragma unroll
    for (int i = 0; i < 16; ++i) { const float dl = v[i] - mean; q += dl * dl; }
    const float rs = rsqrtf(wave_sum(q) * (1.f / 1024.f) + 1e-5f);
#pragma unroll
    for (int i = 0; i < 4; ++i) {
        const int k = i * 256 + lane * 4;
        const float4 gg = *(const float4*)&g[k], bb = *(const float4*)&bta[k];
        float4 o;
        o.x = (v[4 * i] - mean) * rs * gg.x + bb.x; o.y = (v[4 * i + 1] - mean) * rs * gg.y + bb.y;
        o.z = (v[4 * i + 2] - mean) * rs * gg.z + bb.z; o.w = (v[4 * i + 3] - mean) * rs * gg.w + bb.w;
        *(float4*)&dst[k] = o;
        const float4 sc = *(const float4*)&m2[4096 + k], sh = *(const float4*)&m2[3072 + k];
        *(uint2*)&hb[k] = make_uint2(pack2(o.x * (1.f + sc.x) + sh.x, o.y * (1.f + sc.y) + sh.y), pack2(o.z * (1.f + sc.z) + sh.z, o.w * (1.f + sc.w) + sh.w));
    }
}
__device__ void phase_ln1(const W p, int gwave_, int nwaves_, int layer, unsigned char* smem) {
    const int gwave = __builtin_amdgcn_readfirstlane(gwave_), nwaves = __builtin_amdgcn_readfirstlane(nwaves_);
    const int lane = tidx() & 63;
    const bf16_t* yx = WSP(bf16_t, WS_ZX);
    const float* mod = WSP(float, WS_MOD) + (size_t)layer * 5 * 6144;
    const float* g = PAR(layer ? PAR_LN1G1 : PAR_LN1G0);
    const float* bt = PAR(layer ? PAR_LN1B1 : PAR_LN1B0);
    const float* xlat = layer ? p.out : p.x;
    const float* xctx = layer ? WSP(float, WS_CTX) : p.ctx;
    float* sp = (float*)smem;
    for (int i = tidx(); i < 1024; i += 256) {
        sp[i] = g[i]; sp[1024 + i] = bt[i];
#pragma unroll
        for (int v = 0; v < 5; ++v) {
            sp[2048 + v * 1024 + i] = mod[v * 6144 + 2048 + i];
            sp[7168 + v * 1024 + i] = mod[v * 6144 + 4096 + i];
            sp[12288 + v * 1024 + i] = mod[v * 6144 + 3072 + i];
        }
    }
    __syncthreads();
    const int nv = layer ? NB * TT : NTOK;
    if (gwave >= nv) return;
#define LN1_TOK(J) (layer ? ((J) / TT) * SS + LC + ((J) % TT) : (J))
#define LN1_SRC(R_) ((R_) % SS < LC ? xctx + ((size_t)(((R_) / SS) * LC + (R_) % SS)) * DM : xlat + ((size_t)(((R_) / SS) * TT + (R_) % SS - LC)) * DM)
#define LN1_LOAD(XD, YD, R_) { const float* s_ = LN1_SRC(R_); const int l4_ = (tidx() & 63) * 4; \
        _Pragma("unroll") for (int i_ = 0; i_ < 4; ++i_) { const float4 x4_ = *(const float4*)&s_[i_ * 256 + l4_]; const uint2 y_ = *(const uint2*)&yx[(size_t)(R_) * 1024 + i_ * 256 + l4_]; \
            XD[4 * i_] = x4_.x; XD[4 * i_ + 1] = x4_.y; XD[4 * i_ + 2] = x4_.z; XD[4 * i_ + 3] = x4_.w; YD[2 * i_] = y_.x; YD[2 * i_ + 1] = y_.y; } }
    float xa[16]; unsigned ya[8];
    int R = LN1_TOK(gwave);
    LN1_LOAD(xa, ya, R)
    for (int jt = gwave; jt < nv; jt += nwaves) {
        const int b = R / SS, s = R - b * SS;
        float* dst = s < LC ? WSP(float, WS_CTX) + ((size_t)(b * LC + s)) * DM : p.out + ((size_t)(b * TT + s - LC)) * DM;
        const int var = s < LC ? 4 : b;
        const int Rn = LN1_TOK(jt + nwaves < nv ? jt + nwaves : jt);
        float xb[16]; unsigned yb[8];
        LN1_LOAD(xb, yb, Rn)
        float v[16];
#pragma unroll
        for (int i = 0; i < 4; ++i) {
            const int k = i * 256 + lane * 4;
            const float4 g4 = *(const float4*)&sp[2048 + var * 1024 + k];
            v[4 * i] = ALPHA_F * xa[4 * i] + g4.x * bflo(ya[2 * i]);         v[4 * i + 1] = ALPHA_F * xa[4 * i + 1] + g4.y * bfhi(ya[2 * i]);
            v[4 * i + 2] = ALPHA_F * xa[4 * i + 2] + g4.z * bflo(ya[2 * i + 1]); v[4 * i + 3] = ALPHA_F * xa[4 * i + 3] + g4.w * bfhi(ya[2 * i + 1]);
        }
        float sm = 0.f;
#pragma unroll
        for (int i = 0; i < 16; ++i) sm += v[i];
        const float mean = wave_sum(sm) * (1.f / 1024.f);
        float q = 0.f;
#pragma unroll
        for (int i = 0; i < 16; ++i) { const float dl = v[i] - mean; q += dl * dl; }
        const float rs = rsqrtf(wave_sum(q) * (1.f / 1024.f) + 1e-5f);
        bf16_t* hb = WSP(bf16_t, WS_HB) + (size_t)R * 1024;
#pragma unroll
        for (int i = 0; i < 4; ++i) {
            const int k = i * 256 + lane * 4;
            const float4 gg = *(const float4*)&sp[k], bb = *(const float4*)&sp[1024 + k];
            float4 o;
            o.x = (v[4 * i] - mean) * rs * gg.x + bb.x; o.y = (v[4 * i + 1] - mean) * rs * gg.y + bb.y;
            o.z = (v[4 * i + 2] - mean) * rs * gg.z + bb.z; o.w = (v[4 * i + 3] - mean) * rs * gg.w + bb.w;
            *(float4*)&dst[k] = o;
            const float4 sc = *(const float4*)&sp[7168 + var * 1024 + k], sh = *(const float4*)&sp[12288 + var * 1024 + k];
            *(uint2*)&hb[k] = make_uint2(pack2(o.x * (1.f + sc.x) + sh.x, o.y * (1.f + sc.y) + sh.y), pack2(o.z * (1.f + sc.z) + sh.z, o.w * (1.f + sc.w) + sh.w));
        }
        R = Rn;
#pragma unroll
        for (int i = 0; i < 16; ++i) xa[i] = xb[i];
#pragma unroll
        for (int i = 0; i < 8; ++i) ya[i] = yb[i];
    }
#undef LN1_LOAD
#undef LN1_SRC
#undef LN1_TOK
}

__device__ void phase_gemm_q(const W p, unsigned char* smem, int bid, int nblk, int layer);
#define NEG_BIG (-3.0e38f)
#define TOPK_SMEM_BYTES (4 * (2 * 16 * 132) * 4)
__device__ const unsigned char kCandTab[64] = {0, 1, 2, 3, 4, 5, 6, 7, 8, 9, 10, 11, 12, 13, 14, 15, 16, 17, 18, 19, 20, 21, 22, 23, 32, 33, 34, 35, 36, 48, 49, 50, 51, 64, 65, 66, 80, 81, 96, 97, 112, 113, 128, 144, 160, 176, 192, 208, 224, 240, 255, 255, 255, 255, 255, 255, 255, 255, 255, 255, 255, 255, 255, 255};
template <int CTRL> __device__ __forceinline__ unsigned dppu(unsigned x) { return (unsigned)__builtin_amdgcn_mov_dpp((int)x, CTRL, 0xf, 0xf, true); }
__device__ __forceinline__ unsigned umax_(unsigned a, unsigned b) { return a > b ? a : b; }
__device__ __forceinline__ unsigned row16_maxu(unsigned x) {
    x = umax_(x, dppu<DPP_XOR1>(x)); x = umax_(x, dppu<DPP_XOR2>(x)); x = umax_(x, dppu<DPP_ROR4>(x)); x = umax_(x, dppu<DPP_ROR8>(x)); return x;
}
__device__ __forceinline__ unsigned fsort_key(float f) { const unsigned b = __float_as_uint(f); return b ^ ((b >> 31) ? 0xffffffffu : 0x80000000u); }
__device__ void peer_topk_item(const W p, int item, unsigned char* smem, int layer) {
    const int tile = item >> 3, h = item & 7;
    const int tid = tidx(), lane = tid & 63, wave = tid >> 6, l15 = lane & 15, rowbase = lane & 48;
    const int R0 = tile * 64 + wave * 16;
    const bf16_t* Q = WSP(bf16_t, WS_YB);
    const bf16_t* keys = WSP(bf16_t, layer ? WS_KEYS1 : WS_KEYS0);
    float* sc = (float*)smem + wave * (2 * 16 * 132);
    int* idxo = WSP(int, WS_IDX);
    float* gato = WSP(float, WS_GATE);
#pragma unroll
    for (int c = 0; c < 2; ++c) {
        f32x4 acc[8];
#pragma unroll
        for (int nt = 0; nt < 8; ++nt) acc[nt] = (f32x4){0.f, 0.f, 0.f, 0.f};
#pragma unroll
        for (int kk = 0; kk < 2; ++kk) {
            const bf16x8 a = *(const bf16x8*)&Q[(size_t)(R0 + (lane & 15)) * 1024 + h * 128 + c * 64 + kk * 32 + 8 * (lane >> 4)];
#pragma unroll
            for (int nt = 0; nt < 8; ++nt) {
                const bf16x8 bq = *(const bf16x8*)&keys[(size_t)((h * 2 + c) * 128 + nt * 16 + (lane & 15)) * 64 + kk * 32 + 8 * (lane >> 4)];
                acc[nt] = __builtin_amdgcn_mfma_f32_16x16x32_bf16(a, bq, acc[nt], 0, 0, 0);
            }
        }
#pragma unroll
        for (int nt = 0; nt < 8; ++nt)
#pragma unroll
            for (int r = 0; r < 4; ++r) sc[c * (16 * 132) + ((lane >> 4) * 4 + r) * 132 + nt * 16 + (lane & 15)] = acc[nt][r];
    }
#pragma unroll 1
    for (int tg = 0; tg < 4; ++tg) {
        const int t = tg * 4 + (lane >> 4), R = R0 + t;
        const float* s0p = sc + t * 132;
        const float* s1p = sc + 16 * 132 + t * 132;
        unsigned ka[8], kb[8];
#pragma unroll
        for (int m = 0; m < 8; ++m) {
            const int ix = l15 + 16 * m;
            ka[m] = (fsort_key(s0p[ix]) & ~127u) | (unsigned)(127 - ix);
            kb[m] = (fsort_key(s1p[ix]) & ~127u) | (unsigned)(127 - ix);
        }
        unsigned minea = 0u, mineb = 0u;
#pragma unroll 1
        for (int it = 0; it < 16; ++it) {
            const unsigned la = umax_(umax_(umax_(ka[0], ka[1]), umax_(ka[2], ka[3])), umax_(umax_(ka[4], ka[5]), umax_(ka[6], ka[7])));
            const unsigned lb = umax_(umax_(umax_(kb[0], kb[1]), umax_(kb[2], kb[3])), umax_(umax_(kb[4], kb[5]), umax_(kb[6], kb[7])));
            const unsigned ma = row16_maxu(la), mb = row16_maxu(lb);
#pragma unroll
            for (int m = 0; m < 8; ++m) { ka[m] = (ka[m] == ma) ? 0u : ka[m]; kb[m] = (kb[m] == mb) ? 0u : kb[m]; }
            minea = (l15 == it) ? ma : minea; mineb = (l15 == it) ? mb : mineb;
        }
        const int j1 = 127 - (int)(minea & 127u), j2 = 127 - (int)(mineb & 127u);
        const float a1 = s0p[j1], a2 = s1p[j2];
        unsigned k[4];
#pragma unroll
        for (int m = 0; m < 4; ++m) {
            const int slot = l15 + 16 * m;
            const int ij = kCandTab[slot];
            const float v = __shfl(a1, rowbase + ((ij >> 4) & 15)) + __shfl(a2, rowbase + (ij & 15));
            k[m] = (ij == 255) ? 0u : ((fsort_key(v) & ~63u) | (unsigned)(63 - slot));
        }
        unsigned mine = 0u;
#pragma unroll 1
        for (int it = 0; it < 16; ++it) {
            const unsigned lm = umax_(umax_(k[0], k[1]), umax_(k[2], k[3]));
            const unsigned mx = row16_maxu(lm);
#pragma unroll
            for (int m = 0; m < 4; ++m) k[m] = (k[m] == mx) ? 0u : k[m];
            mine = (l15 == it) ? mx : mine;
        }
        const int ij = kCandTab[63 - (int)(mine & 63u)];
        const int i = (ij >> 4) & 15, j = ij & 15;
        const float tv = __shfl(a1, rowbase + i) + __shfl(a2, rowbase + j);
        const int e1 = __shfl(j1, rowbase + i), e2 = __shfl(j2, rowbase + j);
        const float mx = __shfl(tv, rowbase);
        const float ex = __expf(tv - mx);
        const float den = row16_sum(ex);
        idxo[(size_t)R * 128 + h * 16 + l15] = e1 * 128 + e2;
        gato[(size_t)R * 128 + h * 16 + l15] = ex / den;
    }
}

struct EpiTopk {
    const bf16_t* keys; int* idxo; float* gato; int h; int m0; unsigned char* smem;
    __device__ void run128(const float* Cs, int tid) const {
        const int lane = tid & 63, wave = tid >> 6, l15 = lane & 15, rowbase = lane & 48;
        int ijm[4];
#pragma unroll
        for (int m = 0; m < 4; ++m) ijm[m] = kCandTab[l15 + 16 * m];
        bf16x8 qa[2][2][2];
#pragma unroll
        for (int ps = 0; ps < 2; ++ps)
#pragma unroll
            for (int c = 0; c < 2; ++c)
#pragma unroll
                for (int kk = 0; kk < 2; ++kk) {
                    const float* src = &Cs[(ps * 64 + wave * 16 + l15) * CS_LD + c * 64 + kk * 32 + 8 * (lane >> 4)];
                    const float4 f0 = *(const float4*)src, f1 = *(const float4*)(src + 4);
                    union { bf16x8 v; unsigned u[4]; } pk;
                    pk.u[0] = pack2(f0.x, f0.y); pk.u[1] = pack2(f0.z, f0.w); pk.u[2] = pack2(f1.x, f1.y); pk.u[3] = pack2(f1.z, f1.w);
                    qa[ps][c][kk] = pk.v;
                }
        __syncthreads();
        float* sc = (float*)smem + wave * (2 * 16 * 132);
#pragma unroll
        for (int ps = 0; ps < 2; ++ps) {
        const int R0 = m0 + ps * 64 + wave * 16;
#pragma unroll
        for (int c = 0; c < 2; ++c) {
            f32x4 acc[8];
#pragma unroll
            for (int nt = 0; nt < 8; ++nt) acc[nt] = (f32x4){0.f, 0.f, 0.f, 0.f};
            bf16x8 bq[2][8];
#pragma unroll
            for (int kk = 0; kk < 2; ++kk)
#pragma unroll
                for (int nt = 0; nt < 8; ++nt) bq[kk][nt] = *(const bf16x8*)&keys[(size_t)((h * 2 + c) * 128 + nt * 16 + (lane & 15)) * 64 + kk * 32 + 8 * (lane >> 4)];
#pragma unroll
            for (int kk = 0; kk < 2; ++kk) {
                const bf16x8 a = qa[ps][c][kk];
#pragma unroll
                for (int nt = 0; nt < 8; ++nt) acc[nt] = __builtin_amdgcn_mfma_f32_16x16x32_bf16(a, bq[kk][nt], acc[nt], 0, 0, 0);
            }
#pragma unroll
            for (int nt = 0; nt < 8; ++nt)
#pragma unroll
                for (int r = 0; r < 4; ++r) sc[c * (16 * 132) + ((lane >> 4) * 4 + r) * 132 + nt * 16 + (lane & 15)] = acc[nt][r];
        }
#pragma unroll 1
        for (int tg = 0; tg < 4; ++tg) {
            const int t = tg * 4 + (lane >> 4), R = R0 + t;
            const float* s0p = sc + t * 132;
            const float* s1p = sc + 16 * 132 + t * 132;
            unsigned ka[8], kb[8];
#pragma unroll
            for (int m = 0; m < 8; ++m) {
                const int ix = l15 + 16 * m;
                ka[m] = (fsort_key(s0p[ix]) & ~127u) | (unsigned)(127 - ix);
                kb[m] = (fsort_key(s1p[ix]) & ~127u) | (unsigned)(127 - ix);
            }
#define CE_(K, i, j) { const unsigned hi_ = umax_(K[i], K[j]), lo_ = K[i] < K[j] ? K[i] : K[j]; K[i] = hi_; K[j] = lo_; }
#define SORT8_(K) { CE_(K,0,1) CE_(K,2,3) CE_(K,4,5) CE_(K,6,7)  CE_(K,0,2) CE_(K,1,3) CE_(K,4,6) CE_(K,5,7)  CE_(K,1,2) CE_(K,5,6) \
                    CE_(K,0,4) CE_(K,1,5) CE_(K,2,6) CE_(K,3,7)  CE_(K,2,4) CE_(K,3,5)  CE_(K,1,2) CE_(K,3,4) CE_(K,5,6) }
            SORT8_(ka) SORT8_(kb)
            unsigned minea = 0u, mineb = 0u;
#pragma unroll 1
            for (int it = 0; it < 16; ++it) {
                const unsigned ma = row16_maxu(ka[0]), mb = row16_maxu(kb[0]);
                const bool pa = ka[0] == ma, pb = kb[0] == mb;
#pragma unroll
                for (int m = 0; m < 7; ++m) { ka[m] = pa ? ka[m + 1] : ka[m]; kb[m] = pb ? kb[m + 1] : kb[m]; }
                ka[7] = pa ? 0u : ka[7]; kb[7] = pb ? 0u : kb[7];
                minea = (l15 == it) ? ma : minea; mineb = (l15 == it) ? mb : mineb;
            }
#undef SORT8_
            const int j1 = 127 - (int)(minea & 127u), j2 = 127 - (int)(mineb & 127u);
            const float a1 = s0p[j1], a2 = s1p[j2];
            unsigned k[4];
#pragma unroll
            for (int m = 0; m < 4; ++m) {
                const int ij = ijm[m];
                const float v = __shfl(a1, rowbase + ((ij >> 4) & 15)) + __shfl(a2, rowbase + (ij & 15));
                k[m] = (ij == 255) ? 0u : ((fsort_key(v) & ~255u) | (unsigned)ij);
            }
            CE_(k,0,1) CE_(k,2,3) CE_(k,0,2) CE_(k,1,3) CE_(k,1,2)
#undef CE_
            unsigned mine = 0u;
#pragma unroll 1
            for (int it = 0; it < 16; ++it) {
                const unsigned mx = row16_maxu(k[0]);
                const bool pk = k[0] == mx;
                k[0] = pk ? k[1] : k[0]; k[1] = pk ? k[2] : k[1]; k[2] = pk ? k[3] : k[2]; k[3] = pk ? 0u : k[3];
                mine = (l15 == it) ? mx : mine;
            }
            const int i = (int)((mine >> 4) & 15u), j = (int)(mine & 15u);
            const float tv = __shfl(a1, rowbase + i) + __shfl(a2, rowbase + j);
            const int e1 = __shfl(j1, rowbase + i), e2 = __shfl(j2, rowbase + j);
            const float mx = __shfl(tv, rowbase);
            const float ex = __expf(tv - mx);
            const float den = row16_sum(ex);
            idxo[(size_t)R * 128 + h * 16 + l15] = e1 * 128 + e2;
            gato[(size_t)R * 128 + h * 16 + l15] = ex / den;
        }
        }
        __syncthreads();
    }
};

__device__ void phase_gemm_q(const W p, unsigned char* smem, int bid, int nblk, int layer) {
    LdBf16 al{WSP(bf16_t, WS_HB), 1024};
    LdBf16 bl{WSP(bf16_t, layer ? WS_WQ1T : WS_WQ0T), 1024};
    const int total = (NTOK / 128) * 8;
    for (int t = xcd_swz(bid, nblk); t < total; t += nblk) {
        const int m0 = (t >> 3) * 128, n0 = (t & 7) * 128;
        if (layer && (m0 % SS) < LC) continue;
        EpiTopk epi{WSP(bf16_t, layer ? WS_KEYS1 : WS_KEYS0), WSP(int, WS_IDX), WSP(float, WS_GATE), t & 7, m0, smem};
        gemm_tile_dma<2>(al.base, al.ld, bl.base, bl.ld, 1024, m0, n0, epi, smem);
    }
}

using f32x2 = __attribute__((ext_vector_type(2))) float;
using v6u = __attribute__((ext_vector_type(6))) unsigned;
using v32f = __attribute__((ext_vector_type(32))) float;
__device__ __forceinline__ v32f fp6x32_to_f32(const U3& a, const U3& b) {
    v6u s; s[0] = a.x; s[1] = a.y; s[2] = a.z; s[3] = b.x; s[4] = b.y; s[5] = b.z;
    return __builtin_amdgcn_cvt_scalef32_pk32_f32_fp6(s, 1.0f);
}
__device__ __forceinline__ float erf_fast(float x) {
    const float ax = fabsf(x);
    const float t = 1.f / (1.f + 0.3275911f * ax);
    const float poly = t * (0.254829592f + t * (-0.284496736f + t * (1.421413741f + t * (-1.453152027f + t * 1.061405429f))));
    const float r = 1.f - poly * __expf(-ax * ax);
    return copysignf(r, x);
}
constexpr int GD = 8;
struct __attribute__((packed, aligned(4))) U2 { unsigned y, z; };
#define G_ISSUE(J, TAB, IA, IB, E) { \
    const unsigned offa_ = (unsigned)__builtin_amdgcn_readlane(IA, E) * 768u + lane12; \
    const unsigned offb_ = (unsigned)__builtin_amdgcn_readlane(IB, E) * 768u + lane12; \
    unsigned offb4_ = offb_ + 4u; asm volatile("" : "+v"(offb4_)); \
    const U3 q0_ = *(const U3*)((TAB) + offa_); \
    const unsigned q1x_ = *(const unsigned*)((TAB) + offb_); \
    const U2 q1_ = *(const U2*)((TAB) + offb4_); \
    rg[J][0] = q0_.x; rg[J][1] = q0_.y; rg[J][2] = q0_.z; rg[J][3] = q1x_; rg[J][4] = q1_.y; rg[J][5] = q1_.z; }
#define BFLY(OUT, A, B, BIT, CTRL) { const float k_ = (BIT) ? (B) : (A), g_ = (BIT) ? (A) : (B); OUT = k_ + dppf<CTRL>(g_); }
#define G_PIN(J) asm volatile("" : "+v"(rg[J]));
constexpr size_t WS_ACT = WS_ZX;
__device__ __forceinline__ int gather_tok(int layer, int j) { return layer ? (j / TT) * SS + LC + (j % TT) : j; }
__device__ __forceinline__ const float* gather_xrow(const W& p, int R) {
    const int b = R / SS, s = R - b * SS;
    return s < LC ? WSP(float, WS_CTX) + ((size_t)(b * LC + s)) * DM : p.out + ((size_t)(b * TT + s - LC)) * DM;
}
__device__ void phase_peer_act(const W p, int gwave_, int nwaves_, int layer) {
    const int gwave = __builtin_amdgcn_readfirstlane(gwave_), nwaves = __builtin_amdgcn_readfirstlane(nwaves_);
    const int lane = tidx() & 63;
    const float* mod = WSP(float, WS_MOD) + (size_t)layer * 5 * 6144;
    const unsigned char* U = p.ws + (layer ? WS_TABU1 : WS_TABU0);
    const float* su = WSP(float, WS_TABSC) + (layer ? 2 : 0) * 16384;
    const float* sv = su + 16384;
    const int* idxo = WSP(int, WS_IDX);
    const float* gato = WSP(float, WS_GATE);
    float* acto = WSP(float, WS_ACT);
    const int nv = layer ? NB * TT : NTOK;
    if (gwave >= nv) return;
    v6u rg[GD];
    static_assert(GD == 8, "the transpose-reduce below merges 8 steps x 2 lists");
    const bool lb0 = (lane & 1) != 0, lb1 = (lane & 2) != 0, lb2 = (lane & 4) != 0, lb3 = (lane & 8) != 0;
    const unsigned lane12 = (unsigned)lane * 12u;
    int R = gather_tok(layer, gwave);
    int ia = idxo[(size_t)R * 128 + lane], ib = idxo[(size_t)R * 128 + 64 + lane];
#pragma unroll
    for (int j = 0; j < GD; ++j) G_ISSUE(j, U, ia, ib, j)
    int Rn = gather_tok(layer, gwave + nwaves < nv ? gwave + nwaves : gwave);
    int ian = idxo[(size_t)Rn * 128 + lane], ibn = idxo[(size_t)Rn * 128 + 64 + lane];
    float hh[16];
    { const int b = R / SS, s = R - b * SS;
      const float* xrow = gather_xrow(p, R);
      const float* m = mod + (s < LC ? 4 : b) * 6144;
#pragma unroll
      for (int q4 = 0; q4 < 4; ++q4) {
          const int k = lane * 16 + q4 * 4;
          const float4 xv = *(const float4*)&xrow[k], sc = *(const float4*)&m[4096 + k], sh = *(const float4*)&m[3072 + k];
          hh[q4 * 4 + 0] = xv.x * (1.f + sc.x) + sh.x; hh[q4 * 4 + 1] = xv.y * (1.f + sc.y) + sh.y;
          hh[q4 * 4 + 2] = xv.z * (1.f + sc.z) + sh.z; hh[q4 * 4 + 3] = xv.w * (1.f + sc.w) + sh.w;
      } }
    for (int jt = gwave; jt < nv; jt += nwaves) {
        const int j2 = jt + 2 * nwaves < nv ? jt + 2 * nwaves : jt;
        const int R2 = gather_tok(layer, j2);
        const int ln0 = tidx() & 63;
        const int ian2 = idxo[(size_t)R2 * 128 + ln0], ibn2 = idxo[(size_t)R2 * 128 + 64 + ln0];
        const float ga = gato[(size_t)R * 128 + ln0], gb = gato[(size_t)R * 128 + 64 + ln0];
        const float sua = su[ia], sub = su[ib], sva = sv[ia], svb = sv[ib];
        float xn[16], scn[16], shn[16];
        { const int bn = Rn / SS, sn = Rn - bn * SS;
          const float* xrown = gather_xrow(p, Rn);
          const float* mn = mod + (sn < LC ? 4 : bn) * 6144;
          const int lk2 = ln0 * 16;
#pragma unroll
          for (int q4 = 0; q4 < 4; ++q4) {
              const float4 xv = *(const float4*)&xrown[lk2 + q4 * 4], sc = *(const float4*)&mn[4096 + lk2 + q4 * 4], sh = *(const float4*)&mn[3072 + lk2 + q4 * 4];
              xn[q4 * 4] = xv.x; xn[q4 * 4 + 1] = xv.y; xn[q4 * 4 + 2] = xv.z; xn[q4 * 4 + 3] = xv.w;
              scn[q4 * 4] = sc.x; scn[q4 * 4 + 1] = sc.y; scn[q4 * 4 + 2] = sc.z; scn[q4 * 4 + 3] = sc.w;
              shn[q4 * 4] = sh.x; shn[q4 * 4 + 1] = sh.y; shn[q4 * 4 + 2] = sh.z; shn[q4 * 4 + 3] = sh.w;
          } }
        asm volatile("" :: "v"(ian), "v"(ibn));
        float acta = 0.f, actb = 0.f;
#pragma unroll 1
        for (int e0 = 0; e0 < 64; e0 += GD) {
            const bool last = e0 + GD >= 64;
            const int ja = last ? ian : ia, jb = last ? ibn : ib;
            float pr[16];
#pragma unroll
            for (int j = 0; j < GD; ++j) {
                G_PIN(j)
                const v32f uu = __builtin_amdgcn_cvt_scalef32_pk32_f32_fp6(rg[j], 1.0f);
                G_ISSUE(j, U, ja, jb, (e0 + j + GD) & 63)
                f32x2 a0 = {0.f, 0.f}, a1 = {0.f, 0.f};
#pragma unroll
                for (int i = 0; i < 8; ++i) {
                    const f32x2 h2 = {hh[2 * i], hh[2 * i + 1]}, u0 = {uu[2 * i], uu[2 * i + 1]}, u1 = {uu[16 + 2 * i], uu[17 + 2 * i]};
                    a0 = __builtin_elementwise_fma(h2, u0, a0); a1 = __builtin_elementwise_fma(h2, u1, a1);
                }
                pr[j] = a0[0] + a0[1]; pr[8 + j] = a1[0] + a1[1];
                __builtin_amdgcn_sched_barrier(0);
            }
            float q8[8], r4[4], s2[2], tt;
#pragma unroll
            for (int m = 0; m < 8; ++m) BFLY(q8[m], pr[2 * m], pr[2 * m + 1], lb0, DPP_XOR1)
#pragma unroll
            for (int m = 0; m < 4; ++m) BFLY(r4[m], q8[2 * m], q8[2 * m + 1], lb1, DPP_XOR2)
#pragma unroll
            for (int m = 0; m < 2; ++m) BFLY(s2[m], r4[2 * m], r4[2 * m + 1], lb2, DPP_ROR4)
            BFLY(tt, s2[0], s2[1], lb3, DPP_ROR8)
            tt = xrow_sum(tt);
            const float tx = dppf<DPP_ROR8>(tt);
            const bool inr = (lane >> 3) == (e0 >> 3), hi8 = (e0 & 8) != 0;
            acta = inr ? (hi8 ? tx : tt) : acta; actb = inr ? (hi8 ? tt : tx) : actb;
        }
        { const float da = acta * sua, db = actb * sub;
          acta = ga * (0.5f * da * (1.f + erf_fast(da * 0.70710678118654752f))) * sva;
          actb = gb * (0.5f * db * (1.f + erf_fast(db * 0.70710678118654752f))) * svb; }
        { const int ln1 = tidx() & 63;
          acto[(size_t)R * 128 + ln1] = acta; acto[(size_t)R * 128 + 64 + ln1] = actb; }
        R = Rn; Rn = R2; ia = ian; ib = ibn; ian = ian2; ibn = ibn2;
#pragma unroll
        for (int i = 0; i < 16; ++i) hh[i] = xn[i] * (1.f + scn[i]) + shn[i];
    }
}
__device__ void phase_peer_out(const W p, int gwave_, int nwaves_, int layer, unsigned char* smem) {
    const int gwave = __builtin_amdgcn_readfirstlane(gwave_), nwaves = __builtin_amdgcn_readfirstlane(nwaves_);
    const int lane = tidx() & 63;
    const float* mod = WSP(float, WS_MOD) + (size_t)layer * 5 * 6144;
    const unsigned char* V = p.ws + (layer ? WS_TABV1 : WS_TABV0);
    const int* idxo = WSP(int, WS_IDX);
    const float* acto = WSP(float, WS_ACT);
    const float* g = PAR(layer ? PAR_LN2G1 : PAR_LN2G0);
    const float* bt = PAR(layer ? PAR_LN2B1 : PAR_LN2B0);
    float* sp = (float*)smem;
    for (int i = tidx(); i < 1024; i += 256) {
        sp[i] = g[i]; sp[1024 + i] = bt[i];
#pragma unroll
        for (int v = 0; v < 5; ++v) {
            sp[2048 + v * 1024 + i] = mod[v * 6144 + 5120 + i];
            if (layer == 0) { sp[7168 + v * 1024 + i] = mod[(5 + v) * 6144 + 1024 + i]; sp[12288 + v * 1024 + i] = mod[(5 + v) * 6144 + i]; }
        }
    }
    __syncthreads();
    const int nv = layer ? NB * TT : NTOK;
    if (gwave >= nv) return;
    v6u rg[GD];
    const unsigned lane12 = (unsigned)lane * 12u;
    int R = gather_tok(layer, gwave);
    int ia = idxo[(size_t)R * 128 + lane], ib = idxo[(size_t)R * 128 + 64 + lane];
#pragma unroll
    for (int j = 0; j < GD; ++j) G_ISSUE(j, V, ia, ib, j)
    int Rn = gather_tok(layer, gwave + nwaves < nv ? gwave + nwaves : gwave);
    int ian = idxo[(size_t)Rn * 128 + lane], ibn = idxo[(size_t)Rn * 128 + 64 + lane];
    float acta = acto[(size_t)R * 128 + lane], actb = acto[(size_t)R * 128 + 64 + lane];
    float xr[16];
    { const float* xrow = gather_xrow(p, R);
#pragma unroll
      for (int q4 = 0; q4 < 4; ++q4) { const float4 xv = *(const float4*)&xrow[lane * 16 + q4 * 4]; xr[q4 * 4] = xv.x; xr[q4 * 4 + 1] = xv.y; xr[q4 * 4 + 2] = xv.z; xr[q4 * 4 + 3] = xv.w; } }
    for (int jt = gwave; jt < nv; jt += nwaves) {
        const int b = R / SS, s = R - b * SS;
        float* xrow = s < LC ? WSP(float, WS_CTX) + ((size_t)(b * LC + s)) * DM : p.out + ((size_t)(b * TT + s - LC)) * DM;
        const int var = s < LC ? 4 : b;
        const int j2 = jt + 2 * nwaves < nv ? jt + 2 * nwaves : jt;
        const int R2 = gather_tok(layer, j2);
        const int ln0 = tidx() & 63;
        const int ian2 = idxo[(size_t)R2 * 128 + ln0], ibn2 = idxo[(size_t)R2 * 128 + 64 + ln0];
        const float actan = acto[(size_t)Rn * 128 + ln0], actbn = acto[(size_t)Rn * 128 + 64 + ln0];
        f32x2 o2[8]; float xn[16];
#pragma unroll
        for (int i = 0; i < 8; ++i) o2[i] = (f32x2){0.f, 0.f};
        { const float* xrown = gather_xrow(p, Rn);
          const int lk2 = ln0 * 16;
#pragma unroll
          for (int q4 = 0; q4 < 4; ++q4) { const float4 xv = *(const float4*)&xrown[lk2 + q4 * 4]; xn[q4 * 4] = xv.x; xn[q4 * 4 + 1] = xv.y; xn[q4 * 4 + 2] = xv.z; xn[q4 * 4 + 3] = xv.w; } }
        asm volatile("" :: "v"(ian), "v"(ibn), "v"(acta), "v"(actb));
#pragma unroll 1
        for (int e0 = 0; e0 < 64; e0 += GD) {
            const bool last = e0 + GD >= 64;
            const int ja = last ? ian : ia, jb = last ? ibn : ib;
#pragma unroll
            for (int j = 0; j < GD; ++j) {
                G_PIN(j)
                const v32f vv = __builtin_amdgcn_cvt_scalef32_pk32_f32_fp6(rg[j], 1.0f);
                G_ISSUE(j, V, ja, jb, (e0 + j + GD) & 63)
                const float w0 = __builtin_bit_cast(float, __builtin_amdgcn_readlane(__builtin_bit_cast(int, acta), e0 + j));
                const float w1 = __builtin_bit_cast(float, __builtin_amdgcn_readlane(__builtin_bit_cast(int, actb), e0 + j));
                const f32x2 w02 = {w0, w0}, w12 = {w1, w1};
#pragma unroll
                for (int i = 0; i < 8; ++i) {
                    o2[i] = __builtin_elementwise_fma(w02, (f32x2){vv[2 * i], vv[2 * i + 1]}, o2[i]);
                    o2[i] = __builtin_elementwise_fma(w12, (f32x2){vv[16 + 2 * i], vv[17 + 2 * i]}, o2[i]);
                }
                asm volatile("" : "+v"(o2[0]), "+v"(o2[1]), "+v"(o2[2]), "+v"(o2[3]), "+v"(o2[4]), "+v"(o2[5]), "+v"(o2[6]), "+v"(o2[7]));
                __builtin_amdgcn_sched_barrier(0);
            }
        }
        float o[16];
#pragma unroll
        for (int i = 0; i < 8; ++i) { o[2 * i] = o2[i][0]; o[2 * i + 1] = o2[i][1]; }
        float vsum = 0.f;
        const int lk3 = (tidx() & 63) * 16;
#pragma unroll
        for (int q4 = 0; q4 < 4; ++q4) {
            const int k = lk3 + q4 * 4;
            const float4 g2 = *(const float4*)&sp[2048 + var * 1024 + k];
            o[q4 * 4 + 0] = ALPHA_F * xr[q4 * 4 + 0] + g2.x * o[q4 * 4 + 0];
            o[q4 * 4 + 1] = ALPHA_F * xr[q4 * 4 + 1] + g2.y * o[q4 * 4 + 1];
            o[q4 * 4 + 2] = ALPHA_F * xr[q4 * 4 + 2] + g2.z * o[q4 * 4 + 2];
            o[q4 * 4 + 3] = ALPHA_F * xr[q4 * 4 + 3] + g2.w * o[q4 * 4 + 3];
        }
#pragma unroll
        for (int i = 0; i < 16; ++i) vsum += o[i];
        const float mean = wave_sum(vsum) * (1.f / 1024.f);
        float vq2 = 0.f;
#pragma unroll
        for (int i = 0; i < 16; ++i) { const float dl = o[i] - mean; vq2 += dl * dl; }
        const float rs = rsqrtf(wave_sum(vq2) * (1.f / 1024.f) + 1e-5f);
#pragma unroll
        for (int q4 = 0; q4 < 4; ++q4) {
            const int k = lk3 + q4 * 4;
            const float4 gg = *(const float4*)&sp[k], bb = *(const float4*)&sp[1024 + k];
            float4 r;
            r.x = (o[q4 * 4 + 0] - mean) * rs * gg.x + bb.x; r.y = (o[q4 * 4 + 1] - mean) * rs * gg.y + bb.y;
            r.z = (o[q4 * 4 + 2] - mean) * rs * gg.z + bb.z; r.w = (o[q4 * 4 + 3] - mean) * rs * gg.w + bb.w;
            *(float4*)&xrow[k] = r;
            if (layer == 0) {
                const float4 sc = *(const float4*)&sp[7168 + var * 1024 + k], sh = *(const float4*)&sp[12288 + var * 1024 + k];
                *(uint2*)(WSP(bf16_t, WS_HB2) + (size_t)R * 1024 + k) =
                    make_uint2(pack2(r.x * (1.f + sc.x) + sh.x, r.y * (1.f + sc.y) + sh.y), pack2(r.z * (1.f + sc.z) + sh.z, r.w * (1.f + sc.w) + sh.w));
            }
        }
        R = Rn; Rn = R2; ia = ian; ib = ibn; ian = ian2; ibn = ibn2; acta = actan; actb = actbn;
#pragma unroll
        for (int i = 0; i < 16; ++i) xr[i] = xn[i];
    }
}
#undef G_ISSUE
#undef G_PIN
#undef BFLY

constexpr size_t WS_ROPE = WS_END;
static_assert(WS_ROPE + 16384 <= (size_t)536870912, "rope table fits");
__device__ void phase_rope_table(const P& p, size_t gtid, size_t gthreads) {
    float* rt = WSP(float, WS_ROPE);
    for (size_t e = gtid; e < 128 * 16; e += gthreads) {
        const int i = (int)(e & 15), pos = (int)(e >> 4);
        const float freq = powf(10000.f, -(float)i / 16.f);
        const float ang = (float)pos * freq;
        rt[e * 2] = cosf(ang); rt[e * 2 + 1] = sinf(ang);
    }
}
struct EpiZX1 {
    bf16_t* zx; bf16_t* vt; const float* rope; int m0, n0;
    __device__ void operator()(const float* Cs, int pass, int tid) const {
        const int Rb = m0 + pass * 64;
        const int b = Rb / SS, sb = Rb - b * SS;
        const bool isv = (n0 == 640) || (n0 >= 1792);
        if (isv) {
            const int hv0 = (n0 == 640) ? 0 : 2 + (n0 - 1792) / 64;
#pragma unroll
            for (int i = 0; i < 4; ++i) {
                const int c = tid + 256 * i, col = c >> 3, r8 = (c & 7) * 8;
                float v[8];
#pragma unroll
                for (int u = 0; u < 8; ++u) v[u] = Cs[(r8 + u) * CS_LD + col];
                uint4 o; o.x = pack2(v[0], v[1]); o.y = pack2(v[2], v[3]); o.z = pack2(v[4], v[5]); o.w = pack2(v[6], v[7]);
                *(uint4*)&vt[((size_t)(b * 10 + hv0 + (col >> 6)) * 64 + (col & 63)) * SS + sb + r8] = o;
            }
            return;
        }
        const bool dorope = (n0 < 640) && (sb >= LC);
#pragma unroll
        for (int i = 0; i < 4; ++i) {
            const int c = tid + 256 * i, row = c >> 4, col8 = (c & 15) * 8;
            const int R = Rb + row;
            float v[8];
            const float4 a = *(const float4*)&Cs[row * CS_LD + col8], bq = *(const float4*)&Cs[row * CS_LD + col8 + 4];
            v[0] = a.x; v[1] = a.y; v[2] = a.z; v[3] = a.w; v[4] = bq.x; v[5] = bq.y; v[6] = bq.z; v[7] = bq.w;
            if (dorope) {
                const int t = sb + row - LC;
                const int e0 = col8 & 31, half = (col8 >> 5) & 1;
                const int pos = half ? (t & 63) : (t >> 6);
                const bool lo = e0 < 16;
                const int pc = lo ? col8 + 16 : col8 - 16;
                const float4 pa = *(const float4*)&Cs[row * CS_LD + pc], pb = *(const float4*)&Cs[row * CS_LD + pc + 4];
                const float pv[8] = {pa.x, pa.y, pa.z, pa.w, pb.x, pb.y, pb.z, pb.w};
#pragma unroll
                for (int u = 0; u < 8; ++u) {
                    const int fi = (e0 & 15) + u;
                    const float cs = rope[(pos * 16 + fi) * 2], sn = rope[(pos * 16 + fi) * 2 + 1];
                    v[u] = lo ? (v[u] * cs - pv[u] * sn) : (v[u] * cs + pv[u] * sn);
                }
            }
            uint4 o; o.x = pack2(v[0], v[1]); o.y = pack2(v[2], v[3]); o.z = pack2(v[4], v[5]); o.w = pack2(v[6], v[7]);
            *(uint4*)&zx[(size_t)R * ZW1 + n0 + col8] = o;
        }
    }
};
__device__ void phase_gemm_win1(const W p, unsigned char* smem, int bid, int nblk) {
    LdBf16 al{WSP(bf16_t, WS_HB2), 1024};
    LdBf16 bl{WSP(bf16_t, WS_WIN1T), 1024};
    const int ntn = ZW1 / 128, total = (NTOK / 128) * ntn;
    for (int t = xcd_swz(bid, nblk); t < total; t += nblk) {
        const int m0 = (t / ntn) * 128, n0 = (t % ntn) * 128;
        EpiZX1 epi{WSP(bf16_t, WS_ZX), WSP(bf16_t, WS_VT), WSP(float, WS_ROPE), m0, n0};
        gemm_tile_dma(al.base, al.ld, bl.base, bl.ld, 1024, m0, n0, epi, smem);
    }
}

#define AT_LD 72
#define ATTN_SMEM_BYTES (2 * 64 * AT_LD * 2)
#define MASK_NEG (-1.0e30f)
template <int kind>
__device__ void attn_item(const W p, int item, unsigned char* smem) {
    const int qt = item & 63, hq = (item >> 6) & 7, b = (item >> 9) & 3;
    const int tid = tidx(), lane = tid & 63, wave = tid >> 6, hh = lane >> 5, ql = lane & 31;
    bf16_t* Ks = (bf16_t*)smem;
    bf16_t* Vs = Ks + 64 * AT_LD;
    const bf16_t* zx = WSP(bf16_t, WS_ZX);
    const int t0 = qt * 128;
    const int qcol = kind ? 768 + hq * 64 : hq * 64;
    const int kcol = kind ? 1280 + hq * 64 : 512 + (hq >> 2) * 64;
    const bf16_t* vt = WSP(bf16_t, WS_VT) + ((size_t)(b * 10 + (kind ? 2 + hq : (hq >> 2))) * 64) * SS;
    const int ocol = kind ? 512 + hq * 64 : hq * 64;
    const int tq = t0 + wave * 32 + ql, tq0w = t0 + wave * 32;
    const size_t Rq = (size_t)b * SS + LC + tq;
    bf16x8 qf[4];
#pragma unroll
    for (int st = 0; st < 4; ++st) qf[st] = *(const bf16x8*)&zx[Rq * ZW1 + qcol + st * 16 + 8 * hh];
    int lk0, lk1;
    const int r0 = t0 >> 6;
    if (kind == 0) { lk0 = t0 - 128 < 0 ? 0 : t0 - 128; lk1 = t0 + 256 > TT ? TT : t0 + 256; }
    else {
        int rs0 = r0 - 4; rs0 = rs0 < 0 ? 0 : (rs0 > 120 ? 120 : rs0);
        int rs1 = r0 + 1 - 4; rs1 = rs1 < 0 ? 0 : (rs1 > 120 ? 120 : rs1);
        lk0 = rs0 * 64; lk1 = (rs1 + 8) * 64;
    }
    const int nloc = (lk1 - lk0) >> 6;
    const int rq = tq >> 6, cq = tq & 63;
    int rsq = rq - 4; rsq = rsq < 0 ? 0 : (rsq > 120 ? 120 : rsq);
    int csq = cq - 8; csq = csq < 0 ? 0 : (csq > 48 ? 48 : csq);
    const float* rpb = PAR(PAR_RPB) + (size_t)hq * 15 * 31;
    float m = MASK_NEG, l = 0.f;
    f32x16 oacc[2];
#pragma unroll
    for (int r = 0; r < 16; ++r) { oacc[0][r] = 0.f; oacc[1][r] = 0.f; }
    const int prr = tid >> 3, pc8 = (tid & 7) * 8;
    u32x4v pk0, pk1, pv0, pv1;
    pk0 = *(const u32x4v*)&zx[((size_t)b * SS + prr) * ZW1 + kcol + pc8];        pk1 = *(const u32x4v*)&zx[((size_t)b * SS + 32 + prr) * ZW1 + kcol + pc8];
    pv0 = *(const u32x4v*)&vt[(size_t)prr * SS + pc8];                           pv1 = *(const u32x4v*)&vt[(size_t)(32 + prr) * SS + pc8];
    for (int ti = 0; ti < 4 + nloc; ++ti) {
        const bool isctx = ti < 4;
        const int sbase = isctx ? ti * 64 : LC + lk0 + (ti - 4) * 64;
        __syncthreads();
        *(u32x4v*)&Ks[prr * AT_LD + pc8] = pk0; *(u32x4v*)&Ks[(32 + prr) * AT_LD + pc8] = pk1;
        *(u32x4v*)&Vs[prr * AT_LD + pc8] = pv0; *(u32x4v*)&Vs[(32 + prr) * AT_LD + pc8] = pv1;
        __syncthreads();
        if (ti + 1 < 4 + nloc) {
            const int sbn = (ti + 1 < 4) ? (ti + 1) * 64 : LC + lk0 + (ti + 1 - 4) * 64;
            pk0 = *(const u32x4v*)&zx[((size_t)b * SS + sbn + prr) * ZW1 + kcol + pc8];  pk1 = *(const u32x4v*)&zx[((size_t)b * SS + sbn + 32 + prr) * ZW1 + kcol + pc8];
            pv0 = *(const u32x4v*)&vt[(size_t)prr * SS + sbn + pc8];                     pv1 = *(const u32x4v*)&vt[(size_t)(32 + prr) * SS + sbn + pc8];
        }
        const int tk0 = sbase - LC;
        const int kr = tk0 >> 6;
        if (!isctx && kind == 1) {
            const int rqw = (t0 + wave * 32) >> 6;
            int rsw = rqw - 4; rsw = rsw < 0 ? 0 : (rsw > 120 ? 120 : rsw);
            if (kr < rsw || kr >= rsw + 8) continue;
        }
#pragma unroll
        for (int sub = 0; sub < 2; ++sub) {
            f32x16 sacc;
#pragma unroll
            for (int r = 0; r < 16; ++r) sacc[r] = 0.f;
#pragma unroll
            for (int st = 0; st < 4; ++st) {
                const bf16x8 kf = *(const bf16x8*)&Ks[(sub * 32 + ql) * AT_LD + st * 16 + 8 * hh];
                sacc = __builtin_amdgcn_mfma_f32_32x32x16_bf16(kf, qf[st], sacc, 0, 0, 0);
            }
            float sv[16], smax = MASK_NEG;
            const bool needmask = !isctx && (kind == 1 || (tk0 + 63 - tq0w > 128) || (tk0 - (tq0w + 31) < -128));
            if (kind == 1 && needmask) {
                const float* rb = rpb + (kr - rq + 7) * 31 + (15 - cq);
                float bias[16];
#pragma unroll
                for (int r = 0; r < 16; ++r) {
                    const int key = sub * 32 + (r & 3) + 8 * (r >> 2) + 4 * hh;
                    const bool valid = (unsigned)(key - csq) < 16u;
                    bias[r] = rb[valid ? key : csq];
                }
#pragma unroll
                for (int r = 0; r < 16; ++r) {
                    const int key = sub * 32 + (r & 3) + 8 * (r >> 2) + 4 * hh;
                    const bool valid = (unsigned)(key - csq) < 16u;
                    const float x = valid ? sacc[r] * 0.18033688011f + 1.44269504089f * bias[r] : MASK_NEG;
                    sv[r] = x; smax = fmaxf(smax, x);
                }
            } else {
#pragma unroll
                for (int r = 0; r < 16; ++r) {
                    const int key = sub * 32 + (r & 3) + 8 * (r >> 2) + 4 * hh;
                    float x = sacc[r] * 0.18033688011f;
                    if (kind == 0 && needmask) { const int dlt = tk0 + key - tq; if (dlt > 128 || dlt < -128) x = MASK_NEG; }
                    sv[r] = x; smax = fmaxf(smax, x);
                }
            }
            smax = half_swap_max(smax);
            const float mn = fmaxf(m, smax);
            if (__builtin_amdgcn_ballot_w64(mn > m)) {
                const float alpha = __builtin_amdgcn_exp2f(m - mn);
                l *= alpha;
#pragma unroll
                for (int r = 0; r < 16; ++r) { oacc[0][r] *= alpha; oacc[1][r] *= alpha; }
                m = mn;
            }
            float ps = 0.f;
#pragma unroll
            for (int r = 0; r < 16; ++r) { sv[r] = __builtin_amdgcn_exp2f(sv[r] - m); ps += sv[r]; }
            l += ps;
#pragma unroll
            for (int s2 = 0; s2 < 2; ++s2) {
                union { bf16x8 v; unsigned u[4]; } pb;
#pragma unroll
                for (int u = 0; u < 4; ++u) pb.u[u] = pack2(sv[8 * s2 + 2 * u], sv[8 * s2 + 2 * u + 1]);
#pragma unroll
                for (int db = 0; db < 2; ++db) {
                    union { bf16x8 v; uint2 h[2]; } vf;
                    const bf16_t* vrow = &Vs[(db * 32 + ql) * AT_LD + sub * 32 + 16 * s2 + 4 * hh];
                    vf.h[0] = *(const uint2*)vrow;
                    vf.h[1] = *(const uint2*)(vrow + 8);
                    oacc[db] = __builtin_amdgcn_mfma_f32_32x32x16_bf16(vf.v, pb.v, oacc[db], 0, 0, 0);
                }
            }
        }
    }
    float lt = half_swap_sum(l);
    if (kind == 0) lt += __builtin_amdgcn_exp2f(1.44269504089f * PAR(PAR_SINK)[hq] - m);
    const float inv = 1.f / lt;
    bf16_t* mix = WSP(bf16_t, WS_MIX);
#pragma unroll
    for (int db = 0; db < 2; ++db)
#pragma unroll
        for (int g4 = 0; g4 < 4; ++g4) {
            const int dd = db * 32 + 8 * g4 + 4 * hh;
            uint2 o; o.x = pack2(oacc[db][4 * g4] * inv, oacc[db][4 * g4 + 1] * inv); o.y = pack2(oacc[db][4 * g4 + 2] * inv, oacc[db][4 * g4 + 3] * inv);
            *(uint2*)&mix[Rq * 1024 + ocol + dd] = o;
        }
}


enum { PH_TRANSPOSE = 0, PH_CONVERT, PH_MODP, PH_MISC, PH_S5TAB, PH_WIN0, PH_S5E, PH_S5CARRY, PH_S5Y, PH_RWKV, PH_GLU, PH_RWKVOUT,
       PH_WOUT, PH_LN1, PH_QGEMM, PH_TOPK, PH_GATHER, PH_GATHERB, PH_WIN1, PH_ATTN, PH_RWPREP, PH_COUNT };
template <int PH> struct PhaseSmem { static constexpr int bytes = 1024; };
template <> struct PhaseSmem<PH_TRANSPOSE> { static constexpr int bytes = 64 * 65 * 4; };
template <> struct PhaseSmem<PH_WIN0>    { static constexpr int bytes = GEMM_SMEM_BYTES; };
template <> struct PhaseSmem<PH_S5E>     { static constexpr int bytes = GEMM_SMEM_BYTES; };
template <> struct PhaseSmem<PH_S5Y>     { static constexpr int bytes = GEMM_SMEM_BYTES; };
template <> struct PhaseSmem<PH_RWKV>    { static constexpr int bytes = (int)sizeof(RwkvSmem); };
template <> struct PhaseSmem<PH_GLU>     { static constexpr int bytes = GEMM_SMEM_BYTES; };
template <> struct PhaseSmem<PH_RWKVOUT> { static constexpr int bytes = GEMM_SMEM_BYTES; };
template <> struct PhaseSmem<PH_WOUT>    { static constexpr int bytes = GEMM_SMEM_BYTES; };
template <> struct PhaseSmem<PH_QGEMM>   { static constexpr int bytes = GEMM_SMEM_BYTES; };
template <> struct PhaseSmem<PH_TOPK>    { static constexpr int bytes = TOPK_SMEM_BYTES; };
template <> struct PhaseSmem<PH_WIN1>    { static constexpr int bytes = GEMM_SMEM_BYTES; };
template <> struct PhaseSmem<PH_ATTN>    { static constexpr int bytes = ATTN_SMEM_BYTES; };

template <int PH>
__device__ __forceinline__ void run_early(const P& p, unsigned char* smem) {
    const int bid = bidx(), nblk = gridDim.x;
    const size_t gtid = (size_t)bid * 256 + tidx(), gthreads = (size_t)nblk * 256;
    const int gwave = bid * 4 + (tidx() >> 6), nwaves = nblk * 4;
    if constexpr (PH == PH_TRANSPOSE) phase_transpose(p, (float*)smem, bid, nblk);
    else if constexpr (PH == PH_CONVERT) phase_convert(p, gtid, gthreads);
    else if constexpr (PH == PH_MODP) phase_mod_partial(p, gwave, nwaves);
    else if constexpr (PH == PH_MISC) { phase_s5_pow(p, gtid, gthreads); phase_rope_table(p, gtid, gthreads); phase_pack_params(p, gtid, gthreads); }
    else if constexpr (PH == PH_S5TAB) { phase_mod_reduce(p, gtid, gthreads); phase_s5_tables(p, gtid, gthreads); }
}
template <int PH>
__device__ __forceinline__ void run_phase(const W p, int layer, unsigned char* smem) {
    const int bid = bidx(), nblk = gridDim.x;
    const size_t gtid = (size_t)bid * 256 + tidx(), gthreads = (size_t)nblk * 256;
    const int gwave = bid * 4 + (tidx() >> 6), nwaves = nblk * 4;
    if constexpr (PH == PH_WIN0) phase_gemm_win0(p, smem, bid, nblk);
    else if constexpr (PH == PH_RWPREP) { phase_rw_shift(p, gwave, nwaves); phase_rw_lora(p, smem, bid, nblk); }
    else if constexpr (PH == PH_S5E) phase_s5_E(p, smem, (bid + nblk - 8448 % nblk) % nblk, nblk);
    else if constexpr (PH == PH_S5CARRY) phase_s5_carry(p, gtid, gthreads);
    else if constexpr (PH == PH_S5Y) phase_s5_Y(p, smem, bid, nblk);
    else if constexpr (PH == PH_RWKV) { for (int it = bid; it < 256; it += nblk) rwkv_scan_item(p, it, smem); }
    else if constexpr (PH == PH_GLU) phase_glu(p, smem, bid, nblk);
    else if constexpr (PH == PH_RWKVOUT) phase_rwkv_out(p, smem, bid, nblk);
    else if constexpr (PH == PH_WOUT) phase_gemm_wout(p, smem, bid, nblk, layer);
    else if constexpr (PH == PH_LN1) phase_ln1(p, gwave, nwaves, layer, smem);
    else if constexpr (PH == PH_QGEMM) phase_gemm_q(p, smem, bid, nblk, layer);
    else if constexpr (PH == PH_TOPK) {
        for (int it = bid; it < (NTOK / 64) * 8; it += nblk) { if (layer && ((it >> 3) * 64) % SS < LC) continue; peer_topk_item(p, it, smem, layer); }
    }
    else if constexpr (PH == PH_GATHER) phase_peer_act(p, gwave, nwaves, layer);
    else if constexpr (PH == PH_GATHERB) phase_peer_out(p, gwave, nwaves, layer, smem);
    else if constexpr (PH == PH_WIN1) phase_gemm_win1(p, smem, bid, nblk);
    else if constexpr (PH == PH_ATTN) { for (int it = bid; it < 2048; it += nblk) attn_item<1>(p, it, smem); for (int it = bid; it < 2048; it += nblk) attn_item<0>(p, it, smem); }
}

namespace cg = cooperative_groups;
constexpr int cmax(int a, int b) { return a > b ? a : b; }
constexpr int MEGA_SMEM = cmax(cmax(GEMM_SMEM_BYTES, RW1_SMEM_BYTES), cmax(TOPK_SMEM_BYTES, ATTN_SMEM_BYTES));
static_assert(MEGA_SMEM >= 17408 * 4, "gather epilogue vectors fit in LDS");
static_assert(MEGA_SMEM >= 128 * CS_LD * 4, "128-row C staging fits");

#define DIAG 0
#define DIAG_A0 13
#define DIAG_A1 14
#if DIAG
#define STAMP(k) do { if (bidx() == 0 && tidx() == 0) ((volatile unsigned long long*)(p.ws + WS_TS))[k] = __builtin_amdgcn_s_memrealtime(); } while (0)
#define DIAG_TAIL() do { GSYNC(); STAMP(63); GSYNC(); \
    const volatile unsigned long long* ts = (const volatile unsigned long long*)(p.ws + WS_TS); \
    const float ra = (float)(ts[DIAG_A1] - ts[DIAG_A0]) * (1.f / 500000.f);     \
    const float sc = 1.f + sqrtf(0.04f * ra); \
    for (size_t i = (size_t)bidx() * 256 + tidx(); i < (size_t)NB * TT * DM; i += (size_t)gridDim.x * 256) p.out[i] *= sc; } while (0)
#else
#define STAMP(k)
#define DIAG_TAIL()
#endif
#define GSYNC() xcd_barrier(xb)

__device__ __forceinline__ void phase_scan_and_side(const P& p, const W w, unsigned char* smem, volatile LAS unsigned* bc) {
    unsigned* ctl = (unsigned*)(p.ws + WS_CTL);
    if (bidx() < 64) { __builtin_amdgcn_s_setprio(3); rw2_chain(w, bidx(), smem); __builtin_amdgcn_s_setprio(0); }
    STAMP(20);
    for (;;) { const int t = take_ticket(&ctl[CT_S5YT], bc); if (t >= 640) break; phase_s5_Y(w, smem, t, 1 << 30); }
}

__global__ void __launch_bounds__(256, 2) mega_kernel(P p) {
    __shared__ __attribute__((aligned(16))) unsigned char smem[MEGA_SMEM + 64];
    cg::grid_group grid = cg::this_grid();
    volatile LAS unsigned* st = (volatile LAS unsigned*)(smem + MEGA_SMEM);
    if (tidx() < 4) st[tidx()] = 0u;
    __syncthreads();
    XcdBarrier xb = xcd_barrier_post((unsigned*)(p.ws + WS_CTL), st);
    volatile LAS unsigned* bc = st + 2;
    STAMP(0);
    run_early<PH_TRANSPOSE>(p, smem); STAMP(21);
    run_early<PH_MODP>(p, smem); STAMP(22);
    run_early<PH_MISC>(p, smem);
    GSYNC(); STAMP(1);
    run_early<PH_S5TAB>(p, smem);
    GSYNC(); STAMP(2);
    const W w{p.in[I_X], p.in[I_CTX], p.out, p.ws};
    phase_xcvt(w, smem);
    GSYNC();
    run_phase<PH_WIN0>(w, 0, smem);
    GSYNC(); STAMP(3);
    run_phase<PH_S5E>(w, 0, smem);
    for (int it = bidx(); it < 8448; it += gridDim.x) rw1_item(w, it, smem);
    { unsigned* ctl = (unsigned*)(p.ws + WS_CTL);
      wait_count(ctl, CT_S5ED, 160u);
      for (;;) { const int t = take_ticket(&ctl[CT_CARRYT], bc); if (t >= 32) break; phase_s5_carry(w, (size_t)t * 256 + tidx(), (size_t)1 << 40); } }
    GSYNC(); STAMP(4);
    phase_scan_and_side(p, w, smem, bc);
    GSYNC(); STAMP(5);
    run_phase<PH_GLU>(w, 0, smem);
    run_phase<PH_RWKVOUT>(w, 0, smem);
    run_early<PH_CONVERT>(p, smem);
    GSYNC(); STAMP(7);
    run_phase<PH_WOUT>(w, 0, smem);   GSYNC(); STAMP(8);
    run_phase<PH_LN1>(w, 0, smem);    GSYNC(); STAMP(9);
    run_phase<PH_QGEMM>(w, 0, smem);  GSYNC(); STAMP(10);
    STAMP(11);
    run_phase<PH_GATHER>(w, 0, smem); GSYNC(); run_phase<PH_GATHERB>(w, 0, smem); GSYNC(); STAMP(12);
    run_phase<PH_WIN1>(w, 1, smem);   GSYNC(); STAMP(13);
    run_phase<PH_ATTN>(w, 1, smem);   GSYNC(); STAMP(14);
    run_phase<PH_WOUT>(w, 1, smem);   GSYNC(); STAMP(15);
    run_phase<PH_LN1>(w, 1, smem);    GSYNC(); STAMP(16);
    run_phase<PH_QGEMM>(w, 1, smem);  GSYNC(); STAMP(17);
    STAMP(18);
    run_phase<PH_GATHER>(w, 1, smem); GSYNC(); run_phase<PH_GATHERB>(w, 1, smem);
    DIAG_TAIL();
    grid.sync();
}

extern "C" void kernel_launch(void* const* d_in, const int* in_sizes, int n_in, void* d_out, int out_size, void* d_ws, size_t ws_size,
                              hipStream_t stream) {
    (void)in_sizes; (void)n_in; (void)out_size; (void)ws_size;
    static int grid_blocks = 0;
    if (!grid_blocks) {
        int dev = 0, cus = 0, per_cu = 0;
        hipGetDevice(&dev);
        hipDeviceGetAttribute(&cus, hipDeviceAttributeMultiprocessorCount, dev);
        hipOccupancyMaxActiveBlocksPerMultiprocessor(&per_cu, mega_kernel, 256, 0);
        if (per_cu > 2) per_cu = 2;
        if (per_cu < 1) per_cu = 1;
        grid_blocks = cus * per_cu;
    }
    P p{};
    for (int i = 0; i < 51; ++i) p.in[i] = (const float*)d_in[i];
    p.out = (float*)d_out; p.ws = (unsigned char*)d_ws;
    hipMemsetAsync((unsigned char*)d_ws + WS_CTL, 0, CTL_WORDS * 4, stream);
    void* args[] = {&p};
    hipError_t e = hipLaunchCooperativeKernel((void*)mega_kernel, dim3(grid_blocks), dim3(256), args, 0, stream);
    if (e != hipSuccess) fprintf(stderr, "cooperative launch failed: %s (grid %d)\n", hipGetErrorString(e), grid_blocks);
}
```

```cpp
#include <hip/hip_runtime.h>
#include <hip/hip_cooperative_groups.h>
#include <stdint.h>
#include <stdio.h>
#define DIAGX 0

#define DM      1024
#define NB      4
#define TT      8192
#define LC      256
#define SS      8448
#define NTOK    33792
#define ZW0     2176
#define ZW1     2304
#define ALPHA_F 1.41421356237f
#define NCH     132

typedef unsigned short bf16_t;
using bf16x8 = __attribute__((ext_vector_type(8))) short;
using f32x16 = __attribute__((ext_vector_type(16))) float;
using f32x4  = __attribute__((ext_vector_type(4))) float;
using bf16x2v = __attribute__((ext_vector_type(2))) __bf16;
using u32x4v = __attribute__((ext_vector_type(4))) unsigned;


__device__ __forceinline__ int tidx() { int t = (int)threadIdx.x; asm volatile("" : "+v"(t)); return t; }
__device__ __forceinline__ int bidx() { int t = (int)blockIdx.x; asm volatile("" : "+s"(t)); return t; }
typedef __bf16 hwbf16x2_t __attribute__((ext_vector_type(2)));
typedef float hwf32x2_t __attribute__((ext_vector_type(2)));
__device__ __forceinline__ bf16_t f2bf(float f) { return (bf16_t)__builtin_bit_cast(unsigned short, (__bf16)f); }
__device__ __forceinline__ float bf2f(bf16_t h) { return __uint_as_float(((unsigned)h) << 16); }
__device__ __forceinline__ unsigned pack2(float lo, float hi) { const hwf32x2_t f = {lo, hi}; return __builtin_bit_cast(unsigned, __builtin_convertvector(f, hwbf16x2_t)); }
__device__ __forceinline__ float bflo(unsigned u) { return __uint_as_float(u << 16); }
__device__ __forceinline__ float bfhi(unsigned u) { return __uint_as_float(u & 0xffff0000u); }
__device__ __forceinline__ float sigmoidf_(float x) { return 1.f / (1.f + __expf(-x)); }
__device__ __forceinline__ float siluf_(float x) { return x / (1.f + __expf(-x)); }
__device__ __forceinline__ float geluf_(float x) { return 0.5f * x * (1.f + erff(x * 0.70710678118654752f)); }

template <int CTRL> __device__ __forceinline__ float dppf(float x) {
    return __builtin_bit_cast(float, __builtin_amdgcn_mov_dpp(__builtin_bit_cast(int, x), CTRL, 0xf, 0xf, true));
}
#define DPP_XOR1 0xB1
#define DPP_XOR2 0x4E
#define DPP_ROR4 0x124
#define DPP_ROR8 0x128
__device__ __forceinline__ float row16_sum(float x) {
    x += dppf<DPP_XOR1>(x); x += dppf<DPP_XOR2>(x); x += dppf<DPP_ROR4>(x); x += dppf<DPP_ROR8>(x); return x;
}
__device__ __forceinline__ float row16_max(float x) {
    x = fmaxf(x, dppf<DPP_XOR1>(x)); x = fmaxf(x, dppf<DPP_XOR2>(x)); x = fmaxf(x, dppf<DPP_ROR4>(x)); x = fmaxf(x, dppf<DPP_ROR8>(x)); return x;
}
__device__ __forceinline__ float xrow_sum(float x) {
    auto s = __builtin_amdgcn_permlane16_swap(__float_as_uint(x), __float_as_uint(x), false, false);
    x = __uint_as_float(s[0]) + __uint_as_float(s[1]);
    auto t = __builtin_amdgcn_permlane32_swap(__float_as_uint(x), __float_as_uint(x), false, false);
    return __uint_as_float(t[0]) + __uint_as_float(t[1]);
}
__device__ __forceinline__ float xrow_max(float x) {
    auto s = __builtin_amdgcn_permlane16_swap(__float_as_uint(x), __float_as_uint(x), false, false);
    x = fmaxf(__uint_as_float(s[0]), __uint_as_float(s[1]));
    auto t = __builtin_amdgcn_permlane32_swap(__float_as_uint(x), __float_as_uint(x), false, false);
    return fmaxf(__uint_as_float(t[0]), __uint_as_float(t[1]));
}
__device__ __forceinline__ float wave_sum(float x) { return xrow_sum(row16_sum(x)); }
__device__ __forceinline__ float wave_max(float x) { return xrow_max(row16_max(x)); }
__device__ __forceinline__ float half_swap_sum(float x) {
    auto t = __builtin_amdgcn_permlane32_swap(__float_as_uint(x), __float_as_uint(x), false, false);
    return __uint_as_float(t[0]) + __uint_as_float(t[1]);
}
__device__ __forceinline__ float half_swap_max(float x) {
    auto t = __builtin_amdgcn_permlane32_swap(__float_as_uint(x), __float_as_uint(x), false, false);
    return fmaxf(__uint_as_float(t[0]), __uint_as_float(t[1]));
}

constexpr size_t al256(size_t x) { return (x + 255) & ~(size_t)255; }
constexpr size_t WS_WIN0T  = 0;
constexpr size_t WS_WOUT0T = WS_WIN0T  + al256((size_t)ZW0 * 1024 * 2);
constexpr size_t WS_WQ0T   = WS_WOUT0T + al256((size_t)1024 * 768 * 2);
constexpr size_t WS_KEYS0  = WS_WQ0T   + al256((size_t)1024 * 1024 * 2);
constexpr size_t WS_WIN1T  = WS_KEYS0  + al256((size_t)2048 * 64 * 2);
constexpr size_t WS_WOUT1T = WS_WIN1T  + al256((size_t)ZW1 * 1024 * 2);
constexpr size_t WS_WQ1T   = WS_WOUT1T + al256((size_t)1024 * 1024 * 2);
constexpr size_t WS_KEYS1  = WS_WQ1T   + al256((size_t)1024 * 1024 * 2);
constexpr size_t WS_WGLUT  = WS_KEYS1  + al256((size_t)2048 * 64 * 2);
constexpr size_t WS_W2T    = WS_WGLUT  + al256((size_t)256 * 256 * 2);
constexpr size_t WS_A2T    = WS_W2T    + al256((size_t)2 * 512 * 64 * 2);
constexpr size_t WS_G2T    = WS_A2T    + al256((size_t)2 * 512 * 64 * 2);
constexpr size_t WS_S5POW  = WS_G2T    + al256((size_t)512 * 128 * 2);
constexpr size_t WS_S5K    = WS_S5POW  + al256((size_t)2 * 16 * 64 * 65 * 2 * 4);
constexpr size_t WS_S5W    = WS_S5K    + al256((size_t)2 * 16 * 64 * 256 * 2);
constexpr size_t WS_S5V    = WS_S5W    + al256((size_t)2 * 16 * 128 * 1024 * 2);
constexpr size_t WS_MODP   = WS_S5V    + al256((size_t)2 * 16 * 1024 * 128 * 2);
constexpr size_t WS_MOD    = WS_MODP   + al256((size_t)8 * 2 * 5 * 6144 * 4);
constexpr size_t WS_TABU0  = WS_MOD    + al256((size_t)2 * 5 * 6144 * 4);
constexpr size_t WS_TABV0  = WS_TABU0  + (size_t)16384 * 1024;
constexpr size_t WS_TABU1  = WS_TABV0  + (size_t)16384 * 1024;
constexpr size_t WS_TABV1  = WS_TABU1  + (size_t)16384 * 1024;
constexpr size_t WS_TABSC  = WS_TABV1  + (size_t)16384 * 1024;
constexpr size_t WS_ZX     = WS_TABU0  + (size_t)4 * 16384 * 1024 * 2;
constexpr size_t WS_CTX    = WS_ZX     + al256((size_t)NTOK * ZW1 * 2);
constexpr size_t WS_US5    = WS_CTX    + al256((size_t)1024 * 1024 * 4);
constexpr size_t WS_S5E    = WS_US5    + al256((size_t)16 * NTOK * 16 * 2);
constexpr size_t WS_S5H    = WS_S5E    + al256((size_t)2 * 16 * 528 * 128 * 4);
constexpr size_t WS_YA     = WS_S5H    + al256((size_t)2 * 16 * 528 * 128 * 2);
constexpr size_t WS_YB     = WS_YA     + al256((size_t)NTOK * 256 * 2);
constexpr size_t WS_BON    = WS_YB     + al256((size_t)2 * NTOK * 512 * 2);
constexpr size_t WS_MIX    = WS_BON    + al256((size_t)NTOK * 16 * 4);
constexpr size_t WS_END    = WS_MIX    + al256((size_t)NTOK * 1024 * 2);
constexpr size_t WS_VT     = WS_TABSC + (size_t)4 * 16384 * 4;
static_assert(WS_VT + (size_t)4 * 10 * 64 * SS * 2 <= WS_ZX, "VT fits behind the fp8 tables");
constexpr size_t WS_HB     = WS_MIX;
constexpr size_t WS_HB2    = WS_YB;
constexpr int PAR_SHIFT = 0, PAR_A0 = 3840, PAR_W0 = 4864, PAR_KK = 5888, PAR_KA = 6400, PAR_RK = 6912, PAR_BGLU = 7424, PAR_GNW = 7680, PAR_GNB = 8192,
              PAR_LN1G0 = 8704, PAR_LN1B0 = 9728, PAR_LN2G0 = 10752, PAR_LN2B0 = 11776, PAR_LN1G1 = 12800, PAR_LN1B1 = 13824, PAR_LN2G1 = 14848, PAR_LN2B1 = 15872,
              PAR_RPB = 16896, PAR_SINK = 20736, PAR_TOTAL = 20800;
constexpr size_t WS_PAR    = WS_END + 16384;
static_assert(WS_PAR + (size_t)PAR_TOTAL * 4 <= (size_t)536870912, "param pack fits");
constexpr size_t WS_TS     = WS_PAR + (size_t)PAR_TOTAL * 4 + 256;
static_assert(WS_TS + 512 <= (size_t)536870912, "ts fits");
constexpr size_t WS_RWR    = WS_TABU0;
constexpr size_t WS_RWK    = WS_RWR + (size_t)NTOK * 512 * 2;
constexpr size_t WS_RWAS   = WS_RWK + (size_t)NTOK * 512 * 2;
constexpr size_t WS_RWNRM  = WS_RWAS + (size_t)2 * NTOK * 512;
static_assert(WS_RWNRM + (size_t)NTOK * 8 * 4 <= WS_ZX, "rwkv hand-off fits in the table region");
constexpr size_t WS_RWLW   = WS_MIX;
constexpr size_t WS_IDX    = WS_US5;
constexpr size_t WS_GATE   = WS_YA;
static_assert((size_t)NTOK * 128 * 4 <= (size_t)16 * NTOK * 16 * 2 && (size_t)NTOK * 128 * 4 <= (size_t)NTOK * 256 * 2, "idx/gate overlays");
static_assert(WS_END <= (size_t)536870912, "workspace budget");

struct P {
    const float* in[51];
    float* out;
    unsigned char* ws;
};
struct W { const float* x; const float* ctx; float* out; unsigned char* ws; };
enum {
    I_X = 0, I_C, I_CTX, I_CCTX,
    I0_WMOD, I0_BMOD, I0_WIN, I0_LAMRE, I0_LAMIM, I0_LOGDT, I0_BRE, I0_BIM, I0_CRE, I0_CIM, I0_S5D, I0_WGLU, I0_BGLU,
    I0_SHIFT, I0_W0, I0_W2, I0_A0, I0_A2, I0_G2, I0_KK, I0_KA, I0_RK, I0_GNW, I0_GNB, I0_WOUT, I0_LN1G, I0_LN1B,
    I0_WQ, I0_KEYS, I0_U, I0_V, I0_LN2G, I0_LN2B,
    I1_WMOD, I1_BMOD, I1_WIN, I1_SINK, I1_RPB, I1_WOUT, I1_LN1G, I1_LN1B, I1_WQ, I1_KEYS, I1_U, I1_V, I1_LN2G, I1_LN2B
};
static_assert(I1_LN2B == 50, "51 inputs");

#define WSP(T, off) ((T*)(p.ws + (off)))
#define PAR(off) (((const float*)(p.ws + WS_PAR)) + (off))

constexpr size_t WS_CTL = WS_TS + 512;
#define CTL_WORDS 8192
constexpr size_t WS_S5BB = WS_CTL + CTL_WORDS * 4;
static_assert(WS_S5BB + (size_t)2048 * 32 * 4 <= (size_t)536870912, "ctl + bbar fit");
#define XB_TMO      128
#define XB_XCNT(j)  (256  + 64 * (j))
#define XB_XSUB(j)  (1280 + 64 * (j))
#define XB_XGEN(j)  (2304 + 64 * (j))
#define XB_TOP      3328
#define XB_TOPGEN   3392
#define CT_ELECT    4096
#define CT_NEXT     6144
#define CT_CARRYT   6208
#define CT_CARRYD   6272
#define CT_S5YT     6336
#define CT_S5YD     6400
#define CT_CONVT    6464
#define CT_GLUT     6528
#define CT_S5ED     6592
#define XB_SPIN_CAP (1u << 22)
#define LAS __attribute__((address_space(3)))
__device__ __forceinline__ unsigned xb_ld(unsigned* p)              { return __hip_atomic_load(p, __ATOMIC_RELAXED, __HIP_MEMORY_SCOPE_AGENT); }
__device__ __forceinline__ unsigned xb_add(unsigned* p, unsigned v) { return __hip_atomic_fetch_add(p, v, __ATOMIC_RELAXED, __HIP_MEMORY_SCOPE_AGENT); }
__device__ __forceinline__ unsigned xb_xcc_id() { return (unsigned)__builtin_amdgcn_s_getreg((3 << 11) | 20) & 0xFu; }
__device__ __forceinline__ unsigned cu_key() { return ((unsigned)__builtin_amdgcn_s_getreg(63492) >> 8) & 0xffu; }
#define XB_SPIN(cond, bar) do { unsigned _sp = 0; while (cond) { __builtin_amdgcn_s_sleep(1); \
    if ((++_sp & 255u) == 0u) { if (xb_ld(&(bar)[XB_TMO])) break; if (_sp > XB_SPIN_CAP) { atomicAdd(&(bar)[XB_TMO], 1u); break; } } } } while (0)
struct XcdBarrier { unsigned* bar; unsigned x; volatile LAS unsigned* st; };
__device__ __forceinline__ XcdBarrier xcd_barrier_post(unsigned* bar, volatile LAS unsigned* st) {
    XcdBarrier b; b.bar = bar; b.x = xb_xcc_id(); b.st = st;
    if (tidx() == 0) (void)xb_add(&bar[XB_XCNT(b.x)], 1u);
    return b;
}
__device__ __forceinline__ void xcd_barrier_complete(unsigned* bar, unsigned x, unsigned& nloc, unsigned& nx) {
    const unsigned G = gridDim.x;
    unsigned sum, cnt, mine, sp = 0u;
    for (;;) {
        sum = 0u; cnt = 0u; mine = 0u;
#pragma unroll
        for (unsigned j = 0; j < 16; ++j) { const unsigned c = xb_ld(&bar[XB_XCNT(j)]); sum += c; cnt += (c > 0u) ? 1u : 0u; mine = (j == x) ? c : mine; }
        if (sum == G) break;
        __builtin_amdgcn_s_sleep(1);
        if ((++sp & 255u) == 0u) { if (xb_ld(&bar[XB_TMO])) break; if (sp > XB_SPIN_CAP) { atomicAdd(&bar[XB_TMO], 1u); break; } }
    }
    nloc = mine > 0u ? mine : 1u; nx = cnt > 0u ? cnt : 1u;
}
__device__ __forceinline__ void xcd_barrier(const XcdBarrier& b) {
    asm volatile("s_waitcnt vmcnt(0)" ::: "memory");
    __syncthreads();
    if (tidx() == 0) {
        unsigned* bar = b.bar;
        __builtin_amdgcn_s_waitcnt(0);
        unsigned nloc = b.st[0], nx = b.st[1];
        if (nloc == 0u) { xcd_barrier_complete(bar, b.x, nloc, nx); b.st[0] = nloc; b.st[1] = nx; }
        const unsigned old = xb_add(&bar[XB_XSUB(b.x)], 1u);
        const unsigned gen = old / nloc;
        if (old + 1u == (gen + 1u) * nloc) {
            __builtin_amdgcn_fence(__ATOMIC_RELEASE, "agent");
            asm volatile("s_waitcnt vmcnt(0)" ::: "memory");
            const unsigned og = xb_add(&bar[XB_TOP], 1u);
            const unsigned tg = og / nx;
            if (og + 1u == (tg + 1u) * nx) xb_add(&bar[XB_TOPGEN], 1u);
            else XB_SPIN(xb_ld(&bar[XB_TOPGEN]) == tg, bar);
            __builtin_amdgcn_fence(__ATOMIC_ACQUIRE, "agent");
            xb_add(&bar[XB_XGEN(b.x)], 1u);
            asm volatile("s_waitcnt vmcnt(0)" ::: "memory");
        } else {
            XB_SPIN(xb_ld(&bar[XB_XGEN(b.x)]) == gen, bar);
            __builtin_amdgcn_fence(__ATOMIC_ACQUIRE, "agent");
            asm volatile("s_waitcnt vmcnt(0)" ::: "memory");
        }
    }
    __syncthreads();
}
__device__ __forceinline__ int take_ticket(unsigned* ctr, volatile LAS unsigned* bc) {
    __syncthreads();
    if (tidx() == 0) bc[0] = xb_add(ctr, 1u);
    __syncthreads();
    return (int)bc[0];
}
__device__ __forceinline__ void signal_done(unsigned* ctr) {
    asm volatile("s_waitcnt vmcnt(0)" ::: "memory");
    __syncthreads();
    if (tidx() == 0) {
        __builtin_amdgcn_fence(__ATOMIC_RELEASE, "agent");
        asm volatile("s_waitcnt vmcnt(0)" ::: "memory");
        xb_add(ctr, 1u);
    }
}
__device__ __forceinline__ void wait_count(unsigned* ctl, int word, unsigned target) {
    if (tidx() == 0) {
        XB_SPIN(xb_ld(&ctl[word]) < target, ctl);
        __builtin_amdgcn_fence(__ATOMIC_ACQUIRE, "agent");
        asm volatile("s_waitcnt vmcnt(0)" ::: "memory");
    }
    __syncthreads();
}

__device__ void transpose_cvt_tile(const float* __restrict__ W, int K, int N, bf16_t* __restrict__ Wt, int tile, float* sm) {
    const int tn = N / 64;
    const int k0 = (tile / tn) * 64, n0 = (tile % tn) * 64;
    const int tid = tidx();
    for (int e = tid; e < 4096; e += 256) { int r = e >> 6, c = e & 63; sm[r * 65 + c] = W[(size_t)(k0 + r) * N + n0 + c]; }
    __syncthreads();
    for (int e = tid; e < 4096; e += 256) { int r = e >> 6, c = e & 63; Wt[(size_t)(n0 + r) * K + k0 + c] = f2bf(sm[c * 65 + r]); }
    __syncthreads();
}

struct TrDesc { int in_idx; size_t in_off; int K, N; size_t out_off; };
#define N_TR 12
__device__ __forceinline__ TrDesc tr_desc(int i) {
    switch (i) {
        case 0:  return {I0_WIN, 0, 1024, ZW0, WS_WIN0T};
        case 1:  return {I0_WOUT, 0, 768, 1024, WS_WOUT0T};
        case 2:  return {I0_WQ, 0, 1024, 1024, WS_WQ0T};
        case 3:  return {I1_WIN, 0, 1024, ZW1, WS_WIN1T};
        case 4:  return {I1_WOUT, 0, 1024, 1024, WS_WOUT1T};
        case 5:  return {I1_WQ, 0, 1024, 1024, WS_WQ1T};
        case 6:  return {I0_WGLU, 0, 256, 256, WS_WGLUT};
        case 7:  return {I0_W2, 0, 64, 512, WS_W2T};
        case 8:  return {I0_W2, (size_t)64 * 512, 64, 512, WS_W2T + (size_t)512 * 64 * 2};
        case 9:  return {I0_A2, 0, 64, 512, WS_A2T};
        case 10: return {I0_A2, (size_t)64 * 512, 64, 512, WS_A2T + (size_t)512 * 64 * 2};
        default: return {I0_G2, 0, 128, 512, WS_G2T};
    }
}
__device__ int tr_total_tiles() { int t = 0; for (int i = 0; i < N_TR; ++i) { TrDesc d = tr_desc(i); t += (d.K / 64) * (d.N / 64); } return t; }

__device__ void phase_transpose(const P& p, float* sm, int bid, int nblk) {
    const int total = tr_total_tiles();
    for (int t = bid; t < total; t += nblk) {
        int rem = t, i = 0;
        for (; i < N_TR; ++i) { TrDesc d = tr_desc(i); int n = (d.K / 64) * (d.N / 64); if (rem < n) break; rem -= n; }
        TrDesc d = tr_desc(i);
        transpose_cvt_tile(p.in[d.in_idx] + d.in_off, d.K, d.N, (bf16_t*)(p.ws + d.out_off), rem, sm);
    }
}

__device__ void cvt_range(const float* __restrict__ src, bf16_t* __restrict__ dst, size_t n, size_t gtid, size_t gthreads) {
    const size_t n8 = n / 8;
    for (size_t i = gtid; i < n8; i += gthreads) {
        float4 a = ((const float4*)src)[2 * i], b = ((const float4*)src)[2 * i + 1];
        uint4 o; o.x = pack2(a.x, a.y); o.y = pack2(a.z, a.w); o.z = pack2(b.x, b.y); o.w = pack2(b.z, b.w);
        ((uint4*)dst)[i] = o;
    }
}
struct __attribute__((aligned(4))) U3 { unsigned x, y, z; };
__device__ __forceinline__ unsigned e2m3_code(float v) {
    const float a = fabsf(v);
    const float c = a < 2.f ? rintf(a * 8.f) : (a < 4.f ? 16.f + rintf((a - 2.f) * 4.f) : 24.f + rintf((a - 4.f) * 2.f));
    return (unsigned)fminf(c, 31.f) | (v < 0.f ? 32u : 0u);
}
__device__ void phase_convert(const P& p, size_t gtid, size_t gthreads) {
    cvt_range(p.in[I0_KEYS], WSP(bf16_t, WS_KEYS0), (size_t)2048 * 64, gtid, gthreads);
    cvt_range(p.in[I1_KEYS], WSP(bf16_t, WS_KEYS1), (size_t)2048 * 64, gtid, gthreads);
    const int lane = (int)(gtid & 63);
    const size_t gwave = gtid >> 6, nwaves = gthreads >> 6;
    float* scl = WSP(float, WS_TABSC);
    const float* t0 = p.in[I0_U]; const float* t1 = p.in[I0_V]; const float* t2 = p.in[I1_U]; const float* t3 = p.in[I1_V];
#define CV_SRC(R_) ((((R_) >> 14) == 0 ? t0 : ((R_) >> 14) == 1 ? t1 : ((R_) >> 14) == 2 ? t2 : t3) + (size_t)((R_) & 16383) * 1024 + lane * 16)
#define CV_LOAD(DST, R_) { const size_t rr_ = (R_) < (size_t)4 * 16384 ? (R_) : (size_t)4 * 16384 - 1; const float4* s_ = (const float4*)CV_SRC(rr_); \
        _Pragma("unroll") for (int q_ = 0; q_ < 4; ++q_) { const float4 t_ = s_[q_]; DST[4 * q_] = t_.x; DST[4 * q_ + 1] = t_.y; DST[4 * q_ + 2] = t_.z; DST[4 * q_ + 3] = t_.w; } }
    float pa[16], pb[16];
    CV_LOAD(pa, gwave) CV_LOAD(pb, gwave + nwaves)
    for (size_t r = gwave; r < (size_t)4 * 16384; r += nwaves) {
        const int tb = (int)(r >> 14), row = (int)(r & 16383);
        unsigned char* dst = p.ws + (tb == 0 ? WS_TABU0 : tb == 1 ? WS_TABV0 : tb == 2 ? WS_TABU1 : WS_TABV1) + (size_t)row * 768 + lane * 12;
        float v[16];
#pragma unroll
        for (int u = 0; u < 16; ++u) { v[u] = pa[u]; pa[u] = pb[u]; }
        CV_LOAD(pb, r + 2 * nwaves)
        float mx = 0.f;
#pragma unroll
        for (int u = 0; u < 16; ++u) mx = fmaxf(mx, fabsf(v[u]));
        mx = wave_max(mx);
        const float sc = mx > 0.f ? 7.5f / mx : 1.f;
        unsigned c[16];
#pragma unroll
        for (int u = 0; u < 16; ++u) c[u] = e2m3_code(v[u] * sc);
        unsigned long long lo = 0ull;
#pragma unroll
        for (int u = 0; u < 10; ++u) lo |= (unsigned long long)c[u] << (6 * u);
        lo |= (unsigned long long)(c[10] & 15u) << 60;
        U3 o3;
        o3.x = (unsigned)lo; o3.y = (unsigned)(lo >> 32);
        o3.z = (c[10] >> 4) | (c[11] << 2) | (c[12] << 8) | (c[13] << 14) | (c[14] << 20) | (c[15] << 26);
        *(U3*)dst = o3;
        if (lane == 0) scl[r] = mx > 0.f ? mx / 7.5f : 1.f;
    }
#undef CV_LOAD
#undef CV_SRC
}
#define PSEG(IDX, OFF, CNT) if (r < (CNT)) { dst[(OFF) + r] = p.in[IDX][r]; continue; } r -= (CNT);
__device__ void phase_pack_params(const P& p, size_t gtid, size_t gthreads) {
    float* dst = (float*)(p.ws + WS_PAR);
    for (size_t i = gtid; i < 20624; i += gthreads) {
        int r = (int)i;
        PSEG(I0_SHIFT, PAR_SHIFT, 3840) PSEG(I0_A0, PAR_A0, 1024) PSEG(I0_W0, PAR_W0, 1024) PSEG(I0_KK, PAR_KK, 512) PSEG(I0_KA, PAR_KA, 512)
        PSEG(I0_RK, PAR_RK, 512) PSEG(I0_BGLU, PAR_BGLU, 256) PSEG(I0_GNW, PAR_GNW, 512) PSEG(I0_GNB, PAR_GNB, 512)
        PSEG(I0_LN1G, PAR_LN1G0, 1024) PSEG(I0_LN1B, PAR_LN1B0, 1024) PSEG(I0_LN2G, PAR_LN2G0, 1024) PSEG(I0_LN2B, PAR_LN2B0, 1024)
        PSEG(I1_LN1G, PAR_LN1G1, 1024) PSEG(I1_LN1B, PAR_LN1B1, 1024) PSEG(I1_LN2G, PAR_LN2G1, 1024) PSEG(I1_LN2B, PAR_LN2B1, 1024)
        PSEG(I1_RPB, PAR_RPB, 3720) PSEG(I1_SINK, PAR_SINK, 8)
    }
}
#undef PSEG
__device__ void phase_mod_partial(const P& p, int gwave, int nwaves) {
    const int lane = tidx() & 63;
    for (int it = gwave; it < 2 * 96 * 8; it += nwaves) {
        const int kc = it & 7, ct = (it >> 3) % 96, l = it / (8 * 96);
        const float* wm = p.in[l ? I1_WMOD : I0_WMOD];
        const int col = ct * 64 + lane;
        float sa[5], sb[5];
#pragma unroll
        for (int n = 0; n < 5; ++n) {
            const float* cv = n < 4 ? p.in[I_C] + n * 1024 : p.in[I_CCTX];
            sa[n] = siluf_(cv[kc * 128 + lane]); sb[n] = siluf_(cv[kc * 128 + 64 + lane]);
        }
        float acc[5] = {0.f, 0.f, 0.f, 0.f, 0.f};
        const float* wp = wm + (size_t)(kc * 128) * 6144 + col;
#pragma unroll 1
        for (int i0 = 0; i0 < 64; i0 += 32) {
            float w0[32], w1[32];
#pragma unroll
            for (int j = 0; j < 32; ++j) { w0[j] = wp[(size_t)(i0 + j) * 6144]; w1[j] = wp[(size_t)(64 + i0 + j) * 6144]; }
#pragma unroll
            for (int j = 0; j < 32; ++j)
#pragma unroll
                for (int n = 0; n < 5; ++n) {
                    const float s0 = __builtin_bit_cast(float, __builtin_amdgcn_readlane(__builtin_bit_cast(int, sa[n]), i0 + j));
                    const float s1 = __builtin_bit_cast(float, __builtin_amdgcn_readlane(__builtin_bit_cast(int, sb[n]), i0 + j));
                    acc[n] += s0 * w0[j] + s1 * w1[j];
                }
        }
        float* mp = WSP(float, WS_MODP);
#pragma unroll
        for (int n = 0; n < 5; ++n) mp[(((size_t)kc * 2 + l) * 5 + n) * 6144 + col] = acc[n];
    }
}
__device__ void phase_mod_reduce(const P& p, size_t gtid, size_t gthreads) {
    const float* mp = WSP(float, WS_MODP);
    float* mo = WSP(float, WS_MOD);
    for (size_t i = gtid; i < (size_t)2 * 5 * 6144; i += gthreads) {
        const int l = (int)(i / (5 * 6144)), col = (int)(i % 6144);
        float s = p.in[l ? I1_BMOD : I0_BMOD][col];
        for (int kc = 0; kc < 8; ++kc) s += mp[(size_t)kc * 2 * 5 * 6144 + i];
        mo[i] = s;
    }
}

__device__ void phase_s5_pow(const P& p, size_t gtid, size_t gthreads) {
    float* pw = WSP(float, WS_S5POW);
    for (size_t e = gtid; e < (size_t)2048 * 65; e += gthreads) {
        const int i = (int)(e / 65), j = (int)(e - (size_t)i * 65);
        const float lr = p.in[I0_LAMRE][i], li = p.in[I0_LAMIM][i];
        const float dt = expf(p.in[I0_LOGDT][i >> 6]);
        const float mag = expf(lr * dt * (float)j), ang = li * dt * (float)j;
        pw[e * 2] = mag * cosf(ang); pw[e * 2 + 1] = mag * sinf(ang);
    }
    for (size_t e = gtid; e < (size_t)2048 * 16; e += gthreads) {
        const int i = (int)(e >> 4), q = (int)(e & 15);
        const float lr = p.in[I0_LAMRE][i], li = p.in[I0_LAMIM][i];
        const float dt = expf(p.in[I0_LOGDT][i >> 6]);
        const float mag = expf(lr * dt);
        const float ar = mag * cosf(li * dt), ai = mag * sinf(li * dt);
        const float den = lr * lr + li * li, nr1 = ar - 1.f;
        const float kr = (nr1 * lr + ai * li) / den, ki = (ai * lr - nr1 * li) / den;
        const float xr = p.in[I0_BRE][e], xi = p.in[I0_BIM][e];
        float* bbt = (float*)(p.ws + WS_S5BB) + (size_t)i * 32 + 2 * q;
        bbt[0] = kr * xr - ki * xi; bbt[1] = kr * xi + ki * xr;
    }
}
__device__ __forceinline__ void s5_bbar(const P& p, int dgp, int i, float& br, float& bi) {
    const float* bbt = (const float*)(p.ws + WS_S5BB) + (size_t)dgp * 32 + 2 * i;
    br = bbt[0]; bi = bbt[1];
}
#define TSTAMP(k) do { if (DIAGX && bidx() == 0 && tidx() == 0) ((volatile unsigned long long*)(p.ws + WS_TS))[k] = __builtin_amdgcn_s_memrealtime(); } while (0)
__device__ void phase_s5_tables(const P& p, size_t gtid, size_t gthreads) {
    const float* pw = WSP(float, WS_S5POW);
    const float* bbt = (const float*)(p.ws + WS_S5BB);
    bf16_t* Kt = WSP(bf16_t, WS_S5K);
    bf16_t* Wt = WSP(bf16_t, WS_S5W);
    bf16_t* Vt = WSP(bf16_t, WS_S5V);
    for (size_t e = gtid; e < (size_t)32 * 64 * 64; e += gthreads) {
        const int ipq = (int)(e & 3), i = (int)((e >> 2) & 15), lag = (int)((e >> 6) & 63), dg = (int)(e >> 12);
        float acc[4] = {0.f, 0.f, 0.f, 0.f};
        const float* crp = p.in[I0_CRE] + ((size_t)dg * 16 + i) * 64;
        const float* cip = p.in[I0_CIM] + ((size_t)dg * 16 + i) * 64;
#pragma unroll 8
        for (int pp = 0; pp < 64; ++pp) {
            const int dgp = dg * 64 + pp;
            const float2 a = *(const float2*)&pw[((size_t)dgp * 65 + lag) * 2];
            const float cr = crp[pp], ci = cip[pp];
            const float tr = cr * a.x - ci * a.y, ti = cr * a.y + ci * a.x;
            const float4 b0 = *(const float4*)&bbt[(size_t)dgp * 32 + ipq * 8], b1 = *(const float4*)&bbt[(size_t)dgp * 32 + ipq * 8 + 4];
            acc[0] += tr * b0.x - ti * b0.y; acc[1] += tr * b0.z - ti * b0.w;
            acc[2] += tr * b1.x - ti * b1.y; acc[3] += tr * b1.z - ti * b1.w;
        }
        if (lag == 0 && dg < 16 && (i >> 2) == ipq) acc[i & 3] += p.in[I0_S5D][(dg & 15) * 16 + i];
        *(uint2*)&Kt[e * 4] = make_uint2(pack2(acc[0], acc[1]), pack2(acc[2], acc[3]));
    }
    for (size_t e = gtid; e < (size_t)32 * 64 * 64; e += gthreads) {
        const int s_ = (int)(e & 63), pp = (int)((e >> 6) & 63), dg = (int)(e >> 12), d = dg >> 4;
        const int dgp = dg * 64 + pp;
        const int ex = d ? s_ : 63 - s_;
        const float2 a = *(const float2*)&pw[((size_t)dgp * 65 + ex) * 2];
        float tr[16], ti[16];
#pragma unroll
        for (int q = 0; q < 8; ++q) {
            const float4 b = *(const float4*)&bbt[(size_t)dgp * 32 + q * 4];
            tr[2 * q] = a.x * b.x - a.y * b.y; ti[2 * q] = a.x * b.y + a.y * b.x;
            tr[2 * q + 1] = a.x * b.z - a.y * b.w; ti[2 * q + 1] = a.x * b.w + a.y * b.z;
        }
        bf16_t* w0 = Wt + ((size_t)dg * 128 + pp * 2) * 1024 + s_ * 16;
        *(uint4*)&w0[0] = make_uint4(pack2(tr[0], tr[1]), pack2(tr[2], tr[3]), pack2(tr[4], tr[5]), pack2(tr[6], tr[7]));
        *(uint4*)&w0[8] = make_uint4(pack2(tr[8], tr[9]), pack2(tr[10], tr[11]), pack2(tr[12], tr[13]), pack2(tr[14], tr[15]));
        *(uint4*)&w0[1024] = make_uint4(pack2(ti[0], ti[1]), pack2(ti[2], ti[3]), pack2(ti[4], ti[5]), pack2(ti[6], ti[7]));
        *(uint4*)&w0[1032] = make_uint4(pack2(ti[8], ti[9]), pack2(ti[10], ti[11]), pack2(ti[12], ti[13]), pack2(ti[14], ti[15]));
    }
    for (size_t e = gtid; e < (size_t)32 * 64 * 64; e += gthreads) {
        const int pp = (int)(e & 63), t = (int)((e >> 6) & 63), dg = (int)(e >> 12), d = dg >> 4;
        const int dgp = dg * 64 + pp;
        const int ex = d ? 64 - t : t + 1;
        const float2 a = *(const float2*)&pw[((size_t)dgp * 65 + ex) * 2];
        bf16_t* v0 = Vt + ((size_t)dg * 1024 + t * 16) * 128 + pp * 2;
#pragma unroll
        for (int i = 0; i < 16; ++i) {
            const float cr = p.in[I0_CRE][((size_t)dg * 16 + i) * 64 + pp], ci = p.in[I0_CIM][((size_t)dg * 16 + i) * 64 + pp];
            *(unsigned*)&v0[(size_t)i * 128] = pack2(cr * a.x - ci * a.y, -(cr * a.y + ci * a.x));
        }
    }
}

#define GM_LD 72
#define CS_LD 132
#define GEMM_SMEM_BYTES (2 * 128 * (128 + 8) * 2)
static_assert(64 * CS_LD * 4 <= 2 * 128 * GM_LD * 2, "C staging fits");

template <int BK, class AL, class BL, class Epi>
__device__ void gemm_tile(const AL& al, const BL& bl, int K, int m0, int n0, Epi& epi, unsigned char* smem) {
    constexpr int LD = BK + 8;
    constexpr int NC = BK / 64;
    bf16_t* As = (bf16_t*)smem;
    bf16_t* Bs = As + 128 * LD;
    const int tid = tidx(), lane = tid & 63, wave = tid >> 6;
    const int wm = wave >> 1, wn = wave & 1;
    const int lrow = tid >> 3, kc = (tid & 7) * 8;
    typename AL::RowCtx arow[4];
    typename BL::RowCtx brow[4];
#pragma unroll
    for (int i = 0; i < 4; ++i) { arow[i] = al.row(m0 + lrow + 32 * i); brow[i] = bl.row(n0 + lrow + 32 * i); }
    f32x16 acc[2][2];
#pragma unroll
    for (int i = 0; i < 2; ++i)
#pragma unroll
        for (int j = 0; j < 2; ++j)
#pragma unroll
            for (int r = 0; r < 16; ++r) acc[i][j][r] = 0.f;
    uint4 ra[4 * NC], rb[4 * NC];
#pragma unroll
    for (int c = 0; c < NC; ++c)
#pragma unroll
        for (int i = 0; i < 4; ++i) { ra[c * 4 + i] = al.load8(arow[i], c * 64 + kc); rb[c * 4 + i] = bl.load8(brow[i], c * 64 + kc); }
    for (int k0 = 0; k0 < K; k0 += BK) {
        __syncthreads();
#pragma unroll
        for (int c = 0; c < NC; ++c)
#pragma unroll
            for (int i = 0; i < 4; ++i) {
                *(uint4*)&As[(lrow + 32 * i) * LD + c * 64 + kc] = ra[c * 4 + i];
                *(uint4*)&Bs[(lrow + 32 * i) * LD + c * 64 + kc] = rb[c * 4 + i];
            }
        __syncthreads();
        if (k0 + BK < K) {
#pragma unroll
            for (int c = 0; c < NC; ++c)
#pragma unroll
                for (int i = 0; i < 4; ++i) { ra[c * 4 + i] = al.load8(arow[i], k0 + BK + c * 64 + kc); rb[c * 4 + i] = bl.load8(brow[i], k0 + BK + c * 64 + kc); }
        }
#pragma unroll
        for (int kk = 0; kk < BK / 16; ++kk) {
            bf16x8 a[2], b[2];
#pragma unroll
            for (int i = 0; i < 2; ++i) a[i] = *(const bf16x8*)&As[(wm * 64 + i * 32 + (lane & 31)) * LD + kk * 16 + 8 * (lane >> 5)];
#pragma unroll
            for (int j = 0; j < 2; ++j) b[j] = *(const bf16x8*)&Bs[(wn * 64 + j * 32 + (lane & 31)) * LD + kk * 16 + 8 * (lane >> 5)];
#pragma unroll
            for (int i = 0; i < 2; ++i)
#pragma unroll
                for (int j = 0; j < 2; ++j) acc[i][j] = __builtin_amdgcn_mfma_f32_32x32x16_bf16(a[i], b[j], acc[i][j], 0, 0, 0);
        }
    }
    float* Cs = (float*)smem;
#pragma unroll
    for (int pass = 0; pass < 2; ++pass) {
        __syncthreads();
        if (wm == pass) {
#pragma unroll
            for (int i = 0; i < 2; ++i)
#pragma unroll
                for (int j = 0; j < 2; ++j)
#pragma unroll
                    for (int r = 0; r < 16; ++r) {
                        const int row = i * 32 + (r & 3) + 8 * (r >> 2) + 4 * (lane >> 5);
                        const int col = wn * 64 + j * 32 + (lane & 31);
                        Cs[row * CS_LD + col] = acc[i][j][r];
                    }
        }
        __syncthreads();
        epi(Cs, pass, tid);
    }
    __syncthreads();
}

template <int MODE = 0, class Epi>
__device__ void gemm_tile_dma(const bf16_t* __restrict__ A, int lda, const bf16_t* __restrict__ Bt, int ldb, int K, int m0, int n0, Epi& epi, unsigned char* smem) {
    const int tid = tidx(), lane = tid & 63, wave = tid >> 6, wm = wave >> 1, wn = wave & 1, l31 = lane & 31, hh = lane >> 5;
    const int prow = lane >> 3, pchunk = (lane & 7) ^ prow;
    const bf16_t* ga = A + (size_t)(m0 + wave * 32 + prow) * lda + pchunk * 8;
    const bf16_t* gb = Bt + (size_t)(n0 + wave * 32 + prow) * ldb + pchunk * 8;
    f32x16 acc[2][2];
#pragma unroll
    for (int i = 0; i < 2; ++i)
#pragma unroll
        for (int j = 0; j < 2; ++j)
#pragma unroll
            for (int r = 0; r < 16; ++r) acc[i][j][r] = 0.f;
    const int wbase = __builtin_amdgcn_readfirstlane(wave) * (32 * 128);
#define DMA_ISSUE(k0_, buf_) { unsigned char* ab_ = smem + (buf_) * 32768 + wbase; unsigned char* bb_ = ab_ + 16384; \
        _Pragma("unroll") for (int j_ = 0; j_ < 4; ++j_) { \
            __builtin_amdgcn_global_load_lds((const unsigned*)(ga + (size_t)(8 * j_) * lda + (k0_)), (unsigned*)(ab_ + j_ * 1024), 16, 0, 0); \
            __builtin_amdgcn_global_load_lds((const unsigned*)(gb + (size_t)(8 * j_) * ldb + (k0_)), (unsigned*)(bb_ + j_ * 1024), 16, 0, 0); } }
    __syncthreads();
    DMA_ISSUE(0, 0)
    asm volatile("s_waitcnt vmcnt(0)" ::: "memory");
    asm volatile("s_waitcnt lgkmcnt(0)" ::: "memory"); __builtin_amdgcn_s_barrier();
    const int nk = K / 64;
    for (int kt = 0; kt < nk; ++kt) {
        const int buf = kt & 1;
        if (kt + 1 < nk) DMA_ISSUE((kt + 1) * 64, buf ^ 1)
        const bf16_t* As = (const bf16_t*)(smem + buf * 32768);
        const bf16_t* Bs = As + 8192;
#pragma unroll
        for (int kk = 0; kk < 4; ++kk) {
            bf16x8 a[2], b[2];
            const int cc = ((kk * 2 + hh) ^ (l31 & 7)) * 8;
#pragma unroll
            for (int i = 0; i < 2; ++i) a[i] = *(const bf16x8*)&As[(wm * 64 + i * 32 + l31) * 64 + cc];
#pragma unroll
            for (int j = 0; j < 2; ++j) b[j] = *(const bf16x8*)&Bs[(wn * 64 + j * 32 + l31) * 64 + cc];
#pragma unroll
            for (int i = 0; i < 2; ++i)
#pragma unroll
                for (int j = 0; j < 2; ++j) acc[i][j] = __builtin_amdgcn_mfma_f32_32x32x16_bf16(a[i], b[j], acc[i][j], 0, 0, 0);
        }
        asm volatile("s_waitcnt vmcnt(0)" ::: "memory");
        asm volatile("s_waitcnt lgkmcnt(0)" ::: "memory"); __builtin_amdgcn_s_barrier();
    }
#undef DMA_ISSUE
    float* Cs = (float*)smem;
    if constexpr (MODE == 2) {
        __syncthreads();
#pragma unroll
        for (int i = 0; i < 2; ++i)
#pragma unroll
            for (int j = 0; j < 2; ++j)
#pragma unroll
                for (int r = 0; r < 16; ++r) {
                    const int row = wm * 64 + i * 32 + (r & 3) + 8 * (r >> 2) + 4 * (lane >> 5);
                    const int col = wn * 64 + j * 32 + (lane & 31);
                    Cs[row * CS_LD + col] = acc[i][j][r];
                }
        __syncthreads();
        epi.run128(Cs, tid);
    } else {
#pragma unroll
    for (int pass = 0; pass < 2; ++pass) {
        __syncthreads();
        if (wm == pass) {
#pragma unroll
            for (int i = 0; i < 2; ++i)
#pragma unroll
                for (int j = 0; j < 2; ++j)
#pragma unroll
                    for (int r = 0; r < 16; ++r) {
                        const int row = i * 32 + (r & 3) + 8 * (r >> 2) + 4 * (lane >> 5);
                        const int col = wn * 64 + j * 32 + (lane & 31);
                        Cs[row * CS_LD + col] = acc[i][j][r];
                    }
        }
        __syncthreads();
        epi(Cs, pass, tid);
    }
    __syncthreads();
    }
}

__device__ __forceinline__ int xcd_swz(int bid, int nblk) { return (nblk & 7) ? bid : (bid & 7) * (nblk >> 3) + (bid >> 3); }

struct LdBf16 {
    const bf16_t* base; int ld;
    typedef const bf16_t* RowCtx;
    __device__ RowCtx row(int r) const { return base + (size_t)r * ld; }
    __device__ uint4 load8(RowCtx rc, int k) const { return *(const uint4*)(rc + k); }
};
struct LdXMod {
    const float* xlat; const float* xctx; const float* mod; int shift_off, scale_off;
    struct RowCtx { const float* src; const float* m; };
    __device__ RowCtx row(int R) const {
        const int b = R / SS, s = R - b * SS;
        RowCtx rc;
        if (s < LC) { rc.src = xctx + ((size_t)(b * LC + s)) * DM; rc.m = mod + 4 * 6144; }
        else        { rc.src = xlat + ((size_t)(b * TT + s - LC)) * DM; rc.m = mod + b * 6144; }
        return rc;
    }
    __device__ uint4 load8(const RowCtx& rc, int k) const {
        const float4 x0 = *(const float4*)(rc.src + k), x1 = *(const float4*)(rc.src + k + 4);
        const float4 c0 = *(const float4*)(rc.m + scale_off + k), c1 = *(const float4*)(rc.m + scale_off + k + 4);
        const float4 h0 = *(const float4*)(rc.m + shift_off + k), h1 = *(const float4*)(rc.m + shift_off + k + 4);
        uint4 o;
        o.x = pack2(x0.x * (1.f + c0.x) + h0.x, x0.y * (1.f + c0.y) + h0.y);
        o.y = pack2(x0.z * (1.f + c0.z) + h0.z, x0.w * (1.f + c0.w) + h0.w);
        o.z = pack2(x1.x * (1.f + c1.x) + h1.x, x1.y * (1.f + c1.y) + h1.y);
        o.w = pack2(x1.z * (1.f + c1.z) + h1.z, x1.w * (1.f + c1.w) + h1.w);
        return o;
    }
};

struct EpiStoreBf16 {
    bf16_t* out; int ld; int m0, n0; int mmax;
    __device__ void operator()(const float* Cs, int pass, int tid) const {
#pragma unroll
        for (int i = 0; i < 4; ++i) {
            const int c = tid + 256 * i, row = c >> 4, col8 = (c & 15) * 8;
            const int R = m0 + pass * 64 + row;
            if (R >= mmax) continue;
            const float4 a = *(const float4*)&Cs[row * CS_LD + col8], b = *(const float4*)&Cs[row * CS_LD + col8 + 4];
            uint4 o; o.x = pack2(a.x, a.y); o.y = pack2(a.z, a.w); o.z = pack2(b.x, b.y); o.w = pack2(b.z, b.w);
            *(uint4*)&out[(size_t)R * ld + n0 + col8] = o;
        }
    }
};
struct EpiStoreF32 {
    float* out; int ld; int m0, n0; int mmax;
    __device__ void operator()(const float* Cs, int pass, int tid) const {
#pragma unroll
        for (int i = 0; i < 8; ++i) {
            const int c = tid + 256 * i, row = c >> 5, col4 = (c & 31) * 4;
            const int R = m0 + pass * 64 + row;
            if (R >= mmax) continue;
            *(float4*)&out[(size_t)R * ld + n0 + col4] = *(const float4*)&Cs[row * CS_LD + col4];
        }
    }
};

__device__ __forceinline__ void phase_xcvt(const W p, unsigned char* smem) {
    const int gwave = __builtin_amdgcn_readfirstlane((int)bidx() * 4 + (tidx() >> 6)), nwaves = (int)gridDim.x * 4;
    const float* mod = WSP(float, WS_MOD);
    bf16_t* hb = WSP(bf16_t, WS_HB);
    float* sp = (float*)smem;
    for (int i = tidx(); i < 1024; i += 256) {
#pragma unroll
        for (int v = 0; v < 5; ++v) { sp[v * 1024 + i] = mod[v * 6144 + i]; sp[5120 + v * 1024 + i] = mod[v * 6144 + 1024 + i]; }
    }
    __syncthreads();
    if (gwave >= NTOK) return;
#define XC_SRC(R_) ((R_) % SS < LC ? p.ctx + ((size_t)(((R_) / SS) * LC + (R_) % SS)) * DM : p.x + ((size_t)(((R_) / SS) * TT + (R_) % SS - LC)) * DM)
#define XC_LOAD(XD, R_) { const float* s_ = XC_SRC(R_); const int l4_ = (tidx() & 63) * 4; \
        _Pragma("unroll") for (int i_ = 0; i_ < 4; ++i_) { const float4 x4_ = *(const float4*)&s_[i_ * 256 + l4_]; \
            XD[4 * i_] = x4_.x; XD[4 * i_ + 1] = x4_.y; XD[4 * i_ + 2] = x4_.z; XD[4 * i_ + 3] = x4_.w; } }
    float xa[16], xb[16];
    XC_LOAD(xa, gwave)
    { const int r1 = gwave + nwaves < NTOK ? gwave + nwaves : gwave; XC_LOAD(xb, r1) }
    for (int R = gwave; R < NTOK; R += nwaves) {
        const int var = (R % SS) < LC ? 4 : R / SS;
        float xc[16];
        { const int r2 = R + 2 * nwaves < NTOK ? R + 2 * nwaves : R; XC_LOAD(xc, r2) }
        const int l4 = (tidx() & 63) * 4;
#pragma unroll
        for (int i = 0; i < 4; ++i) {
            const int k = i * 256 + l4;
            const float4 sh = *(const float4*)&sp[var * 1024 + k], sc = *(const float4*)&sp[5120 + var * 1024 + k];
            *(uint2*)&hb[(size_t)R * 1024 + k] = make_uint2(pack2(xa[4 * i] * (1.f + sc.x) + sh.x, xa[4 * i + 1] * (1.f + sc.y) + sh.y),
                                                            pack2(xa[4 * i + 2] * (1.f + sc.z) + sh.z, xa[4 * i + 3] * (1.f + sc.w) + sh.w));
        }
#pragma unroll
        for (int i = 0; i < 16; ++i) { xa[i] = xb[i]; xb[i] = xc[i]; }
    }
#undef XC_LOAD
#undef XC_SRC
}
struct EpiZX0 {
    bf16_t* zx; bf16_t* us5; int m0, n0;
    __device__ void operator()(const float* Cs, int pass, int tid) const {
#pragma unroll
        for (int i = 0; i < 4; ++i) {
            const int c = tid + 256 * i, row = c >> 4, col8 = (c & 15) * 8;
            const int R = m0 + pass * 64 + row, col = n0 + col8;
            const float4 a = *(const float4*)&Cs[row * CS_LD + col8], b = *(const float4*)&Cs[row * CS_LD + col8 + 4];
            uint4 o; o.x = pack2(a.x, a.y); o.y = pack2(a.z, a.w); o.z = pack2(b.x, b.y); o.w = pack2(b.z, b.w);
            if (col < 256) *(uint4*)&us5[((size_t)(col >> 4) * NTOK + R) * 16 + (col & 8)] = o;
            else           *(uint4*)&zx[(size_t)R * ZW0 + col] = o;
        }
    }
};
__device__ void phase_gemm_win0(const W p, unsigned char* smem, int bid, int nblk) {
    LdBf16 al{WSP(bf16_t, WS_HB), 1024};
    LdBf16 bl{WSP(bf16_t, WS_WIN0T), 1024};
    const int ntn = ZW0 / 128, total = (NTOK / 128) * ntn;
    for (int t = xcd_swz(bid, nblk); t < total; t += nblk) {
        const int m0 = (t / ntn) * 128, n0 = (t % ntn) * 128;
        EpiZX0 epi{WSP(bf16_t, WS_ZX), WSP(bf16_t, WS_US5), m0, n0};
        gemm_tile_dma(al.base, al.ld, bl.base, bl.ld, 1024, m0, n0, epi, smem);
    }
}

struct LdBf16Clamp {
    const bf16_t* base; int ld; int rmax;
    typedef const bf16_t* RowCtx;
    __device__ RowCtx row(int r) const { return base + (size_t)(r < rmax ? r : rmax) * ld; }
    __device__ uint4 load8(RowCtx rc, int k) const { return *(const uint4*)(rc + k); }
};
__device__ void phase_s5_E(const W p, unsigned char* smem, int bid, int nblk) {
    for (int t = bid; t < 32 * 5; t += nblk) {
        const int dg = t / 5, mt = t % 5, g = dg & 15;
        LdBf16Clamp al{WSP(bf16_t, WS_US5) + (size_t)g * NTOK * 16, 1024, 527};
        LdBf16 bl{WSP(bf16_t, WS_S5W) + (size_t)dg * 128 * 1024, 1024};
        EpiStoreF32 epi{WSP(float, WS_S5E) + (size_t)dg * 528 * 128, 128, mt * 128, 0, 528};
        gemm_tile<128>(al, bl, 1024, mt * 128, 0, epi, smem);
        signal_done((unsigned*)(p.ws + WS_CTL) + CT_S5ED);
    }
}
__device__ void phase_s5_carry(const W p, size_t gtid, size_t gthreads) {
    const float* pw = WSP(float, WS_S5POW);
    const float* E = WSP(float, WS_S5E);
    bf16_t* H = WSP(bf16_t, WS_S5H);
    for (size_t i = gtid; i < 8192; i += gthreads) {
        const int pp = (int)(i & 63), b = (int)((i >> 6) & 3), dg = (int)(i >> 8), d = dg >> 4;
        const float ar = pw[((size_t)(dg * 64 + pp) * 65 + 64) * 2], ai = pw[((size_t)(dg * 64 + pp) * 65 + 64) * 2 + 1];
        float hr = 0.f, hi = 0.f;
        for (int cc0 = 0; cc0 < NCH; cc0 += 4) {
            size_t o[4]; float er[4], ei[4];
#pragma unroll
            for (int j = 0; j < 4; ++j) {
                const int cc = cc0 + j;
                const int c = d ? (cc < 4 ? 3 - cc : 131 - (cc - 4)) : cc;
                o[j] = ((size_t)dg * 528 + b * NCH + c) * 128 + pp * 2;
                er[j] = E[o[j]]; ei[j] = E[o[j] + 1];
            }
#pragma unroll
            for (int j = 0; j < 4; ++j) {
                H[o[j]] = f2bf(hr); H[o[j] + 1] = f2bf(hi);
                const float nr = ar * hr - ai * hi + er[j], ni = ar * hi + ai * hr + ei[j];
                hr = nr; hi = ni;
            }
        }
    }
}
struct LdS5YA {
    const bf16_t* u; const bf16_t* h0; const bf16_t* h1;
    struct RowCtx { const bf16_t* u; const bf16_t* h0; const bf16_t* h1; };
    __device__ RowCtx row(int r) const { if (r > 527) r = 527; return {u + (size_t)r * 1024, h0 + (size_t)r * 128, h1 + (size_t)r * 128}; }
    __device__ uint4 load8(const RowCtx& rc, int k) const {
        if (k < 1024) return *(const uint4*)(rc.u + k);
        if (k < 1152) return *(const uint4*)(rc.h0 + (k - 1024));
        if (k < 2176) return *(const uint4*)(rc.u + (k - 1152));
        return *(const uint4*)(rc.h1 + (k - 2176));
    }
};
struct LdS5YB {
    const bf16_t* k0; const bf16_t* k1; const bf16_t* v0; const bf16_t* v1;
    struct RowCtx { int t, i; const bf16_t* v0; const bf16_t* v1; };
    __device__ RowCtx row(int n) const { return {n >> 4, n & 15, v0 + (size_t)n * 128, v1 + (size_t)n * 128}; }
    __device__ uint4 load8(const RowCtx& rc, int k) const {
        if (k < 1024) { const int s = k >> 4, lag = rc.t - s; if (lag < 0) return make_uint4(0, 0, 0, 0); return *(const uint4*)(k0 + (lag * 16 + rc.i) * 16 + (k & 8)); }
        if (k < 1152) return *(const uint4*)(rc.v0 + (k - 1024));
        if (k < 2176) { const int kk = k - 1152, s = kk >> 4, lag = s - rc.t; if (lag < 0) return make_uint4(0, 0, 0, 0); return *(const uint4*)(k1 + (lag * 16 + rc.i) * 16 + (kk & 8)); }
        return *(const uint4*)(rc.v1 + (k - 2176));
    }
};
struct EpiS5Y {
    bf16_t* ya; int g; int m0, n0;
    __device__ void operator()(const float* Cs, int pass, int tid) const {
#pragma unroll
        for (int i = 0; i < 4; ++i) {
            const int c = tid + 256 * i, row = c >> 4, col8 = (c & 15) * 8;
            const int r = m0 + pass * 64 + row;
            if (r > 527) continue;
            const int n = n0 + col8, t = n >> 4;
            const float4 a = *(const float4*)&Cs[row * CS_LD + col8], b = *(const float4*)&Cs[row * CS_LD + col8 + 4];
            uint4 o;
            o.x = pack2(geluf_(a.x), geluf_(a.y)); o.y = pack2(geluf_(a.z), geluf_(a.w));
            o.z = pack2(geluf_(b.x), geluf_(b.y)); o.w = pack2(geluf_(b.z), geluf_(b.w));
            *(uint4*)&ya[((size_t)r * 64 + t) * 256 + g * 16 + (n & 8)] = o;
        }
    }
};
__device__ void phase_s5_Y(const W p, unsigned char* smem, int bid, int nblk) {
    for (int t = bid; t < 16 * 5 * 8; t += nblk) {
        if (t < 0) continue;
        const int g = t / 40, mt = (t % 40) / 8, nt = t % 8;
        LdS5YA al{WSP(bf16_t, WS_US5) + (size_t)g * NTOK * 16, WSP(bf16_t, WS_S5H) + (size_t)g * 528 * 128, WSP(bf16_t, WS_S5H) + (size_t)(16 + g) * 528 * 128};
        LdS5YB bl{WSP(bf16_t, WS_S5K) + (size_t)g * 64 * 256, WSP(bf16_t, WS_S5K) + (size_t)(16 + g) * 64 * 256,
                  WSP(bf16_t, WS_S5V) + (size_t)g * 1024 * 128, WSP(bf16_t, WS_S5V) + (size_t)(16 + g) * 1024 * 128};
        EpiS5Y epi{WSP(bf16_t, WS_YA), g, mt * 128, nt * 128};
        gemm_tile<128>(al, bl, 2304, mt * 128, nt * 128, epi, smem);
    }
}

__device__ __forceinline__ void zx0_shift8(const bf16_t* zx, const float* mu, int R, int col, float (&o)[8]) {
    const int s = R % SS;
    const bool hp = (s != 0) && (s != LC), hn = (s != LC - 1) && (s != SS - 1);
    const uint4 z = *(const uint4*)&zx[(size_t)R * ZW0 + col];
    uint4 zp = make_uint4(0, 0, 0, 0), zn = make_uint4(0, 0, 0, 0);
    if (hp) zp = *(const uint4*)&zx[(size_t)(R - 1) * ZW0 + col];
    if (hn) zn = *(const uint4*)&zx[(size_t)(R + 1) * ZW0 + col];
    const unsigned zu[4] = {z.x, z.y, z.z, z.w}, pu[4] = {zp.x, zp.y, zp.z, zp.w}, nu[4] = {zn.x, zn.y, zn.z, zn.w};
    const int mc = col - 256;
#pragma unroll
    for (int u = 0; u < 4; ++u) {
        const float a0 = bflo(zu[u]), a1 = bfhi(zu[u]);
        o[2 * u]     = a0 + mu[mc + 2 * u] * (bflo(pu[u]) - a0) + mu[1920 + mc + 2 * u] * (bflo(nu[u]) - a0);
        o[2 * u + 1] = a1 + mu[mc + 2 * u + 1] * (bfhi(pu[u]) - a1) + mu[1920 + mc + 2 * u + 1] * (bfhi(nu[u]) - a1);
    }
}

__device__ __forceinline__ float tanh_fast(float x) { const float e = __expf(2.f * fminf(fmaxf(x, -15.f), 15.f)); return 1.f - 2.f / (e + 1.f); }
__device__ __forceinline__ float softplus_fast(float x) { return fmaxf(x, 0.f) + __logf(1.f + __expf(-fabsf(x))); }

__device__ void phase_rw_shift(const W p, int gwave, int nwaves) {
    const int lane = tidx() & 63;
    const bf16_t* zx = WSP(bf16_t, WS_ZX);
    const float* mu = PAR(PAR_SHIFT);
    bf16_t* Rr = WSP(bf16_t, WS_RWR);
    bf16_t* Kk = WSP(bf16_t, WS_RWK);
    float* nrm = WSP(float, WS_RWNRM);
    for (int R = gwave; R < NTOK; R += nwaves) {
        const int b = R / SS, s = R - b * SS, h = lane >> 3, c8 = (lane & 7) * 8;
        float r8[8], k8[8];
        zx0_shift8(zx, mu, R, 256 + lane * 8, r8);
        zx0_shift8(zx, mu, R, 768 + lane * 8, k8);
        float ss = 0.f;
#pragma unroll
        for (int u = 0; u < 8; ++u) { const float kk = k8[u] * PAR(PAR_KK)[lane * 8 + u]; ss += kk * kk; }
        ss += __shfl_xor(ss, 1); ss += __shfl_xor(ss, 2); ss += __shfl_xor(ss, 4);
        const size_t o = (((size_t)(b * 8 + h)) * SS + s) * 64 + c8;
        *(uint4*)&Rr[o] = make_uint4(pack2(r8[0], r8[1]), pack2(r8[2], r8[3]), pack2(r8[4], r8[5]), pack2(r8[6], r8[7]));
        *(uint4*)&Kk[o] = make_uint4(pack2(k8[0], k8[1]), pack2(k8[2], k8[3]), pack2(k8[4], k8[5]), pack2(k8[6], k8[7]));
        if ((lane & 7) == 0) nrm[((size_t)(b * 8 + h)) * SS + s] = rsqrtf(ss + 1e-12f);
    }
}
struct LdLora {
    const bf16_t* zx; const float* mu; int col0; int dotanh;
    typedef int RowCtx;
    __device__ RowCtx row(int R) const { return R; }
    __device__ uint4 load8(RowCtx R, int k) const {
        float v[8]; zx0_shift8(zx, mu, R, col0 + k, v);
        if (dotanh) {
#pragma unroll
            for (int u = 0; u < 8; ++u) v[u] = tanh_fast(v[u]);
        }
        return make_uint4(pack2(v[0], v[1]), pack2(v[2], v[3]), pack2(v[4], v[5]), pack2(v[6], v[7]));
    }
};
template <int MAT>
struct EpiLora {
    int d; const float* bias; bf16_t* lw; unsigned char* as; float* bon; const bf16_t* zx; const float* mu; const float* ka; const float* rk; int m0, n0;
    __device__ void operator()(const float* Cs, int pass, int tid) const {
#pragma unroll 1
        for (int i = 0; i < 4; ++i) {
            const int c = tid + 256 * i, row = c >> 4, col8 = (c & 15) * 8;
            const int R = m0 + pass * 64 + row, col = n0 + col8;
            const float4 a = *(const float4*)&Cs[row * CS_LD + col8], bq = *(const float4*)&Cs[row * CS_LD + col8 + 4];
            const float x[8] = {a.x, a.y, a.z, a.w, bq.x, bq.y, bq.z, bq.w};
            if constexpr (MAT == 0) {
                float o[8];
#pragma unroll
                for (int u = 0; u < 8; ++u) o[u] = -__expf(-softplus_fast(-(x[u] + bias[col + u])) - 0.5f);
                *(uint4*)&lw[(size_t)R * 512 + col] = make_uint4(pack2(o[0], o[1]), pack2(o[2], o[3]), pack2(o[4], o[5]), pack2(o[6], o[7]));
            } else {
                float r8[8], k8[8], bsum = 0.f;
                zx0_shift8(zx, mu, R, 256 + col, r8);
                zx0_shift8(zx, mu, R, 768 + col, k8);
                unsigned q0 = 0u, q1 = 0u;
#pragma unroll
                for (int u = 0; u < 8; ++u) {
                    const float sg = sigmoidf_(x[u] + bias[col + u]);
                    const float kd = k8[u] * (1.f + (sg - 1.f) * ka[col + u]);
                    bsum += r8[u] * kd * rk[col + u];
                    const unsigned qq = ((unsigned)(sg * 255.f + 0.5f)) << (8 * (u & 3));
                    if (u < 4) q0 |= qq; else q1 |= qq;
                }
                *(uint2*)&as[(size_t)R * 512 + col] = make_uint2(q0, q1);
                bsum += __shfl_xor(bsum, 1); bsum += __shfl_xor(bsum, 2); bsum += __shfl_xor(bsum, 4);
                if ((c & 7) == 0) bon[(size_t)R * 16 + (col >> 6) * 2 + d] = bsum;
            }
        }
    }
};
template <int MAT>
__device__ void phase_rw_lora_mat(const W p, unsigned char* smem, int bid, int nblk) {
    const int total = (NTOK / 128) * 4 * 2;
    for (int t = bid; t < total; t += nblk) {
        const int d = t & 1, nt = (t >> 1) & 3, mt = t >> 3;
        LdLora al{WSP(bf16_t, WS_ZX), PAR(PAR_SHIFT), (MAT ? 1920 : 1792) + d * 64, MAT == 0};
        LdBf16 bl{WSP(bf16_t, MAT ? WS_A2T : WS_W2T) + (size_t)d * 512 * 64, 64};
        EpiLora<MAT> epi{d, PAR(MAT ? PAR_A0 : PAR_W0) + d * 512, WSP(bf16_t, WS_RWLW) + (size_t)d * NTOK * 512, WSP(unsigned char, WS_RWAS) + (size_t)d * NTOK * 512,
                         WSP(float, WS_BON), WSP(bf16_t, WS_ZX), PAR(PAR_SHIFT), PAR(PAR_KA), PAR(PAR_RK), mt * 128, nt * 128};
        gemm_tile<64>(al, bl, 64, mt * 128, nt * 128, epi, smem);
    }
}
__device__ void phase_rw_lora(const W p, unsigned char* smem, int bid, int nblk) {
    phase_rw_lora_mat<0>(p, smem, bid, nblk);
    phase_rw_lora_mat<1>(p, smem, bid, nblk);
}

#define RW_CH 32
struct RwkvSmem {
    float dec[RW_CH][64], aa[RW_CH][64], bb[RW_CH][64], kd[RW_CH][64], rr[RW_CH][64];
    float vv[RW_CH][16];
    float yo[RW_CH][16];
};
struct RwStage { uint4 r8, k8, lw8; uint2 as8; float nrm; float v[8]; };
__device__ __forceinline__ int rw_chunk_s0(int d, int cc) {
    if (d == 0) return RW_CH * cc;
    return (cc < LC / RW_CH) ? RW_CH * (LC / RW_CH - 1 - cc) : LC + RW_CH * (TT / RW_CH - 1 - (cc - LC / RW_CH));
}
__device__ __forceinline__ void rw_stage_load(const W p, RwStage& st, int b, int h, int d, int q, int cc, int tid) {
    const int s0 = rw_chunk_s0(d, cc);
    const int j = tid >> 3, c8 = (tid & 7) * 8;
    const int s = d ? (s0 + RW_CH - 1 - j) : (s0 + j);
    const size_t R = (size_t)b * SS + s;
    const size_t o = (((size_t)(b * 8 + h)) * SS + s) * 64 + c8;
    st.r8 = *(const uint4*)(WSP(bf16_t, WS_RWR) + o);
    st.k8 = *(const uint4*)(WSP(bf16_t, WS_RWK) + o);
    st.lw8 = *(const uint4*)(WSP(bf16_t, WS_RWLW) + ((size_t)d * NTOK + R) * 512 + h * 64 + c8);
    st.as8 = *(const uint2*)(WSP(unsigned char, WS_RWAS) + ((size_t)d * NTOK + R) * 512 + h * 64 + c8);
    st.nrm = WSP(float, WS_RWNRM)[((size_t)(b * 8 + h)) * SS + s];
    if ((tid & 7) < 2) zx0_shift8(WSP(bf16_t, WS_ZX), PAR(PAR_SHIFT), (int)R, 1280 + h * 64 + q * 16 + (tid & 7) * 8, st.v);
}
__device__ __forceinline__ void rw_stage_store(const RwStage& st, RwkvSmem& sm, const float (&kkc)[8], const float (&kac)[8], int tid) {
    const int j = tid >> 3, c8 = (tid & 7) * 8;
    const unsigned ru[4] = {st.r8.x, st.r8.y, st.r8.z, st.r8.w}, ku[4] = {st.k8.x, st.k8.y, st.k8.z, st.k8.w}, lu[4] = {st.lw8.x, st.lw8.y, st.lw8.z, st.lw8.w};
    const unsigned au[2] = {st.as8.x, st.as8.y};
    float dec[8], aa[8], bb[8], kd[8], rr[8];
#pragma unroll
    for (int u = 0; u < 8; ++u) {
        const float kt = (u & 1) ? bfhi(ku[u >> 1]) : bflo(ku[u >> 1]);
        const float rt = (u & 1) ? bfhi(ru[u >> 1]) : bflo(ru[u >> 1]);
        const float lw = (u & 1) ? bfhi(lu[u >> 1]) : bflo(lu[u >> 1]);
        const float a = (float)((au[u >> 2] >> (8 * (u & 3))) & 255u) * (1.f / 255.f);
        const float kk = kt * kkc[u] * st.nrm;
        dec[u] = __expf(lw); aa[u] = -kk; bb[u] = kk * a; kd[u] = kt * (1.f + (a - 1.f) * kac[u]); rr[u] = rt;
    }
    *(float4*)&sm.dec[j][c8] = make_float4(dec[0], dec[1], dec[2], dec[3]); *(float4*)&sm.dec[j][c8 + 4] = make_float4(dec[4], dec[5], dec[6], dec[7]);
    *(float4*)&sm.aa[j][c8] = make_float4(aa[0], aa[1], aa[2], aa[3]);     *(float4*)&sm.aa[j][c8 + 4] = make_float4(aa[4], aa[5], aa[6], aa[7]);
    *(float4*)&sm.bb[j][c8] = make_float4(bb[0], bb[1], bb[2], bb[3]);     *(float4*)&sm.bb[j][c8 + 4] = make_float4(bb[4], bb[5], bb[6], bb[7]);
    *(float4*)&sm.kd[j][c8] = make_float4(kd[0], kd[1], kd[2], kd[3]);     *(float4*)&sm.kd[j][c8 + 4] = make_float4(kd[4], kd[5], kd[6], kd[7]);
    *(float4*)&sm.rr[j][c8] = make_float4(rr[0], rr[1], rr[2], rr[3]);     *(float4*)&sm.rr[j][c8 + 4] = make_float4(rr[4], rr[5], rr[6], rr[7]);
    if ((tid & 7) < 2) {
        *(float4*)&sm.vv[j][(tid & 7) * 8] = make_float4(st.v[0], st.v[1], st.v[2], st.v[3]);
        *(float4*)&sm.vv[j][(tid & 7) * 8 + 4] = make_float4(st.v[4], st.v[5], st.v[6], st.v[7]);
    }
}
__device__ void rwkv_scan_item(const W p, int item, unsigned char* smem_raw) {
    RwkvSmem& sm = *(RwkvSmem*)smem_raw;
    const int q = item & 3, d = (item >> 2) & 1, h = (item >> 3) & 7, b = item >> 6;
    const int tid = tidx(), lane = tid & 63, wave = tid >> 6;
    float S0 = 0.f, S1 = 0.f, S2 = 0.f, S3 = 0.f;
    const int kseg = lane & 15, rowl = wave * 4 + (lane >> 4);
    bf16_t* yb = WSP(bf16_t, WS_YB) + (size_t)d * NTOK * 512;
    float kkc[8], kac[8];
#pragma unroll
    for (int u = 0; u < 8; ++u) { kkc[u] = PAR(PAR_KK)[h * 64 + (tid & 7) * 8 + u]; kac[u] = PAR(PAR_KA)[h * 64 + (tid & 7) * 8 + u]; }
    RwStage st;
    rw_stage_load(p, st, b, h, d, q, 0, tid);
    for (int cc = 0; cc < SS / RW_CH; ++cc) {
        const int s0 = rw_chunk_s0(d, cc);
        __syncthreads();
        rw_stage_store(st, sm, kkc, kac, tid);
        __syncthreads();
        if (cc + 1 < SS / RW_CH) rw_stage_load(p, st, b, h, d, q, cc + 1, tid);
        float yk0 = 0.f, yk1 = 0.f;
#pragma unroll
        for (int j = 0; j < RW_CH; ++j) {
            const float4 w4 = *(const float4*)&sm.dec[j][kseg * 4];
            const float4 a4 = *(const float4*)&sm.aa[j][kseg * 4];
            const float4 b4 = *(const float4*)&sm.bb[j][kseg * 4];
            const float4 k4 = *(const float4*)&sm.kd[j][kseg * 4];
            const float4 r4 = *(const float4*)&sm.rr[j][kseg * 4];
            const float vj = sm.vv[j][rowl];
            float sa = (S0 * a4.x + S1 * a4.y) + (S2 * a4.z + S3 * a4.w);
            sa = row16_sum(sa);
            S0 = S0 * w4.x + sa * b4.x + vj * k4.x;
            S1 = S1 * w4.y + sa * b4.y + vj * k4.y;
            S2 = S2 * w4.z + sa * b4.z + vj * k4.z;
            S3 = S3 * w4.w + sa * b4.w + vj * k4.w;
            float y = (S0 * r4.x + S1 * r4.y) + (S2 * r4.z + S3 * r4.w);
            y = row16_sum(y);
            if (j < 16) yk0 = (kseg == j) ? y : yk0; else yk1 = (kseg == j - 16) ? y : yk1;
        }
        {
            const int sA = d ? (s0 + RW_CH - 1 - kseg) : (s0 + kseg), sB = d ? (s0 + RW_CH - 17 - kseg) : (s0 + 16 + kseg);
            yb[((size_t)b * SS + sA) * 512 + h * 64 + q * 16 + rowl] = f2bf(yk0);
            yb[((size_t)b * SS + sB) * 512 + h * 64 + q * 16 + rowl] = f2bf(yk1);
        }
    }
}

#define RLD 72
constexpr size_t WS_RWPHI = WS_TABU0;
constexpr size_t WS_RWG5  = WS_TABU0 + (size_t)8448 * 8192;
constexpr size_t WS_RWG5B = WS_ZX + (size_t)NTOK * ZW0 * 2;
constexpr size_t WS_RWR2  = WS_MIX;
static_assert(WS_RWG5 + (size_t)7936 * 8192 <= WS_ZX, "G5 part A fits");
static_assert(WS_RWG5B + (size_t)512 * 8192 <= WS_ZX + (size_t)NTOK * ZW1 * 2, "G5 part B fits");
__device__ __forceinline__ bf16_t* rw_g5_ptr(const W p, int item) {
    return item < 7936 ? WSP(bf16_t, WS_RWG5) + (size_t)item * 4096 : WSP(bf16_t, WS_RWG5B) + (size_t)(item - 7936) * 4096;
}
__device__ __forceinline__ int rw_chunk64_s0(int d, int cc) { return d == 0 ? 64 * cc : (cc < 4 ? 64 * (3 - cc) : LC + 64 * (127 - (cc - 4))); }
__device__ __forceinline__ void mmq64(const bf16_t* A, const bf16_t* Bt, int qi, int qj, int l31, int hh, f32x16& acc) {
#pragma unroll
    for (int kk = 0; kk < 4; ++kk) {
        const bf16x8 a = *(const bf16x8*)&A[(32 * qi + l31) * RLD + 16 * kk + 8 * hh];
        const bf16x8 b = *(const bf16x8*)&Bt[(32 * qj + l31) * RLD + 16 * kk + 8 * hh];
        acc = __builtin_amdgcn_mfma_f32_32x32x16_bf16(a, b, acc, 0, 0, 0);
    }
}
#define ACC_ROW(r, qi, hh) (32 * (qi) + ((r) & 3) + 8 * ((r) >> 2) + 4 * (hh))
__device__ __forceinline__ void acc_zero(f32x16& a) {
#pragma unroll
    for (int r = 0; r < 16; ++r) a[r] = 0.f;
}
__device__ __forceinline__ void st_rm(bf16_t* D, const f32x16& acc, int qi, int qj, int l31, int hh) {
#pragma unroll
    for (int r = 0; r < 16; ++r) D[ACC_ROW(r, qi, hh) * RLD + 32 * qj + l31] = f2bf(acc[r]);
}
__device__ __forceinline__ float rcp_fast(float x) { return __builtin_amdgcn_rcpf(x); }
__device__ __forceinline__ void rw1_item(const W p, int item, unsigned char* smem) {
    const int chain = item / 132, cc = item - chain * 132;
    const int d = chain & 1, h = (chain >> 1) & 7, b = chain >> 4;
    const int s0 = rw_chunk64_s0(d, cc);
    const int seg_lo = (s0 < LC) ? 0 : LC, seg_hi = (s0 < LC) ? LC : SS;
    const int tid = tidx(), lane = tid & 63, wave = tid >> 6, l31 = lane & 31, hh = lane >> 5, qi = wave >> 1, qj = wave & 1;
    const int tau = tid >> 2, kq = tid & 3, k0 = kq * 16;
    bf16_t* M0 = (bf16_t*)smem;            bf16_t* M1 = M0 + 64 * RLD; bf16_t* M2 = M1 + 64 * RLD; bf16_t* M3 = M2 + 64 * RLD;
    bf16_t* M4 = M3 + 64 * RLD;            bf16_t* M5 = M4 + 64 * RLD; bf16_t* M6 = M5 + 64 * RLD;
    float* gam = (float*)(smem + 7 * 64 * RLD * 2);
    bf16_t* T11 = (bf16_t*)(gam + 64);
    bf16_t* Wrm = T11 + 32 * 40;
    float* muS = gam + 64;
    float* hcS = muS + 640;
    float* LW = (float*)smem;
    bf16_t* AS = (bf16_t*)(LW + 64 * 64);
    float* tot = (float*)(AS + 64 * 64);
    const bf16_t* zx = WSP(bf16_t, WS_ZX);
    const float* mu = PAR(PAR_SHIFT);
    unsigned* scr = (unsigned*)(WSP(bf16_t, WS_YA) + (size_t)bidx() * 4 * 4096 + tau * 64 + k0);
    const int colr = 256 + h * 64, colk = 768 + h * 64, colv = 1280 + h * 64, colw = 1792 + d * 64, cola = 1920 + d * 64;
    __syncthreads();
    {
        bf16_t* raw = (bf16_t*)smem;
        u32x4v rv[11];
#pragma unroll
        for (int q = 0; q < 11; ++q) {
            const int c = tid + 256 * q;
            const int cc = c < 5 * 66 * 8 ? c : 5 * 66 * 8 - 1;
            const int c8 = (cc & 7) * 8, rix = (cc >> 3) % 66, sl = cc / (8 * 66);
            int s = s0 - 1 + rix;
            const bool inr = s >= seg_lo && s < seg_hi;
            s = inr ? s : seg_lo;
            const int col = (sl == 0 ? colr : sl == 1 ? colk : sl == 2 ? colv : sl == 3 ? colw : cola) + c8;
            const u32x4v v = *(const u32x4v*)&zx[((size_t)b * SS + s) * ZW0 + col];
            rv[q] = inr ? v : (u32x4v){0u, 0u, 0u, 0u};
        }
        float m0v[2], m1v[2];
#pragma unroll
        for (int q = 0; q < 2; ++q) {
            const int e = tid + 256 * q, ee = e < 320 ? e : 319;
            const int sl = ee >> 6, ch = ee & 63;
            const int mc = (sl == 0 ? colr : sl == 1 ? colk : sl == 2 ? colv : sl == 3 ? colw : cola) - 256 + ch;
            m0v[q] = mu[mc]; m1v[q] = mu[1920 + mc];
        }
        const float hcv = PAR(tid < 64 ? PAR_KK : tid < 128 ? PAR_KA : PAR_RK)[h * 64 + (tid & 63)];
#pragma unroll
        for (int q = 0; q < 11; ++q) {
            const int c = tid + 256 * q;
            if (c < 5 * 66 * 8) { const int c8 = (c & 7) * 8, rix = (c >> 3) % 66, sl = c / (8 * 66); *(u32x4v*)&raw[(sl * 66 + rix) * 64 + c8] = rv[q]; }
        }
#pragma unroll
        for (int q = 0; q < 2; ++q) { const int e = tid + 256 * q; if (e < 320) { muS[e * 2] = m0v[q]; muS[e * 2 + 1] = m1v[q]; } }
        if (tid < 192) hcS[tid] = hcv;
    }
    __syncthreads();
    unsigned rpa[8], kpa[8], vpa[8], atp[8], rtp[8], btp[8], ktp[8];
    {
        const bf16_t* raw = (const bf16_t*)smem;
        const int jj = d ? (63 - tau) : tau;
#pragma unroll
        for (int sl = 0; sl < 5; ++sl) {
            const uint4* rp_ = (const uint4*)&raw[(sl * 66 + jj) * 64 + k0];
            const uint4 p0 = rp_[0], p1 = rp_[1], z0 = rp_[8], z1 = rp_[9], n0 = rp_[16], n1 = rp_[17];
            const unsigned pu[8] = {p0.x, p0.y, p0.z, p0.w, p1.x, p1.y, p1.z, p1.w}, zu[8] = {z0.x, z0.y, z0.z, z0.w, z1.x, z1.y, z1.z, z1.w},
                           nu[8] = {n0.x, n0.y, n0.z, n0.w, n1.x, n1.y, n1.z, n1.w};
            unsigned o[8];
#pragma unroll
            for (int u2 = 0; u2 < 8; ++u2) {
                const float4 mw = *(const float4*)&muS[(sl * 64 + k0 + 2 * u2) * 2];
                const float za = bflo(zu[u2]), zb = bfhi(zu[u2]);
                float oa = za + mw.x * (bflo(pu[u2]) - za) + mw.y * (bflo(nu[u2]) - za);
                float ob = zb + mw.z * (bfhi(pu[u2]) - zb) + mw.w * (bfhi(nu[u2]) - zb);
                if (sl == 3) { oa = tanh_fast(oa); ob = tanh_fast(ob); }
                o[u2] = pack2(oa, ob);
            }
            if (sl < 3) {
#pragma unroll
                for (int u2 = 0; u2 < 8; ++u2) { if (sl == 0) rpa[u2] = o[u2]; else if (sl == 1) kpa[u2] = o[u2]; else vpa[u2] = o[u2]; }
            }
            else { bf16_t* Dm = (sl == 3 ? M5 : M6); *(uint4*)&Dm[tau * RLD + k0] = make_uint4(o[0], o[1], o[2], o[3]); *(uint4*)&Dm[tau * RLD + k0 + 8] = make_uint4(o[4], o[5], o[6], o[7]); }
        }
    }
    __syncthreads();
    {
        f32x16 aw, aa; acc_zero(aw); acc_zero(aa);
        const bf16_t* w2t = WSP(bf16_t, WS_W2T) + ((size_t)d * 512 + h * 64 + 32 * qj + l31) * 64 + 8 * hh;
        const bf16_t* a2t = WSP(bf16_t, WS_A2T) + ((size_t)d * 512 + h * 64 + 32 * qj + l31) * 64 + 8 * hh;
#pragma unroll
        for (int kk = 0; kk < 4; ++kk) {
            const bf16x8 xa = *(const bf16x8*)&M5[(32 * qi + l31) * RLD + 16 * kk + 8 * hh];
            const bf16x8 xb = *(const bf16x8*)&M6[(32 * qi + l31) * RLD + 16 * kk + 8 * hh];
            aw = __builtin_amdgcn_mfma_f32_32x32x16_bf16(xa, *(const bf16x8*)(w2t + 16 * kk), aw, 0, 0, 0);
            aa = __builtin_amdgcn_mfma_f32_32x32x16_bf16(xb, *(const bf16x8*)(a2t + 16 * kk), aa, 0, 0, 0);
        }
        const int n = 32 * qj + l31;
        const float w0 = PAR(PAR_W0)[d * 512 + h * 64 + n], a0 = PAR(PAR_A0)[d * 512 + h * 64 + n];
#pragma unroll
        for (int r = 0; r < 16; ++r) {
            const int t = ACC_ROW(r, qi, hh);
            LW[t * 64 + n] = -0.60653065971f * rcp_fast(1.f + __expf(-(aw[r] + w0)));
            AS[t * 64 + n] = f2bf(rcp_fast(1.f + __expf(-(aa[r] + a0))));
        }
    }
    __syncthreads();
    {
        const int k = tid & 63, part = tid >> 6;
        float run = 0.f;
#pragma unroll 4
        for (int i = 0; i < 16; ++i) { run += LW[(16 * part + i) * 64 + k]; LW[(16 * part + i) * 64 + k] = run; }
        tot[part * 64 + k] = run;
        __syncthreads();
        float off = 0.f;
        for (int pp = 0; pp < part; ++pp) off += tot[pp * 64 + k];
#pragma unroll 4
        for (int i = 0; i < 16; ++i) LW[(16 * part + i) * 64 + k] = __expf(LW[(16 * part + i) * 64 + k] + off);
    }
    __syncthreads();
    {
        float ss = 0.f;
#pragma unroll
        for (int u2 = 0; u2 < 8; ++u2) { const unsigned kp = kpa[u2]; const float a = bflo(kp) * hcS[k0 + 2 * u2], c = bfhi(kp) * hcS[k0 + 2 * u2 + 1]; ss += a * a + c * c; }
        ss += dppf<DPP_XOR1>(ss); ss += dppf<DPP_XOR2>(ss);
        const float nrm = rsqrtf(ss + 1e-12f);
        float bsum = 0.f;
#pragma unroll
        for (int u2 = 0; u2 < 8; ++u2) {
            const unsigned kp = kpa[u2], rp = rpa[u2], vp = vpa[u2];
            float fa[2], fr[2], fb[2], fk[2];
#pragma unroll
            for (int e = 0; e < 2; ++e) {
                const int k = k0 + 2 * u2 + e;
                const float kv = e ? bfhi(kp) : bflo(kp), rv = e ? bfhi(rp) : bflo(rp);
                const float eL = LW[tau * 64 + k], eLp = tau ? LW[(tau - 1) * 64 + k] : 1.f, sg = bf2f(AS[tau * 64 + k]);
                const float kk = kv * hcS[k] * nrm;
                const float kd = kv * (1.f + (sg - 1.f) * hcS[64 + k]);
                bsum += rv * kd * hcS[128 + k];
                const float eNL = rcp_fast(eL);
                fa[e] = -kk * eLp; fr[e] = rv * eL; fb[e] = kk * sg * eNL; fk[e] = kd * eNL;
                if (tau == 63) gam[k] = eL;
            }
            const unsigned pa = pack2(fa[0], fa[1]), pr = pack2(fr[0], fr[1]), pb = pack2(fb[0], fb[1]), pk = pack2(fk[0], fk[1]);
            *(unsigned*)&M4[tau * RLD + k0 + 2 * u2] = pa; *(unsigned*)&M5[tau * RLD + k0 + 2 * u2] = pb; *(unsigned*)&M6[tau * RLD + k0 + 2 * u2] = pk;
            atp[u2] = pa; rtp[u2] = pr; btp[u2] = pb; ktp[u2] = pk;
            M3[(k0 + 2 * u2) * RLD + tau] = (bf16_t)(vp & 0xffffu); M3[(k0 + 2 * u2 + 1) * RLD + tau] = (bf16_t)(vp >> 16);
        }
        bsum += dppf<DPP_XOR1>(bsum); bsum += dppf<DPP_XOR2>(bsum);
        if (kq == 0) { const int s = d ? (s0 + 63 - tau) : (s0 + tau); WSP(float, WS_BON)[((size_t)b * SS + s) * 16 + h * 2 + d] = bsum; }
    }
    __syncthreads();
#define CP_TM(D, a) { *(uint4*)&(D)[tau * RLD + k0] = make_uint4(a[0], a[1], a[2], a[3]); *(uint4*)&(D)[tau * RLD + k0 + 8] = make_uint4(a[4], a[5], a[6], a[7]); }
#define CP_KM(D, a, USEG) { _Pragma("unroll") for (int u2 = 0; u2 < 8; ++u2) { const unsigned q_ = a[u2]; const int kx_ = k0 + 2 * u2; \
        (D)[kx_ * RLD + tau] = f2bf(bflo(q_) * ((USEG) ? gam[kx_] : 1.f)); (D)[(kx_ + 1) * RLD + tau] = f2bf(bfhi(q_) * ((USEG) ? gam[kx_ + 1] : 1.f)); } }
    {
        const int sc = 32 * qj + l31;
        f32x16 x0, x1; acc_zero(x0); acc_zero(x1);
        mmq64(M4, M5, qi, qj, l31, hh, x0);
        mmq64(M4, M6, qi, qj, l31, hh, x1);
#pragma unroll
        for (int r = 0; r < 16; ++r) { const bool z = !(sc < ACC_ROW(r, qi, hh)); x0[r] = z ? 0.f : x0[r]; x1[r] = z ? 0.f : x1[r]; }
        st_rm(M0, x0, qi, qj, l31, hh);
        st_rm(M1, x1, qi, qj, l31, hh);
    }
    __syncthreads();
    CP_TM(M4, rtp)
    __syncthreads();
    {
        const int sc = 32 * qj + l31;
        f32x16 x0, x1; acc_zero(x0); acc_zero(x1);
        mmq64(M4, M5, qi, qj, l31, hh, x0);
        mmq64(M4, M6, qi, qj, l31, hh, x1);
#pragma unroll
        for (int r = 0; r < 16; ++r) { const bool z = !(sc <= ACC_ROW(r, qi, hh)); x0[r] = z ? 0.f : x0[r]; x1[r] = z ? 0.f : x1[r]; }
        st_rm(M2, x0, qi, qj, l31, hh);
        __syncthreads();
        st_rm(M6, x1, qi, qj, l31, hh);
    }
    __syncthreads();
    if (wave == 0) {
        const int blk = lane >> 5, rr = lane & 31;
        float Tr[32];
        u32x4v rq0 = {0u, 0u, 0u, 0u}, rq1 = rq0, rq2 = rq0, rq3 = rq0;
#pragma unroll
        for (int t = 0; t < 32; ++t) {
            u32x4v nq0 = rq0, nq1 = rq1, nq2 = rq2, nq3 = rq3;
            if (t + 1 < 32) {
                const bf16_t* nrow = &M0[(32 * blk + t + 1) * RLD + 32 * blk];
                nq0 = *(const u32x4v*)&nrow[0];
                if (t + 1 > 8)  nq1 = *(const u32x4v*)&nrow[8];
                if (t + 1 > 16) nq2 = *(const u32x4v*)&nrow[16];
                if (t + 1 > 24) nq3 = *(const u32x4v*)&nrow[24];
            }
            float ac4[4] = {(t == rr) ? 1.f : 0.f, 0.f, 0.f, 0.f};
#pragma unroll
            for (int c8 = 0; c8 * 8 < t; ++c8) {
                const u32x4v q = c8 == 0 ? rq0 : c8 == 1 ? rq1 : c8 == 2 ? rq2 : rq3;
#pragma unroll
                for (int e = 0; e < 8; ++e) if (8 * c8 + e < t) ac4[e & 3] += Tr[8 * c8 + e] * ((e & 1) ? bfhi(q[e >> 1]) : bflo(q[e >> 1]));
            }
            const float acc = (ac4[0] + ac4[1]) + (ac4[2] + ac4[3]);
            Tr[t] = acc;
            M5[(32 * blk + t) * RLD + 32 * blk + rr] = f2bf(acc);
            if (blk == 0) { T11[rr * 40 + t] = f2bf(acc); M5[t * RLD + 32 + rr] = 0; }
            rq0 = nq0; rq1 = nq1; rq2 = nq2; rq3 = nq3;
        }
        f32x16 wv; acc_zero(wv);
#pragma unroll
        for (int kk = 0; kk < 2; ++kk) {
            const bf16x8 a = *(const bf16x8*)&T11[l31 * 40 + 16 * kk + 8 * hh];
            const bf16x8 bq = *(const bf16x8*)&M0[(32 + l31) * RLD + 16 * kk + 8 * hh];
            wv = __builtin_amdgcn_mfma_f32_32x32x16_bf16(a, bq, wv, 0, 0, 0);
        }
#pragma unroll
        for (int r = 0; r < 16; ++r) Wrm[ACC_ROW(r, 0, hh) * 40 + l31] = f2bf(wv[r]);
        f32x16 t12; acc_zero(t12);
#pragma unroll
        for (int kk = 0; kk < 2; ++kk) {
            const bf16x8 a = *(const bf16x8*)&Wrm[l31 * 40 + 16 * kk + 8 * hh];
            const bf16x8 bq = *(const bf16x8*)&M5[(32 + l31) * RLD + 32 + 16 * kk + 8 * hh];
            t12 = __builtin_amdgcn_mfma_f32_32x32x16_bf16(a, bq, t12, 0, 0, 0);
        }
#pragma unroll
        for (int g4 = 0; g4 < 4; ++g4)
            *(uint2*)&M5[(32 + l31) * RLD + 8 * g4 + 4 * hh] = make_uint2(pack2(t12[4 * g4], t12[4 * g4 + 1]), pack2(t12[4 * g4 + 2], t12[4 * g4 + 3]));
    }
    __syncthreads();
    { f32x16 x; acc_zero(x); mmq64(M3, M1, qi, qj, l31, hh, x); __syncthreads(); st_rm(M0, x, qi, qj, l31, hh); }
    CP_KM(M1, atp, false)
    __syncthreads();
    { f32x16 xa, xg; acc_zero(xa); acc_zero(xg);
      mmq64(M1, M5, qi, qj, l31, hh, xa);
      mmq64(M0, M5, qi, qj, l31, hh, xg);
      st_rm(M4, xa, qi, qj, l31, hh);
      __syncthreads();
      st_rm(M1, xg, qi, qj, l31, hh); }
    __syncthreads();
    CP_TM(M0, rtp)
    CP_KM(M5, btp, true)
    __syncthreads();
    {
        const int cix = 32 * qj + l31;
        f32x16 xr, xp; acc_zero(xr); acc_zero(xp);
        mmq64(M2, M4, qi, qj, l31, hh, xr);
        mmq64(M5, M4, qi, qj, l31, hh, xp);
        const float gc = gam[cix];
#pragma unroll
        for (int r = 0; r < 16; ++r) { xr[r] += bf2f(M0[ACC_ROW(r, qi, hh) * RLD + cix]); xp[r] += (ACC_ROW(r, qi, hh) == cix) ? gc : 0.f; }
        __syncthreads();
        st_rm(M0, xr, qi, qj, l31, hh); st_rm(M4, xp, qi, qj, l31, hh);
    }
    __syncthreads();
    {
        bf16_t* r2g = WSP(bf16_t, WS_RWR2) + (size_t)item * 4096;
        bf16_t* phg = WSP(bf16_t, WS_RWPHI) + (size_t)item * 4096;
        for (int c = tid; c < 512; c += 256) {
            const int row = c >> 3, c8 = (c & 7) * 8;
            *(uint4*)&r2g[row * 64 + c8] = *(const uint4*)&M0[row * RLD + c8];
            *(uint4*)&phg[row * 64 + c8] = *(const uint4*)&M4[row * RLD + c8];
        }
    }
    f32x16 xo; acc_zero(xo);
    {
        f32x16 x; acc_zero(x);
        mmq64(M1, M2, qi, qj, l31, hh, x); mmq64(M3, M6, qi, qj, l31, hh, x);
        mmq64(M1, M5, qi, qj, l31, hh, xo);
        const int t = 32 * qj + l31;
        const int s = d ? (s0 + 63 - t) : (s0 + t);
        bf16_t* yrow = WSP(bf16_t, WS_YB) + (size_t)d * NTOK * 512 + ((size_t)b * SS + s) * 512 + h * 64;
#pragma unroll
        for (int g4 = 0; g4 < 4; ++g4)
            *(uint2*)&yrow[32 * qi + 8 * g4 + 4 * hh] = make_uint2(pack2(x[4 * g4], x[4 * g4 + 1]), pack2(x[4 * g4 + 2], x[4 * g4 + 3]));
    }
    __syncthreads();
    CP_KM(M0, ktp, true)
    __syncthreads();
    { mmq64(M3, M0, qi, qj, l31, hh, xo); st_rm(M4, xo, qi, qj, l31, hh); }
    __syncthreads();
    {
        bf16_t* g5g = rw_g5_ptr(p, item);
        for (int c = tid; c < 512; c += 256) { const int row = c >> 3, c8 = (c & 7) * 8; *(uint4*)&g5g[row * 64 + c8] = *(const uint4*)&M4[row * RLD + c8]; }
    }
#undef CP_TM
#undef CP_KM
}
#define RW1_SMEM_BYTES (7 * 64 * RLD * 2 + 256 + 2 * 32 * 40 * 2)
static_assert(256 + 640 * 4 + 192 * 4 <= 256 + 2 * 32 * 40 * 2, "stage A..E tables fit in the scratch tail");

#define RW2_BUF_BYTES (3 * 64 * RLD * 2)
struct Rw2Stage { u32x4v q0, q1, q2, q3, q4, q5; };
__device__ __forceinline__ void rw2_issue(const W p, int item, int tid, Rw2Stage& st) {
    const bf16_t* s0_ = WSP(bf16_t, WS_RWPHI) + (size_t)item * 4096; const bf16_t* s1_ = WSP(bf16_t, WS_RWR2) + (size_t)item * 4096; const bf16_t* s2_ = rw_g5_ptr(p, item);
    const int o0 = (tid >> 3) * 64 + (tid & 7) * 8, o1 = o0 + 32 * 64;
    st.q0 = *(const u32x4v*)&s0_[o0]; st.q1 = *(const u32x4v*)&s0_[o1];
    st.q2 = *(const u32x4v*)&s1_[o0]; st.q3 = *(const u32x4v*)&s1_[o1];
    st.q4 = *(const u32x4v*)&s2_[o0]; st.q5 = *(const u32x4v*)&s2_[o1];
}
__device__ __forceinline__ void rw2_commit(unsigned char* buf, int tid, const Rw2Stage& st) {
    bf16_t* bb = (bf16_t*)buf;
    const int o0 = (tid >> 3) * RLD + (tid & 7) * 8, o1 = o0 + 32 * RLD;
    *(u32x4v*)&bb[o0] = st.q0; *(u32x4v*)&bb[o1] = st.q1;
    *(u32x4v*)&bb[64 * RLD + o0] = st.q2; *(u32x4v*)&bb[64 * RLD + o1] = st.q3;
    *(u32x4v*)&bb[128 * RLD + o0] = st.q4; *(u32x4v*)&bb[128 * RLD + o1] = st.q5;
}
__device__ __forceinline__ void rw2_step(const unsigned char* bufc, f32x4 (&st)[4], bf16_t* Yt, int wave, int l15, int g) {
    const bf16_t* PH = (const bf16_t*)bufc; const bf16_t* R2 = PH + 64 * RLD; const bf16_t* G5 = R2 + 64 * RLD;
    bf16x8 sb[2];
#pragma unroll
    for (int s2 = 0; s2 < 2; ++s2) {
        union { bf16x8 v; unsigned u[4]; } pk;
        pk.u[0] = pack2(st[2 * s2][0], st[2 * s2][1]); pk.u[1] = pack2(st[2 * s2][2], st[2 * s2][3]);
        pk.u[2] = pack2(st[2 * s2 + 1][0], st[2 * s2 + 1][1]); pk.u[3] = pack2(st[2 * s2 + 1][2], st[2 * s2 + 1][3]);
        sb[s2] = pk.v;
    }
    f32x4 yn[4], sn[4];
#pragma unroll
    for (int mt = 0; mt < 4; ++mt) {
        yn[mt] = (f32x4){0.f, 0.f, 0.f, 0.f};
        const uint2 gq = *(const uint2*)&G5[(16 * wave + l15) * RLD + 16 * mt + 4 * g];
        sn[mt] = (f32x4){bflo(gq.x), bfhi(gq.x), bflo(gq.y), bfhi(gq.y)};
#pragma unroll
        for (int s2 = 0; s2 < 2; ++s2) {
            union { bf16x8 v; uint2 hq[2]; } fa, fb;
            fa.hq[0] = *(const uint2*)&R2[(16 * mt + l15) * RLD + 32 * s2 + 4 * g]; fa.hq[1] = *(const uint2*)&R2[(16 * mt + l15) * RLD + 32 * s2 + 16 + 4 * g];
            fb.hq[0] = *(const uint2*)&PH[(16 * mt + l15) * RLD + 32 * s2 + 4 * g]; fb.hq[1] = *(const uint2*)&PH[(16 * mt + l15) * RLD + 32 * s2 + 16 + 4 * g];
            yn[mt] = __builtin_amdgcn_mfma_f32_16x16x32_bf16(fa.v, sb[s2], yn[mt], 0, 0, 0);
            sn[mt] = __builtin_amdgcn_mfma_f32_16x16x32_bf16(fb.v, sb[s2], sn[mt], 0, 0, 0);
        }
    }
#pragma unroll
    for (int mt = 0; mt < 4; ++mt)
#pragma unroll
        for (int r = 0; r < 4; ++r) Yt[(16 * mt + 4 * g + r) * RLD + 16 * wave + l15] = f2bf(yn[mt][r]);
#pragma unroll
    for (int mt = 0; mt < 4; ++mt) st[mt] = sn[mt];
}
__device__ __forceinline__ void rw2_yaddr(int d, int cc, int tid, size_t& off) {
    const int s0 = rw_chunk64_s0(d, cc < 132 ? cc : 131);
    const int t = tid >> 2; const int s = d ? (s0 + 63 - t) : (s0 + t);
    off = (size_t)s * 512 + (tid & 3) * 16;
}
__device__ __forceinline__ void rw2_yout(bf16_t* ybase, size_t off, const bf16_t* Yt, int tid, const u32x4v& o0, const u32x4v& o1) {
    const int t = tid >> 2, c0 = (tid & 3) * 16;
    const u32x4v a0 = *(const u32x4v*)&Yt[t * RLD + c0], a1 = *(const u32x4v*)&Yt[t * RLD + c0 + 8];
    u32x4v r0, r1;
#pragma unroll
    for (int i = 0; i < 4; ++i) {
        r0[i] = pack2(bflo(o0[i]) + bflo(a0[i]), bfhi(o0[i]) + bfhi(a0[i]));
        r1[i] = pack2(bflo(o1[i]) + bflo(a1[i]), bfhi(o1[i]) + bfhi(a1[i]));
    }
    *(u32x4v*)&ybase[off] = r0; *(u32x4v*)&ybase[off + 8] = r1;
}
__device__ __forceinline__ void rw2_chain(const W p, int chain, unsigned char* smem) {
    const int d = chain & 1, h = (chain >> 1) & 7, b = chain >> 4;
    const int tid = tidx(), lane = tid & 63, wave = tid >> 6, l15 = lane & 15, g = lane >> 4;
    f32x4 st[4];
#pragma unroll
    for (int mt = 0; mt < 4; ++mt) st[mt] = (f32x4){0.f, 0.f, 0.f, 0.f};
    bf16_t* ybase = WSP(bf16_t, WS_YB) + (size_t)d * NTOK * 512 + (size_t)b * SS * 512 + h * 64;
    unsigned char* buf0 = smem; unsigned char* buf1 = smem + RW2_BUF_BYTES;
    bf16_t* Yt = (bf16_t*)(smem + 2 * RW2_BUF_BYTES);
    const int it0 = chain * 132;
    Rw2Stage ra, rb;
    u32x4v oa0, oa1, ob0, ob1; size_t offa, offb;
    __syncthreads();
    rw2_issue(p, it0, tid, ra); rw2_issue(p, it0 + 1, tid, rb);
    rw2_commit(buf0, tid, ra); rw2_issue(p, it0 + 2, tid, ra);
    rw2_commit(buf1, tid, rb); rw2_issue(p, it0 + 3, tid, rb);
    rw2_yaddr(d, 0, tid, offa); oa0 = *(const u32x4v*)&ybase[offa]; oa1 = *(const u32x4v*)&ybase[offa + 8];
#pragma unroll 1
    for (int cc = 0; cc < 132; cc += 2) {
        rw2_yaddr(d, cc + 1, tid, offb); ob0 = *(const u32x4v*)&ybase[offb]; ob1 = *(const u32x4v*)&ybase[offb + 8];
        __syncthreads();
        rw2_step(buf0, st, Yt, wave, l15, g);
        __syncthreads();
        rw2_yout(ybase, offa, Yt, tid, oa0, oa1);
        rw2_commit(buf0, tid, ra);
        rw2_issue(p, it0 + (cc + 4 < 132 ? cc + 4 : 131), tid, ra);
        rw2_yaddr(d, cc + 2, tid, offa); oa0 = *(const u32x4v*)&ybase[offa]; oa1 = *(const u32x4v*)&ybase[offa + 8];
        __syncthreads();
        rw2_step(buf1, st, Yt, wave, l15, g);
        __syncthreads();
        rw2_yout(ybase, offb, Yt, tid, ob0, ob1);
        rw2_commit(buf1, tid, rb);
        rw2_issue(p, it0 + (cc + 5 < 132 ? cc + 5 : 131), tid, rb);
    }
    __syncthreads();
}
static_assert(2 * RW2_BUF_BYTES + 64 * RLD * 2 <= RW1_SMEM_BYTES, "RW2 ring + y tile fit");

struct EpiGlu {
    const bf16_t* ya; const float* bglu; bf16_t* mix; int m0, n0;
    __device__ void operator()(const float* Cs, int pass, int tid) const {
#pragma unroll
        for (int i = 0; i < 4; ++i) {
            const int c = tid + 256 * i, row = c >> 4, col8 = (c & 15) * 8;
            const int R = m0 + pass * 64 + row, col = n0 + col8;
            const uint4 yv = *(const uint4*)&ya[(size_t)R * 256 + col];
            const unsigned yu[4] = {yv.x, yv.y, yv.z, yv.w};
            unsigned o[4];
#pragma unroll
            for (int u = 0; u < 4; ++u) {
                const float y0 = bflo(yu[u]), y1 = bfhi(yu[u]);
                const float g0 = sigmoidf_(Cs[row * CS_LD + col8 + 2 * u] + bglu[col + 2 * u]);
                const float g1 = sigmoidf_(Cs[row * CS_LD + col8 + 2 * u + 1] + bglu[col + 2 * u + 1]);
                o[u] = pack2(y0 * g0, y1 * g1);
            }
            *(uint4*)&mix[(size_t)R * 768 + col] = make_uint4(o[0], o[1], o[2], o[3]);
        }
    }
};
__device__ void phase_glu(const W p, unsigned char* smem, int bid, int nblk) {
    LdBf16 al{WSP(bf16_t, WS_YA), 256};
    LdBf16 bl{WSP(bf16_t, WS_WGLUT), 256};
    for (int t = bid; t < (NTOK / 128) * 2; t += nblk) {
        const int m0 = (t >> 1) * 128, n0 = (t & 1) * 128;
        EpiGlu epi{WSP(bf16_t, WS_YA), PAR(PAR_BGLU), WSP(bf16_t, WS_MIX), m0, n0};
        gemm_tile<128>(al, bl, 256, m0, n0, epi, smem);
    }
}
struct LdGlo {
    const bf16_t* zx; const float* mu;
    typedef int RowCtx;
    __device__ RowCtx row(int R) const { return R; }
    __device__ uint4 load8(RowCtx R, int k) const {
        float v[8]; zx0_shift8(zx, mu, R, 2048 + k, v);
        uint4 o; o.x = pack2(sigmoidf_(v[0]), sigmoidf_(v[1])); o.y = pack2(sigmoidf_(v[2]), sigmoidf_(v[3]));
        o.z = pack2(sigmoidf_(v[4]), sigmoidf_(v[5])); o.w = pack2(sigmoidf_(v[6]), sigmoidf_(v[7]));
        return o;
    }
};
struct EpiRwkvOut {
    const bf16_t* yb0; const bf16_t* yb1; const float* bon; const bf16_t* zx; const float* mu; const float* gnw; const float* gnb; bf16_t* mix; int m0, n0;
    __device__ void operator()(const float* Cs, int pass, int tid) const {
#pragma unroll 1
        for (int i = 0; i < 4; ++i) {
            const int c = tid + 256 * i, row = c >> 4, col8 = (c & 15) * 8;
            const int R = m0 + pass * 64 + row, col = n0 + col8, head = col >> 6;
            const uint4 a = *(const uint4*)&yb0[(size_t)R * 512 + col], b = *(const uint4*)&yb1[(size_t)R * 512 + col];
            const unsigned au[4] = {a.x, a.y, a.z, a.w}, bu[4] = {b.x, b.y, b.z, b.w};
            float y[8], sum = 0.f, sq = 0.f;
#pragma unroll
            for (int u = 0; u < 4; ++u) { y[2 * u] = bflo(au[u]) + bflo(bu[u]); y[2 * u + 1] = bfhi(au[u]) + bfhi(bu[u]); }
#pragma unroll
            for (int u = 0; u < 8; ++u) sum += y[u];
            sum += __shfl_xor(sum, 1); sum += __shfl_xor(sum, 2); sum += __shfl_xor(sum, 4);
            const float mean = sum * (1.f / 64.f);
#pragma unroll
            for (int u = 0; u < 8; ++u) { const float dl = y[u] - mean; sq += dl * dl; }
            sq += __shfl_xor(sq, 1); sq += __shfl_xor(sq, 2); sq += __shfl_xor(sq, 4);
            const float rs = rsqrtf(sq * (1.f / 64.f) + 64e-5f);
            const float bc = bon[(size_t)R * 16 + head * 2] + bon[(size_t)R * 16 + head * 2 + 1];
            float v[8]; zx0_shift8(zx, mu, R, 1280 + col, v);
            const float4 g0 = *(const float4*)&Cs[row * CS_LD + col8], g1 = *(const float4*)&Cs[row * CS_LD + col8 + 4];
            const float gg[8] = {g0.x, g0.y, g0.z, g0.w, g1.x, g1.y, g1.z, g1.w};
            float o[8];
#pragma unroll
            for (int u = 0; u < 8; ++u) o[u] = ((y[u] - mean) * rs * gnw[col + u] + gnb[col + u] + bc * v[u]) * gg[u];
            *(uint4*)&mix[(size_t)R * 768 + 256 + col] = make_uint4(pack2(o[0], o[1]), pack2(o[2], o[3]), pack2(o[4], o[5]), pack2(o[6], o[7]));
        }
    }
};
__device__ void phase_rwkv_out(const W p, unsigned char* smem, int bid, int nblk) {
    LdGlo al{WSP(bf16_t, WS_ZX), PAR(PAR_SHIFT)};
    LdBf16 bl{WSP(bf16_t, WS_G2T), 128};
    for (int t = bid; t < (NTOK / 128) * 4; t += nblk) {
        const int m0 = (t >> 2) * 128, n0 = (t & 3) * 128;
        EpiRwkvOut epi{WSP(bf16_t, WS_YB), WSP(bf16_t, WS_YB) + (size_t)NTOK * 512, WSP(float, WS_BON), WSP(bf16_t, WS_ZX), PAR(PAR_SHIFT),
                       PAR(PAR_GNW), PAR(PAR_GNB), WSP(bf16_t, WS_MIX), m0, n0};
        gemm_tile<128>(al, bl, 128, m0, n0, epi, smem);
    }
}

__device__ void phase_gemm_wout(const W p, unsigned char* smem, int bid, int nblk, int layer) {
    const int K = layer ? 1024 : 768;
    LdBf16 al{WSP(bf16_t, WS_MIX), K};
    LdBf16 bl{WSP(bf16_t, layer ? WS_WOUT1T : WS_WOUT0T), K};
    const int total = (NTOK / 128) * 8;
    for (int t = xcd_swz(bid, nblk); t < total; t += nblk) {
        const int m0 = (t >> 3) * 128, n0 = (t & 7) * 128;
        if (layer && (m0 % SS) < LC) continue;
        EpiStoreBf16 epi{WSP(bf16_t, WS_ZX), 1024, m0, n0, NTOK};
        gemm_tile_dma(al.base, al.ld, bl.base, bl.ld, K, m0, n0, epi, smem);
    }
}

__device__ __forceinline__ void ln_row_store(float (&v)[16], const float* g, const float* bta, float* dst, int lane, const float* m2, bf16_t* hb) {
    float s = 0.f;
#pragma unroll
    for (int i = 0; i < 16; ++i) s += v[i];
    const float mean = wave_sum(s) * (1.f / 1024.f);
    float q = 0.f;
#pragma unroll
    for (int i = 0; i < 16; ++i) { const float dl = v[i] - mean; q += dl * dl; }
    const float rs = rsqrtf(wave_sum(q) * (1.f / 1024.f) + 1e-5f);
#pragma unroll
    for (int i = 0; i < 4; ++i) {
        const int k = i * 256 + lane * 4;
        const float4 gg = *(const float4*)&g[k], bb = *(const float4*)&bta[k];
        float4 o;
        o.x = (v[4 * i] - mean) * rs * gg.x + bb.x; o.y = (v[4 * i + 1] - mean) * rs * gg.y + bb.y;
        o.z = (v[4 * i + 2] - mean) * rs * gg.z + bb.z; o.w = (v[4 * i + 3] - mean) * rs * gg.w + bb.w;
        *(float4*)&dst[k] = o;
        const float4 sc = *(const float4*)&m2[4096 + k], sh = *(const float4*)&m2[3072 + k];
        *(uint2*)&hb[k] = make_uint2(pack2(o.x * (1.f + sc.x) + sh.x, o.y * (1.f + sc.y) + sh.y), pack2(o.z * (1.f + sc.z) + sh.z, o.w * (1.f + sc.w) + sh.w));
    }
}
__device__ void phase_ln1(const W p, int gwave_, int nwaves_, int layer, unsigned char* smem) {
    const int gwave = __builtin_amdgcn_readfirstlane(gwave_), nwaves = __builtin_amdgcn_readfirstlane(nwaves_);
    const int lane = tidx() & 63;
    const bf16_t* yx = WSP(bf16_t, WS_ZX);
    const float* mod = WSP(float, WS_MOD) + (size_t)layer * 5 * 6144;
    const float* g = PAR(layer ? PAR_LN1G1 : PAR_LN1G0);
    const float* bt = PAR(layer ? PAR_LN1B1 : PAR_LN1B0);
    const float* xlat = layer ? p.out : p.x;
    const float* xctx = layer ? WSP(float, WS_CTX) : p.ctx;
    float* sp = (float*)smem;
    for (int i = tidx(); i < 1024; i += 256) {
        sp[i] = g[i]; sp[1024 + i] = bt[i];
#pragma unroll
        for (int v = 0; v < 5; ++v) {
            sp[2048 + v * 1024 + i] = mod[v * 6144 + 2048 + i];
            sp[7168 + v * 1024 + i] = mod[v * 6144 + 4096 + i];
            sp[12288 + v * 1024 + i] = mod[v * 6144 + 3072 + i];
        }
    }
    __syncthreads();
    const int nv = layer ? NB * TT : NTOK;
    if (gwave >= nv) return;
#define LN1_TOK(J) (layer ? ((J) / TT) * SS + LC + ((J) % TT) : (J))
#define LN1_SRC(R_) ((R_) % SS < LC ? xctx + ((size_t)(((R_) / SS) * LC + (R_) % SS)) * DM : xlat + ((size_t)(((R_) / SS) * TT + (R_) % SS - LC)) * DM)
#define LN1_LOAD(XD, YD, R_) { const float* s_ = LN1_SRC(R_); const int l4_ = (tidx() & 63) * 4; \
        _Pragma("unroll") for (int i_ = 0; i_ < 4; ++i_) { const float4 x4_ = *(const float4*)&s_[i_ * 256 + l4_]; const uint2 y_ = *(const uint2*)&yx[(size_t)(R_) * 1024 + i_ * 256 + l4_]; \
            XD[4 * i_] = x4_.x; XD[4 * i_ + 1] = x4_.y; XD[4 * i_ + 2] = x4_.z; XD[4 * i_ + 3] = x4_.w; YD[2 * i_] = y_.x; YD[2 * i_ + 1] = y_.y; } }
    float xa[16]; unsigned ya[8];
    int R = LN1_TOK(gwave);
    LN1_LOAD(xa, ya, R)
    for (int jt = gwave; jt < nv; jt += nwaves) {
        const int b = R / SS, s = R - b * SS;
        float* dst = s < LC ? WSP(float, WS_CTX) + ((size_t)(b * LC + s)) * DM : p.out + ((size_t)(b * TT + s - LC)) * DM;
        const int var = s < LC ? 4 : b;
        const int Rn = LN1_TOK(jt + nwaves < nv ? jt + nwaves : jt);
        float xb[16]; unsigned yb[8];
        LN1_LOAD(xb, yb, Rn)
        float v[16];
#pragma unroll
        for (int i = 0; i < 4; ++i) {
            const int k = i * 256 + lane * 4;
            const float4 g4 = *(const float4*)&sp[2048 + var * 1024 + k];
            v[4 * i] = ALPHA_F * xa[4 * i] + g4.x * bflo(ya[2 * i]);         v[4 * i + 1] = ALPHA_F * xa[4 * i + 1] + g4.y * bfhi(ya[2 * i]);
            v[4 * i + 2] = ALPHA_F * xa[4 * i + 2] + g4.z * bflo(ya[2 * i + 1]); v[4 * i + 3] = ALPHA_F * xa[4 * i + 3] + g4.w * bfhi(ya[2 * i + 1]);
        }
        float sm = 0.f;
#pragma unroll
        for (int i = 0; i < 16; ++i) sm += v[i];
        const float mean = wave_sum(sm) * (1.f / 1024.f);
        float q = 0.f;
#pragma unroll
        for (int i = 0; i < 16; ++i) { const float dl = v[i] - mean; q += dl * dl; }
        const float rs = rsqrtf(wave_sum(q) * (1.f / 1024.f) + 1e-5f);
        bf16_t* hb = WSP(bf16_t, WS_HB) + (size_t)R * 1024;
#pragma unroll
        for (int i = 0; i < 4; ++i) {
            const int k = i * 256 + lane * 4;
            const float4 gg = *(const float4*)&sp[k], bb = *(const float4*)&sp[1024 + k];
            float4 o;
            o.x = (v[4 * i] - mean) * rs * gg.x + bb.x; o.y = (v[4 * i + 1] - mean) * rs * gg.y + bb.y;
            o.z = (v[4 * i + 2] - mean) * rs * gg.z + bb.z; o.w = (v[4 * i + 3] - mean) * rs * gg.w + bb.w;
            *(float4*)&dst[k] = o;
            const float4 sc = *(const float4*)&sp[7168 + var * 1024 + k], sh = *(const float4*)&sp[12288 + var * 1024 + k];
            *(uint2*)&hb[k] = make_uint2(pack2(o.x * (1.f + sc.x) + sh.x, o.y * (1.f + sc.y) + sh.y), pack2(o.z * (1.f + sc.z) + sh.z, o.w * (1.f + sc.w) + sh.w));
        }
        R = Rn;
#pragma unroll
        for (int i = 0; i < 16; ++i) xa[i] = xb[i];
#pragma unroll
        for (int i = 0; i < 8; ++i) ya[i] = yb[i];
    }
#undef LN1_LOAD
#undef LN1_SRC
#undef LN1_TOK
}

__device__ void phase_gemm_q(const W p, unsigned char* smem, int bid, int nblk, int layer);
#define NEG_BIG (-3.0e38f)
#define TOPK_SMEM_BYTES (4 * (2 * 16 * 132) * 4)
__device__ const unsigned char kCandTab[64] = {0, 1, 2, 3, 4, 5, 6, 7, 8, 9, 10, 11, 12, 13, 14, 15, 16, 17, 18, 19, 20, 21, 22, 23, 32, 33, 34, 35, 36, 48, 49, 50, 51, 64, 65, 66, 80, 81, 96, 97, 112, 113, 128, 144, 160, 176, 192, 208, 224, 240, 255, 255, 255, 255, 255, 255, 255, 255, 255, 255, 255, 255, 255, 255};
template <int CTRL> __device__ __forceinline__ unsigned dppu(unsigned x) { return (unsigned)__builtin_amdgcn_mov_dpp((int)x, CTRL, 0xf, 0xf, true); }
__device__ __forceinline__ unsigned umax_(unsigned a, unsigned b) { return a > b ? a : b; }
__device__ __forceinline__ unsigned row16_maxu(unsigned x) {
    x = umax_(x, dppu<DPP_XOR1>(x)); x = umax_(x, dppu<DPP_XOR2>(x)); x = umax_(x, dppu<DPP_ROR4>(x)); x = umax_(x, dppu<DPP_ROR8>(x)); return x;
}
__device__ __forceinline__ unsigned fsort_key(float f) { const unsigned b = __float_as_uint(f); return b ^ ((b >> 31) ? 0xffffffffu : 0x80000000u); }
__device__ void peer_topk_item(const W p, int item, unsigned char* smem, int layer) {
    const int tile = item >> 3, h = item & 7;
    const int tid = tidx(), lane = tid & 63, wave = tid >> 6, l15 = lane & 15, rowbase = lane & 48;
    const int R0 = tile * 64 + wave * 16;
    const bf16_t* Q = WSP(bf16_t, WS_YB);
    const bf16_t* keys = WSP(bf16_t, layer ? WS_KEYS1 : WS_KEYS0);
    float* sc = (float*)smem + wave * (2 * 16 * 132);
    int* idxo = WSP(int, WS_IDX);
    float* gato = WSP(float, WS_GATE);
#pragma unroll
    for (int c = 0; c < 2; ++c) {
        f32x4 acc[8];
#pragma unroll
        for (int nt = 0; nt < 8; ++nt) acc[nt] = (f32x4){0.f, 0.f, 0.f, 0.f};
#pragma unroll
        for (int kk = 0; kk < 2; ++kk) {
            const bf16x8 a = *(const bf16x8*)&Q[(size_t)(R0 + (lane & 15)) * 1024 + h * 128 + c * 64 + kk * 32 + 8 * (lane >> 4)];
#pragma unroll
            for (int nt = 0; nt < 8; ++nt) {
                const bf16x8 bq = *(const bf16x8*)&keys[(size_t)((h * 2 + c) * 128 + nt * 16 + (lane & 15)) * 64 + kk * 32 + 8 * (lane >> 4)];
                acc[nt] = __builtin_amdgcn_mfma_f32_16x16x32_bf16(a, bq, acc[nt], 0, 0, 0);
            }
        }
#pragma unroll
        for (int nt = 0; nt < 8; ++nt)
#pragma unroll
            for (int r = 0; r < 4; ++r) sc[c * (16 * 132) + ((lane >> 4) * 4 + r) * 132 + nt * 16 + (lane & 15)] = acc[nt][r];
    }
#pragma unroll 1
    for (int tg = 0; tg < 4; ++tg) {
        const int t = tg * 4 + (lane >> 4), R = R0 + t;
        const float* s0p = sc + t * 132;
        const float* s1p = sc + 16 * 132 + t * 132;
        unsigned ka[8], kb[8];
#pragma unroll
        for (int m = 0; m < 8; ++m) {
            const int ix = l15 + 16 * m;
            ka[m] = (fsort_key(s0p[ix]) & ~127u) | (unsigned)(127 - ix);
            kb[m] = (fsort_key(s1p[ix]) & ~127u) | (unsigned)(127 - ix);
        }
        unsigned minea = 0u, mineb = 0u;
#pragma unroll 1
        for (int it = 0; it < 16; ++it) {
            const unsigned la = umax_(umax_(umax_(ka[0], ka[1]), umax_(ka[2], ka[3])), umax_(umax_(ka[4], ka[5]), umax_(ka[6], ka[7])));
            const unsigned lb = umax_(umax_(umax_(kb[0], kb[1]), umax_(kb[2], kb[3])), umax_(umax_(kb[4], kb[5]), umax_(kb[6], kb[7])));
            const unsigned ma = row16_maxu(la), mb = row16_maxu(lb);
#pragma unroll
            for (int m = 0; m < 8; ++m) { ka[m] = (ka[m] == ma) ? 0u : ka[m]; kb[m] = (kb[m] == mb) ? 0u : kb[m]; }
            minea = (l15 == it) ? ma : minea; mineb = (l15 == it) ? mb : mineb;
        }
        const int j1 = 127 - (int)(minea & 127u), j2 = 127 - (int)(mineb & 127u);
        const float a1 = s0p[j1], a2 = s1p[j2];
        unsigned k[4];
#pragma unroll
        for (int m = 0; m < 4; ++m) {
            const int slot = l15 + 16 * m;
            const int ij = kCandTab[slot];
            const float v = __shfl(a1, rowbase + ((ij >> 4) & 15)) + __shfl(a2, rowbase + (ij & 15));
            k[m] = (ij == 255) ? 0u : ((fsort_key(v) & ~63u) | (unsigned)(63 - slot));
        }
        unsigned mine = 0u;
#pragma unroll 1
        for (int it = 0; it < 16; ++it) {
            const unsigned lm = umax_(umax_(k[0], k[1]), umax_(k[2], k[3]));
            const unsigned mx = row16_maxu(lm);
#pragma unroll
            for (int m = 0; m < 4; ++m) k[m] = (k[m] == mx) ? 0u : k[m];
            mine = (l15 == it) ? mx : mine;
        }
        const int ij = kCandTab[63 - (int)(mine & 63u)];
        const int i = (ij >> 4) & 15, j = ij & 15;
        const float tv = __shfl(a1, rowbase + i) + __shfl(a2, rowbase + j);
        const int e1 = __shfl(j1, rowbase + i), e2 = __shfl(j2, rowbase + j);
        const float mx = __shfl(tv, rowbase);
        const float ex = __expf(tv - mx);
        const float den = row16_sum(ex);
        idxo[(size_t)R * 128 + h * 16 + l15] = e1 * 128 + e2;
        gato[(size_t)R * 128 + h * 16 + l15] = ex / den;
    }
}

struct EpiTopk {
    const bf16_t* keys; int* idxo; float* gato; int h; int m0; unsigned char* smem;
    __device__ void run128(const float* Cs, int tid) const {
        const int lane = tid & 63, wave = tid >> 6, l15 = lane & 15, rowbase = lane & 48;
        int ijm[4];
#pragma unroll
        for (int m = 0; m < 4; ++m) ijm[m] = kCandTab[l15 + 16 * m];
        bf16x8 qa[2][2][2];
#pragma unroll
        for (int ps = 0; ps < 2; ++ps)
#pragma unroll
            for (int c = 0; c < 2; ++c)
#pragma unroll
                for (int kk = 0; kk < 2; ++kk) {
                    const float* src = &Cs[(ps * 64 + wave * 16 + l15) * CS_LD + c * 64 + kk * 32 + 8 * (lane >> 4)];
                    const float4 f0 = *(const float4*)src, f1 = *(const float4*)(src + 4);
                    union { bf16x8 v; unsigned u[4]; } pk;
                    pk.u[0] = pack2(f0.x, f0.y); pk.u[1] = pack2(f0.z, f0.w); pk.u[2] = pack2(f1.x, f1.y); pk.u[3] = pack2(f1.z, f1.w);
                    qa[ps][c][kk] = pk.v;
                }
        __syncthreads();
        float* sc = (float*)smem + wave * (2 * 16 * 132);
#pragma unroll
        for (int ps = 0; ps < 2; ++ps) {
        const int R0 = m0 + ps * 64 + wave * 16;
#pragma unroll
        for (int c = 0; c < 2; ++c) {
            f32x4 acc[8];
#pragma unroll
            for (int nt = 0; nt < 8; ++nt) acc[nt] = (f32x4){0.f, 0.f, 0.f, 0.f};
            bf16x8 bq[2][8];
#pragma unroll
            for (int kk = 0; kk < 2; ++kk)
#pragma unroll
                for (int nt = 0; nt < 8; ++nt) bq[kk][nt] = *(const bf16x8*)&keys[(size_t)((h * 2 + c) * 128 + nt * 16 + (lane & 15)) * 64 + kk * 32 + 8 * (lane >> 4)];
#pragma unroll
            for (int kk = 0; kk < 2; ++kk) {
                const bf16x8 a = qa[ps][c][kk];
#pragma unroll
                for (int nt = 0; nt < 8; ++nt) acc[nt] = __builtin_amdgcn_mfma_f32_16x16x32_bf16(a, bq[kk][nt], acc[nt], 0, 0, 0);
            }
#pragma unroll
            for (int nt = 0; nt < 8; ++nt)
#pragma unroll
                for (int r = 0; r < 4; ++r) sc[c * (16 * 132) + ((lane >> 4) * 4 + r) * 132 + nt * 16 + (lane & 15)] = acc[nt][r];
        }
#pragma unroll 1
        for (int tg = 0; tg < 4; ++tg) {
            const int t = tg * 4 + (lane >> 4), R = R0 + t;
            const float* s0p = sc + t * 132;
            const float* s1p = sc + 16 * 132 + t * 132;
            unsigned ka[8], kb[8];
#pragma unroll
            for (int m = 0; m < 8; ++m) {
                const int ix = l15 + 16 * m;
                ka[m] = (fsort_key(s0p[ix]) & ~127u) | (unsigned)(127 - ix);
                kb[m] = (fsort_key(s1p[ix]) & ~127u) | (unsigned)(127 - ix);
            }
#define CE_(K, i, j) { const unsigned hi_ = umax_(K[i], K[j]), lo_ = K[i] < K[j] ? K[i] : K[j]; K[i] = hi_; K[j] = lo_; }
#define SORT8_(K) { CE_(K,0,1) CE_(K,2,3) CE_(K,4,5) CE_(K,6,7)  CE_(K,0,2) CE_(K,1,3) CE_(K,4,6) CE_(K,5,7)  CE_(K,1,2) CE_(K,5,6) \
                    CE_(K,0,4) CE_(K,1,5) CE_(K,2,6) CE_(K,3,7)  CE_(K,2,4) CE_(K,3,5)  CE_(K,1,2) CE_(K,3,4) CE_(K,5,6) }
            SORT8_(ka) SORT8_(kb)
            unsigned minea = 0u, mineb = 0u;
#pragma unroll 4
            for (int it = 0; it < 16; ++it) {
                const unsigned ma = row16_maxu(ka[0]), mb = row16_maxu(kb[0]);
                const bool pa = ka[0] == ma, pb = kb[0] == mb;
#pragma unroll
                for (int m = 0; m < 7; ++m) { ka[m] = pa ? ka[m + 1] : ka[m]; kb[m] = pb ? kb[m + 1] : kb[m]; }
                ka[7] = pa ? 0u : ka[7]; kb[7] = pb ? 0u : kb[7];
                minea = (l15 == it) ? ma : minea; mineb = (l15 == it) ? mb : mineb;
            }
#undef SORT8_
            const int j1 = 127 - (int)(minea & 127u), j2 = 127 - (int)(mineb & 127u);
            const float a1 = s0p[j1], a2 = s1p[j2];
            unsigned k[4];
#pragma unroll
            for (int m = 0; m < 4; ++m) {
                const int ij = ijm[m];
                const float v = __shfl(a1, rowbase + ((ij >> 4) & 15)) + __shfl(a2, rowbase + (ij & 15));
                k[m] = (ij == 255) ? 0u : ((fsort_key(v) & ~255u) | (unsigned)ij);
            }
            CE_(k,0,1) CE_(k,2,3) CE_(k,0,2) CE_(k,1,3) CE_(k,1,2)
#undef CE_
            unsigned mine = 0u;
#pragma unroll 4
            for (int it = 0; it < 16; ++it) {
                const unsigned mx = row16_maxu(k[0]);
                const bool pk = k[0] == mx;
                k[0] = pk ? k[1] : k[0]; k[1] = pk ? k[2] : k[1]; k[2] = pk ? k[3] : k[2]; k[3] = pk ? 0u : k[3];
                mine = (l15 == it) ? mx : mine;
            }
            const int i = (int)((mine >> 4) & 15u), j = (int)(mine & 15u);
            const float tv = __shfl(a1, rowbase + i) + __shfl(a2, rowbase + j);
            const int e1 = __shfl(j1, rowbase + i), e2 = __shfl(j2, rowbase + j);
            const float mx = __shfl(tv, rowbase);
            const float ex = __expf(tv - mx);
            const float den = row16_sum(ex);
            idxo[(size_t)R * 128 + h * 16 + l15] = e1 * 128 + e2;
            gato[(size_t)R * 128 + h * 16 + l15] = ex / den;
        }
        }
        __syncthreads();
    }
};

__device__ void phase_gemm_q(const W p, unsigned char* smem, int bid, int nblk, int layer) {
    LdBf16 al{WSP(bf16_t, WS_HB), 1024};
    LdBf16 bl{WSP(bf16_t, layer ? WS_WQ1T : WS_WQ0T), 1024};
    const int total = (NTOK / 128) * 8;
    for (int t = xcd_swz(bid, nblk); t < total; t += nblk) {
        const int m0 = (t >> 3) * 128, n0 = (t & 7) * 128;
        if (layer && (m0 % SS) < LC) continue;
        EpiTopk epi{WSP(bf16_t, layer ? WS_KEYS1 : WS_KEYS0), WSP(int, WS_IDX), WSP(float, WS_GATE), t & 7, m0, smem};
        gemm_tile_dma<2>(al.base, al.ld, bl.base, bl.ld, 1024, m0, n0, epi, smem);
    }
}

using f32x2 = __attribute__((ext_vector_type(2))) float;
using v6u = __attribute__((ext_vector_type(6))) unsigned;
using v32f = __attribute__((ext_vector_type(32))) float;
__device__ __forceinline__ v32f fp6x32_to_f32(const U3& a, const U3& b) {
    v6u s; s[0] = a.x; s[1] = a.y; s[2] = a.z; s[3] = b.x; s[4] = b.y; s[5] = b.z;
    return __builtin_amdgcn_cvt_scalef32_pk32_f32_fp6(s, 1.0f);
}
__device__ __forceinline__ float erf_fast(float x) {
    const float ax = fabsf(x);
    const float t = 1.f / (1.f + 0.3275911f * ax);
    const float poly = t * (0.254829592f + t * (-0.284496736f + t * (1.421413741f + t * (-1.453152027f + t * 1.061405429f))));
    const float r = 1.f - poly * __expf(-ax * ax);
    return copysignf(r, x);
}
constexpr int GD = 8;
struct __attribute__((packed, aligned(4))) U2 { unsigned y, z; };
#define G_ISSUE(J, TAB, IA, IB, E) { \
    const unsigned offa_ = (unsigned)__builtin_amdgcn_readlane(IA, E) * 768u + lane12; \
    const unsigned offb_ = (unsigned)__builtin_amdgcn_readlane(IB, E) * 768u + lane12; \
    unsigned offb4_ = offb_ + 4u; asm volatile("" : "+v"(offb4_)); \
    const U3 q0_ = *(const U3*)((TAB) + offa_); \
    const unsigned q1x_ = *(const unsigned*)((TAB) + offb_); \
    const U2 q1_ = *(const U2*)((TAB) + offb4_); \
    rg[J][0] = q0_.x; rg[J][1] = q0_.y; rg[J][2] = q0_.z; rg[J][3] = q1x_; rg[J][4] = q1_.y; rg[J][5] = q1_.z; }
#define BFLY(OUT, A, B, BIT, CTRL) { const float k_ = (BIT) ? (B) : (A), g_ = (BIT) ? (A) : (B); OUT = k_ + dppf<CTRL>(g_); }
#define G_PIN(J) asm volatile("" : "+v"(rg[J]));
constexpr size_t WS_ACT = WS_ZX;
__device__ __forceinline__ int gather_tok(int layer, int j) { return layer ? (j / TT) * SS + LC + (j % TT) : j; }
__device__ __forceinline__ const float* gather_xrow(const W& p, int R) {
    const int b = R / SS, s = R - b * SS;
    return s < LC ? WSP(float, WS_CTX) + ((size_t)(b * LC + s)) * DM : p.out + ((size_t)(b * TT + s - LC)) * DM;
}
__device__ void phase_peer_act(const W p, int gwave_, int nwaves_, int layer) {
    const int gwave = __builtin_amdgcn_readfirstlane(gwave_), nwaves = __builtin_amdgcn_readfirstlane(nwaves_);
    const int lane = tidx() & 63;
    const float* mod = WSP(float, WS_MOD) + (size_t)layer * 5 * 6144;
    const unsigned char* U = p.ws + (layer ? WS_TABU1 : WS_TABU0);
    const float* su = WSP(float, WS_TABSC) + (layer ? 2 : 0) * 16384;
    const float* sv = su + 16384;
    const int* idxo = WSP(int, WS_IDX);
    const float* gato = WSP(float, WS_GATE);
    float* acto = WSP(float, WS_ACT);
    const int nv = layer ? NB * TT : NTOK;
    if (gwave >= nv) return;
    v6u rg[GD];
    static_assert(GD == 8, "the transpose-reduce below merges 8 steps x 2 lists");
    const bool lb0 = (lane & 1) != 0, lb1 = (lane & 2) != 0, lb2 = (lane & 4) != 0, lb3 = (lane & 8) != 0;
    const unsigned lane12 = (unsigned)lane * 12u;
    int R = gather_tok(layer, gwave);
    int ia = idxo[(size_t)R * 128 + lane], ib = idxo[(size_t)R * 128 + 64 + lane];
#pragma unroll
    for (int j = 0; j < GD; ++j) G_ISSUE(j, U, ia, ib, j)
    int Rn = gather_tok(layer, gwave + nwaves < nv ? gwave + nwaves : gwave);
    int ian = idxo[(size_t)Rn * 128 + lane], ibn = idxo[(size_t)Rn * 128 + 64 + lane];
    float hh[16];
    { const int b = R / SS, s = R - b * SS;
      const float* xrow = gather_xrow(p, R);
      const float* m = mod + (s < LC ? 4 : b) * 6144;
#pragma unroll
      for (int q4 = 0; q4 < 4; ++q4) {
          const int k = lane * 16 + q4 * 4;
          const float4 xv = *(const float4*)&xrow[k], sc = *(const float4*)&m[4096 + k], sh = *(const float4*)&m[3072 + k];
          hh[q4 * 4 + 0] = xv.x * (1.f + sc.x) + sh.x; hh[q4 * 4 + 1] = xv.y * (1.f + sc.y) + sh.y;
          hh[q4 * 4 + 2] = xv.z * (1.f + sc.z) + sh.z; hh[q4 * 4 + 3] = xv.w * (1.f + sc.w) + sh.w;
      } }
    for (int jt = gwave; jt < nv; jt += nwaves) {
        const int j2 = jt + 2 * nwaves < nv ? jt + 2 * nwaves : jt;
        const int R2 = gather_tok(layer, j2);
        const int ln0 = tidx() & 63;
        const int ian2 = idxo[(size_t)R2 * 128 + ln0], ibn2 = idxo[(size_t)R2 * 128 + 64 + ln0];
        const float ga = gato[(size_t)R * 128 + ln0], gb = gato[(size_t)R * 128 + 64 + ln0];
        const float sua = su[ia], sub = su[ib], sva = sv[ia], svb = sv[ib];
        float xn[16], scn[16], shn[16];
        { const int bn = Rn / SS, sn = Rn - bn * SS;
          const float* xrown = gather_xrow(p, Rn);
          const float* mn = mod + (sn < LC ? 4 : bn) * 6144;
          const int lk2 = ln0 * 16;
#pragma unroll
          for (int q4 = 0; q4 < 4; ++q4) {
              const float4 xv = *(const float4*)&xrown[lk2 + q4 * 4], sc = *(const float4*)&mn[4096 + lk2 + q4 * 4], sh = *(const float4*)&mn[3072 + lk2 + q4 * 4];
              xn[q4 * 4] = xv.x; xn[q4 * 4 + 1] = xv.y; xn[q4 * 4 + 2] = xv.z; xn[q4 * 4 + 3] = xv.w;
              scn[q4 * 4] = sc.x; scn[q4 * 4 + 1] = sc.y; scn[q4 * 4 + 2] = sc.z; scn[q4 * 4 + 3] = sc.w;
              shn[q4 * 4] = sh.x; shn[q4 * 4 + 1] = sh.y; shn[q4 * 4 + 2] = sh.z; shn[q4 * 4 + 3] = sh.w;
          } }
        asm volatile("" :: "v"(ian), "v"(ibn));
        float acta = 0.f, actb = 0.f;
#pragma unroll 1
        for (int e0 = 0; e0 < 64; e0 += GD) {
            const bool last = e0 + GD >= 64;
            const int ja = last ? ian : ia, jb = last ? ibn : ib;
            float pr[16];
#pragma unroll
            for (int j = 0; j < GD; ++j) {
                G_PIN(j)
                const v32f uu = __builtin_amdgcn_cvt_scalef32_pk32_f32_fp6(rg[j], 1.0f);
                G_ISSUE(j, U, ja, jb, (e0 + j + GD) & 63)
                f32x2 a0 = {0.f, 0.f}, a1 = {0.f, 0.f};
#pragma unroll
                for (int i = 0; i < 8; ++i) {
                    const f32x2 h2 = {hh[2 * i], hh[2 * i + 1]}, u0 = {uu[2 * i], uu[2 * i + 1]}, u1 = {uu[16 + 2 * i], uu[17 + 2 * i]};
                    a0 = __builtin_elementwise_fma(h2, u0, a0); a1 = __builtin_elementwise_fma(h2, u1, a1);
                }
                pr[j] = a0[0] + a0[1]; pr[8 + j] = a1[0] + a1[1];
                __builtin_amdgcn_sched_barrier(0);
            }
            float q8[8], r4[4], s2[2], tt;
#pragma unroll
            for (int m = 0; m < 8; ++m) BFLY(q8[m], pr[2 * m], pr[2 * m + 1], lb0, DPP_XOR1)
#pragma unroll
            for (int m = 0; m < 4; ++m) BFLY(r4[m], q8[2 * m], q8[2 * m + 1], lb1, DPP_XOR2)
#pragma unroll
            for (int m = 0; m < 2; ++m) BFLY(s2[m], r4[2 * m], r4[2 * m + 1], lb2, DPP_ROR4)
            BFLY(tt, s2[0], s2[1], lb3, DPP_ROR8)
            tt = xrow_sum(tt);
            const float tx = dppf<DPP_ROR8>(tt);
            const bool inr = (lane >> 3) == (e0 >> 3), hi8 = (e0 & 8) != 0;
            acta = inr ? (hi8 ? tx : tt) : acta; actb = inr ? (hi8 ? tt : tx) : actb;
        }
        { const float da = acta * sua, db = actb * sub;
          acta = ga * (0.5f * da * (1.f + erf_fast(da * 0.70710678118654752f))) * sva;
          actb = gb * (0.5f * db * (1.f + erf_fast(db * 0.70710678118654752f))) * svb; }
        { const int ln1 = tidx() & 63;
          acto[(size_t)R * 128 + ln1] = acta; acto[(size_t)R * 128 + 64 + ln1] = actb; }
        R = Rn; Rn = R2; ia = ian; ib = ibn; ian = ian2; ibn = ibn2;
#pragma unroll
        for (int i = 0; i < 16; ++i) hh[i] = xn[i] * (1.f + scn[i]) + shn[i];
    }
}
__device__ void phase_peer_out(const W p, int gwave_, int nwaves_, int layer, unsigned char* smem) {
    const int gwave = __builtin_amdgcn_readfirstlane(gwave_), nwaves = __builtin_amdgcn_readfirstlane(nwaves_);
    const int lane = tidx() & 63;
    const float* mod = WSP(float, WS_MOD) + (size_t)layer * 5 * 6144;
    const unsigned char* V = p.ws + (layer ? WS_TABV1 : WS_TABV0);
    const int* idxo = WSP(int, WS_IDX);
    const float* acto = WSP(float, WS_ACT);
    const float* g = PAR(layer ? PAR_LN2G1 : PAR_LN2G0);
    const float* bt = PAR(layer ? PAR_LN2B1 : PAR_LN2B0);
    float* sp = (float*)smem;
    for (int i = tidx(); i < 1024; i += 256) {
        sp[i] = g[i]; sp[1024 + i] = bt[i];
#pragma unroll
        for (int v = 0; v < 5; ++v) {
            sp[2048 + v * 1024 + i] = mod[v * 6144 + 5120 + i];
            if (layer == 0) { sp[7168 + v * 1024 + i] = mod[(5 + v) * 6144 + 1024 + i]; sp[12288 + v * 1024 + i] = mod[(5 + v) * 6144 + i]; }
        }
    }
    __syncthreads();
    const int nv = layer ? NB * TT : NTOK;
    if (gwave >= nv) return;
    v6u rg[GD];
    const unsigned lane12 = (unsigned)lane * 12u;
    int R = gather_tok(layer, gwave);
    int ia = idxo[(size_t)R * 128 + lane], ib = idxo[(size_t)R * 128 + 64 + lane];
#pragma unroll
    for (int j = 0; j < GD; ++j) G_ISSUE(j, V, ia, ib, j)
    int Rn = gather_tok(layer, gwave + nwaves < nv ? gwave + nwaves : gwave);
    int ian = idxo[(size_t)Rn * 128 + lane], ibn = idxo[(size_t)Rn * 128 + 64 + lane];
    float acta = acto[(size_t)R * 128 + lane], actb = acto[(size_t)R * 128 + 64 + lane];
    float xr[16];
    { const float* xrow = gather_xrow(p, R);
#pragma unroll
      for (int q4 = 0; q4 < 4; ++q4) { const float4 xv = *(const float4*)&xrow[lane * 16 + q4 * 4]; xr[q4 * 4] = xv.x; xr[q4 * 4 + 1] = xv.y; xr[q4 * 4 + 2] = xv.z; xr[q4 * 4 + 3] = xv.w; } }
    for (int jt = gwave; jt < nv; jt += nwaves) {
        const int b = R / SS, s = R - b * SS;
        float* xrow = s < LC ? WSP(float, WS_CTX) + ((size_t)(b * LC + s)) * DM : p.out + ((size_t)(b * TT + s - LC)) * DM;
        const int var = s < LC ? 4 : b;
        const int j2 = jt + 2 * nwaves < nv ? jt + 2 * nwaves : jt;
        const int R2 = gather_tok(layer, j2);
        const int ln0 = tidx() & 63;
        const int ian2 = idxo[(size_t)R2 * 128 + ln0], ibn2 = idxo[(size_t)R2 * 128 + 64 + ln0];
        const float actan = acto[(size_t)Rn * 128 + ln0], actbn = acto[(size_t)Rn * 128 + 64 + ln0];
        f32x2 o2[8]; float xn[16];
#pragma unroll
        for (int i = 0; i < 8; ++i) o2[i] = (f32x2){0.f, 0.f};
        { const float* xrown = gather_xrow(p, Rn);
          const int lk2 = ln0 * 16;
#pragma unroll
          for (int q4 = 0; q4 < 4; ++q4) { const float4 xv = *(const float4*)&xrown[lk2 + q4 * 4]; xn[q4 * 4] = xv.x; xn[q4 * 4 + 1] = xv.y; xn[q4 * 4 + 2] = xv.z; xn[q4 * 4 + 3] = xv.w; } }
        asm volatile("" :: "v"(ian), "v"(ibn), "v"(acta), "v"(actb));
#pragma unroll 1
        for (int e0 = 0; e0 < 64; e0 += GD) {
            const bool last = e0 + GD >= 64;
            const int ja = last ? ian : ia, jb = last ? ibn : ib;
#pragma unroll
            for (int j = 0; j < GD; ++j) {
                G_PIN(j)
                const v32f vv = __builtin_amdgcn_cvt_scalef32_pk32_f32_fp6(rg[j], 1.0f);
                G_ISSUE(j, V, ja, jb, (e0 + j + GD) & 63)
                const float w0 = __builtin_bit_cast(float, __builtin_amdgcn_readlane(__builtin_bit_cast(int, acta), e0 + j));
                const float w1 = __builtin_bit_cast(float, __builtin_amdgcn_readlane(__builtin_bit_cast(int, actb), e0 + j));
                const f32x2 w02 = {w0, w0}, w12 = {w1, w1};
#pragma unroll
                for (int i = 0; i < 8; ++i) {
                    o2[i] = __builtin_elementwise_fma(w02, (f32x2){vv[2 * i], vv[2 * i + 1]}, o2[i]);
                    o2[i] = __builtin_elementwise_fma(w12, (f32x2){vv[16 + 2 * i], vv[17 + 2 * i]}, o2[i]);
                }
                asm volatile("" : "+v"(o2[0]), "+v"(o2[1]), "+v"(o2[2]), "+v"(o2[3]), "+v"(o2[4]), "+v"(o2[5]), "+v"(o2[6]), "+v"(o2[7]));
                __builtin_amdgcn_sched_barrier(0);
            }
        }
        float o[16];
#pragma unroll
        for (int i = 0; i < 8; ++i) { o[2 * i] = o2[i][0]; o[2 * i + 1] = o2[i][1]; }
        float vsum = 0.f;
        const int lk3 = (tidx() & 63) * 16;
#pragma unroll
        for (int q4 = 0; q4 < 4; ++q4) {
            const int k = lk3 + q4 * 4;
            const float4 g2 = *(const float4*)&sp[2048 + var * 1024 + k];
            o[q4 * 4 + 0] = ALPHA_F * xr[q4 * 4 + 0] + g2.x * o[q4 * 4 + 0];
            o[q4 * 4 + 1] = ALPHA_F * xr[q4 * 4 + 1] + g2.y * o[q4 * 4 + 1];
            o[q4 * 4 + 2] = ALPHA_F * xr[q4 * 4 + 2] + g2.z * o[q4 * 4 + 2];
            o[q4 * 4 + 3] = ALPHA_F * xr[q4 * 4 + 3] + g2.w * o[q4 * 4 + 3];
        }
#pragma unroll
        for (int i = 0; i < 16; ++i) vsum += o[i];
        const float mean = wave_sum(vsum) * (1.f / 1024.f);
        float vq2 = 0.f;
#pragma unroll
        for (int i = 0; i < 16; ++i) { const float dl = o[i] - mean; vq2 += dl * dl; }
        const float rs = rsqrtf(wave_sum(vq2) * (1.f / 1024.f) + 1e-5f);
#pragma unroll
        for (int q4 = 0; q4 < 4; ++q4) {
            const int k = lk3 + q4 * 4;
            const float4 gg = *(const float4*)&sp[k], bb = *(const float4*)&sp[1024 + k];
            float4 r;
            r.x = (o[q4 * 4 + 0] - mean) * rs * gg.x + bb.x; r.y = (o[q4 * 4 + 1] - mean) * rs * gg.y + bb.y;
            r.z = (o[q4 * 4 + 2] - mean) * rs * gg.z + bb.z; r.w = (o[q4 * 4 + 3] - mean) * rs * gg.w + bb.w;
            *(float4*)&xrow[k] = r;
            if (layer == 0) {
                const float4 sc = *(const float4*)&sp[7168 + var * 1024 + k], sh = *(const float4*)&sp[12288 + var * 1024 + k];
                *(uint2*)(WSP(bf16_t, WS_HB2) + (size_t)R * 1024 + k) =
                    make_uint2(pack2(r.x * (1.f + sc.x) + sh.x, r.y * (1.f + sc.y) + sh.y), pack2(r.z * (1.f + sc.z) + sh.z, r.w * (1.f + sc.w) + sh.w));
            }
        }
        R = Rn; Rn = R2; ia = ian; ib = ibn; ian = ian2; ibn = ibn2; acta = actan; actb = actbn;
#pragma unroll
        for (int i = 0; i < 16; ++i) xr[i] = xn[i];
    }
}
#undef G_ISSUE
#undef G_PIN
#undef BFLY

constexpr size_t WS_ROPE = WS_END;
static_assert(WS_ROPE + 16384 <= (size_t)536870912, "rope table fits");
__device__ void phase_rope_table(const P& p, size_t gtid, size_t gthreads) {
    float* rt = WSP(float, WS_ROPE);
    for (size_t e = gtid; e < 128 * 16; e += gthreads) {
        const int i = (int)(e & 15), pos = (int)(e >> 4);
        const float freq = powf(10000.f, -(float)i / 16.f);
        const float ang = (float)pos * freq;
        rt[e * 2] = cosf(ang); rt[e * 2 + 1] = sinf(ang);
    }
}
struct EpiZX1 {
    bf16_t* zx; bf16_t* vt; const float* rope; int m0, n0;
    __device__ void operator()(const float* Cs, int pass, int tid) const {
        const int Rb = m0 + pass * 64;
        const int b = Rb / SS, sb = Rb - b * SS;
        const bool isv = (n0 == 640) || (n0 >= 1792);
        if (isv) {
            const int hv0 = (n0 == 640) ? 0 : 2 + (n0 - 1792) / 64;
#pragma unroll
            for (int i = 0; i < 4; ++i) {
                const int c = tid + 256 * i, col = c >> 3, r8 = (c & 7) * 8;
                float v[8];
#pragma unroll
                for (int u = 0; u < 8; ++u) v[u] = Cs[(r8 + u) * CS_LD + col];
                uint4 o; o.x = pack2(v[0], v[1]); o.y = pack2(v[2], v[3]); o.z = pack2(v[4], v[5]); o.w = pack2(v[6], v[7]);
                *(uint4*)&vt[((size_t)(b * 10 + hv0 + (col >> 6)) * 64 + (col & 63)) * SS + sb + r8] = o;
            }
            return;
        }
        const bool dorope = (n0 < 640) && (sb >= LC);
#pragma unroll
        for (int i = 0; i < 4; ++i) {
            const int c = tid + 256 * i, row = c >> 4, col8 = (c & 15) * 8;
            const int R = Rb + row;
            float v[8];
            const float4 a = *(const float4*)&Cs[row * CS_LD + col8], bq = *(const float4*)&Cs[row * CS_LD + col8 + 4];
            v[0] = a.x; v[1] = a.y; v[2] = a.z; v[3] = a.w; v[4] = bq.x; v[5] = bq.y; v[6] = bq.z; v[7] = bq.w;
            if (dorope) {
                const int t = sb + row - LC;
                const int e0 = col8 & 31, half = (col8 >> 5) & 1;
                const int pos = half ? (t & 63) : (t >> 6);
                const bool lo = e0 < 16;
                const int pc = lo ? col8 + 16 : col8 - 16;
                const float4 pa = *(const float4*)&Cs[row * CS_LD + pc], pb = *(const float4*)&Cs[row * CS_LD + pc + 4];
                const float pv[8] = {pa.x, pa.y, pa.z, pa.w, pb.x, pb.y, pb.z, pb.w};
#pragma unroll
                for (int u = 0; u < 8; ++u) {
                    const int fi = (e0 & 15) + u;
                    const float cs = rope[(pos * 16 + fi) * 2], sn = rope[(pos * 16 + fi) * 2 + 1];
                    v[u] = lo ? (v[u] * cs - pv[u] * sn) : (v[u] * cs + pv[u] * sn);
                }
            }
            uint4 o; o.x = pack2(v[0], v[1]); o.y = pack2(v[2], v[3]); o.z = pack2(v[4], v[5]); o.w = pack2(v[6], v[7]);
            *(uint4*)&zx[(size_t)R * ZW1 + n0 + col8] = o;
        }
    }
};
__device__ void phase_gemm_win1(const W p, unsigned char* smem, int bid, int nblk) {
    LdBf16 al{WSP(bf16_t, WS_HB2), 1024};
    LdBf16 bl{WSP(bf16_t, WS_WIN1T), 1024};
    const int ntn = ZW1 / 128, total = (NTOK / 128) * ntn;
    for (int t = xcd_swz(bid, nblk); t < total; t += nblk) {
        const int m0 = (t / ntn) * 128, n0 = (t % ntn) * 128;
        EpiZX1 epi{WSP(bf16_t, WS_ZX), WSP(bf16_t, WS_VT), WSP(float, WS_ROPE), m0, n0};
        gemm_tile_dma(al.base, al.ld, bl.base, bl.ld, 1024, m0, n0, epi, smem);
    }
}

#define AT_LD 72
#define ATTN_SMEM_BYTES (2 * 64 * AT_LD * 2)
#define MASK_NEG (-1.0e30f)
template <int kind>
__device__ void attn_item(const W p, int item, unsigned char* smem) {
    const int qt = item & 63, hq = (item >> 6) & 7, b = (item >> 9) & 3;
    const int tid = tidx(), lane = tid & 63, wave = tid >> 6, hh = lane >> 5, ql = lane & 31;
    bf16_t* Ks = (bf16_t*)smem;
    bf16_t* Vs = Ks + 64 * AT_LD;
    const bf16_t* zx = WSP(bf16_t, WS_ZX);
    const int t0 = qt * 128;
    const int qcol = kind ? 768 + hq * 64 : hq * 64;
    const int kcol = kind ? 1280 + hq * 64 : 512 + (hq >> 2) * 64;
    const bf16_t* vt = WSP(bf16_t, WS_VT) + ((size_t)(b * 10 + (kind ? 2 + hq : (hq >> 2))) * 64) * SS;
    const int ocol = kind ? 512 + hq * 64 : hq * 64;
    const int tq = t0 + wave * 32 + ql, tq0w = t0 + wave * 32;
    const size_t Rq = (size_t)b * SS + LC + tq;
    bf16x8 qf[4];
#pragma unroll
    for (int st = 0; st < 4; ++st) qf[st] = *(const bf16x8*)&zx[Rq * ZW1 + qcol + st * 16 + 8 * hh];
    int lk0, lk1;
    const int r0 = t0 >> 6;
    if (kind == 0) { lk0 = t0 - 128 < 0 ? 0 : t0 - 128; lk1 = t0 + 256 > TT ? TT : t0 + 256; }
    else {
        int rs0 = r0 - 4; rs0 = rs0 < 0 ? 0 : (rs0 > 120 ? 120 : rs0);
        int rs1 = r0 + 1 - 4; rs1 = rs1 < 0 ? 0 : (rs1 > 120 ? 120 : rs1);
        lk0 = rs0 * 64; lk1 = (rs1 + 8) * 64;
    }
    const int nloc = (lk1 - lk0) >> 6;
    const int rq = tq >> 6, cq = tq & 63;
    int rsq = rq - 4; rsq = rsq < 0 ? 0 : (rsq > 120 ? 120 : rsq);
    int csq = cq - 8; csq = csq < 0 ? 0 : (csq > 48 ? 48 : csq);
    const float* rpb = PAR(PAR_RPB) + (size_t)hq * 15 * 31;
    float m = MASK_NEG, l = 0.f;
    f32x16 oacc[2];
#pragma unroll
    for (int r = 0; r < 16; ++r) { oacc[0][r] = 0.f; oacc[1][r] = 0.f; }
    const int prr = tid >> 3, pc8 = (tid & 7) * 8;
    u32x4v pk0, pk1, pv0, pv1;
    pk0 = *(const u32x4v*)&zx[((size_t)b * SS + prr) * ZW1 + kcol + pc8];        pk1 = *(const u32x4v*)&zx[((size_t)b * SS + 32 + prr) * ZW1 + kcol + pc8];
    pv0 = *(const u32x4v*)&vt[(size_t)prr * SS + pc8];                           pv1 = *(const u32x4v*)&vt[(size_t)(32 + prr) * SS + pc8];
    for (int ti = 0; ti < 4 + nloc; ++ti) {
        const bool isctx = ti < 4;
        const int sbase = isctx ? ti * 64 : LC + lk0 + (ti - 4) * 64;
        __syncthreads();
        *(u32x4v*)&Ks[prr * AT_LD + pc8] = pk0; *(u32x4v*)&Ks[(32 + prr) * AT_LD + pc8] = pk1;
        *(u32x4v*)&Vs[prr * AT_LD + pc8] = pv0; *(u32x4v*)&Vs[(32 + prr) * AT_LD + pc8] = pv1;
        __syncthreads();
        if (ti + 1 < 4 + nloc) {
            const int sbn = (ti + 1 < 4) ? (ti + 1) * 64 : LC + lk0 + (ti + 1 - 4) * 64;
            pk0 = *(const u32x4v*)&zx[((size_t)b * SS + sbn + prr) * ZW1 + kcol + pc8];  pk1 = *(const u32x4v*)&zx[((size_t)b * SS + sbn + 32 + prr) * ZW1 + kcol + pc8];
            pv0 = *(const u32x4v*)&vt[(size_t)prr * SS + sbn + pc8];                     pv1 = *(const u32x4v*)&vt[(size_t)(32 + prr) * SS + sbn + pc8];
        }
        const int tk0 = sbase - LC;
        const int kr = tk0 >> 6;
        if (!isctx && kind == 1) {
            const int rqw = (t0 + wave * 32) >> 6;
            int rsw = rqw - 4; rsw = rsw < 0 ? 0 : (rsw > 120 ? 120 : rsw);
            if (kr < rsw || kr >= rsw + 8) continue;
        }
#pragma unroll
        for (int sub = 0; sub < 2; ++sub) {
            f32x16 sacc;
#pragma unroll
            for (int r = 0; r < 16; ++r) sacc[r] = 0.f;
#pragma unroll
            for (int st = 0; st < 4; ++st) {
                const bf16x8 kf = *(const bf16x8*)&Ks[(sub * 32 + ql) * AT_LD + st * 16 + 8 * hh];
                sacc = __builtin_amdgcn_mfma_f32_32x32x16_bf16(kf, qf[st], sacc, 0, 0, 0);
            }
            float sv[16], smax = MASK_NEG;
            const bool needmask = !isctx && (kind == 1 || (tk0 + 63 - tq0w > 128) || (tk0 - (tq0w + 31) < -128));
            if (kind == 1 && needmask) {
                const float* rb = rpb + (kr - rq + 7) * 31 + (15 - cq);
                float bias[16];
#pragma unroll
                for (int r = 0; r < 16; ++r) {
                    const int key = sub * 32 + (r & 3) + 8 * (r >> 2) + 4 * hh;
                    const bool valid = (unsigned)(key - csq) < 16u;
                    bias[r] = rb[valid ? key : csq];
                }
#pragma unroll
                for (int r = 0; r < 16; ++r) {
                    const int key = sub * 32 + (r & 3) + 8 * (r >> 2) + 4 * hh;
                    const bool valid = (unsigned)(key - csq) < 16u;
                    const float x = valid ? sacc[r] * 0.18033688011f + 1.44269504089f * bias[r] : MASK_NEG;
                    sv[r] = x; smax = fmaxf(smax, x);
                }
            } else {
#pragma unroll
                for (int r = 0; r < 16; ++r) {
                    const int key = sub * 32 + (r & 3) + 8 * (r >> 2) + 4 * hh;
                    float x = sacc[r] * 0.18033688011f;
                    if (kind == 0 && needmask) { const int dlt = tk0 + key - tq; if (dlt > 128 || dlt < -128) x = MASK_NEG; }
                    sv[r] = x; smax = fmaxf(smax, x);
                }
            }
            smax = half_swap_max(smax);
            const float mn = fmaxf(m, smax);
            if (__builtin_amdgcn_ballot_w64(mn > m)) {
                const float alpha = __builtin_amdgcn_exp2f(m - mn);
                l *= alpha;
#pragma unroll
                for (int r = 0; r < 16; ++r) { oacc[0][r] *= alpha; oacc[1][r] *= alpha; }
                m = mn;
            }
            float ps = 0.f;
#pragma unroll
            for (int r = 0; r < 16; ++r) { sv[r] = __builtin_amdgcn_exp2f(sv[r] - m); ps += sv[r]; }
            l += ps;
#pragma unroll
            for (int s2 = 0; s2 < 2; ++s2) {
                union { bf16x8 v; unsigned u[4]; } pb;
#pragma unroll
                for (int u = 0; u < 4; ++u) pb.u[u] = pack2(sv[8 * s2 + 2 * u], sv[8 * s2 + 2 * u + 1]);
#pragma unroll
                for (int db = 0; db < 2; ++db) {
                    union { bf16x8 v; uint2 h[2]; } vf;
                    const bf16_t* vrow = &Vs[(db * 32 + ql) * AT_LD + sub * 32 + 16 * s2 + 4 * hh];
                    vf.h[0] = *(const uint2*)vrow;
                    vf.h[1] = *(const uint2*)(vrow + 8);
                    oacc[db] = __builtin_amdgcn_mfma_f32_32x32x16_bf16(vf.v, pb.v, oacc[db], 0, 0, 0);
                }
            }
        }
    }
    float lt = half_swap_sum(l);
    if (kind == 0) lt += __builtin_amdgcn_exp2f(1.44269504089f * PAR(PAR_SINK)[hq] - m);
    const float inv = 1.f / lt;
    bf16_t* mix = WSP(bf16_t, WS_MIX);
#pragma unroll
    for (int db = 0; db < 2; ++db)
#pragma unroll
        for (int g4 = 0; g4 < 4; ++g4) {
            const int dd = db * 32 + 8 * g4 + 4 * hh;
            uint2 o; o.x = pack2(oacc[db][4 * g4] * inv, oacc[db][4 * g4 + 1] * inv); o.y = pack2(oacc[db][4 * g4 + 2] * inv, oacc[db][4 * g4 + 3] * inv);
            *(uint2*)&mix[Rq * 1024 + ocol + dd] = o;
        }
}


enum { PH_TRANSPOSE = 0, PH_CONVERT, PH_MODP, PH_MISC, PH_S5TAB, PH_WIN0, PH_S5E, PH_S5CARRY, PH_S5Y, PH_RWKV, PH_GLU, PH_RWKVOUT,
       PH_WOUT, PH_LN1, PH_QGEMM, PH_TOPK, PH_GATHER, PH_GATHERB, PH_WIN1, PH_ATTN, PH_RWPREP, PH_COUNT };
template <int PH> struct PhaseSmem { static constexpr int bytes = 1024; };
template <> struct PhaseSmem<PH_TRANSPOSE> { static constexpr int bytes = 64 * 65 * 4; };
template <> struct PhaseSmem<PH_WIN0>    { static constexpr int bytes = GEMM_SMEM_BYTES; };
template <> struct PhaseSmem<PH_S5E>     { static constexpr int bytes = GEMM_SMEM_BYTES; };
template <> struct PhaseSmem<PH_S5Y>     { static constexpr int bytes = GEMM_SMEM_BYTES; };
template <> struct PhaseSmem<PH_RWKV>    { static constexpr int bytes = (int)sizeof(RwkvSmem); };
template <> struct PhaseSmem<PH_GLU>     { static constexpr int bytes = GEMM_SMEM_BYTES; };
template <> struct PhaseSmem<PH_RWKVOUT> { static constexpr int bytes = GEMM_SMEM_BYTES; };
template <> struct PhaseSmem<PH_WOUT>    { static constexpr int bytes = GEMM_SMEM_BYTES; };
template <> struct PhaseSmem<PH_QGEMM>   { static constexpr int bytes = GEMM_SMEM_BYTES; };
template <> struct PhaseSmem<PH_TOPK>    { static constexpr int bytes = TOPK_SMEM_BYTES; };
template <> struct PhaseSmem<PH_WIN1>    { static constexpr int bytes = GEMM_SMEM_BYTES; };
template <> struct PhaseSmem<PH_ATTN>    { static constexpr int bytes = ATTN_SMEM_BYTES; };

template <int PH>
__device__ __forceinline__ void run_early(const P& p, unsigned char* smem) {
    const int bid = bidx(), nblk = gridDim.x;
    const size_t gtid = (size_t)bid * 256 + tidx(), gthreads = (size_t)nblk * 256;
    const int gwave = bid * 4 + (tidx() >> 6), nwaves = nblk * 4;
    if constexpr (PH == PH_TRANSPOSE) phase_transpose(p, (float*)smem, bid, nblk);
    else if constexpr (PH == PH_CONVERT) phase_convert(p, gtid, gthreads);
    else if constexpr (PH == PH_MODP) phase_mod_partial(p, gwave, nwaves);
    else if constexpr (PH == PH_MISC) { phase_s5_pow(p, gtid, gthreads); phase_rope_table(p, gtid, gthreads); phase_pack_params(p, gtid, gthreads); }
    else if constexpr (PH == PH_S5TAB) { phase_mod_reduce(p, gtid, gthreads); phase_s5_tables(p, gtid, gthreads); }
}
template <int PH>
__device__ __forceinline__ void run_phase(const W p, int layer, unsigned char* smem) {
    const int bid = bidx(), nblk = gridDim.x;
    const size_t gtid = (size_t)bid * 256 + tidx(), gthreads = (size_t)nblk * 256;
    const int gwave = bid * 4 + (tidx() >> 6), nwaves = nblk * 4;
    if constexpr (PH == PH_WIN0) phase_gemm_win0(p, smem, bid, nblk);
    else if constexpr (PH == PH_RWPREP) { phase_rw_shift(p, gwave, nwaves); phase_rw_lora(p, smem, bid, nblk); }
    else if constexpr (PH == PH_S5E) phase_s5_E(p, smem, (bid + nblk - 8448 % nblk) % nblk, nblk);
    else if constexpr (PH == PH_S5CARRY) phase_s5_carry(p, gtid, gthreads);
    else if constexpr (PH == PH_S5Y) phase_s5_Y(p, smem, bid, nblk);
    else if constexpr (PH == PH_RWKV) { for (int it = bid; it < 256; it += nblk) rwkv_scan_item(p, it, smem); }
    else if constexpr (PH == PH_GLU) phase_glu(p, smem, bid, nblk);
    else if constexpr (PH == PH_RWKVOUT) phase_rwkv_out(p, smem, bid, nblk);
    else if constexpr (PH == PH_WOUT) phase_gemm_wout(p, smem, bid, nblk, layer);
    else if constexpr (PH == PH_LN1) phase_ln1(p, gwave, nwaves, layer, smem);
    else if constexpr (PH == PH_QGEMM) phase_gemm_q(p, smem, bid, nblk, layer);
    else if constexpr (PH == PH_TOPK) {
        for (int it = bid; it < (NTOK / 64) * 8; it += nblk) { if (layer && ((it >> 3) * 64) % SS < LC) continue; peer_topk_item(p, it, smem, layer); }
    }
    else if constexpr (PH == PH_GATHER) phase_peer_act(p, gwave, nwaves, layer);
    else if constexpr (PH == PH_GATHERB) phase_peer_out(p, gwave, nwaves, layer, smem);
    else if constexpr (PH == PH_WIN1) phase_gemm_win1(p, smem, bid, nblk);
    else if constexpr (PH == PH_ATTN) { for (int it = bid; it < 2048; it += nblk) attn_item<1>(p, it, smem); for (int it = bid; it < 2048; it += nblk) attn_item<0>(p, it, smem); }
}

namespace cg = cooperative_groups;
constexpr int cmax(int a, int b) { return a > b ? a : b; }
constexpr int MEGA_SMEM = cmax(cmax(GEMM_SMEM_BYTES, RW1_SMEM_BYTES), cmax(TOPK_SMEM_BYTES, ATTN_SMEM_BYTES));
static_assert(MEGA_SMEM >= 17408 * 4, "gather epilogue vectors fit in LDS");
static_assert(MEGA_SMEM >= 128 * CS_LD * 4, "128-row C staging fits");

#define DIAG 0
#define DIAG_A0 13
#define DIAG_A1 14
#if DIAG
#define STAMP(k) do { if (bidx() == 0 && tidx() == 0) ((volatile unsigned long long*)(p.ws + WS_TS))[k] = __builtin_amdgcn_s_memrealtime(); } while (0)
#define DIAG_TAIL() do { GSYNC(); STAMP(63); GSYNC(); \
    const volatile unsigned long long* ts = (const volatile unsigned long long*)(p.ws + WS_TS); \
    const float ra = (float)(ts[DIAG_A1] - ts[DIAG_A0]) * (1.f / 500000.f);     \
    const float sc = 1.f + sqrtf(0.04f * ra); \
    for (size_t i = (size_t)bidx() * 256 + tidx(); i < (size_t)NB * TT * DM; i += (size_t)gridDim.x * 256) p.out[i] *= sc; } while (0)
#else
#define STAMP(k)
#define DIAG_TAIL()
#endif
#define GSYNC() xcd_barrier(xb)

__device__ __forceinline__ void phase_scan_and_side(const P& p, const W w, unsigned char* smem, volatile LAS unsigned* bc) {
    unsigned* ctl = (unsigned*)(p.ws + WS_CTL);
    if (bidx() < 64) rw2_chain(w, bidx(), smem);
    STAMP(20);
    for (;;) { const int t = take_ticket(&ctl[CT_S5YT], bc); if (t >= 640) break; phase_s5_Y(w, smem, t, 1 << 30); }
}

__global__ void __launch_bounds__(256, 2) mega_kernel(P p) {
    __shared__ __attribute__((aligned(16))) unsigned char smem[MEGA_SMEM + 64];
    cg::grid_group grid = cg::this_grid();
    volatile LAS unsigned* st = (volatile LAS unsigned*)(smem + MEGA_SMEM);
    if (tidx() < 4) st[tidx()] = 0u;
    __syncthreads();
    XcdBarrier xb = xcd_barrier_post((unsigned*)(p.ws + WS_CTL), st);
    volatile LAS unsigned* bc = st + 2;
    STAMP(0);
    run_early<PH_TRANSPOSE>(p, smem); STAMP(21);
    run_early<PH_MODP>(p, smem); STAMP(22);
    run_early<PH_MISC>(p, smem);
    GSYNC(); STAMP(1);
    run_early<PH_S5TAB>(p, smem);
    GSYNC(); STAMP(2);
    const W w{p.in[I_X], p.in[I_CTX], p.out, p.ws};
    phase_xcvt(w, smem);
    GSYNC();
    run_phase<PH_WIN0>(w, 0, smem);
    GSYNC(); STAMP(3);
    run_phase<PH_S5E>(w, 0, smem);
    for (int it = bidx(); it < 8448; it += gridDim.x) rw1_item(w, it, smem);
    { unsigned* ctl = (unsigned*)(p.ws + WS_CTL);
      wait_count(ctl, CT_S5ED, 160u);
      for (;;) { const int t = take_ticket(&ctl[CT_CARRYT], bc); if (t >= 32) break; phase_s5_carry(w, (size_t)t * 256 + tidx(), (size_t)1 << 40); } }
    GSYNC(); STAMP(4);
    phase_scan_and_side(p, w, smem, bc);
    GSYNC(); STAMP(5);
    run_phase<PH_GLU>(w, 0, smem);
    run_phase<PH_RWKVOUT>(w, 0, smem);
    run_early<PH_CONVERT>(p, smem);
    GSYNC(); STAMP(7);
    run_phase<PH_WOUT>(w, 0, smem);   GSYNC(); STAMP(8);
    run_phase<PH_LN1>(w, 0, smem);    GSYNC(); STAMP(9);
    run_phase<PH_QGEMM>(w, 0, smem);  GSYNC(); STAMP(10);
    STAMP(11);
    run_phase<PH_GATHER>(w, 0, smem); GSYNC(); run_phase<PH_GATHERB>(w, 0, smem); GSYNC(); STAMP(12);
    run_phase<PH_WIN1>(w, 1, smem);   GSYNC(); STAMP(13);
    run_phase<PH_ATTN>(w, 1, smem);   GSYNC(); STAMP(14);
    run_phase<PH_WOUT>(w, 1, smem);   GSYNC(); STAMP(15);
    run_phase<PH_LN1>(w, 1, smem);    GSYNC(); STAMP(16);
    run_phase<PH_QGEMM>(w, 1, smem);  GSYNC(); STAMP(17);
    STAMP(18);
    run_phase<PH_GATHER>(w, 1, smem); GSYNC(); run_phase<PH_GATHERB>(w, 1, smem);
    DIAG_TAIL();
    grid.sync();
}

extern "C" void kernel_launch(void* const* d_in, const int* in_sizes, int n_in, void* d_out, int out_size, void* d_ws, size_t ws_size,
                              hipStream_t stream) {
    (void)in_sizes; (void)n_in; (void)out_size; (void)ws_size;
    static int grid_blocks = 0;
    if (!grid_blocks) {
        int dev = 0, cus = 0, per_cu = 0;
        hipGetDevice(&dev);
        hipDeviceGetAttribute(&cus, hipDeviceAttributeMultiprocessorCount, dev);
        hipOccupancyMaxActiveBlocksPerMultiprocessor(&per_cu, mega_kernel, 256, 0);
        if (per_cu > 2) per_cu = 2;
        if (per_cu < 1) per_cu = 1;
        grid_blocks = cus * per_cu;
    }
    P p{};
    for (int i = 0; i < 51; ++i) p.in[i] = (const float*)d_in[i];
    p.out = (float*)d_out; p.ws = (unsigned char*)d_ws;
    hipMemsetAsync((unsigned char*)d_ws + WS_CTL, 0, CTL_WORDS * 4, stream);
    void* args[] = {&p};
    hipError_t e = hipLaunchCooperativeKernel((void*)mega_kernel, dim3(grid_blocks), dim3(256), args, 0, stream);
    if (e != hipSuccess) fprintf(stderr, "cooperative launch failed: %s (grid %d)\n", hipGetErrorString(e), grid_blocks);
}
```

```cpp
#include <hip/hip_runtime.h>
#include <hip/hip_cooperative_groups.h>
#include <stdint.h>
#include <stdio.h>
#define DIAGX 0

#define DM      1024
#define NB      4
#define TT      8192
#define LC      256
#define SS      8448
#define NTOK    33792
#define ZW0     2176
#define ZW1     2304
#define ALPHA_F 1.41421356237f
#define NCH     132

typedef unsigned short bf16_t;
using bf16x8 = __attribute__((ext_vector_type(8))) short;
using f32x16 = __attribute__((ext_vector_type(16))) float;
using f32x4  = __attribute__((ext_vector_type(4))) float;
using bf16x2v = __attribute__((ext_vector_type(2))) __bf16;
using u32x4v = __attribute__((ext_vector_type(4))) unsigned;


__device__ __forceinline__ int tidx() { int t = (int)threadIdx.x; asm volatile("" : "+v"(t)); return t; }
__device__ __forceinline__ int bidx() { int t = (int)blockIdx.x; asm volatile("" : "+s"(t)); return t; }
typedef __bf16 hwbf16x2_t __attribute__((ext_vector_type(2)));
typedef float hwf32x2_t __attribute__((ext_vector_type(2)));
__device__ __forceinline__ bf16_t f2bf(float f) { return (bf16_t)__builtin_bit_cast(unsigned short, (__bf16)f); }
__device__ __forceinline__ float bf2f(bf16_t h) { return __uint_as_float(((unsigned)h) << 16); }
__device__ __forceinline__ unsigned pack2(float lo, float hi) { const hwf32x2_t f = {lo, hi}; return __builtin_bit_cast(unsigned, __builtin_convertvector(f, hwbf16x2_t)); }
__device__ __forceinline__ float bflo(unsigned u) { return __uint_as_float(u << 16); }
__device__ __forceinline__ float bfhi(unsigned u) { return __uint_as_float(u & 0xffff0000u); }
__device__ __forceinline__ float sigmoidf_(float x) { return 1.f / (1.f + __expf(-x)); }
__device__ __forceinline__ float siluf_(float x) { return x / (1.f + __expf(-x)); }
__device__ __forceinline__ float geluf_(float x) { return 0.5f * x * (1.f + erff(x * 0.70710678118654752f)); }

template <int CTRL> __device__ __forceinline__ float dppf(float x) {
    return __builtin_bit_cast(float, __builtin_amdgcn_mov_dpp(__builtin_bit_cast(int, x), CTRL, 0xf, 0xf, true));
}
#define DPP_XOR1 0xB1
#define DPP_XOR2 0x4E
#define DPP_ROR4 0x124
#define DPP_ROR8 0x128
__device__ __forceinline__ float row16_sum(float x) {
    x += dppf<DPP_XOR1>(x); x += dppf<DPP_XOR2>(x); x += dppf<DPP_ROR4>(x); x += dppf<DPP_ROR8>(x); return x;
}
__device__ __forceinline__ float row16_max(float x) {
    x = fmaxf(x, dppf<DPP_XOR1>(x)); x = fmaxf(x, dppf<DPP_XOR2>(x)); x = fmaxf(x, dppf<DPP_ROR4>(x)); x = fmaxf(x, dppf<DPP_ROR8>(x)); return x;
}
__device__ __forceinline__ float xrow_sum(float x) {
    auto s = __builtin_amdgcn_permlane16_swap(__float_as_uint(x), __float_as_uint(x), false, false);
    x = __uint_as_float(s[0]) + __uint_as_float(s[1]);
    auto t = __builtin_amdgcn_permlane32_swap(__float_as_uint(x), __float_as_uint(x), false, false);
    return __uint_as_float(t[0]) + __uint_as_float(t[1]);
}
__device__ __forceinline__ float xrow_max(float x) {
    auto s = __builtin_amdgcn_permlane16_swap(__float_as_uint(x), __float_as_uint(x), false, false);
    x = fmaxf(__uint_as_float(s[0]), __uint_as_float(s[1]));
    auto t = __builtin_amdgcn_permlane32_swap(__float_as_uint(x), __float_as_uint(x), false, false);
    return fmaxf(__uint_as_float(t[0]), __uint_as_float(t[1]));
}
__device__ __forceinline__ float wave_sum(float x) { return xrow_sum(row16_sum(x)); }
__device__ __forceinline__ float wave_max(float x) { return xrow_max(row16_max(x)); }
__device__ __forceinline__ float half_swap_sum(float x) {
    auto t = __builtin_amdgcn_permlane32_swap(__float_as_uint(x), __float_as_uint(x), false, false);
    return __uint_as_float(t[0]) + __uint_as_float(t[1]);
}
__device__ __forceinline__ float half_swap_max(float x) {
    auto t = __builtin_amdgcn_permlane32_swap(__float_as_uint(x), __float_as_uint(x), false, false);
    return fmaxf(__uint_as_float(t[0]), __uint_as_float(t[1]));
}

constexpr size_t al256(size_t x) { return (x + 255) & ~(size_t)255; }
constexpr size_t WS_WIN0T  = 0;
constexpr size_t WS_WOUT0T = WS_WIN0T  + al256((size_t)ZW0 * 1024 * 2);
constexpr size_t WS_WQ0T   = WS_WOUT0T + al256((size_t)1024 * 768 * 2);
constexpr size_t WS_KEYS0  = WS_WQ0T   + al256((size_t)1024 * 1024 * 2);
constexpr size_t WS_WIN1T  = WS_KEYS0  + al256((size_t)2048 * 64 * 2);
constexpr size_t WS_WOUT1T = WS_WIN1T  + al256((size_t)ZW1 * 1024 * 2);
constexpr size_t WS_WQ1T   = WS_WOUT1T + al256((size_t)1024 * 1024 * 2);
constexpr size_t WS_KEYS1  = WS_WQ1T   + al256((size_t)1024 * 1024 * 2);
constexpr size_t WS_WGLUT  = WS_KEYS1  + al256((size_t)2048 * 64 * 2);
constexpr size_t WS_W2T    = WS_WGLUT  + al256((size_t)256 * 256 * 2);
constexpr size_t WS_A2T    = WS_W2T    + al256((size_t)2 * 512 * 64 * 2);
constexpr size_t WS_G2T    = WS_A2T    + al256((size_t)2 * 512 * 64 * 2);
constexpr size_t WS_S5POW  = WS_G2T    + al256((size_t)512 * 128 * 2);
constexpr size_t WS_S5K    = WS_S5POW  + al256((size_t)2 * 16 * 64 * 65 * 2 * 4);
constexpr size_t WS_S5W    = WS_S5K    + al256((size_t)2 * 16 * 64 * 256 * 2);
constexpr size_t WS_S5V    = WS_S5W    + al256((size_t)2 * 16 * 128 * 1024 * 2);
constexpr size_t WS_MODP   = WS_S5V    + al256((size_t)2 * 16 * 1024 * 128 * 2);
constexpr size_t WS_MOD    = WS_MODP   + al256((size_t)8 * 2 * 5 * 6144 * 4);
constexpr size_t WS_TABU0  = WS_MOD    + al256((size_t)2 * 5 * 6144 * 4);
constexpr size_t WS_TABV0  = WS_TABU0  + (size_t)16384 * 1024;
constexpr size_t WS_TABU1  = WS_TABV0  + (size_t)16384 * 1024;
constexpr size_t WS_TABV1  = WS_TABU1  + (size_t)16384 * 1024;
constexpr size_t WS_TABSC  = WS_TABV1  + (size_t)16384 * 1024;
constexpr size_t WS_ZX     = WS_TABU0  + (size_t)4 * 16384 * 1024 * 2;
constexpr size_t WS_CTX    = WS_ZX     + al256((size_t)NTOK * ZW1 * 2);
constexpr size_t WS_US5    = WS_CTX    + al256((size_t)1024 * 1024 * 4);
constexpr size_t WS_S5E    = WS_US5    + al256((size_t)16 * NTOK * 16 * 2);
constexpr size_t WS_S5H    = WS_S5E    + al256((size_t)2 * 16 * 528 * 128 * 4);
constexpr size_t WS_YA     = WS_S5H    + al256((size_t)2 * 16 * 528 * 128 * 2);
constexpr size_t WS_YB     = WS_YA     + al256((size_t)NTOK * 256 * 2);
constexpr size_t WS_BON    = WS_YB     + al256((size_t)2 * NTOK * 512 * 2);
constexpr size_t WS_MIX    = WS_BON    + al256((size_t)NTOK * 16 * 4);
constexpr size_t WS_END    = WS_MIX    + al256((size_t)NTOK * 1024 * 2);
constexpr size_t WS_VT     = WS_TABSC + (size_t)4 * 16384 * 4;
static_assert(WS_VT + (size_t)4 * 10 * 64 * SS * 2 <= WS_ZX, "VT fits behind the fp8 tables");
constexpr size_t WS_HB     = WS_MIX;
constexpr size_t WS_HB2    = WS_YB;
constexpr int PAR_SHIFT = 0, PAR_A0 = 3840, PAR_W0 = 4864, PAR_KK = 5888, PAR_KA = 6400, PAR_RK = 6912, PAR_BGLU = 7424, PAR_GNW = 7680, PAR_GNB = 8192,
              PAR_LN1G0 = 8704, PAR_LN1B0 = 9728, PAR_LN2G0 = 10752, PAR_LN2B0 = 11776, PAR_LN1G1 = 12800, PAR_LN1B1 = 13824, PAR_LN2G1 = 14848, PAR_LN2B1 = 15872,
              PAR_RPB = 16896, PAR_SINK = 20736, PAR_TOTAL = 20800;
constexpr size_t WS_PAR    = WS_END + 16384;
static_assert(WS_PAR + (size_t)PAR_TOTAL * 4 <= (size_t)536870912, "param pack fits");
constexpr size_t WS_TS     = WS_PAR + (size_t)PAR_TOTAL * 4 + 256;
static_assert(WS_TS + 512 <= (size_t)536870912, "ts fits");
constexpr size_t WS_RWR    = WS_TABU0;
constexpr size_t WS_RWK    = WS_RWR + (size_t)NTOK * 512 * 2;
constexpr size_t WS_RWAS   = WS_RWK + (size_t)NTOK * 512 * 2;
constexpr size_t WS_RWNRM  = WS_RWAS + (size_t)2 * NTOK * 512;
static_assert(WS_RWNRM + (size_t)NTOK * 8 * 4 <= WS_ZX, "rwkv hand-off fits in the table region");
constexpr size_t WS_RWLW   = WS_MIX;
constexpr size_t WS_IDX    = WS_US5;
constexpr size_t WS_GATE   = WS_YA;
static_assert((size_t)NTOK * 128 * 4 <= (size_t)16 * NTOK * 16 * 2 && (size_t)NTOK * 128 * 4 <= (size_t)NTOK * 256 * 2, "idx/gate overlays");
static_assert(WS_END <= (size_t)536870912, "workspace budget");

struct P {
    const float* in[51];
    float* out;
    unsigned char* ws;
};
struct W { const float* x; const float* ctx; float* out; unsigned char* ws; };
enum {
    I_X = 0, I_C, I_CTX, I_CCTX,
    I0_WMOD, I0_BMOD, I0_WIN, I0_LAMRE, I0_LAMIM, I0_LOGDT, I0_BRE, I0_BIM, I0_CRE, I0_CIM, I0_S5D, I0_WGLU, I0_BGLU,
    I0_SHIFT, I0_W0, I0_W2, I0_A0, I0_A2, I0_G2, I0_KK, I0_KA, I0_RK, I0_GNW, I0_GNB, I0_WOUT, I0_LN1G, I0_LN1B,
    I0_WQ, I0_KEYS, I0_U, I0_V, I0_LN2G, I0_LN2B,
    I1_WMOD, I1_BMOD, I1_WIN, I1_SINK, I1_RPB, I1_WOUT, I1_LN1G, I1_LN1B, I1_WQ, I1_KEYS, I1_U, I1_V, I1_LN2G, I1_LN2B
};
static_assert(I1_LN2B == 50, "51 inputs");

#define WSP(T, off) ((T*)(p.ws + (off)))
#define PAR(off) (((const float*)(p.ws + WS_PAR)) + (off))

constexpr size_t WS_CTL = WS_TS + 512;
#define CTL_WORDS 8192
constexpr size_t WS_S5BB = WS_CTL + CTL_WORDS * 4;
static_assert(WS_S5BB + (size_t)2048 * 32 * 4 <= (size_t)536870912, "ctl + bbar fit");
#define XB_TMO      128
#define XB_XCNT(j)  (256  + 64 * (j))
#define XB_XSUB(j)  (1280 + 64 * (j))
#define XB_XGEN(j)  (2304 + 64 * (j))
#define XB_TOP      3328
#define XB_TOPGEN   3392
#define CT_ELECT    4096
#define CT_NEXT     6144
#define CT_CARRYT   6208
#define CT_CARRYD   6272
#define CT_S5YT     6336
#define CT_S5YD     6400
#define CT_CONVT    6464
#define CT_GLUT     6528
#define CT_S5ED     6592
#define XB_SPIN_CAP (1u << 22)
#define LAS __attribute__((address_space(3)))
__device__ __forceinline__ unsigned xb_ld(unsigned* p)              { return __hip_atomic_load(p, __ATOMIC_RELAXED, __HIP_MEMORY_SCOPE_AGENT); }
__device__ __forceinline__ unsigned xb_add(unsigned* p, unsigned v) { return __hip_atomic_fetch_add(p, v, __ATOMIC_RELAXED, __HIP_MEMORY_SCOPE_AGENT); }
__device__ __forceinline__ unsigned xb_xcc_id() { return (unsigned)__builtin_amdgcn_s_getreg((3 << 11) | 20) & 0xFu; }
__device__ __forceinline__ unsigned cu_key() { return ((unsigned)__builtin_amdgcn_s_getreg(63492) >> 8) & 0xffu; }
#define XB_SPIN(cond, bar) do { unsigned _sp = 0; while (cond) { __builtin_amdgcn_s_sleep(1); \
    if ((++_sp & 255u) == 0u) { if (xb_ld(&(bar)[XB_TMO])) break; if (_sp > XB_SPIN_CAP) { atomicAdd(&(bar)[XB_TMO], 1u); break; } } } } while (0)
struct XcdBarrier { unsigned* bar; unsigned x; volatile LAS unsigned* st; };
__device__ __forceinline__ XcdBarrier xcd_barrier_post(unsigned* bar, volatile LAS unsigned* st) {
    XcdBarrier b; b.bar = bar; b.x = xb_xcc_id(); b.st = st;
    if (tidx() == 0) (void)xb_add(&bar[XB_XCNT(b.x)], 1u);
    return b;
}
__device__ __forceinline__ void xcd_barrier_complete(unsigned* bar, unsigned x, unsigned& nloc, unsigned& nx) {
    const unsigned G = gridDim.x;
    unsigned sum, cnt, mine, sp = 0u;
    for (;;) {
        sum = 0u; cnt = 0u; mine = 0u;
#pragma unroll
        for (unsigned j = 0; j < 16; ++j) { const unsigned c = xb_ld(&bar[XB_XCNT(j)]); sum += c; cnt += (c > 0u) ? 1u : 0u; mine = (j == x) ? c : mine; }
        if (sum == G) break;
        __builtin_amdgcn_s_sleep(1);
        if ((++sp & 255u) == 0u) { if (xb_ld(&bar[XB_TMO])) break; if (sp > XB_SPIN_CAP) { atomicAdd(&bar[XB_TMO], 1u); break; } }
    }
    nloc = mine > 0u ? mine : 1u; nx = cnt > 0u ? cnt : 1u;
}
__device__ __forceinline__ void xcd_barrier(const XcdBarrier& b) {
    asm volatile("s_waitcnt vmcnt(0)" ::: "memory");
    __syncthreads();
    if (tidx() == 0) {
        unsigned* bar = b.bar;
        __builtin_amdgcn_s_waitcnt(0);
        unsigned nloc = b.st[0], nx = b.st[1];
        if (nloc == 0u) { xcd_barrier_complete(bar, b.x, nloc, nx); b.st[0] = nloc; b.st[1] = nx; }
        const unsigned old = xb_add(&bar[XB_XSUB(b.x)], 1u);
        const unsigned gen = old / nloc;
        if (old + 1u == (gen + 1u) * nloc) {
            __builtin_amdgcn_fence(__ATOMIC_RELEASE, "agent");
            asm volatile("s_waitcnt vmcnt(0)" ::: "memory");
            const unsigned og = xb_add(&bar[XB_TOP], 1u);
            const unsigned tg = og / nx;
            if (og + 1u == (tg + 1u) * nx) xb_add(&bar[XB_TOPGEN], 1u);
            else XB_SPIN(xb_ld(&bar[XB_TOPGEN]) == tg, bar);
            __builtin_amdgcn_fence(__ATOMIC_ACQUIRE, "agent");
            xb_add(&bar[XB_XGEN(b.x)], 1u);
            asm volatile("s_waitcnt vmcnt(0)" ::: "memory");
        } else {
            XB_SPIN(xb_ld(&bar[XB_XGEN(b.x)]) == gen, bar);
            __builtin_amdgcn_fence(__ATOMIC_ACQUIRE, "agent");
            asm volatile("s_waitcnt vmcnt(0)" ::: "memory");
        }
    }
    __syncthreads();
}
__device__ __forceinline__ int take_ticket(unsigned* ctr, volatile LAS unsigned* bc) {
    __syncthreads();
    if (tidx() == 0) bc[0] = xb_add(ctr, 1u);
    __syncthreads();
    return (int)bc[0];
}
__device__ __forceinline__ void signal_done(unsigned* ctr) {
    asm volatile("s_waitcnt vmcnt(0)" ::: "memory");
    __syncthreads();
    if (tidx() == 0) {
        __builtin_amdgcn_fence(__ATOMIC_RELEASE, "agent");
        asm volatile("s_waitcnt vmcnt(0)" ::: "memory");
        xb_add(ctr, 1u);
    }
}
__device__ __forceinline__ void wait_count(unsigned* ctl, int word, unsigned target) {
    if (tidx() == 0) {
        XB_SPIN(xb_ld(&ctl[word]) < target, ctl);
        __builtin_amdgcn_fence(__ATOMIC_ACQUIRE, "agent");
        asm volatile("s_waitcnt vmcnt(0)" ::: "memory");
    }
    __syncthreads();
}

__device__ void transpose_cvt_tile(const float* __restrict__ W, int K, int N, bf16_t* __restrict__ Wt, int tile, float* sm) {
    const int tn = N / 64;
    const int k0 = (tile / tn) * 64, n0 = (tile % tn) * 64;
    const int tid = tidx();
    for (int e = tid; e < 4096; e += 256) { int r = e >> 6, c = e & 63; sm[r * 65 + c] = W[(size_t)(k0 + r) * N + n0 + c]; }
    __syncthreads();
    for (int e = tid; e < 4096; e += 256) { int r = e >> 6, c = e & 63; Wt[(size_t)(n0 + r) * K + k0 + c] = f2bf(sm[c * 65 + r]); }
    __syncthreads();
}

struct TrDesc { int in_idx; size_t in_off; int K, N; size_t out_off; };
#define N_TR 12
__device__ __forceinline__ TrDesc tr_desc(int i) {
    switch (i) {
        case 0:  return {I0_WIN, 0, 1024, ZW0, WS_WIN0T};
        case 1:  return {I0_WOUT, 0, 768, 1024, WS_WOUT0T};
        case 2:  return {I0_WQ, 0, 1024, 1024, WS_WQ0T};
        case 3:  return {I1_WIN, 0, 1024, ZW1, WS_WIN1T};
        case 4:  return {I1_WOUT, 0, 1024, 1024, WS_WOUT1T};
        case 5:  return {I1_WQ, 0, 1024, 1024, WS_WQ1T};
        case 6:  return {I0_WGLU, 0, 256, 256, WS_WGLUT};
        case 7:  return {I0_W2, 0, 64, 512, WS_W2T};
        case 8:  return {I0_W2, (size_t)64 * 512, 64, 512, WS_W2T + (size_t)512 * 64 * 2};
        case 9:  return {I0_A2, 0, 64, 512, WS_A2T};
        case 10: return {I0_A2, (size_t)64 * 512, 64, 512, WS_A2T + (size_t)512 * 64 * 2};
        default: return {I0_G2, 0, 128, 512, WS_G2T};
    }
}
__device__ int tr_total_tiles() { int t = 0; for (int i = 0; i < N_TR; ++i) { TrDesc d = tr_desc(i); t += (d.K / 64) * (d.N / 64); } return t; }

__device__ void phase_transpose(const P& p, float* sm, int bid, int nblk) {
    const int total = tr_total_tiles();
    for (int t = bid; t < total; t += nblk) {
        int rem = t, i = 0;
        for (; i < N_TR; ++i) { TrDesc d = tr_desc(i); int n = (d.K / 64) * (d.N / 64); if (rem < n) break; rem -= n; }
        TrDesc d = tr_desc(i);
        transpose_cvt_tile(p.in[d.in_idx] + d.in_off, d.K, d.N, (bf16_t*)(p.ws + d.out_off), rem, sm);
    }
}

__device__ void cvt_range(const float* __restrict__ src, bf16_t* __restrict__ dst, size_t n, size_t gtid, size_t gthreads) {
    const size_t n8 = n / 8;
    for (size_t i = gtid; i < n8; i += gthreads) {
        float4 a = ((const float4*)src)[2 * i], b = ((const float4*)src)[2 * i + 1];
        uint4 o; o.x = pack2(a.x, a.y); o.y = pack2(a.z, a.w); o.z = pack2(b.x, b.y); o.w = pack2(b.z, b.w);
        ((uint4*)dst)[i] = o;
    }
}
struct __attribute__((aligned(4))) U3 { unsigned x, y, z; };
__device__ __forceinline__ unsigned e2m3_code(float v) {
    const float a = fabsf(v);
    const float c = a < 2.f ? rintf(a * 8.f) : (a < 4.f ? 16.f + rintf((a - 2.f) * 4.f) : 24.f + rintf((a - 4.f) * 2.f));
    return (unsigned)fminf(c, 31.f) | (v < 0.f ? 32u : 0u);
}
__device__ void phase_convert(const P& p, size_t gtid, size_t gthreads) {
    cvt_range(p.in[I0_KEYS], WSP(bf16_t, WS_KEYS0), (size_t)2048 * 64, gtid, gthreads);
    cvt_range(p.in[I1_KEYS], WSP(bf16_t, WS_KEYS1), (size_t)2048 * 64, gtid, gthreads);
    const int lane = (int)(gtid & 63);
    const size_t gwave = gtid >> 6, nwaves = gthreads >> 6;
    float* scl = WSP(float, WS_TABSC);
    const float* t0 = p.in[I0_U]; const float* t1 = p.in[I0_V]; const float* t2 = p.in[I1_U]; const float* t3 = p.in[I1_V];
#define CV_SRC(R_) ((((R_) >> 14) == 0 ? t0 : ((R_) >> 14) == 1 ? t1 : ((R_) >> 14) == 2 ? t2 : t3) + (size_t)((R_) & 16383) * 1024 + lane * 16)
#define CV_LOAD(DST, R_) { const size_t rr_ = (R_) < (size_t)4 * 16384 ? (R_) : (size_t)4 * 16384 - 1; const float4* s_ = (const float4*)CV_SRC(rr_); \
        _Pragma("unroll") for (int q_ = 0; q_ < 4; ++q_) { const float4 t_ = s_[q_]; DST[4 * q_] = t_.x; DST[4 * q_ + 1] = t_.y; DST[4 * q_ + 2] = t_.z; DST[4 * q_ + 3] = t_.w; } }
    float pa[16], pb[16];
    CV_LOAD(pa, gwave) CV_LOAD(pb, gwave + nwaves)
    for (size_t r = gwave; r < (size_t)4 * 16384; r += nwaves) {
        const int tb = (int)(r >> 14), row = (int)(r & 16383);
        unsigned char* dst = p.ws + (tb == 0 ? WS_TABU0 : tb == 1 ? WS_TABV0 : tb == 2 ? WS_TABU1 : WS_TABV1) + (size_t)row * 768 + lane * 12;
        float v[16];
#pragma unroll
        for (int u = 0; u < 16; ++u) { v[u] = pa[u]; pa[u] = pb[u]; }
        CV_LOAD(pb, r + 2 * nwaves)
        float mx = 0.f;
#pragma unroll
        for (int u = 0; u < 16; ++u) mx = fmaxf(mx, fabsf(v[u]));
        mx = wave_max(mx);
        const float sc = mx > 0.f ? 7.5f / mx : 1.f;
        unsigned c[16];
#pragma unroll
        for (int u = 0; u < 16; ++u) c[u] = e2m3_code(v[u] * sc);
        unsigned long long lo = 0ull;
#pragma unroll
        for (int u = 0; u < 10; ++u) lo |= (unsigned long long)c[u] << (6 * u);
        lo |= (unsigned long long)(c[10] & 15u) << 60;
        U3 o3;
        o3.x = (unsigned)lo; o3.y = (unsigned)(lo >> 32);
        o3.z = (c[10] >> 4) | (c[11] << 2) | (c[12] << 8) | (c[13] << 14) | (c[14] << 20) | (c[15] << 26);
        *(U3*)dst = o3;
        if (lane == 0) scl[r] = mx > 0.f ? mx / 7.5f : 1.f;
    }
#undef CV_LOAD
#undef CV_SRC
}
#define PSEG(IDX, OFF, CNT) if (r < (CNT)) { dst[(OFF) + r] = p.in[IDX][r]; continue; } r -= (CNT);
__device__ void phase_pack_params(const P& p, size_t gtid, size_t gthreads) {
    float* dst = (float*)(p.ws + WS_PAR);
    for (size_t i = gtid; i < 20624; i += gthreads) {
        int r = (int)i;
        PSEG(I0_SHIFT, PAR_SHIFT, 3840) PSEG(I0_A0, PAR_A0, 1024) PSEG(I0_W0, PAR_W0, 1024) PSEG(I0_KK, PAR_KK, 512) PSEG(I0_KA, PAR_KA, 512)
        PSEG(I0_RK, PAR_RK, 512) PSEG(I0_BGLU, PAR_BGLU, 256) PSEG(I0_GNW, PAR_GNW, 512) PSEG(I0_GNB, PAR_GNB, 512)
        PSEG(I0_LN1G, PAR_LN1G0, 1024) PSEG(I0_LN1B, PAR_LN1B0, 1024) PSEG(I0_LN2G, PAR_LN2G0, 1024) PSEG(I0_LN2B, PAR_LN2B0, 1024)
        PSEG(I1_LN1G, PAR_LN1G1, 1024) PSEG(I1_LN1B, PAR_LN1B1, 1024) PSEG(I1_LN2G, PAR_LN2G1, 1024) PSEG(I1_LN2B, PAR_LN2B1, 1024)
        PSEG(I1_RPB, PAR_RPB, 3720) PSEG(I1_SINK, PAR_SINK, 8)
    }
}
#undef PSEG
__device__ void phase_mod_partial(const P& p, int gwave, int nwaves) {
    const int lane = tidx() & 63;
    for (int it = gwave; it < 2 * 96 * 8; it += nwaves) {
        const int kc = it & 7, ct = (it >> 3) % 96, l = it / (8 * 96);
        const float* wm = p.in[l ? I1_WMOD : I0_WMOD];
        const int col = ct * 64 + lane;
        float sa[5], sb[5];
#pragma unroll
        for (int n = 0; n < 5; ++n) {
            const float* cv = n < 4 ? p.in[I_C] + n * 1024 : p.in[I_CCTX];
            sa[n] = siluf_(cv[kc * 128 + lane]); sb[n] = siluf_(cv[kc * 128 + 64 + lane]);
        }
        float acc[5] = {0.f, 0.f, 0.f, 0.f, 0.f};
        const float* wp = wm + (size_t)(kc * 128) * 6144 + col;
#pragma unroll 1
        for (int i0 = 0; i0 < 64; i0 += 32) {
            float w0[32], w1[32];
#pragma unroll
            for (int j = 0; j < 32; ++j) { w0[j] = wp[(size_t)(i0 + j) * 6144]; w1[j] = wp[(size_t)(64 + i0 + j) * 6144]; }
#pragma unroll
            for (int j = 0; j < 32; ++j)
#pragma unroll
                for (int n = 0; n < 5; ++n) {
                    const float s0 = __builtin_bit_cast(float, __builtin_amdgcn_readlane(__builtin_bit_cast(int, sa[n]), i0 + j));
                    const float s1 = __builtin_bit_cast(float, __builtin_amdgcn_readlane(__builtin_bit_cast(int, sb[n]), i0 + j));
                    acc[n] += s0 * w0[j] + s1 * w1[j];
                }
        }
        float* mp = WSP(float, WS_MODP);
#pragma unroll
        for (int n = 0; n < 5; ++n) mp[(((size_t)kc * 2 + l) * 5 + n) * 6144 + col] = acc[n];
    }
}
__device__ void phase_mod_reduce(const P& p, size_t gtid, size_t gthreads) {
    const float* mp = WSP(float, WS_MODP);
    float* mo = WSP(float, WS_MOD);
    for (size_t i = gtid; i < (size_t)2 * 5 * 6144; i += gthreads) {
        const int l = (int)(i / (5 * 6144)), col = (int)(i % 6144);
        float s = p.in[l ? I1_BMOD : I0_BMOD][col];
        for (int kc = 0; kc < 8; ++kc) s += mp[(size_t)kc * 2 * 5 * 6144 + i];
        mo[i] = s;
    }
}

__device__ void phase_s5_pow(const P& p, size_t gtid, size_t gthreads) {
    float* pw = WSP(float, WS_S5POW);
    for (size_t e = gtid; e < (size_t)2048 * 65; e += gthreads) {
        const int i = (int)(e / 65), j = (int)(e - (size_t)i * 65);
        const float lr = p.in[I0_LAMRE][i], li = p.in[I0_LAMIM][i];
        const float dt = expf(p.in[I0_LOGDT][i >> 6]);
        const float mag = expf(lr * dt * (float)j), ang = li * dt * (float)j;
        pw[e * 2] = mag * cosf(ang); pw[e * 2 + 1] = mag * sinf(ang);
    }
    for (size_t e = gtid; e < (size_t)2048 * 16; e += gthreads) {
        const int i = (int)(e >> 4), q = (int)(e & 15);
        const float lr = p.in[I0_LAMRE][i], li = p.in[I0_LAMIM][i];
        const float dt = expf(p.in[I0_LOGDT][i >> 6]);
        const float mag = expf(lr * dt);
        const float ar = mag * cosf(li * dt), ai = mag * sinf(li * dt);
        const float den = lr * lr + li * li, nr1 = ar - 1.f;
        const float kr = (nr1 * lr + ai * li) / den, ki = (ai * lr - nr1 * li) / den;
        const float xr = p.in[I0_BRE][e], xi = p.in[I0_BIM][e];
        float* bbt = (float*)(p.ws + WS_S5BB) + (size_t)i * 32 + 2 * q;
        bbt[0] = kr * xr - ki * xi; bbt[1] = kr * xi + ki * xr;
    }
}
__device__ __forceinline__ void s5_bbar(const P& p, int dgp, int i, float& br, float& bi) {
    const float* bbt = (const float*)(p.ws + WS_S5BB) + (size_t)dgp * 32 + 2 * i;
    br = bbt[0]; bi = bbt[1];
}
#define TSTAMP(k) do { if (DIAGX && bidx() == 0 && tidx() == 0) ((volatile unsigned long long*)(p.ws + WS_TS))[k] = __builtin_amdgcn_s_memrealtime(); } while (0)
__device__ void phase_s5_tables(const P& p, size_t gtid, size_t gthreads) {
    const float* pw = WSP(float, WS_S5POW);
    const float* bbt = (const float*)(p.ws + WS_S5BB);
    bf16_t* Kt = WSP(bf16_t, WS_S5K);
    bf16_t* Wt = WSP(bf16_t, WS_S5W);
    bf16_t* Vt = WSP(bf16_t, WS_S5V);
    for (size_t e = gtid; e < (size_t)32 * 64 * 64; e += gthreads) {
        const int ipq = (int)(e & 3), i = (int)((e >> 2) & 15), lag = (int)((e >> 6) & 63), dg = (int)(e >> 12);
        float acc[4] = {0.f, 0.f, 0.f, 0.f};
        const float* crp = p.in[I0_CRE] + ((size_t)dg * 16 + i) * 64;
        const float* cip = p.in[I0_CIM] + ((size_t)dg * 16 + i) * 64;
#pragma unroll 8
        for (int pp = 0; pp < 64; ++pp) {
            const int dgp = dg * 64 + pp;
            const float2 a = *(const float2*)&pw[((size_t)dgp * 65 + lag) * 2];
            const float cr = crp[pp], ci = cip[pp];
            const float tr = cr * a.x - ci * a.y, ti = cr * a.y + ci * a.x;
            const float4 b0 = *(const float4*)&bbt[(size_t)dgp * 32 + ipq * 8], b1 = *(const float4*)&bbt[(size_t)dgp * 32 + ipq * 8 + 4];
            acc[0] += tr * b0.x - ti * b0.y; acc[1] += tr * b0.z - ti * b0.w;
            acc[2] += tr * b1.x - ti * b1.y; acc[3] += tr * b1.z - ti * b1.w;
        }
        if (lag == 0 && dg < 16 && (i >> 2) == ipq) acc[i & 3] += p.in[I0_S5D][(dg & 15) * 16 + i];
        *(uint2*)&Kt[e * 4] = make_uint2(pack2(acc[0], acc[1]), pack2(acc[2], acc[3]));
    }
    for (size_t e = gtid; e < (size_t)32 * 64 * 64; e += gthreads) {
        const int s_ = (int)(e & 63), pp = (int)((e >> 6) & 63), dg = (int)(e >> 12), d = dg >> 4;
        const int dgp = dg * 64 + pp;
        const int ex = d ? s_ : 63 - s_;
        const float2 a = *(const float2*)&pw[((size_t)dgp * 65 + ex) * 2];
        float tr[16], ti[16];
#pragma unroll
        for (int q = 0; q < 8; ++q) {
            const float4 b = *(const float4*)&bbt[(size_t)dgp * 32 + q * 4];
            tr[2 * q] = a.x * b.x - a.y * b.y; ti[2 * q] = a.x * b.y + a.y * b.x;
            tr[2 * q + 1] = a.x * b.z - a.y * b.w; ti[2 * q + 1] = a.x * b.w + a.y * b.z;
        }
        bf16_t* w0 = Wt + ((size_t)dg * 128 + pp * 2) * 1024 + s_ * 16;
        *(uint4*)&w0[0] = make_uint4(pack2(tr[0], tr[1]), pack2(tr[2], tr[3]), pack2(tr[4], tr[5]), pack2(tr[6], tr[7]));
        *(uint4*)&w0[8] = make_uint4(pack2(tr[8], tr[9]), pack2(tr[10], tr[11]), pack2(tr[12], tr[13]), pack2(tr[14], tr[15]));
        *(uint4*)&w0[1024] = make_uint4(pack2(ti[0], ti[1]), pack2(ti[2], ti[3]), pack2(ti[4], ti[5]), pack2(ti[6], ti[7]));
        *(uint4*)&w0[1032] = make_uint4(pack2(ti[8], ti[9]), pack2(ti[10], ti[11]), pack2(ti[12], ti[13]), pack2(ti[14], ti[15]));
    }
    for (size_t e = gtid; e < (size_t)32 * 64 * 64; e += gthreads) {
        const int pp = (int)(e & 63), t = (int)((e >> 6) & 63), dg = (int)(e >> 12), d = dg >> 4;
        const int dgp = dg * 64 + pp;
        const int ex = d ? 64 - t : t + 1;
        const float2 a = *(const float2*)&pw[((size_t)dgp * 65 + ex) * 2];
        bf16_t* v0 = Vt + ((size_t)dg * 1024 + t * 16) * 128 + pp * 2;
#pragma unroll
        for (int i = 0; i < 16; ++i) {
            const float cr = p.in[I0_CRE][((size_t)dg * 16 + i) * 64 + pp], ci = p.in[I0_CIM][((size_t)dg * 16 + i) * 64 + pp];
            *(unsigned*)&v0[(size_t)i * 128] = pack2(cr * a.x - ci * a.y, -(cr * a.y + ci * a.x));
        }
    }
}

#define GM_LD 72
#define CS_LD 132
#define GEMM_SMEM_BYTES (2 * 128 * (128 + 8) * 2)
static_assert(64 * CS_LD * 4 <= 2 * 128 * GM_LD * 2, "C staging fits");

template <int BK, class AL, class BL, class Epi>
__device__ void gemm_tile(const AL& al, const BL& bl, int K, int m0, int n0, Epi& epi, unsigned char* smem) {
    constexpr int LD = BK + 8;
    constexpr int NC = BK / 64;
    bf16_t* As = (bf16_t*)smem;
    bf16_t* Bs = As + 128 * LD;
    const int tid = tidx(), lane = tid & 63, wave = tid >> 6;
    const int wm = wave >> 1, wn = wave & 1;
    const int lrow = tid >> 3, kc = (tid & 7) * 8;
    typename AL::RowCtx arow[4];
    typename BL::RowCtx brow[4];
#pragma unroll
    for (int i = 0; i < 4; ++i) { arow[i] = al.row(m0 + lrow + 32 * i); brow[i] = bl.row(n0 + lrow + 32 * i); }
    f32x16 acc[2][2];
#pragma unroll
    for (int i = 0; i < 2; ++i)
#pragma unroll
        for (int j = 0; j < 2; ++j)
#pragma unroll
            for (int r = 0; r < 16; ++r) acc[i][j][r] = 0.f;
    uint4 ra[4 * NC], rb[4 * NC];
#pragma unroll
    for (int c = 0; c < NC; ++c)
#pragma unroll
        for (int i = 0; i < 4; ++i) { ra[c * 4 + i] = al.load8(arow[i], c * 64 + kc); rb[c * 4 + i] = bl.load8(brow[i], c * 64 + kc); }
    for (int k0 = 0; k0 < K; k0 += BK) {
        __syncthreads();
#pragma unroll
        for (int c = 0; c < NC; ++c)
#pragma unroll
            for (int i = 0; i < 4; ++i) {
                *(uint4*)&As[(lrow + 32 * i) * LD + c * 64 + kc] = ra[c * 4 + i];
                *(uint4*)&Bs[(lrow + 32 * i) * LD + c * 64 + kc] = rb[c * 4 + i];
            }
        __syncthreads();
        if (k0 + BK < K) {
#pragma unroll
            for (int c = 0; c < NC; ++c)
#pragma unroll
                for (int i = 0; i < 4; ++i) { ra[c * 4 + i] = al.load8(arow[i], k0 + BK + c * 64 + kc); rb[c * 4 + i] = bl.load8(brow[i], k0 + BK + c * 64 + kc); }
        }
#pragma unroll
        for (int kk = 0; kk < BK / 16; ++kk) {
            bf16x8 a[2], b[2];
#pragma unroll
            for (int i = 0; i < 2; ++i) a[i] = *(const bf16x8*)&As[(wm * 64 + i * 32 + (lane & 31)) * LD + kk * 16 + 8 * (lane >> 5)];
#pragma unroll
            for (int j = 0; j < 2; ++j) b[j] = *(const bf16x8*)&Bs[(wn * 64 + j * 32 + (lane & 31)) * LD + kk * 16 + 8 * (lane >> 5)];
#pragma unroll
            for (int i = 0; i < 2; ++i)
#pragma unroll
                for (int j = 0; j < 2; ++j) acc[i][j] = __builtin_amdgcn_mfma_f32_32x32x16_bf16(a[i], b[j], acc[i][j], 0, 0, 0);
        }
    }
    float* Cs = (float*)smem;
#pragma unroll
    for (int pass = 0; pass < 2; ++pass) {
        __syncthreads();
        if (wm == pass) {
#pragma unroll
            for (int i = 0; i < 2; ++i)
#pragma unroll
                for (int j = 0; j < 2; ++j)
#pragma unroll
                    for (int r = 0; r < 16; ++r) {
                        const int row = i * 32 + (r & 3) + 8 * (r >> 2) + 4 * (lane >> 5);
                        const int col = wn * 64 + j * 32 + (lane & 31);
                        Cs[row * CS_LD + col] = acc[i][j][r];
                    }
        }
        __syncthreads();
        epi(Cs, pass, tid);
    }
    __syncthreads();
}

template <int MODE = 0, class Epi>
__device__ void gemm_tile_dma(const bf16_t* __restrict__ A, int lda, const bf16_t* __restrict__ Bt, int ldb, int K, int m0, int n0, Epi& epi, unsigned char* smem) {
    const int tid = tidx(), lane = tid & 63, wave = tid >> 6, wm = wave >> 1, wn = wave & 1, l31 = lane & 31, hh = lane >> 5;
    const int prow = lane >> 3, pchunk = (lane & 7) ^ prow;
    const bf16_t* ga = A + (size_t)(m0 + wave * 32 + prow) * lda + pchunk * 8;
    const bf16_t* gb = Bt + (size_t)(n0 + wave * 32 + prow) * ldb + pchunk * 8;
    f32x16 acc[2][2];
#pragma unroll
    for (int i = 0; i < 2; ++i)
#pragma unroll
        for (int j = 0; j < 2; ++j)
#pragma unroll
            for (int r = 0; r < 16; ++r) acc[i][j][r] = 0.f;
    const int wbase = __builtin_amdgcn_readfirstlane(wave) * (32 * 128);
#define DMA_ISSUE(k0_, buf_) { unsigned char* ab_ = smem + (buf_) * 32768 + wbase; unsigned char* bb_ = ab_ + 16384; \
        _Pragma("unroll") for (int j_ = 0; j_ < 4; ++j_) { \
            __builtin_amdgcn_global_load_lds((const unsigned*)(ga + (size_t)(8 * j_) * lda + (k0_)), (unsigned*)(ab_ + j_ * 1024), 16, 0, 0); \
            __builtin_amdgcn_global_load_lds((const unsigned*)(gb + (size_t)(8 * j_) * ldb + (k0_)), (unsigned*)(bb_ + j_ * 1024), 16, 0, 0); } }
    __syncthreads();
    DMA_ISSUE(0, 0)
    asm volatile("s_waitcnt vmcnt(0)" ::: "memory");
    asm volatile("s_waitcnt lgkmcnt(0)" ::: "memory"); __builtin_amdgcn_s_barrier();
    const int nk = K / 64;
    for (int kt = 0; kt < nk; ++kt) {
        const int buf = kt & 1;
        if (kt + 1 < nk) DMA_ISSUE((kt + 1) * 64, buf ^ 1)
        const bf16_t* As = (const bf16_t*)(smem + buf * 32768);
        const bf16_t* Bs = As + 8192;
#pragma unroll
        for (int kk = 0; kk < 4; ++kk) {
            bf16x8 a[2], b[2];
            const int cc = ((kk * 2 + hh) ^ (l31 & 7)) * 8;
#pragma unroll
            for (int i = 0; i < 2; ++i) a[i] = *(const bf16x8*)&As[(wm * 64 + i * 32 + l31) * 64 + cc];
#pragma unroll
            for (int j = 0; j < 2; ++j) b[j] = *(const bf16x8*)&Bs[(wn * 64 + j * 32 + l31) * 64 + cc];
#pragma unroll
            for (int i = 0; i < 2; ++i)
#pragma unroll
                for (int j = 0; j < 2; ++j) acc[i][j] = __builtin_amdgcn_mfma_f32_32x32x16_bf16(a[i], b[j], acc[i][j], 0, 0, 0);
        }
        asm volatile("s_waitcnt vmcnt(0)" ::: "memory");
        asm volatile("s_waitcnt lgkmcnt(0)" ::: "memory"); __builtin_amdgcn_s_barrier();
    }
#undef DMA_ISSUE
    float* Cs = (float*)smem;
    if constexpr (MODE == 2) {
        __syncthreads();
#pragma unroll
        for (int i = 0; i < 2; ++i)
#pragma unroll
            for (int j = 0; j < 2; ++j)
#pragma unroll
                for (int r = 0; r < 16; ++r) {
                    const int row = wm * 64 + i * 32 + (r & 3) + 8 * (r >> 2) + 4 * (lane >> 5);
                    const int col = wn * 64 + j * 32 + (lane & 31);
                    Cs[row * CS_LD + col] = acc[i][j][r];
                }
        __syncthreads();
        epi.run128(Cs, tid);
    } else {
#pragma unroll
    for (int pass = 0; pass < 2; ++pass) {
        __syncthreads();
        if (wm == pass) {
#pragma unroll
            for (int i = 0; i < 2; ++i)
#pragma unroll
                for (int j = 0; j < 2; ++j)
#pragma unroll
                    for (int r = 0; r < 16; ++r) {
                        const int row = i * 32 + (r & 3) + 8 * (r >> 2) + 4 * (lane >> 5);
                        const int col = wn * 64 + j * 32 + (lane & 31);
                        Cs[row * CS_LD + col] = acc[i][j][r];
                    }
        }
        __syncthreads();
        epi(Cs, pass, tid);
    }
    __syncthreads();
    }
}

__device__ __forceinline__ int xcd_swz(int bid, int nblk) { return (nblk & 7) ? bid : (bid & 7) * (nblk >> 3) + (bid >> 3); }

struct LdBf16 {
    const bf16_t* base; int ld;
    typedef const bf16_t* RowCtx;
    __device__ RowCtx row(int r) const { return base + (size_t)r * ld; }
    __device__ uint4 load8(RowCtx rc, int k) const { return *(const uint4*)(rc + k); }
};
struct LdXMod {
    const float* xlat; const float* xctx; const float* mod; int shift_off, scale_off;
    struct RowCtx { const float* src; const float* m; };
    __device__ RowCtx row(int R) const {
        const int b = R / SS, s = R - b * SS;
        RowCtx rc;
        if (s < LC) { rc.src = xctx + ((size_t)(b * LC + s)) * DM; rc.m = mod + 4 * 6144; }
        else        { rc.src = xlat + ((size_t)(b * TT + s - LC)) * DM; rc.m = mod + b * 6144; }
        return rc;
    }
    __device__ uint4 load8(const RowCtx& rc, int k) const {
        const float4 x0 = *(const float4*)(rc.src + k), x1 = *(const float4*)(rc.src + k + 4);
        const float4 c0 = *(const float4*)(rc.m + scale_off + k), c1 = *(const float4*)(rc.m + scale_off + k + 4);
        const float4 h0 = *(const float4*)(rc.m + shift_off + k), h1 = *(const float4*)(rc.m + shift_off + k + 4);
        uint4 o;
        o.x = pack2(x0.x * (1.f + c0.x) + h0.x, x0.y * (1.f + c0.y) + h0.y);
        o.y = pack2(x0.z * (1.f + c0.z) + h0.z, x0.w * (1.f + c0.w) + h0.w);
        o.z = pack2(x1.x * (1.f + c1.x) + h1.x, x1.y * (1.f + c1.y) + h1.y);
        o.w = pack2(x1.z * (1.f + c1.z) + h1.z, x1.w * (1.f + c1.w) + h1.w);
        return o;
    }
};

struct EpiStoreBf16 {
    bf16_t* out; int ld; int m0, n0; int mmax;
    __device__ void operator()(const float* Cs, int pass, int tid) const {
#pragma unroll
        for (int i = 0; i < 4; ++i) {
            const int c = tid + 256 * i, row = c >> 4, col8 = (c & 15) * 8;
            const int R = m0 + pass * 64 + row;
            if (R >= mmax) continue;
            const float4 a = *(const float4*)&Cs[row * CS_LD + col8], b = *(const float4*)&Cs[row * CS_LD + col8 + 4];
            uint4 o; o.x = pack2(a.x, a.y); o.y = pack2(a.z, a.w); o.z = pack2(b.x, b.y); o.w = pack2(b.z, b.w);
            *(uint4*)&out[(size_t)R * ld + n0 + col8] = o;
        }
    }
};
struct EpiStoreF32 {
    float* out; int ld; int m0, n0; int mmax;
    __device__ void operator()(const float* Cs, int pass, int tid) const {
#pragma unroll
        for (int i = 0; i < 8; ++i) {
            const int c = tid + 256 * i, row = c >> 5, col4 = (c & 31) * 4;
            const int R = m0 + pass * 64 + row;
            if (R >= mmax) continue;
            *(float4*)&out[(size_t)R * ld + n0 + col4] = *(const float4*)&Cs[row * CS_LD + col4];
        }
    }
};

__device__ __forceinline__ void phase_xcvt(const W p, unsigned char* smem) {
    const int gwave = __builtin_amdgcn_readfirstlane((int)bidx() * 4 + (tidx() >> 6)), nwaves = (int)gridDim.x * 4;
    const float* mod = WSP(float, WS_MOD);
    bf16_t* hb = WSP(bf16_t, WS_HB);
    float* sp = (float*)smem;
    for (int i = tidx(); i < 1024; i += 256) {
#pragma unroll
        for (int v = 0; v < 5; ++v) { sp[v * 1024 + i] = mod[v * 6144 + i]; sp[5120 + v * 1024 + i] = mod[v * 6144 + 1024 + i]; }
    }
    __syncthreads();
    if (gwave >= NTOK) return;
#define XC_SRC(R_) ((R_) % SS < LC ? p.ctx + ((size_t)(((R_) / SS) * LC + (R_) % SS)) * DM : p.x + ((size_t)(((R_) / SS) * TT + (R_) % SS - LC)) * DM)
#define XC_LOAD(XD, R_) { const float* s_ = XC_SRC(R_); const int l4_ = (tidx() & 63) * 4; \
        _Pragma("unroll") for (int i_ = 0; i_ < 4; ++i_) { const float4 x4_ = *(const float4*)&s_[i_ * 256 + l4_]; \
            XD[4 * i_] = x4_.x; XD[4 * i_ + 1] = x4_.y; XD[4 * i_ + 2] = x4_.z; XD[4 * i_ + 3] = x4_.w; } }
    float xa[16], xb[16];
    XC_LOAD(xa, gwave)
    { const int r1 = gwave + nwaves < NTOK ? gwave + nwaves : gwave; XC_LOAD(xb, r1) }
    for (int R = gwave; R < NTOK; R += nwaves) {
        const int var = (R % SS) < LC ? 4 : R / SS;
        float xc[16];
        { const int r2 = R + 2 * nwaves < NTOK ? R + 2 * nwaves : R; XC_LOAD(xc, r2) }
        const int l4 = (tidx() & 63) * 4;
#pragma unroll
        for (int i = 0; i < 4; ++i) {
            const int k = i * 256 + l4;
            const float4 sh = *(const float4*)&sp[var * 1024 + k], sc = *(const float4*)&sp[5120 + var * 1024 + k];
            *(uint2*)&hb[(size_t)R * 1024 + k] = make_uint2(pack2(xa[4 * i] * (1.f + sc.x) + sh.x, xa[4 * i + 1] * (1.f + sc.y) + sh.y),
                                                            pack2(xa[4 * i + 2] * (1.f + sc.z) + sh.z, xa[4 * i + 3] * (1.f + sc.w) + sh.w));
        }
#pragma unroll
        for (int i = 0; i < 16; ++i) { xa[i] = xb[i]; xb[i] = xc[i]; }
    }
#undef XC_LOAD
#undef XC_SRC
}
struct EpiZX0 {
    bf16_t* zx; bf16_t* us5; int m0, n0;
    __device__ void operator()(const float* Cs, int pass, int tid) const {
#pragma unroll
        for (int i = 0; i < 4; ++i) {
            const int c = tid + 256 * i, row = c >> 4, col8 = (c & 15) * 8;
            const int R = m0 + pass * 64 + row, col = n0 + col8;
            const float4 a = *(const float4*)&Cs[row * CS_LD + col8], b = *(const float4*)&Cs[row * CS_LD + col8 + 4];
            uint4 o; o.x = pack2(a.x, a.y); o.y = pack2(a.z, a.w); o.z = pack2(b.x, b.y); o.w = pack2(b.z, b.w);
            if (col < 256) *(uint4*)&us5[((size_t)(col >> 4) * NTOK + R) * 16 + (col & 8)] = o;
            else           *(uint4*)&zx[(size_t)R * ZW0 + col] = o;
        }
    }
};
__device__ void phase_gemm_win0(const W p, unsigned char* smem, int bid, int nblk) {
    LdBf16 al{WSP(bf16_t, WS_HB), 1024};
    LdBf16 bl{WSP(bf16_t, WS_WIN0T), 1024};
    const int ntn = ZW0 / 128, total = (NTOK / 128) * ntn;
    for (int t = xcd_swz(bid, nblk); t < total; t += nblk) {
        const int m0 = (t / ntn) * 128, n0 = (t % ntn) * 128;
        EpiZX0 epi{WSP(bf16_t, WS_ZX), WSP(bf16_t, WS_US5), m0, n0};
        gemm_tile_dma(al.base, al.ld, bl.base, bl.ld, 1024, m0, n0, epi, smem);
    }
}

struct LdBf16Clamp {
    const bf16_t* base; int ld; int rmax;
    typedef const bf16_t* RowCtx;
    __device__ RowCtx row(int r) const { return base + (size_t)(r < rmax ? r : rmax) * ld; }
    __device__ uint4 load8(RowCtx rc, int k) const { return *(const uint4*)(rc + k); }
};
__device__ void phase_s5_E(const W p, unsigned char* smem, int bid, int nblk) {
    for (int t = bid; t < 32 * 5; t += nblk) {
        const int dg = t / 5, mt = t % 5, g = dg & 15;
        LdBf16Clamp al{WSP(bf16_t, WS_US5) + (size_t)g * NTOK * 16, 1024, 527};
        LdBf16 bl{WSP(bf16_t, WS_S5W) + (size_t)dg * 128 * 1024, 1024};
        EpiStoreF32 epi{WSP(float, WS_S5E) + (size_t)dg * 528 * 128, 128, mt * 128, 0, 528};
        gemm_tile<128>(al, bl, 1024, mt * 128, 0, epi, smem);
        signal_done((unsigned*)(p.ws + WS_CTL) + CT_S5ED);
    }
}
__device__ void phase_s5_carry(const W p, size_t gtid, size_t gthreads) {
    const float* pw = WSP(float, WS_S5POW);
    const float* E = WSP(float, WS_S5E);
    bf16_t* H = WSP(bf16_t, WS_S5H);
    for (size_t i = gtid; i < 8192; i += gthreads) {
        const int pp = (int)(i & 63), b = (int)((i >> 6) & 3), dg = (int)(i >> 8), d = dg >> 4;
        const float ar = pw[((size_t)(dg * 64 + pp) * 65 + 64) * 2], ai = pw[((size_t)(dg * 64 + pp) * 65 + 64) * 2 + 1];
        float hr = 0.f, hi = 0.f;
        for (int cc0 = 0; cc0 < NCH; cc0 += 4) {
            size_t o[4]; float er[4], ei[4];
#pragma unroll
            for (int j = 0; j < 4; ++j) {
                const int cc = cc0 + j;
                const int c = d ? (cc < 4 ? 3 - cc : 131 - (cc - 4)) : cc;
                o[j] = ((size_t)dg * 528 + b * NCH + c) * 128 + pp * 2;
                er[j] = E[o[j]]; ei[j] = E[o[j] + 1];
            }
#pragma unroll
            for (int j = 0; j < 4; ++j) {
                H[o[j]] = f2bf(hr); H[o[j] + 1] = f2bf(hi);
                const float nr = ar * hr - ai * hi + er[j], ni = ar * hi + ai * hr + ei[j];
                hr = nr; hi = ni;
            }
        }
    }
}
struct LdS5YA {
    const bf16_t* u; const bf16_t* h0; const bf16_t* h1;
    struct RowCtx { const bf16_t* u; const bf16_t* h0; const bf16_t* h1; };
    __device__ RowCtx row(int r) const { if (r > 527) r = 527; return {u + (size_t)r * 1024, h0 + (size_t)r * 128, h1 + (size_t)r * 128}; }
    __device__ uint4 load8(const RowCtx& rc, int k) const {
        if (k < 1024) return *(const uint4*)(rc.u + k);
        if (k < 1152) return *(const uint4*)(rc.h0 + (k - 1024));
        if (k < 2176) return *(const uint4*)(rc.u + (k - 1152));
        return *(const uint4*)(rc.h1 + (k - 2176));
    }
};
struct LdS5YB {
    const bf16_t* k0; const bf16_t* k1; const bf16_t* v0; const bf16_t* v1;
    struct RowCtx { int t, i; const bf16_t* v0; const bf16_t* v1; };
    __device__ RowCtx row(int n) const { return {n >> 4, n & 15, v0 + (size_t)n * 128, v1 + (size_t)n * 128}; }
    __device__ uint4 load8(const RowCtx& rc, int k) const {
        if (k < 1024) { const int s = k >> 4, lag = rc.t - s; if (lag < 0) return make_uint4(0, 0, 0, 0); return *(const uint4*)(k0 + (lag * 16 + rc.i) * 16 + (k & 8)); }
        if (k < 1152) return *(const uint4*)(rc.v0 + (k - 1024));
        if (k < 2176) { const int kk = k - 1152, s = kk >> 4, lag = s - rc.t; if (lag < 0) return make_uint4(0, 0, 0, 0); return *(const uint4*)(k1 + (lag * 16 + rc.i) * 16 + (kk & 8)); }
        return *(const uint4*)(rc.v1 + (k - 2176));
    }
};
struct EpiS5Y {
    bf16_t* ya; int g; int m0, n0;
    __device__ void operator()(const float* Cs, int pass, int tid) const {
#pragma unroll
        for (int i = 0; i < 4; ++i) {
            const int c = tid + 256 * i, row = c >> 4, col8 = (c & 15) * 8;
            const int r = m0 + pass * 64 + row;
            if (r > 527) continue;
            const int n = n0 + col8, t = n >> 4;
            const float4 a = *(const float4*)&Cs[row * CS_LD + col8], b = *(const float4*)&Cs[row * CS_LD + col8 + 4];
            uint4 o;
            o.x = pack2(geluf_(a.x), geluf_(a.y)); o.y = pack2(geluf_(a.z), geluf_(a.w));
            o.z = pack2(geluf_(b.x), geluf_(b.y)); o.w = pack2(geluf_(b.z), geluf_(b.w));
            *(uint4*)&ya[((size_t)r * 64 + t) * 256 + g * 16 + (n & 8)] = o;
        }
    }
};
__device__ void phase_s5_Y(const W p, unsigned char* smem, int bid, int nblk) {
    for (int t = bid; t < 16 * 5 * 8; t += nblk) {
        if (t < 0) continue;
        const int g = t / 40, mt = (t % 40) / 8, nt = t % 8;
        LdS5YA al{WSP(bf16_t, WS_US5) + (size_t)g * NTOK * 16, WSP(bf16_t, WS_S5H) + (size_t)g * 528 * 128, WSP(bf16_t, WS_S5H) + (size_t)(16 + g) * 528 * 128};
        LdS5YB bl{WSP(bf16_t, WS_S5K) + (size_t)g * 64 * 256, WSP(bf16_t, WS_S5K) + (size_t)(16 + g) * 64 * 256,
                  WSP(bf16_t, WS_S5V) + (size_t)g * 1024 * 128, WSP(bf16_t, WS_S5V) + (size_t)(16 + g) * 1024 * 128};
        EpiS5Y epi{WSP(bf16_t, WS_YA), g, mt * 128, nt * 128};
        gemm_tile<128>(al, bl, 2304, mt * 128, nt * 128, epi, smem);
    }
}

__device__ __forceinline__ void zx0_shift8(const bf16_t* zx, const float* mu, int R, int col, float (&o)[8]) {
    const int s = R % SS;
    const bool hp = (s != 0) && (s != LC), hn = (s != LC - 1) && (s != SS - 1);
    const uint4 z = *(const uint4*)&zx[(size_t)R * ZW0 + col];
    uint4 zp = make_uint4(0, 0, 0, 0), zn = make_uint4(0, 0, 0, 0);
    if (hp) zp = *(const uint4*)&zx[(size_t)(R - 1) * ZW0 + col];
    if (hn) zn = *(const uint4*)&zx[(size_t)(R + 1) * ZW0 + col];
    const unsigned zu[4] = {z.x, z.y, z.z, z.w}, pu[4] = {zp.x, zp.y, zp.z, zp.w}, nu[4] = {zn.x, zn.y, zn.z, zn.w};
    const int mc = col - 256;
#pragma unroll
    for (int u = 0; u < 4; ++u) {
        const float a0 = bflo(zu[u]), a1 = bfhi(zu[u]);
        o[2 * u]     = a0 + mu[mc + 2 * u] * (bflo(pu[u]) - a0) + mu[1920 + mc + 2 * u] * (bflo(nu[u]) - a0);
        o[2 * u + 1] = a1 + mu[mc + 2 * u + 1] * (bfhi(pu[u]) - a1) + mu[1920 + mc + 2 * u + 1] * (bfhi(nu[u]) - a1);
    }
}

__device__ __forceinline__ float tanh_fast(float x) { const float e = __expf(2.f * fminf(fmaxf(x, -15.f), 15.f)); return 1.f - 2.f / (e + 1.f); }
__device__ __forceinline__ float softplus_fast(float x) { return fmaxf(x, 0.f) + __logf(1.f + __expf(-fabsf(x))); }

__device__ void phase_rw_shift(const W p, int gwave, int nwaves) {
    const int lane = tidx() & 63;
    const bf16_t* zx = WSP(bf16_t, WS_ZX);
    const float* mu = PAR(PAR_SHIFT);
    bf16_t* Rr = WSP(bf16_t, WS_RWR);
    bf16_t* Kk = WSP(bf16_t, WS_RWK);
    float* nrm = WSP(float, WS_RWNRM);
    for (int R = gwave; R < NTOK; R += nwaves) {
        const int b = R / SS, s = R - b * SS, h = lane >> 3, c8 = (lane & 7) * 8;
        float r8[8], k8[8];
        zx0_shift8(zx, mu, R, 256 + lane * 8, r8);
        zx0_shift8(zx, mu, R, 768 + lane * 8, k8);
        float ss = 0.f;
#pragma unroll
        for (int u = 0; u < 8; ++u) { const float kk = k8[u] * PAR(PAR_KK)[lane * 8 + u]; ss += kk * kk; }
        ss += __shfl_xor(ss, 1); ss += __shfl_xor(ss, 2); ss += __shfl_xor(ss, 4);
        const size_t o = (((size_t)(b * 8 + h)) * SS + s) * 64 + c8;
        *(uint4*)&Rr[o] = make_uint4(pack2(r8[0], r8[1]), pack2(r8[2], r8[3]), pack2(r8[4], r8[5]), pack2(r8[6], r8[7]));
        *(uint4*)&Kk[o] = make_uint4(pack2(k8[0], k8[1]), pack2(k8[2], k8[3]), pack2(k8[4], k8[5]), pack2(k8[6], k8[7]));
        if ((lane & 7) == 0) nrm[((size_t)(b * 8 + h)) * SS + s] = rsqrtf(ss + 1e-12f);
    }
}
struct LdLora {
    const bf16_t* zx; const float* mu; int col0; int dotanh;
    typedef int RowCtx;
    __device__ RowCtx row(int R) const { return R; }
    __device__ uint4 load8(RowCtx R, int k) const {
        float v[8]; zx0_shift8(zx, mu, R, col0 + k, v);
        if (dotanh) {
#pragma unroll
            for (int u = 0; u < 8; ++u) v[u] = tanh_fast(v[u]);
        }
        return make_uint4(pack2(v[0], v[1]), pack2(v[2], v[3]), pack2(v[4], v[5]), pack2(v[6], v[7]));
    }
};
template <int MAT>
struct EpiLora {
    int d; const float* bias; bf16_t* lw; unsigned char* as; float* bon; const bf16_t* zx; const float* mu; const float* ka; const float* rk; int m0, n0;
    __device__ void operator()(const float* Cs, int pass, int tid) const {
#pragma unroll 1
        for (int i = 0; i < 4; ++i) {
            const int c = tid + 256 * i, row = c >> 4, col8 = (c & 15) * 8;
            const int R = m0 + pass * 64 + row, col = n0 + col8;
            const float4 a = *(const float4*)&Cs[row * CS_LD + col8], bq = *(const float4*)&Cs[row * CS_LD + col8 + 4];
            const float x[8] = {a.x, a.y, a.z, a.w, bq.x, bq.y, bq.z, bq.w};
            if constexpr (MAT == 0) {
                float o[8];
#pragma unroll
                for (int u = 0; u < 8; ++u) o[u] = -__expf(-softplus_fast(-(x[u] + bias[col + u])) - 0.5f);
                *(uint4*)&lw[(size_t)R * 512 + col] = make_uint4(pack2(o[0], o[1]), pack2(o[2], o[3]), pack2(o[4], o[5]), pack2(o[6], o[7]));
            } else {
                float r8[8], k8[8], bsum = 0.f;
                zx0_shift8(zx, mu, R, 256 + col, r8);
                zx0_shift8(zx, mu, R, 768 + col, k8);
                unsigned q0 = 0u, q1 = 0u;
#pragma unroll
                for (int u = 0; u < 8; ++u) {
                    const float sg = sigmoidf_(x[u] + bias[col + u]);
                    const float kd = k8[u] * (1.f + (sg - 1.f) * ka[col + u]);
                    bsum += r8[u] * kd * rk[col + u];
                    const unsigned qq = ((unsigned)(sg * 255.f + 0.5f)) << (8 * (u & 3));
                    if (u < 4) q0 |= qq; else q1 |= qq;
                }
                *(uint2*)&as[(size_t)R * 512 + col] = make_uint2(q0, q1);
                bsum += __shfl_xor(bsum, 1); bsum += __shfl_xor(bsum, 2); bsum += __shfl_xor(bsum, 4);
                if ((c & 7) == 0) bon[(size_t)R * 16 + (col >> 6) * 2 + d] = bsum;
            }
        }
    }
};
template <int MAT>
__device__ void phase_rw_lora_mat(const W p, unsigned char* smem, int bid, int nblk) {
    const int total = (NTOK / 128) * 4 * 2;
    for (int t = bid; t < total; t += nblk) {
        const int d = t & 1, nt = (t >> 1) & 3, mt = t >> 3;
        LdLora al{WSP(bf16_t, WS_ZX), PAR(PAR_SHIFT), (MAT ? 1920 : 1792) + d * 64, MAT == 0};
        LdBf16 bl{WSP(bf16_t, MAT ? WS_A2T : WS_W2T) + (size_t)d * 512 * 64, 64};
        EpiLora<MAT> epi{d, PAR(MAT ? PAR_A0 : PAR_W0) + d * 512, WSP(bf16_t, WS_RWLW) + (size_t)d * NTOK * 512, WSP(unsigned char, WS_RWAS) + (size_t)d * NTOK * 512,
                         WSP(float, WS_BON), WSP(bf16_t, WS_ZX), PAR(PAR_SHIFT), PAR(PAR_KA), PAR(PAR_RK), mt * 128, nt * 128};
        gemm_tile<64>(al, bl, 64, mt * 128, nt * 128, epi, smem);
    }
}
__device__ void phase_rw_lora(const W p, unsigned char* smem, int bid, int nblk) {
    phase_rw_lora_mat<0>(p, smem, bid, nblk);
    phase_rw_lora_mat<1>(p, smem, bid, nblk);
}

#define RW_CH 32
struct RwkvSmem {
    float dec[RW_CH][64], aa[RW_CH][64], bb[RW_CH][64], kd[RW_CH][64], rr[RW_CH][64];
    float vv[RW_CH][16];
    float yo[RW_CH][16];
};
struct RwStage { uint4 r8, k8, lw8; uint2 as8; float nrm; float v[8]; };
__device__ __forceinline__ int rw_chunk_s0(int d, int cc) {
    if (d == 0) return RW_CH * cc;
    return (cc < LC / RW_CH) ? RW_CH * (LC / RW_CH - 1 - cc) : LC + RW_CH * (TT / RW_CH - 1 - (cc - LC / RW_CH));
}
__device__ __forceinline__ void rw_stage_load(const W p, RwStage& st, int b, int h, int d, int q, int cc, int tid) {
    const int s0 = rw_chunk_s0(d, cc);
    const int j = tid >> 3, c8 = (tid & 7) * 8;
    const int s = d ? (s0 + RW_CH - 1 - j) : (s0 + j);
    const size_t R = (size_t)b * SS + s;
    const size_t o = (((size_t)(b * 8 + h)) * SS + s) * 64 + c8;
    st.r8 = *(const uint4*)(WSP(bf16_t, WS_RWR) + o);
    st.k8 = *(const uint4*)(WSP(bf16_t, WS_RWK) + o);
    st.lw8 = *(const uint4*)(WSP(bf16_t, WS_RWLW) + ((size_t)d * NTOK + R) * 512 + h * 64 + c8);
    st.as8 = *(const uint2*)(WSP(unsigned char, WS_RWAS) + ((size_t)d * NTOK + R) * 512 + h * 64 + c8);
    st.nrm = WSP(float, WS_RWNRM)[((size_t)(b * 8 + h)) * SS + s];
    if ((tid & 7) < 2) zx0_shift8(WSP(bf16_t, WS_ZX), PAR(PAR_SHIFT), (int)R, 1280 + h * 64 + q * 16 + (tid & 7) * 8, st.v);
}
__device__ __forceinline__ void rw_stage_store(const RwStage& st, RwkvSmem& sm, const float (&kkc)[8], const float (&kac)[8], int tid) {
    const int j = tid >> 3, c8 = (tid & 7) * 8;
    const unsigned ru[4] = {st.r8.x, st.r8.y, st.r8.z, st.r8.w}, ku[4] = {st.k8.x, st.k8.y, st.k8.z, st.k8.w}, lu[4] = {st.lw8.x, st.lw8.y, st.lw8.z, st.lw8.w};
    const unsigned au[2] = {st.as8.x, st.as8.y};
    float dec[8], aa[8], bb[8], kd[8], rr[8];
#pragma unroll
    for (int u = 0; u < 8; ++u) {
        const float kt = (u & 1) ? bfhi(ku[u >> 1]) : bflo(ku[u >> 1]);
        const float rt = (u & 1) ? bfhi(ru[u >> 1]) : bflo(ru[u >> 1]);
        const float lw = (u & 1) ? bfhi(lu[u >> 1]) : bflo(lu[u >> 1]);
        const float a = (float)((au[u >> 2] >> (8 * (u & 3))) & 255u) * (1.f / 255.f);
        const float kk = kt * kkc[u] * st.nrm;
        dec[u] = __expf(lw); aa[u] = -kk; bb[u] = kk * a; kd[u] = kt * (1.f + (a - 1.f) * kac[u]); rr[u] = rt;
    }
    *(float4*)&sm.dec[j][c8] = make_float4(dec[0], dec[1], dec[2], dec[3]); *(float4*)&sm.dec[j][c8 + 4] = make_float4(dec[4], dec[5], dec[6], dec[7]);
    *(float4*)&sm.aa[j][c8] = make_float4(aa[0], aa[1], aa[2], aa[3]);     *(float4*)&sm.aa[j][c8 + 4] = make_float4(aa[4], aa[5], aa[6], aa[7]);
    *(float4*)&sm.bb[j][c8] = make_float4(bb[0], bb[1], bb[2], bb[3]);     *(float4*)&sm.bb[j][c8 + 4] = make_float4(bb[4], bb[5], bb[6], bb[7]);
    *(float4*)&sm.kd[j][c8] = make_float4(kd[0], kd[1], kd[2], kd[3]);     *(float4*)&sm.kd[j][c8 + 4] = make_float4(kd[4], kd[5], kd[6], kd[7]);
    *(float4*)&sm.rr[j][c8] = make_float4(rr[0], rr[1], rr[2], rr[3]);     *(float4*)&sm.rr[j][c8 + 4] = make_float4(rr[4], rr[5], rr[6], rr[7]);
    if ((tid & 7) < 2) {
        *(float4*)&sm.vv[j][(tid & 7) * 8] = make_float4(st.v[0], st.v[1], st.v[2], st.v[3]);
        *(float4*)&sm.vv[j][(tid & 7) * 8 + 4] = make_float4(st.v[4], st.v[5], st.v[6], st.v[7]);
    }
}
__device__ void rwkv_scan_item(const W p, int item, unsigned char* smem_raw) {
    RwkvSmem& sm = *(RwkvSmem*)smem_raw;
    const int q = item & 3, d = (item >> 2) & 1, h = (item >> 3) & 7, b = item >> 6;
    const int tid = tidx(), lane = tid & 63, wave = tid >> 6;
    float S0 = 0.f, S1 = 0.f, S2 = 0.f, S3 = 0.f;
    const int kseg = lane & 15, rowl = wave * 4 + (lane >> 4);
    bf16_t* yb = WSP(bf16_t, WS_YB) + (size_t)d * NTOK * 512;
    float kkc[8], kac[8];
#pragma unroll
    for (int u = 0; u < 8; ++u) { kkc[u] = PAR(PAR_KK)[h * 64 + (tid & 7) * 8 + u]; kac[u] = PAR(PAR_KA)[h * 64 + (tid & 7) * 8 + u]; }
    RwStage st;
    rw_stage_load(p, st, b, h, d, q, 0, tid);
    for (int cc = 0; cc < SS / RW_CH; ++cc) {
        const int s0 = rw_chunk_s0(d, cc);
        __syncthreads();
        rw_stage_store(st, sm, kkc, kac, tid);
        __syncthreads();
        if (cc + 1 < SS / RW_CH) rw_stage_load(p, st, b, h, d, q, cc + 1, tid);
        float yk0 = 0.f, yk1 = 0.f;
#pragma unroll
        for (int j = 0; j < RW_CH; ++j) {
            const float4 w4 = *(const float4*)&sm.dec[j][kseg * 4];
            const float4 a4 = *(const float4*)&sm.aa[j][kseg * 4];
            const float4 b4 = *(const float4*)&sm.bb[j][kseg * 4];
            const float4 k4 = *(const float4*)&sm.kd[j][kseg * 4];
            const float4 r4 = *(const float4*)&sm.rr[j][kseg * 4];
            const float vj = sm.vv[j][rowl];
            float sa = (S0 * a4.x + S1 * a4.y) + (S2 * a4.z + S3 * a4.w);
            sa = row16_sum(sa);
            S0 = S0 * w4.x + sa * b4.x + vj * k4.x;
            S1 = S1 * w4.y + sa * b4.y + vj * k4.y;
            S2 = S2 * w4.z + sa * b4.z + vj * k4.z;
            S3 = S3 * w4.w + sa * b4.w + vj * k4.w;
            float y = (S0 * r4.x + S1 * r4.y) + (S2 * r4.z + S3 * r4.w);
            y = row16_sum(y);
            if (j < 16) yk0 = (kseg == j) ? y : yk0; else yk1 = (kseg == j - 16) ? y : yk1;
        }
        {
            const int sA = d ? (s0 + RW_CH - 1 - kseg) : (s0 + kseg), sB = d ? (s0 + RW_CH - 17 - kseg) : (s0 + 16 + kseg);
            yb[((size_t)b * SS + sA) * 512 + h * 64 + q * 16 + rowl] = f2bf(yk0);
            yb[((size_t)b * SS + sB) * 512 + h * 64 + q * 16 + rowl] = f2bf(yk1);
        }
    }
}

#define RLD 72
constexpr size_t WS_RWPHI = WS_TABU0;
constexpr size_t WS_RWG5  = WS_TABU0 + (size_t)8448 * 8192;
constexpr size_t WS_RWG5B = WS_ZX + (size_t)NTOK * ZW0 * 2;
constexpr size_t WS_RWR2  = WS_MIX;
static_assert(WS_RWG5 + (size_t)7936 * 8192 <= WS_ZX, "G5 part A fits");
static_assert(WS_RWG5B + (size_t)512 * 8192 <= WS_ZX + (size_t)NTOK * ZW1 * 2, "G5 part B fits");
__device__ __forceinline__ bf16_t* rw_g5_ptr(const W p, int item) {
    return item < 7936 ? WSP(bf16_t, WS_RWG5) + (size_t)item * 4096 : WSP(bf16_t, WS_RWG5B) + (size_t)(item - 7936) * 4096;
}
__device__ __forceinline__ int rw_chunk64_s0(int d, int cc) { return d == 0 ? 64 * cc : (cc < 4 ? 64 * (3 - cc) : LC + 64 * (127 - (cc - 4))); }
__device__ __forceinline__ void mmq64(const bf16_t* A, const bf16_t* Bt, int qi, int qj, int l31, int hh, f32x16& acc) {
#pragma unroll
    for (int kk = 0; kk < 4; ++kk) {
        const bf16x8 a = *(const bf16x8*)&A[(32 * qi + l31) * RLD + 16 * kk + 8 * hh];
        const bf16x8 b = *(const bf16x8*)&Bt[(32 * qj + l31) * RLD + 16 * kk + 8 * hh];
        acc = __builtin_amdgcn_mfma_f32_32x32x16_bf16(a, b, acc, 0, 0, 0);
    }
}
#define ACC_ROW(r, qi, hh) (32 * (qi) + ((r) & 3) + 8 * ((r) >> 2) + 4 * (hh))
__device__ __forceinline__ void acc_zero(f32x16& a) {
#pragma unroll
    for (int r = 0; r < 16; ++r) a[r] = 0.f;
}
__device__ __forceinline__ void st_rm(bf16_t* D, const f32x16& acc, int qi, int qj, int l31, int hh) {
#pragma unroll
    for (int r = 0; r < 16; ++r) D[ACC_ROW(r, qi, hh) * RLD + 32 * qj + l31] = f2bf(acc[r]);
}
__device__ __forceinline__ float rcp_fast(float x) { return __builtin_amdgcn_rcpf(x); }
__device__ __forceinline__ void rw1_item(const W p, int item, unsigned char* smem) {
    const int chain = item / 132, cc = item - chain * 132;
    const int d = chain & 1, h = (chain >> 1) & 7, b = chain >> 4;
    const int s0 = rw_chunk64_s0(d, cc);
    const int seg_lo = (s0 < LC) ? 0 : LC, seg_hi = (s0 < LC) ? LC : SS;
    const int tid = tidx(), lane = tid & 63, wave = tid >> 6, l31 = lane & 31, hh = lane >> 5, qi = wave >> 1, qj = wave & 1;
    const int tau = tid >> 2, kq = tid & 3, k0 = kq * 16;
    bf16_t* M0 = (bf16_t*)smem;            bf16_t* M1 = M0 + 64 * RLD; bf16_t* M2 = M1 + 64 * RLD; bf16_t* M3 = M2 + 64 * RLD;
    bf16_t* M4 = M3 + 64 * RLD;            bf16_t* M5 = M4 + 64 * RLD; bf16_t* M6 = M5 + 64 * RLD;
    float* gam = (float*)(smem + 7 * 64 * RLD * 2);
    bf16_t* T11 = (bf16_t*)(gam + 64);
    bf16_t* Wrm = T11 + 32 * 40;
    float* muS = gam + 64;
    float* hcS = muS + 640;
    float* LW = (float*)smem;
    bf16_t* AS = (bf16_t*)(LW + 64 * 64);
    float* tot = (float*)(AS + 64 * 64);
    const bf16_t* zx = WSP(bf16_t, WS_ZX);
    const float* mu = PAR(PAR_SHIFT);
    unsigned* scr = (unsigned*)(WSP(bf16_t, WS_YA) + (size_t)bidx() * 4 * 4096 + tau * 64 + k0);
    const int colr = 256 + h * 64, colk = 768 + h * 64, colv = 1280 + h * 64, colw = 1792 + d * 64, cola = 1920 + d * 64;
    __syncthreads();
    {
        bf16_t* raw = (bf16_t*)smem;
        u32x4v rv[11];
#pragma unroll
        for (int q = 0; q < 11; ++q) {
            const int c = tid + 256 * q;
            const int cc = c < 5 * 66 * 8 ? c : 5 * 66 * 8 - 1;
            const int c8 = (cc & 7) * 8, rix = (cc >> 3) % 66, sl = cc / (8 * 66);
            int s = s0 - 1 + rix;
            const bool inr = s >= seg_lo && s < seg_hi;
            s = inr ? s : seg_lo;
            const int col = (sl == 0 ? colr : sl == 1 ? colk : sl == 2 ? colv : sl == 3 ? colw : cola) + c8;
            const u32x4v v = *(const u32x4v*)&zx[((size_t)b * SS + s) * ZW0 + col];
            rv[q] = inr ? v : (u32x4v){0u, 0u, 0u, 0u};
        }
        float m0v[2], m1v[2];
#pragma unroll
        for (int q = 0; q < 2; ++q) {
            const int e = tid + 256 * q, ee = e < 320 ? e : 319;
            const int sl = ee >> 6, ch = ee & 63;
            const int mc = (sl == 0 ? colr : sl == 1 ? colk : sl == 2 ? colv : sl == 3 ? colw : cola) - 256 + ch;
            m0v[q] = mu[mc]; m1v[q] = mu[1920 + mc];
        }
        const float hcv = PAR(tid < 64 ? PAR_KK : tid < 128 ? PAR_KA : PAR_RK)[h * 64 + (tid & 63)];
#pragma unroll
        for (int q = 0; q < 11; ++q) {
            const int c = tid + 256 * q;
            if (c < 5 * 66 * 8) { const int c8 = (c & 7) * 8, rix = (c >> 3) % 66, sl = c / (8 * 66); *(u32x4v*)&raw[(sl * 66 + rix) * 64 + c8] = rv[q]; }
        }
#pragma unroll
        for (int q = 0; q < 2; ++q) { const int e = tid + 256 * q; if (e < 320) { muS[e * 2] = m0v[q]; muS[e * 2 + 1] = m1v[q]; } }
        if (tid < 192) hcS[tid] = hcv;
    }
    __syncthreads();
    unsigned rpa[8], kpa[8], vpa[8], atp[8], rtp[8], btp[8], ktp[8];
    {
        const bf16_t* raw = (const bf16_t*)smem;
        const int jj = d ? (63 - tau) : tau;
#pragma unroll
        for (int sl = 0; sl < 5; ++sl) {
            const uint4* rp_ = (const uint4*)&raw[(sl * 66 + jj) * 64 + k0];
            const uint4 p0 = rp_[0], p1 = rp_[1], z0 = rp_[8], z1 = rp_[9], n0 = rp_[16], n1 = rp_[17];
            const unsigned pu[8] = {p0.x, p0.y, p0.z, p0.w, p1.x, p1.y, p1.z, p1.w}, zu[8] = {z0.x, z0.y, z0.z, z0.w, z1.x, z1.y, z1.z, z1.w},
                           nu[8] = {n0.x, n0.y, n0.z, n0.w, n1.x, n1.y, n1.z, n1.w};
            unsigned o[8];
#pragma unroll
            for (int u2 = 0; u2 < 8; ++u2) {
                const float4 mw = *(const float4*)&muS[(sl * 64 + k0 + 2 * u2) * 2];
                const float za = bflo(zu[u2]), zb = bfhi(zu[u2]);
                float oa = za + mw.x * (bflo(pu[u2]) - za) + mw.y * (bflo(nu[u2]) - za);
                float ob = zb + mw.z * (bfhi(pu[u2]) - zb) + mw.w * (bfhi(nu[u2]) - zb);
                if (sl == 3) { oa = tanh_fast(oa); ob = tanh_fast(ob); }
                o[u2] = pack2(oa, ob);
            }
            if (sl < 3) {
#pragma unroll
                for (int u2 = 0; u2 < 8; ++u2) { if (sl == 0) rpa[u2] = o[u2]; else if (sl == 1) kpa[u2] = o[u2]; else vpa[u2] = o[u2]; }
            }
            else { bf16_t* Dm = (sl == 3 ? M5 : M6); *(uint4*)&Dm[tau * RLD + k0] = make_uint4(o[0], o[1], o[2], o[3]); *(uint4*)&Dm[tau * RLD + k0 + 8] = make_uint4(o[4], o[5], o[6], o[7]); }
        }
    }
    __syncthreads();
    {
        f32x16 aw, aa; acc_zero(aw); acc_zero(aa);
        const bf16_t* w2t = WSP(bf16_t, WS_W2T) + ((size_t)d * 512 + h * 64 + 32 * qj + l31) * 64 + 8 * hh;
        const bf16_t* a2t = WSP(bf16_t, WS_A2T) + ((size_t)d * 512 + h * 64 + 32 * qj + l31) * 64 + 8 * hh;
#pragma unroll
        for (int kk = 0; kk < 4; ++kk) {
            const bf16x8 xa = *(const bf16x8*)&M5[(32 * qi + l31) * RLD + 16 * kk + 8 * hh];
            const bf16x8 xb = *(const bf16x8*)&M6[(32 * qi + l31) * RLD + 16 * kk + 8 * hh];
            aw = __builtin_amdgcn_mfma_f32_32x32x16_bf16(xa, *(const bf16x8*)(w2t + 16 * kk), aw, 0, 0, 0);
            aa = __builtin_amdgcn_mfma_f32_32x32x16_bf16(xb, *(const bf16x8*)(a2t + 16 * kk), aa, 0, 0, 0);
        }
        const int n = 32 * qj + l31;
        const float w0 = PAR(PAR_W0)[d * 512 + h * 64 + n], a0 = PAR(PAR_A0)[d * 512 + h * 64 + n];
#pragma unroll
        for (int r = 0; r < 16; ++r) {
            const int t = ACC_ROW(r, qi, hh);
            LW[t * 64 + n] = -0.60653065971f * rcp_fast(1.f + __expf(-(aw[r] + w0)));
            AS[t * 64 + n] = f2bf(rcp_fast(1.f + __expf(-(aa[r] + a0))));
        }
    }
    __syncthreads();
    {
        const int k = tid & 63, part = tid >> 6;
        float run = 0.f;
#pragma unroll 4
        for (int i = 0; i < 16; ++i) { run += LW[(16 * part + i) * 64 + k]; LW[(16 * part + i) * 64 + k] = run; }
        tot[part * 64 + k] = run;
        __syncthreads();
        float off = 0.f;
        for (int pp = 0; pp < part; ++pp) off += tot[pp * 64 + k];
#pragma unroll 4
        for (int i = 0; i < 16; ++i) LW[(16 * part + i) * 64 + k] = __expf(LW[(16 * part + i) * 64 + k] + off);
    }
    __syncthreads();
    {
        float ss = 0.f;
#pragma unroll
        for (int u2 = 0; u2 < 8; ++u2) { const unsigned kp = kpa[u2]; const float a = bflo(kp) * hcS[k0 + 2 * u2], c = bfhi(kp) * hcS[k0 + 2 * u2 + 1]; ss += a * a + c * c; }
        ss += dppf<DPP_XOR1>(ss); ss += dppf<DPP_XOR2>(ss);
        const float nrm = rsqrtf(ss + 1e-12f);
        float bsum = 0.f;
#pragma unroll
        for (int u2 = 0; u2 < 8; ++u2) {
            const unsigned kp = kpa[u2], rp = rpa[u2], vp = vpa[u2];
            float fa[2], fr[2], fb[2], fk[2];
#pragma unroll
            for (int e = 0; e < 2; ++e) {
                const int k = k0 + 2 * u2 + e;
                const float kv = e ? bfhi(kp) : bflo(kp), rv = e ? bfhi(rp) : bflo(rp);
                const float eL = LW[tau * 64 + k], eLp = tau ? LW[(tau - 1) * 64 + k] : 1.f, sg = bf2f(AS[tau * 64 + k]);
                const float kk = kv * hcS[k] * nrm;
                const float kd = kv * (1.f + (sg - 1.f) * hcS[64 + k]);
                bsum += rv * kd * hcS[128 + k];
                const float eNL = rcp_fast(eL);
                fa[e] = -kk * eLp; fr[e] = rv * eL; fb[e] = kk * sg * eNL; fk[e] = kd * eNL;
                if (tau == 63) gam[k] = eL;
            }
            const unsigned pa = pack2(fa[0], fa[1]), pr = pack2(fr[0], fr[1]), pb = pack2(fb[0], fb[1]), pk = pack2(fk[0], fk[1]);
            *(unsigned*)&M4[tau * RLD + k0 + 2 * u2] = pa; *(unsigned*)&M5[tau * RLD + k0 + 2 * u2] = pb; *(unsigned*)&M6[tau * RLD + k0 + 2 * u2] = pk;
            atp[u2] = pa; rtp[u2] = pr; btp[u2] = pb; ktp[u2] = pk;
            M3[(k0 + 2 * u2) * RLD + tau] = (bf16_t)(vp & 0xffffu); M3[(k0 + 2 * u2 + 1) * RLD + tau] = (bf16_t)(vp >> 16);
        }
        bsum += dppf<DPP_XOR1>(bsum); bsum += dppf<DPP_XOR2>(bsum);
        if (kq == 0) { const int s = d ? (s0 + 63 - tau) : (s0 + tau); WSP(float, WS_BON)[((size_t)b * SS + s) * 16 + h * 2 + d] = bsum; }
    }
    __syncthreads();
#define CP_TM(D, a) { *(uint4*)&(D)[tau * RLD + k0] = make_uint4(a[0], a[1], a[2], a[3]); *(uint4*)&(D)[tau * RLD + k0 + 8] = make_uint4(a[4], a[5], a[6], a[7]); }
#define CP_KM(D, a, USEG) { _Pragma("unroll") for (int u2 = 0; u2 < 8; ++u2) { const unsigned q_ = a[u2]; const int kx_ = k0 + 2 * u2; \
        (D)[kx_ * RLD + tau] = f2bf(bflo(q_) * ((USEG) ? gam[kx_] : 1.f)); (D)[(kx_ + 1) * RLD + tau] = f2bf(bfhi(q_) * ((USEG) ? gam[kx_ + 1] : 1.f)); } }
    {
        const int sc = 32 * qj + l31;
        f32x16 x0, x1; acc_zero(x0); acc_zero(x1);
        mmq64(M4, M5, qi, qj, l31, hh, x0);
        mmq64(M4, M6, qi, qj, l31, hh, x1);
#pragma unroll
        for (int r = 0; r < 16; ++r) { const bool z = !(sc < ACC_ROW(r, qi, hh)); x0[r] = z ? 0.f : x0[r]; x1[r] = z ? 0.f : x1[r]; }
        st_rm(M0, x0, qi, qj, l31, hh);
        st_rm(M1, x1, qi, qj, l31, hh);
    }
    __syncthreads();
    CP_TM(M4, rtp)
    __syncthreads();
    {
        const int sc = 32 * qj + l31;
        f32x16 x0, x1; acc_zero(x0); acc_zero(x1);
        mmq64(M4, M5, qi, qj, l31, hh, x0);
        mmq64(M4, M6, qi, qj, l31, hh, x1);
#pragma unroll
        for (int r = 0; r < 16; ++r) { const bool z = !(sc <= ACC_ROW(r, qi, hh)); x0[r] = z ? 0.f : x0[r]; x1[r] = z ? 0.f : x1[r]; }
        st_rm(M2, x0, qi, qj, l31, hh);
        __syncthreads();
        st_rm(M6, x1, qi, qj, l31, hh);
    }
    __syncthreads();
    if (wave == 0) {
        const int blk = lane >> 5, rr = lane & 31;
        float Tr[32];
        u32x4v rq0 = {0u, 0u, 0u, 0u}, rq1 = rq0, rq2 = rq0, rq3 = rq0;
#pragma unroll
        for (int t = 0; t < 32; ++t) {
            u32x4v nq0 = rq0, nq1 = rq1, nq2 = rq2, nq3 = rq3;
            if (t + 1 < 32) {
                const bf16_t* nrow = &M0[(32 * blk + t + 1) * RLD + 32 * blk];
                nq0 = *(const u32x4v*)&nrow[0];
                if (t + 1 > 8)  nq1 = *(const u32x4v*)&nrow[8];
                if (t + 1 > 16) nq2 = *(const u32x4v*)&nrow[16];
                if (t + 1 > 24) nq3 = *(const u32x4v*)&nrow[24];
            }
            float ac4[4] = {(t == rr) ? 1.f : 0.f, 0.f, 0.f, 0.f};
#pragma unroll
            for (int c8 = 0; c8 * 8 < t; ++c8) {
                const u32x4v q = c8 == 0 ? rq0 : c8 == 1 ? rq1 : c8 == 2 ? rq2 : rq3;
#pragma unroll
                for (int e = 0; e < 8; ++e) if (8 * c8 + e < t) ac4[e & 3] += Tr[8 * c8 + e] * ((e & 1) ? bfhi(q[e >> 1]) : bflo(q[e >> 1]));
            }
            const float acc = (ac4[0] + ac4[1]) + (ac4[2] + ac4[3]);
            Tr[t] = acc;
            M5[(32 * blk + t) * RLD + 32 * blk + rr] = f2bf(acc);
            if (blk == 0) { T11[rr * 40 + t] = f2bf(acc); M5[t * RLD + 32 + rr] = 0; }
            rq0 = nq0; rq1 = nq1; rq2 = nq2; rq3 = nq3;
        }
        f32x16 wv; acc_zero(wv);
#pragma unroll
        for (int kk = 0; kk < 2; ++kk) {
            const bf16x8 a = *(const bf16x8*)&T11[l31 * 40 + 16 * kk + 8 * hh];
            const bf16x8 bq = *(const bf16x8*)&M0[(32 + l31) * RLD + 16 * kk + 8 * hh];
            wv = __builtin_amdgcn_mfma_f32_32x32x16_bf16(a, bq, wv, 0, 0, 0);
        }
#pragma unroll
        for (int r = 0; r < 16; ++r) Wrm[ACC_ROW(r, 0, hh) * 40 + l31] = f2bf(wv[r]);
        f32x16 t12; acc_zero(t12);
#pragma unroll
        for (int kk = 0; kk < 2; ++kk) {
            const bf16x8 a = *(const bf16x8*)&Wrm[l31 * 40 + 16 * kk + 8 * hh];
            const bf16x8 bq = *(const bf16x8*)&M5[(32 + l31) * RLD + 32 + 16 * kk + 8 * hh];
            t12 = __builtin_amdgcn_mfma_f32_32x32x16_bf16(a, bq, t12, 0, 0, 0);
        }
#pragma unroll
        for (int g4 = 0; g4 < 4; ++g4)
            *(uint2*)&M5[(32 + l31) * RLD + 8 * g4 + 4 * hh] = make_uint2(pack2(t12[4 * g4], t12[4 * g4 + 1]), pack2(t12[4 * g4 + 2], t12[4 * g4 + 3]));
    }
    __syncthreads();
    { f32x16 x; acc_zero(x); mmq64(M3, M1, qi, qj, l31, hh, x); __syncthreads(); st_rm(M0, x, qi, qj, l31, hh); }
    CP_KM(M1, atp, false)
    __syncthreads();
    { f32x16 xa, xg; acc_zero(xa); acc_zero(xg);
      mmq64(M1, M5, qi, qj, l31, hh, xa);
      mmq64(M0, M5, qi, qj, l31, hh, xg);
      st_rm(M4, xa, qi, qj, l31, hh);
      __syncthreads();
      st_rm(M1, xg, qi, qj, l31, hh); }
    __syncthreads();
    CP_TM(M0, rtp)
    CP_KM(M5, btp, true)
    __syncthreads();
    {
        const int cix = 32 * qj + l31;
        f32x16 xr, xp; acc_zero(xr); acc_zero(xp);
        mmq64(M2, M4, qi, qj, l31, hh, xr);
        mmq64(M5, M4, qi, qj, l31, hh, xp);
        const float gc = gam[cix];
#pragma unroll
        for (int r = 0; r < 16; ++r) { xr[r] += bf2f(M0[ACC_ROW(r, qi, hh) * RLD + cix]); xp[r] += (ACC_ROW(r, qi, hh) == cix) ? gc : 0.f; }
        __syncthreads();
        st_rm(M0, xr, qi, qj, l31, hh); st_rm(M4, xp, qi, qj, l31, hh);
    }
    __syncthreads();
    {
        bf16_t* r2g = WSP(bf16_t, WS_RWR2) + (size_t)item * 4096;
        bf16_t* phg = WSP(bf16_t, WS_RWPHI) + (size_t)item * 4096;
        for (int c = tid; c < 512; c += 256) {
            const int row = c >> 3, c8 = (c & 7) * 8;
            *(uint4*)&r2g[row * 64 + c8] = *(const uint4*)&M0[row * RLD + c8];
            *(uint4*)&phg[row * 64 + c8] = *(const uint4*)&M4[row * RLD + c8];
        }
    }
    f32x16 xo; acc_zero(xo);
    {
        f32x16 x; acc_zero(x);
        mmq64(M1, M2, qi, qj, l31, hh, x); mmq64(M3, M6, qi, qj, l31, hh, x);
        mmq64(M1, M5, qi, qj, l31, hh, xo);
        const int t = 32 * qj + l31;
        const int s = d ? (s0 + 63 - t) : (s0 + t);
        bf16_t* yrow = WSP(bf16_t, WS_YB) + (size_t)d * NTOK * 512 + ((size_t)b * SS + s) * 512 + h * 64;
#pragma unroll
        for (int g4 = 0; g4 < 4; ++g4)
            *(uint2*)&yrow[32 * qi + 8 * g4 + 4 * hh] = make_uint2(pack2(x[4 * g4], x[4 * g4 + 1]), pack2(x[4 * g4 + 2], x[4 * g4 + 3]));
    }
    __syncthreads();
    CP_KM(M0, ktp, true)
    __syncthreads();
    { mmq64(M3, M0, qi, qj, l31, hh, xo); st_rm(M4, xo, qi, qj, l31, hh); }
    __syncthreads();
    {
        bf16_t* g5g = rw_g5_ptr(p, item);
        for (int c = tid; c < 512; c += 256) { const int row = c >> 3, c8 = (c & 7) * 8; *(uint4*)&g5g[row * 64 + c8] = *(const uint4*)&M4[row * RLD + c8]; }
    }
#undef CP_TM
#undef CP_KM
}
#define RW1_SMEM_BYTES (7 * 64 * RLD * 2 + 256 + 2 * 32 * 40 * 2)
static_assert(256 + 640 * 4 + 192 * 4 <= 256 + 2 * 32 * 40 * 2, "stage A..E tables fit in the scratch tail");

#define RW2_BUF_BYTES (3 * 64 * RLD * 2)
struct Rw2Stage { u32x4v q0, q1, q2, q3, q4, q5; };
__device__ __forceinline__ void rw2_issue(const W p, int item, int tid, Rw2Stage& st) {
    const bf16_t* s0_ = WSP(bf16_t, WS_RWPHI) + (size_t)item * 4096; const bf16_t* s1_ = WSP(bf16_t, WS_RWR2) + (size_t)item * 4096; const bf16_t* s2_ = rw_g5_ptr(p, item);
    const int o0 = (tid >> 3) * 64 + (tid & 7) * 8, o1 = o0 + 32 * 64;
    st.q0 = *(const u32x4v*)&s0_[o0]; st.q1 = *(const u32x4v*)&s0_[o1];
    st.q2 = *(const u32x4v*)&s1_[o0]; st.q3 = *(const u32x4v*)&s1_[o1];
    st.q4 = *(const u32x4v*)&s2_[o0]; st.q5 = *(const u32x4v*)&s2_[o1];
}
__device__ __forceinline__ void rw2_commit(unsigned char* buf, int tid, const Rw2Stage& st) {
    bf16_t* bb = (bf16_t*)buf;
    const int o0 = (tid >> 3) * RLD + (tid & 7) * 8, o1 = o0 + 32 * RLD;
    *(u32x4v*)&bb[o0] = st.q0; *(u32x4v*)&bb[o1] = st.q1;
    *(u32x4v*)&bb[64 * RLD + o0] = st.q2; *(u32x4v*)&bb[64 * RLD + o1] = st.q3;
    *(u32x4v*)&bb[128 * RLD + o0] = st.q4; *(u32x4v*)&bb[128 * RLD + o1] = st.q5;
}
__device__ __forceinline__ void rw2_step(const unsigned char* bufc, f32x4 (&st)[4], bf16_t* Yt, int wave, int l15, int g) {
    const bf16_t* PH = (const bf16_t*)bufc; const bf16_t* R2 = PH + 64 * RLD; const bf16_t* G5 = R2 + 64 * RLD;
    bf16x8 sb[2];
#pragma unroll
    for (int s2 = 0; s2 < 2; ++s2) {
        union { bf16x8 v; unsigned u[4]; } pk;
        pk.u[0] = pack2(st[2 * s2][0], st[2 * s2][1]); pk.u[1] = pack2(st[2 * s2][2], st[2 * s2][3]);
        pk.u[2] = pack2(st[2 * s2 + 1][0], st[2 * s2 + 1][1]); pk.u[3] = pack2(st[2 * s2 + 1][2], st[2 * s2 + 1][3]);
        sb[s2] = pk.v;
    }
    f32x4 yn[4], sn[4];
#pragma unroll
    for (int mt = 0; mt < 4; ++mt) {
        yn[mt] = (f32x4){0.f, 0.f, 0.f, 0.f};
        const uint2 gq = *(const uint2*)&G5[(16 * wave + l15) * RLD + 16 * mt + 4 * g];
        sn[mt] = (f32x4){bflo(gq.x), bfhi(gq.x), bflo(gq.y), bfhi(gq.y)};
#pragma unroll
        for (int s2 = 0; s2 < 2; ++s2) {
            union { bf16x8 v; uint2 hq[2]; } fa, fb;
            fa.hq[0] = *(const uint2*)&R2[(16 * mt + l15) * RLD + 32 * s2 + 4 * g]; fa.hq[1] = *(const uint2*)&R2[(16 * mt + l15) * RLD + 32 * s2 + 16 + 4 * g];
            fb.hq[0] = *(const uint2*)&PH[(16 * mt + l15) * RLD + 32 * s2 + 4 * g]; fb.hq[1] = *(const uint2*)&PH[(16 * mt + l15) * RLD + 32 * s2 + 16 + 4 * g];
            yn[mt] = __builtin_amdgcn_mfma_f32_16x16x32_bf16(fa.v, sb[s2], yn[mt], 0, 0, 0);
            sn[mt] = __builtin_amdgcn_mfma_f32_16x16x32_bf16(fb.v, sb[s2], sn[mt], 0, 0, 0);
        }
    }
#pragma unroll
    for (int mt = 0; mt < 4; ++mt)
#pragma unroll
        for (int r = 0; r < 4; ++r) Yt[(16 * mt + 4 * g + r) * RLD + 16 * wave + l15] = f2bf(yn[mt][r]);
#pragma unroll
    for (int mt = 0; mt < 4; ++mt) st[mt] = sn[mt];
}
__device__ __forceinline__ void rw2_yaddr(int d, int cc, int tid, size_t& off) {
    const int s0 = rw_chunk64_s0(d, cc < 132 ? cc : 131);
    const int t = tid >> 2; const int s = d ? (s0 + 63 - t) : (s0 + t);
    off = (size_t)s * 512 + (tid & 3) * 16;
}
__device__ __forceinline__ void rw2_yout(bf16_t* ybase, size_t off, const bf16_t* Yt, int tid, const u32x4v& o0, const u32x4v& o1) {
    const int t = tid >> 2, c0 = (tid & 3) * 16;
    const u32x4v a0 = *(const u32x4v*)&Yt[t * RLD + c0], a1 = *(const u32x4v*)&Yt[t * RLD + c0 + 8];
    u32x4v r0, r1;
#pragma unroll
    for (int i = 0; i < 4; ++i) {
        r0[i] = pack2(bflo(o0[i]) + bflo(a0[i]), bfhi(o0[i]) + bfhi(a0[i]));
        r1[i] = pack2(bflo(o1[i]) + bflo(a1[i]), bfhi(o1[i]) + bfhi(a1[i]));
    }
    *(u32x4v*)&ybase[off] = r0; *(u32x4v*)&ybase[off + 8] = r1;
}
__device__ __forceinline__ void rw2_chain(const W p, int chain, unsigned char* smem) {
    const int d = chain & 1, h = (chain >> 1) & 7, b = chain >> 4;
    const int tid = tidx(), lane = tid & 63, wave = tid >> 6, l15 = lane & 15, g = lane >> 4;
    f32x4 st[4];
#pragma unroll
    for (int mt = 0; mt < 4; ++mt) st[mt] = (f32x4){0.f, 0.f, 0.f, 0.f};
    bf16_t* ybase = WSP(bf16_t, WS_YB) + (size_t)d * NTOK * 512 + (size_t)b * SS * 512 + h * 64;
    unsigned char* buf0 = smem; unsigned char* buf1 = smem + RW2_BUF_BYTES;
    bf16_t* Yt = (bf16_t*)(smem + 2 * RW2_BUF_BYTES);
    const int it0 = chain * 132;
    Rw2Stage ra, rb;
    u32x4v oa0, oa1, ob0, ob1; size_t offa, offb;
    __syncthreads();
    rw2_issue(p, it0, tid, ra); rw2_issue(p, it0 + 1, tid, rb);
    rw2_commit(buf0, tid, ra); rw2_issue(p, it0 + 2, tid, ra);
    rw2_commit(buf1, tid, rb); rw2_issue(p, it0 + 3, tid, rb);
    rw2_yaddr(d, 0, tid, offa); oa0 = *(const u32x4v*)&ybase[offa]; oa1 = *(const u32x4v*)&ybase[offa + 8];
#pragma unroll 1
    for (int cc = 0; cc < 132; cc += 2) {
        rw2_yaddr(d, cc + 1, tid, offb); ob0 = *(const u32x4v*)&ybase[offb]; ob1 = *(const u32x4v*)&ybase[offb + 8];
        __syncthreads();
        rw2_step(buf0, st, Yt, wave, l15, g);
        __syncthreads();
        rw2_yout(ybase, offa, Yt, tid, oa0, oa1);
        rw2_commit(buf0, tid, ra);
        rw2_issue(p, it0 + (cc + 4 < 132 ? cc + 4 : 131), tid, ra);
        rw2_yaddr(d, cc + 2, tid, offa); oa0 = *(const u32x4v*)&ybase[offa]; oa1 = *(const u32x4v*)&ybase[offa + 8];
        __syncthreads();
        rw2_step(buf1, st, Yt, wave, l15, g);
        __syncthreads();
        rw2_yout(ybase, offb, Yt, tid, ob0, ob1);
        rw2_commit(buf1, tid, rb);
        rw2_issue(p, it0 + (cc + 5 < 132 ? cc + 5 : 131), tid, rb);
    }
    __syncthreads();
}
static_assert(2 * RW2_BUF_BYTES + 64 * RLD * 2 <= RW1_SMEM_BYTES, "RW2 ring + y tile fit");

struct EpiGlu {
    const bf16_t* ya; const float* bglu; bf16_t* mix; int m0, n0;
    __device__ void operator()(const float* Cs, int pass, int tid) const {
#pragma unroll
        for (int i = 0; i < 4; ++i) {
            const int c = tid + 256 * i, row = c >> 4, col8 = (c & 15) * 8;
            const int R = m0 + pass * 64 + row, col = n0 + col8;
            const uint4 yv = *(const uint4*)&ya[(size_t)R * 256 + col];
            const unsigned yu[4] = {yv.x, yv.y, yv.z, yv.w};
            unsigned o[4];
#pragma unroll
            for (int u = 0; u < 4; ++u) {
                const float y0 = bflo(yu[u]), y1 = bfhi(yu[u]);
                const float g0 = sigmoidf_(Cs[row * CS_LD + col8 + 2 * u] + bglu[col + 2 * u]);
                const float g1 = sigmoidf_(Cs[row * CS_LD + col8 + 2 * u + 1] + bglu[col + 2 * u + 1]);
                o[u] = pack2(y0 * g0, y1 * g1);
            }
            *(uint4*)&mix[(size_t)R * 768 + col] = make_uint4(o[0], o[1], o[2], o[3]);
        }
    }
};
__device__ void phase_glu(const W p, unsigned char* smem, int bid, int nblk) {
    LdBf16 al{WSP(bf16_t, WS_YA), 256};
    LdBf16 bl{WSP(bf16_t, WS_WGLUT), 256};
    for (int t = bid; t < (NTOK / 128) * 2; t += nblk) {
        const int m0 = (t >> 1) * 128, n0 = (t & 1) * 128;
        EpiGlu epi{WSP(bf16_t, WS_YA), PAR(PAR_BGLU), WSP(bf16_t, WS_MIX), m0, n0};
        gemm_tile<128>(al, bl, 256, m0, n0, epi, smem);
    }
}
struct LdGlo {
    const bf16_t* zx; const float* mu;
    typedef int RowCtx;
    __device__ RowCtx row(int R) const { return R; }
    __device__ uint4 load8(RowCtx R, int k) const {
        float v[8]; zx0_shift8(zx, mu, R, 2048 + k, v);
        uint4 o; o.x = pack2(sigmoidf_(v[0]), sigmoidf_(v[1])); o.y = pack2(sigmoidf_(v[2]), sigmoidf_(v[3]));
        o.z = pack2(sigmoidf_(v[4]), sigmoidf_(v[5])); o.w = pack2(sigmoidf_(v[6]), sigmoidf_(v[7]));
        return o;
    }
};
struct EpiRwkvOut {
    const bf16_t* yb0; const bf16_t* yb1; const float* bon; const bf16_t* zx; const float* mu; const float* gnw; const float* gnb; bf16_t* mix; int m0, n0;
    __device__ void operator()(const float* Cs, int pass, int tid) const {
#pragma unroll 1
        for (int i = 0; i < 4; ++i) {
            const int c = tid + 256 * i, row = c >> 4, col8 = (c & 15) * 8;
            const int R = m0 + pass * 64 + row, col = n0 + col8, head = col >> 6;
            const uint4 a = *(const uint4*)&yb0[(size_t)R * 512 + col], b = *(const uint4*)&yb1[(size_t)R * 512 + col];
            const unsigned au[4] = {a.x, a.y, a.z, a.w}, bu[4] = {b.x, b.y, b.z, b.w};
            float y[8], sum = 0.f, sq = 0.f;
#pragma unroll
            for (int u = 0; u < 4; ++u) { y[2 * u] = bflo(au[u]) + bflo(bu[u]); y[2 * u + 1] = bfhi(au[u]) + bfhi(bu[u]); }
#pragma unroll
            for (int u = 0; u < 8; ++u) sum += y[u];
            sum += __shfl_xor(sum, 1); sum += __shfl_xor(sum, 2); sum += __shfl_xor(sum, 4);
            const float mean = sum * (1.f / 64.f);
#pragma unroll
            for (int u = 0; u < 8; ++u) { const float dl = y[u] - mean; sq += dl * dl; }
            sq += __shfl_xor(sq, 1); sq += __shfl_xor(sq, 2); sq += __shfl_xor(sq, 4);
            const float rs = rsqrtf(sq * (1.f / 64.f) + 64e-5f);
            const float bc = bon[(size_t)R * 16 + head * 2] + bon[(size_t)R * 16 + head * 2 + 1];
            float v[8]; zx0_shift8(zx, mu, R, 1280 + col, v);
            const float4 g0 = *(const float4*)&Cs[row * CS_LD + col8], g1 = *(const float4*)&Cs[row * CS_LD + col8 + 4];
            const float gg[8] = {g0.x, g0.y, g0.z, g0.w, g1.x, g1.y, g1.z, g1.w};
            float o[8];
#pragma unroll
            for (int u = 0; u < 8; ++u) o[u] = ((y[u] - mean) * rs * gnw[col + u] + gnb[col + u] + bc * v[u]) * gg[u];
            *(uint4*)&mix[(size_t)R * 768 + 256 + col] = make_uint4(pack2(o[0], o[1]), pack2(o[2], o[3]), pack2(o[4], o[5]), pack2(o[6], o[7]));
        }
    }
};
__device__ void phase_rwkv_out(const W p, unsigned char* smem, int bid, int nblk) {
    LdGlo al{WSP(bf16_t, WS_ZX), PAR(PAR_SHIFT)};
    LdBf16 bl{WSP(bf16_t, WS_G2T), 128};
    for (int t = bid; t < (NTOK / 128) * 4; t += nblk) {
        const int m0 = (t >> 2) * 128, n0 = (t & 3) * 128;
        EpiRwkvOut epi{WSP(bf16_t, WS_YB), WSP(bf16_t, WS_YB) + (size_t)NTOK * 512, WSP(float, WS_BON), WSP(bf16_t, WS_ZX), PAR(PAR_SHIFT),
                       PAR(PAR_GNW), PAR(PAR_GNB), WSP(bf16_t, WS_MIX), m0, n0};
        gemm_tile<128>(al, bl, 128, m0, n0, epi, smem);
    }
}

__device__ void phase_gemm_wout(const W p, unsigned char* smem, int bid, int nblk, int layer) {
    const int K = layer ? 1024 : 768;
    LdBf16 al{WSP(bf16_t, WS_MIX), K};
    LdBf16 bl{WSP(bf16_t, layer ? WS_WOUT1T : WS_WOUT0T), K};
    const int total = (NTOK / 128) * 8;
    for (int t = xcd_swz(bid, nblk); t < total; t += nblk) {
        const int m0 = (t >> 3) * 128, n0 = (t & 7) * 128;
        if (layer && (m0 % SS) < LC) continue;
        EpiStoreBf16 epi{WSP(bf16_t, WS_ZX), 1024, m0, n0, NTOK};
        gemm_tile_dma(al.base, al.ld, bl.base, bl.ld, K, m0, n0, epi, smem);
    }
}

__device__ __forceinline__ void ln_row_store(float (&v)[16], const float* g, const float* bta, float* dst, int lane, const float* m2, bf16_t* hb) {
    float s = 0.f;
#pragma unroll
    for (int i = 0; i < 16; ++i) s += v[i];
    const float mean = wave_sum(s) * (1.f / 1024.f);
    float q = 0.f;
#pragma unroll
    for (int i = 0; i < 16; ++i) { const float dl = v[i] - mean; q += dl * dl; }
    const float rs = rsqrtf(wave_sum(q) * (1.f / 1024.f) + 1e-5f);
#pragma unroll
    for (int i = 0; i < 4; ++i) {
        const int k = i * 256 + lane * 4;
        const float4 gg = *(const float4*)&g[k], bb = *(const float4*)&bta[k];
        float4 o;
        o.x = (v[4 * i] - mean) * rs * gg.x + bb.x; o.y = (v[4 * i + 1] - mean) * rs * gg.y + bb.y;
        o.z = (v[4 * i + 2] - mean) * rs * gg.z + bb.z; o.w = (v[4 * i + 3] - mean) * rs * gg.w + bb.w;
        *(float4*)&dst[k] = o;
        const float4 sc = *(const float4*)&m2[4096 + k], sh = *(const float4*)&m2[3072 + k];
        *(uint2*)&hb[k] = make_uint2(pack2(o.x * (1.f + sc.x) + sh.x, o.y * (1.f + sc.y) + sh.y), pack2(o.z * (1.f + sc.z) + sh.z, o.w * (1.f + sc.w) + sh.w));
    }
}
__device__ void phase_ln1(const W p, int gwave_, int nwaves_, int layer, unsigned char* smem) {
    const int gwave = __builtin_amdgcn_readfirstlane(gwave_), nwaves = __builtin_amdgcn_readfirstlane(nwaves_);
    const int lane = tidx() & 63;
    const bf16_t* yx = WSP(bf16_t, WS_ZX);
    const float* mod = WSP(float, WS_MOD) + (size_t)layer * 5 * 6144;
    const float* g = PAR(layer ? PAR_LN1G1 : PAR_LN1G0);
    const float* bt = PAR(layer ? PAR_LN1B1 : PAR_LN1B0);
    const float* xlat = layer ? p.out : p.x;
    const float* xctx = layer ? WSP(float, WS_CTX) : p.ctx;
    float* sp = (float*)smem;
    for (int i = tidx(); i < 1024; i += 256) {
        sp[i] = g[i]; sp[1024 + i] = bt[i];
#pragma unroll
        for (int v = 0; v < 5; ++v) {
            sp[2048 + v * 1024 + i] = mod[v * 6144 + 2048 + i];
            sp[7168 + v * 1024 + i] = mod[v * 6144 + 4096 + i];
            sp[12288 + v * 1024 + i] = mod[v * 6144 + 3072 + i];
        }
    }
    __syncthreads();
    const int nv = layer ? NB * TT : NTOK;
    if (gwave >= nv) return;
#define LN1_TOK(J) (layer ? ((J) / TT) * SS + LC + ((J) % TT) : (J))
#define LN1_SRC(R_) ((R_) % SS < LC ? xctx + ((size_t)(((R_) / SS) * LC + (R_) % SS)) * DM : xlat + ((size_t)(((R_) / SS) * TT + (R_) % SS - LC)) * DM)
#define LN1_LOAD(XD, YD, R_) { const float* s_ = LN1_SRC(R_); const int l4_ = (tidx() & 63) * 4; \
        _Pragma("unroll") for (int i_ = 0; i_ < 4; ++i_) { const float4 x4_ = *(const float4*)&s_[i_ * 256 + l4_]; const uint2 y_ = *(const uint2*)&yx[(size_t)(R_) * 1024 + i_ * 256 + l4_]; \
            XD[4 * i_] = x4_.x; XD[4 * i_ + 1] = x4_.y; XD[4 * i_ + 2] = x4_.z; XD[4 * i_ + 3] = x4_.w; YD[2 * i_] = y_.x; YD[2 * i_ + 1] = y_.y; } }
    float xa[16]; unsigned ya[8];
    int R = LN1_TOK(gwave);
    LN1_LOAD(xa, ya, R)
    for (int jt = gwave; jt < nv; jt += nwaves) {
        const int b = R / SS, s = R - b * SS;
        float* dst = s < LC ? WSP(float, WS_CTX) + ((size_t)(b * LC + s)) * DM : p.out + ((size_t)(b * TT + s - LC)) * DM;
        const int var = s < LC ? 4 : b;
        const int Rn = LN1_TOK(jt + nwaves < nv ? jt + nwaves : jt);
        float xb[16]; unsigned yb[8];
        LN1_LOAD(xb, yb, Rn)
        float v[16];
#pragma unroll
        for (int i = 0; i < 4; ++i) {
            const int k = i * 256 + lane * 4;
            const float4 g4 = *(const float4*)&sp[2048 + var * 1024 + k];
            v[4 * i] = ALPHA_F * xa[4 * i] + g4.x * bflo(ya[2 * i]);         v[4 * i + 1] = ALPHA_F * xa[4 * i + 1] + g4.y * bfhi(ya[2 * i]);
            v[4 * i + 2] = ALPHA_F * xa[4 * i + 2] + g4.z * bflo(ya[2 * i + 1]); v[4 * i + 3] = ALPHA_F * xa[4 * i + 3] + g4.w * bfhi(ya[2 * i + 1]);
        }
        float sm = 0.f;
#pragma unroll
        for (int i = 0; i < 16; ++i) sm += v[i];
        const float mean = wave_sum(sm) * (1.f / 1024.f);
        float q = 0.f;
#pragma unroll
        for (int i = 0; i < 16; ++i) { const float dl = v[i] - mean; q += dl * dl; }
        const float rs = rsqrtf(wave_sum(q) * (1.f / 1024.f) + 1e-5f);
        bf16_t* hb = WSP(bf16_t, WS_HB) + (size_t)R * 1024;
#pragma unroll
        for (int i = 0; i < 4; ++i) {
            const int k = i * 256 + lane * 4;
            const float4 gg = *(const float4*)&sp[k], bb = *(const float4*)&sp[1024 + k];
            float4 o;
            o.x = (v[4 * i] - mean) * rs * gg.x + bb.x; o.y = (v[4 * i + 1] - mean) * rs * gg.y + bb.y;
            o.z = (v[4 * i + 2] - mean) * rs * gg.z + bb.z; o.w = (v[4 * i + 3] - mean) * rs * gg.w + bb.w;
            *(float4*)&dst[k] = o;
            const float4 sc = *(const float4*)&sp[7168 + var * 1024 + k], sh = *(const float4*)&sp[12288 + var * 1024 + k];
            *(uint2*)&hb[k] = make_uint2(pack2(o.x * (1.f + sc.x) + sh.x, o.y * (1.f + sc.y) + sh.y), pack2(o.z * (1.f + sc.z) + sh.z, o.w * (1.f + sc.w) + sh.w));
        }
        R = Rn;
#pragma unroll
        for (int i = 0; i < 16; ++i) xa[i] = xb[i];
#pragma unroll
        for (int i = 0; i < 8; ++i) ya[i] = yb[i];
    }
#undef LN1_LOAD
#undef LN1_SRC
#undef LN1_TOK
}

__device__ void phase_gemm_q(const W p, unsigned char* smem, int bid, int nblk, int layer);
#define NEG_BIG (-3.0e38f)
#define TOPK_SMEM_BYTES (4 * (2 * 16 * 132) * 4)
__device__ const unsigned char kCandTab[64] = {0, 1, 2, 3, 4, 5, 6, 7, 8, 9, 10, 11, 12, 13, 14, 15, 16, 17, 18, 19, 20, 21, 22, 23, 32, 33, 34, 35, 36, 48, 49, 50, 51, 64, 65, 66, 80, 81, 96, 97, 112, 113, 128, 144, 160, 176, 192, 208, 224, 240, 255, 255, 255, 255, 255, 255, 255, 255, 255, 255, 255, 255, 255, 255};
template <int CTRL> __device__ __forceinline__ unsigned dppu(unsigned x) { return (unsigned)__builtin_amdgcn_mov_dpp((int)x, CTRL, 0xf, 0xf, true); }
__device__ __forceinline__ unsigned umax_(unsigned a, unsigned b) { return a > b ? a : b; }
__device__ __forceinline__ unsigned row16_maxu(unsigned x) {
    x = umax_(x, dppu<DPP_XOR1>(x)); x = umax_(x, dppu<DPP_XOR2>(x)); x = umax_(x, dppu<DPP_ROR4>(x)); x = umax_(x, dppu<DPP_ROR8>(x)); return x;
}
__device__ __forceinline__ unsigned fsort_key(float f) { const unsigned b = __float_as_uint(f); return b ^ ((b >> 31) ? 0xffffffffu : 0x80000000u); }
__device__ void peer_topk_item(const W p, int item, unsigned char* smem, int layer) {
    const int tile = item >> 3, h = item & 7;
    const int tid = tidx(), lane = tid & 63, wave = tid >> 6, l15 = lane & 15, rowbase = lane & 48;
    const int R0 = tile * 64 + wave * 16;
    const bf16_t* Q = WSP(bf16_t, WS_YB);
    const bf16_t* keys = WSP(bf16_t, layer ? WS_KEYS1 : WS_KEYS0);
    float* sc = (float*)smem + wave * (2 * 16 * 132);
    int* idxo = WSP(int, WS_IDX);
    float* gato = WSP(float, WS_GATE);
#pragma unroll
    for (int c = 0; c < 2; ++c) {
        f32x4 acc[8];
#pragma unroll
        for (int nt = 0; nt < 8; ++nt) acc[nt] = (f32x4){0.f, 0.f, 0.f, 0.f};
#pragma unroll
        for (int kk = 0; kk < 2; ++kk) {
            const bf16x8 a = *(const bf16x8*)&Q[(size_t)(R0 + (lane & 15)) * 1024 + h * 128 + c * 64 + kk * 32 + 8 * (lane >> 4)];
#pragma unroll
            for (int nt = 0; nt < 8; ++nt) {
                const bf16x8 bq = *(const bf16x8*)&keys[(size_t)((h * 2 + c) * 128 + nt * 16 + (lane & 15)) * 64 + kk * 32 + 8 * (lane >> 4)];
                acc[nt] = __builtin_amdgcn_mfma_f32_16x16x32_bf16(a, bq, acc[nt], 0, 0, 0);
            }
        }
#pragma unroll
        for (int nt = 0; nt < 8; ++nt)
#pragma unroll
            for (int r = 0; r < 4; ++r) sc[c * (16 * 132) + ((lane >> 4) * 4 + r) * 132 + nt * 16 + (lane & 15)] = acc[nt][r];
    }
#pragma unroll 1
    for (int tg = 0; tg < 4; ++tg) {
        const int t = tg * 4 + (lane >> 4), R = R0 + t;
        const float* s0p = sc + t * 132;
        const float* s1p = sc + 16 * 132 + t * 132;
        unsigned ka[8], kb[8];
#pragma unroll
        for (int m = 0; m < 8; ++m) {
            const int ix = l15 + 16 * m;
            ka[m] = (fsort_key(s0p[ix]) & ~127u) | (unsigned)(127 - ix);
            kb[m] = (fsort_key(s1p[ix]) & ~127u) | (unsigned)(127 - ix);
        }
        unsigned minea = 0u, mineb = 0u;
#pragma unroll 1
        for (int it = 0; it < 16; ++it) {
            const unsigned la = umax_(umax_(umax_(ka[0], ka[1]), umax_(ka[2], ka[3])), umax_(umax_(ka[4], ka[5]), umax_(ka[6], ka[7])));
            const unsigned lb = umax_(umax_(umax_(kb[0], kb[1]), umax_(kb[2], kb[3])), umax_(umax_(kb[4], kb[5]), umax_(kb[6], kb[7])));
            const unsigned ma = row16_maxu(la), mb = row16_maxu(lb);
#pragma unroll
            for (int m = 0; m < 8; ++m) { ka[m] = (ka[m] == ma) ? 0u : ka[m]; kb[m] = (kb[m] == mb) ? 0u : kb[m]; }
            minea = (l15 == it) ? ma : minea; mineb = (l15 == it) ? mb : mineb;
        }
        const int j1 = 127 - (int)(minea & 127u), j2 = 127 - (int)(mineb & 127u);
        const float a1 = s0p[j1], a2 = s1p[j2];
        unsigned k[4];
#pragma unroll
        for (int m = 0; m < 4; ++m) {
            const int slot = l15 + 16 * m;
            const int ij = kCandTab[slot];
            const float v = __shfl(a1, rowbase + ((ij >> 4) & 15)) + __shfl(a2, rowbase + (ij & 15));
            k[m] = (ij == 255) ? 0u : ((fsort_key(v) & ~63u) | (unsigned)(63 - slot));
        }
        unsigned mine = 0u;
#pragma unroll 1
        for (int it = 0; it < 16; ++it) {
            const unsigned lm = umax_(umax_(k[0], k[1]), umax_(k[2], k[3]));
            const unsigned mx = row16_maxu(lm);
#pragma unroll
            for (int m = 0; m < 4; ++m) k[m] = (k[m] == mx) ? 0u : k[m];
            mine = (l15 == it) ? mx : mine;
        }
        const int ij = kCandTab[63 - (int)(mine & 63u)];
        const int i = (ij >> 4) & 15, j = ij & 15;
        const float tv = __shfl(a1, rowbase + i) + __shfl(a2, rowbase + j);
        const int e1 = __shfl(j1, rowbase + i), e2 = __shfl(j2, rowbase + j);
        const float mx = __shfl(tv, rowbase);
        const float ex = __expf(tv - mx);
        const float den = row16_sum(ex);
        idxo[(size_t)R * 128 + h * 16 + l15] = e1 * 128 + e2;
        gato[(size_t)R * 128 + h * 16 + l15] = ex / den;
    }
}

struct EpiTopk {
    const bf16_t* keys; int* idxo; float* gato; int h; int m0; unsigned char* smem;
    __device__ void run128(const float* Cs, int tid) const {
        const int lane = tid & 63, wave = tid >> 6, l15 = lane & 15, rowbase = lane & 48;
        int ijm[4];
#pragma unroll
        for (int m = 0; m < 4; ++m) ijm[m] = kCandTab[l15 + 16 * m];
        bf16x8 qa[2][2][2];
#pragma unroll
        for (int ps = 0; ps < 2; ++ps)
#pragma unroll
            for (int c = 0; c < 2; ++c)
#pragma unroll
                for (int kk = 0; kk < 2; ++kk) {
                    const float* src = &Cs[(ps * 64 + wave * 16 + l15) * CS_LD + c * 64 + kk * 32 + 8 * (lane >> 4)];
                    const float4 f0 = *(const float4*)src, f1 = *(const float4*)(src + 4);
                    union { bf16x8 v; unsigned u[4]; } pk;
                    pk.u[0] = pack2(f0.x, f0.y); pk.u[1] = pack2(f0.z, f0.w); pk.u[2] = pack2(f1.x, f1.y); pk.u[3] = pack2(f1.z, f1.w);
                    qa[ps][c][kk] = pk.v;
                }
        __syncthreads();
        float* sc = (float*)smem + wave * (2 * 16 * 132);
#pragma unroll
        for (int ps = 0; ps < 2; ++ps) {
        const int R0 = m0 + ps * 64 + wave * 16;
#pragma unroll
        for (int c = 0; c < 2; ++c) {
            f32x4 acc[8];
#pragma unroll
            for (int nt = 0; nt < 8; ++nt) acc[nt] = (f32x4){0.f, 0.f, 0.f, 0.f};
            bf16x8 bq[2][8];
#pragma unroll
            for (int kk = 0; kk < 2; ++kk)
#pragma unroll
                for (int nt = 0; nt < 8; ++nt) bq[kk][nt] = *(const bf16x8*)&keys[(size_t)((h * 2 + c) * 128 + nt * 16 + (lane & 15)) * 64 + kk * 32 + 8 * (lane >> 4)];
#pragma unroll
            for (int kk = 0; kk < 2; ++kk) {
                const bf16x8 a = qa[ps][c][kk];
#pragma unroll
                for (int nt = 0; nt < 8; ++nt) acc[nt] = __builtin_amdgcn_mfma_f32_16x16x32_bf16(a, bq[kk][nt], acc[nt], 0, 0, 0);
            }
#pragma unroll
            for (int nt = 0; nt < 8; ++nt)
#pragma unroll
                for (int r = 0; r < 4; ++r) sc[c * (16 * 132) + ((lane >> 4) * 4 + r) * 132 + nt * 16 + (lane & 15)] = acc[nt][r];
        }
#pragma unroll 1
        for (int tg = 0; tg < 4; ++tg) {
            const int t = tg * 4 + (lane >> 4), R = R0 + t;
            const float* s0p = sc + t * 132;
            const float* s1p = sc + 16 * 132 + t * 132;
            unsigned ka[8], kb[8];
#pragma unroll
            for (int m = 0; m < 8; ++m) {
                const int ix = l15 + 16 * m;
                ka[m] = (fsort_key(s0p[ix]) & ~127u) | (unsigned)(127 - ix);
                kb[m] = (fsort_key(s1p[ix]) & ~127u) | (unsigned)(127 - ix);
            }
#define CE_(K, i, j) { const unsigned hi_ = umax_(K[i], K[j]), lo_ = K[i] < K[j] ? K[i] : K[j]; K[i] = hi_; K[j] = lo_; }
#define SORT8_(K) { CE_(K,0,1) CE_(K,2,3) CE_(K,4,5) CE_(K,6,7)  CE_(K,0,2) CE_(K,1,3) CE_(K,4,6) CE_(K,5,7)  CE_(K,1,2) CE_(K,5,6) \
                    CE_(K,0,4) CE_(K,1,5) CE_(K,2,6) CE_(K,3,7)  CE_(K,2,4) CE_(K,3,5)  CE_(K,1,2) CE_(K,3,4) CE_(K,5,6) }
            SORT8_(ka) SORT8_(kb)
            unsigned minea = 0u, mineb = 0u;
#pragma unroll 8
            for (int it = 0; it < 16; ++it) {
                const unsigned ma = row16_maxu(ka[0]), mb = row16_maxu(kb[0]);
                const bool pa = ka[0] == ma, pb = kb[0] == mb;
#pragma unroll
                for (int m = 0; m < 7; ++m) { ka[m] = pa ? ka[m + 1] : ka[m]; kb[m] = pb ? kb[m + 1] : kb[m]; }
                ka[7] = pa ? 0u : ka[7]; kb[7] = pb ? 0u : kb[7];
                minea = (l15 == it) ? ma : minea; mineb = (l15 == it) ? mb : mineb;
            }
#undef SORT8_
            const int j1 = 127 - (int)(minea & 127u), j2 = 127 - (int)(mineb & 127u);
            const float a1 = s0p[j1], a2 = s1p[j2];
            unsigned k[4];
#pragma unroll
            for (int m = 0; m < 4; ++m) {
                const int ij = ijm[m];
                const float v = __shfl(a1, rowbase + ((ij >> 4) & 15)) + __shfl(a2, rowbase + (ij & 15));
                k[m] = (ij == 255) ? 0u : ((fsort_key(v) & ~255u) | (unsigned)ij);
            }
            CE_(k,0,1) CE_(k,2,3) CE_(k,0,2) CE_(k,1,3) CE_(k,1,2)
#undef CE_
            unsigned mine = 0u;
#pragma unroll 8
            for (int it = 0; it < 16; ++it) {
                const unsigned mx = row16_maxu(k[0]);
                const bool pk = k[0] == mx;
                k[0] = pk ? k[1] : k[0]; k[1] = pk ? k[2] : k[1]; k[2] = pk ? k[3] : k[2]; k[3] = pk ? 0u : k[3];
                mine = (l15 == it) ? mx : mine;
            }
            const int i = (int)((mine >> 4) & 15u), j = (int)(mine & 15u);
            const float tv = __shfl(a1, rowbase + i) + __shfl(a2, rowbase + j);
            const int e1 = __shfl(j1, rowbase + i), e2 = __shfl(j2, rowbase + j);
            const float mx = __shfl(tv, rowbase);
            const float ex = __expf(tv - mx);
            const float den = row16_sum(ex);
            idxo[(size_t)R * 128 + h * 16 + l15] = e1 * 128 + e2;
            gato[(size_t)R * 128 + h * 16 + l15] = ex / den;
        }
        }
        __syncthreads();
    }
};

__device__ void phase_gemm_q(const W p, unsigned char* smem, int bid, int nblk, int layer) {
    LdBf16 al{WSP(bf16_t, WS_HB), 1024};
    LdBf16 bl{WSP(bf16_t, layer ? WS_WQ1T : WS_WQ0T), 1024};
    const int total = (NTOK / 128) * 8;
    for (int t = xcd_swz(bid, nblk); t < total; t += nblk) {
        const int m0 = (t >> 3) * 128, n0 = (t & 7) * 128;
        if (layer && (m0 % SS) < LC) continue;
        EpiTopk epi{WSP(bf16_t, layer ? WS_KEYS1 : WS_KEYS0), WSP(int, WS_IDX), WSP(float, WS_GATE), t & 7, m0, smem};
        gemm_tile_dma<2>(al.base, al.ld, bl.base, bl.ld, 1024, m0, n0, epi, smem);
    }
}

using f32x2 = __attribute__((ext_vector_type(2))) float;
using v6u = __attribute__((ext_vector_type(6))) unsigned;
using v32f = __attribute__((ext_vector_type(32))) float;
__device__ __forceinline__ v32f fp6x32_to_f32(const U3& a, const U3& b) {
    v6u s; s[0] = a.x; s[1] = a.y; s[2] = a.z; s[3] = b.x; s[4] = b.y; s[5] = b.z;
    return __builtin_amdgcn_cvt_scalef32_pk32_f32_fp6(s, 1.0f);
}
__device__ __forceinline__ float erf_fast(float x) {
    const float ax = fabsf(x);
    const float t = 1.f / (1.f + 0.3275911f * ax);
    const float poly = t * (0.254829592f + t * (-0.284496736f + t * (1.421413741f + t * (-1.453152027f + t * 1.061405429f))));
    const float r = 1.f - poly * __expf(-ax * ax);
    return copysignf(r, x);
}
constexpr int GD = 8;
struct __attribute__((packed, aligned(4))) U2 { unsigned y, z; };
#define G_ISSUE(J, TAB, IA, IB, E) { \
    const unsigned offa_ = (unsigned)__builtin_amdgcn_readlane(IA, E) * 768u + lane12; \
    const unsigned offb_ = (unsigned)__builtin_amdgcn_readlane(IB, E) * 768u + lane12; \
    unsigned offb4_ = offb_ + 4u; asm volatile("" : "+v"(offb4_)); \
    const U3 q0_ = *(const U3*)((TAB) + offa_); \
    const unsigned q1x_ = *(const unsigned*)((TAB) + offb_); \
    const U2 q1_ = *(const U2*)((TAB) + offb4_); \
    rg[J][0] = q0_.x; rg[J][1] = q0_.y; rg[J][2] = q0_.z; rg[J][3] = q1x_; rg[J][4] = q1_.y; rg[J][5] = q1_.z; }
#define BFLY(OUT, A, B, BIT, CTRL) { const float k_ = (BIT) ? (B) : (A), g_ = (BIT) ? (A) : (B); OUT = k_ + dppf<CTRL>(g_); }
#define G_PIN(J) asm volatile("" : "+v"(rg[J]));
constexpr size_t WS_ACT = WS_ZX;
__device__ __forceinline__ int gather_tok(int layer, int j) { return layer ? (j / TT) * SS + LC + (j % TT) : j; }
__device__ __forceinline__ const float* gather_xrow(const W& p, int R) {
    const int b = R / SS, s = R - b * SS;
    return s < LC ? WSP(float, WS_CTX) + ((size_t)(b * LC + s)) * DM : p.out + ((size_t)(b * TT + s - LC)) * DM;
}
__device__ void phase_peer_act(const W p, int gwave_, int nwaves_, int layer) {
    const int gwave = __builtin_amdgcn_readfirstlane(gwave_), nwaves = __builtin_amdgcn_readfirstlane(nwaves_);
    const int lane = tidx() & 63;
    const float* mod = WSP(float, WS_MOD) + (size_t)layer * 5 * 6144;
    const unsigned char* U = p.ws + (layer ? WS_TABU1 : WS_TABU0);
    const float* su = WSP(float, WS_TABSC) + (layer ? 2 : 0) * 16384;
    const float* sv = su + 16384;
    const int* idxo = WSP(int, WS_IDX);
    const float* gato = WSP(float, WS_GATE);
    float* acto = WSP(float, WS_ACT);
    const int nv = layer ? NB * TT : NTOK;
    if (gwave >= nv) return;
    v6u rg[GD];
    static_assert(GD == 8, "the transpose-reduce below merges 8 steps x 2 lists");
    const bool lb0 = (lane & 1) != 0, lb1 = (lane & 2) != 0, lb2 = (lane & 4) != 0, lb3 = (lane & 8) != 0;
    const unsigned lane12 = (unsigned)lane * 12u;
    int R = gather_tok(layer, gwave);
    int ia = idxo[(size_t)R * 128 + lane], ib = idxo[(size_t)R * 128 + 64 + lane];
#pragma unroll
    for (int j = 0; j < GD; ++j) G_ISSUE(j, U, ia, ib, j)
    int Rn = gather_tok(layer, gwave + nwaves < nv ? gwave + nwaves : gwave);
    int ian = idxo[(size_t)Rn * 128 + lane], ibn = idxo[(size_t)Rn * 128 + 64 + lane];
    float hh[16];
    { const int b = R / SS, s = R - b * SS;
      const float* xrow = gather_xrow(p, R);
      const float* m = mod + (s < LC ? 4 : b) * 6144;
#pragma unroll
      for (int q4 = 0; q4 < 4; ++q4) {
          const int k = lane * 16 + q4 * 4;
          const float4 xv = *(const float4*)&xrow[k], sc = *(const float4*)&m[4096 + k], sh = *(const float4*)&m[3072 + k];
          hh[q4 * 4 + 0] = xv.x * (1.f + sc.x) + sh.x; hh[q4 * 4 + 1] = xv.y * (1.f + sc.y) + sh.y;
          hh[q4 * 4 + 2] = xv.z * (1.f + sc.z) + sh.z; hh[q4 * 4 + 3] = xv.w * (1.f + sc.w) + sh.w;
      } }
    for (int jt = gwave; jt < nv; jt += nwaves) {
        const int j2 = jt + 2 * nwaves < nv ? jt + 2 * nwaves : jt;
        const int R2 = gather_tok(layer, j2);
        const int ln0 = tidx() & 63;
        const int ian2 = idxo[(size_t)R2 * 128 + ln0], ibn2 = idxo[(size_t)R2 * 128 + 64 + ln0];
        const float ga = gato[(size_t)R * 128 + ln0], gb = gato[(size_t)R * 128 + 64 + ln0];
        const float sua = su[ia], sub = su[ib], sva = sv[ia], svb = sv[ib];
        float xn[16], scn[16], shn[16];
        { const int bn = Rn / SS, sn = Rn - bn * SS;
          const float* xrown = gather_xrow(p, Rn);
          const float* mn = mod + (sn < LC ? 4 : bn) * 6144;
          const int lk2 = ln0 * 16;
#pragma unroll
          for (int q4 = 0; q4 < 4; ++q4) {
              const float4 xv = *(const float4*)&xrown[lk2 + q4 * 4], sc = *(const float4*)&mn[4096 + lk2 + q4 * 4], sh = *(const float4*)&mn[3072 + lk2 + q4 * 4];
              xn[q4 * 4] = xv.x; xn[q4 * 4 + 1] = xv.y; xn[q4 * 4 + 2] = xv.z; xn[q4 * 4 + 3] = xv.w;
              scn[q4 * 4] = sc.x; scn[q4 * 4 + 1] = sc.y; scn[q4 * 4 + 2] = sc.z; scn[q4 * 4 + 3] = sc.w;
              shn[q4 * 4] = sh.x; shn[q4 * 4 + 1] = sh.y; shn[q4 * 4 + 2] = sh.z; shn[q4 * 4 + 3] = sh.w;
          } }
        asm volatile("" :: "v"(ian), "v"(ibn));
        float acta = 0.f, actb = 0.f;
#pragma unroll 1
        for (int e0 = 0; e0 < 64; e0 += GD) {
            const bool last = e0 + GD >= 64;
            const int ja = last ? ian : ia, jb = last ? ibn : ib;
            float pr[16];
#pragma unroll
            for (int j = 0; j < GD; ++j) {
                G_PIN(j)
                const v32f uu = __builtin_amdgcn_cvt_scalef32_pk32_f32_fp6(rg[j], 1.0f);
                G_ISSUE(j, U, ja, jb, (e0 + j + GD) & 63)
                f32x2 a0 = {0.f, 0.f}, a1 = {0.f, 0.f};
#pragma unroll
                for (int i = 0; i < 8; ++i) {
                    const f32x2 h2 = {hh[2 * i], hh[2 * i + 1]}, u0 = {uu[2 * i], uu[2 * i + 1]}, u1 = {uu[16 + 2 * i], uu[17 + 2 * i]};
                    a0 = __builtin_elementwise_fma(h2, u0, a0); a1 = __builtin_elementwise_fma(h2, u1, a1);
                }
                pr[j] = a0[0] + a0[1]; pr[8 + j] = a1[0] + a1[1];
                __builtin_amdgcn_sched_barrier(0);
            }
            float q8[8], r4[4], s2[2], tt;
#pragma unroll
            for (int m = 0; m < 8; ++m) BFLY(q8[m], pr[2 * m], pr[2 * m + 1], lb0, DPP_XOR1)
#pragma unroll
            for (int m = 0; m < 4; ++m) BFLY(r4[m], q8[2 * m], q8[2 * m + 1], lb1, DPP_XOR2)
#pragma unroll
            for (int m = 0; m < 2; ++m) BFLY(s2[m], r4[2 * m], r4[2 * m + 1], lb2, DPP_ROR4)
            BFLY(tt, s2[0], s2[1], lb3, DPP_ROR8)
            tt = xrow_sum(tt);
            const float tx = dppf<DPP_ROR8>(tt);
            const bool inr = (lane >> 3) == (e0 >> 3), hi8 = (e0 & 8) != 0;
            acta = inr ? (hi8 ? tx : tt) : acta; actb = inr ? (hi8 ? tt : tx) : actb;
        }
        { const float da = acta * sua, db = actb * sub;
          acta = ga * (0.5f * da * (1.f + erf_fast(da * 0.70710678118654752f))) * sva;
          actb = gb * (0.5f * db * (1.f + erf_fast(db * 0.70710678118654752f))) * svb; }
        { const int ln1 = tidx() & 63;
          acto[(size_t)R * 128 + ln1] = acta; acto[(size_t)R * 128 + 64 + ln1] = actb; }
        R = Rn; Rn = R2; ia = ian; ib = ibn; ian = ian2; ibn = ibn2;
#pragma unroll
        for (int i = 0; i < 16; ++i) hh[i] = xn[i] * (1.f + scn[i]) + shn[i];
    }
}
__device__ void phase_peer_out(const W p, int gwave_, int nwaves_, int layer, unsigned char* smem) {
    const int gwave = __builtin_amdgcn_readfirstlane(gwave_), nwaves = __builtin_amdgcn_readfirstlane(nwaves_);
    const int lane = tidx() & 63;
    const float* mod = WSP(float, WS_MOD) + (size_t)layer * 5 * 6144;
    const unsigned char* V = p.ws + (layer ? WS_TABV1 : WS_TABV0);
    const int* idxo = WSP(int, WS_IDX);
    const float* acto = WSP(float, WS_ACT);
    const float* g = PAR(layer ? PAR_LN2G1 : PAR_LN2G0);
    const float* bt = PAR(layer ? PAR_LN2B1 : PAR_LN2B0);
    float* sp = (float*)smem;
    for (int i = tidx(); i < 1024; i += 256) {
        sp[i] = g[i]; sp[1024 + i] = bt[i];
#pragma unroll
        for (int v = 0; v < 5; ++v) {
            sp[2048 + v * 1024 + i] = mod[v * 6144 + 5120 + i];
            if (layer == 0) { sp[7168 + v * 1024 + i] = mod[(5 + v) * 6144 + 1024 + i]; sp[12288 + v * 1024 + i] = mod[(5 + v) * 6144 + i]; }
        }
    }
    __syncthreads();
    const int nv = layer ? NB * TT : NTOK;
    if (gwave >= nv) return;
    v6u rg[GD];
    const unsigned lane12 = (unsigned)lane * 12u;
    int R = gather_tok(layer, gwave);
    int ia = idxo[(size_t)R * 128 + lane], ib = idxo[(size_t)R * 128 + 64 + lane];
#pragma unroll
    for (int j = 0; j < GD; ++j) G_ISSUE(j, V, ia, ib, j)
    int Rn = gather_tok(layer, gwave + nwaves < nv ? gwave + nwaves : gwave);
    int ian = idxo[(size_t)Rn * 128 + lane], ibn = idxo[(size_t)Rn * 128 + 64 + lane];
    float acta = acto[(size_t)R * 128 + lane], actb = acto[(size_t)R * 128 + 64 + lane];
    float xr[16];
    { const float* xrow = gather_xrow(p, R);
#pragma unroll
      for (int q4 = 0; q4 < 4; ++q4) { const float4 xv = *(const float4*)&xrow[lane * 16 + q4 * 4]; xr[q4 * 4] = xv.x; xr[q4 * 4 + 1] = xv.y; xr[q4 * 4 + 2] = xv.z; xr[q4 * 4 + 3] = xv.w; } }
    for (int jt = gwave; jt < nv; jt += nwaves) {
        const int b = R / SS, s = R - b * SS;
        float* xrow = s < LC ? WSP(float, WS_CTX) + ((size_t)(b * LC + s)) * DM : p.out + ((size_t)(b * TT + s - LC)) * DM;
        const int var = s < LC ? 4 : b;
        const int j2 = jt + 2 * nwaves < nv ? jt + 2 * nwaves : jt;
        const int R2 = gather_tok(layer, j2);
        const int ln0 = tidx() & 63;
        const int ian2 = idxo[(size_t)R2 * 128 + ln0], ibn2 = idxo[(size_t)R2 * 128 + 64 + ln0];
        const float actan = acto[(size_t)Rn * 128 + ln0], actbn = acto[(size_t)Rn * 128 + 64 + ln0];
        f32x2 o2[8]; float xn[16];
#pragma unroll
        for (int i = 0; i < 8; ++i) o2[i] = (f32x2){0.f, 0.f};
        { const float* xrown = gather_xrow(p, Rn);
          const int lk2 = ln0 * 16;
#pragma unroll
          for (int q4 = 0; q4 < 4; ++q4) { const float4 xv = *(const float4*)&xrown[lk2 + q4 * 4]; xn[q4 * 4] = xv.x; xn[q4 * 4 + 1] = xv.y; xn[q4 * 4 + 2] = xv.z; xn[q4 * 4 + 3] = xv.w; } }
        asm volatile("" :: "v"(ian), "v"(ibn), "v"(acta), "v"(actb));
#pragma unroll 1
        for (int e0 = 0; e0 < 64; e0 += GD) {
            const bool last = e0 + GD >= 64;
            const int ja = last ? ian : ia, jb = last ? ibn : ib;
#pragma unroll
            for (int j = 0; j < GD; ++j) {
                G_PIN(j)
                const v32f vv = __builtin_amdgcn_cvt_scalef32_pk32_f32_fp6(rg[j], 1.0f);
                G_ISSUE(j, V, ja, jb, (e0 + j + GD) & 63)
                const float w0 = __builtin_bit_cast(float, __builtin_amdgcn_readlane(__builtin_bit_cast(int, acta), e0 + j));
                const float w1 = __builtin_bit_cast(float, __builtin_amdgcn_readlane(__builtin_bit_cast(int, actb), e0 + j));
                const f32x2 w02 = {w0, w0}, w12 = {w1, w1};
#pragma unroll
                for (int i = 0; i < 8; ++i) {
                    o2[i] = __builtin_elementwise_fma(w02, (f32x2){vv[2 * i], vv[2 * i + 1]}, o2[i]);
                    o2[i] = __builtin_elementwise_fma(w12, (f32x2){vv[16 + 2 * i], vv[17 + 2 * i]}, o2[i]);
                }
                asm volatile("" : "+v"(o2[0]), "+v"(o2[1]), "+v"(o2[2]), "+v"(o2[3]), "+v"(o2[4]), "+v"(o2[5]), "+v"(o2[6]), "+v"(o2[7]));
                __builtin_amdgcn_sched_barrier(0);
            }
        }
        float o[16];
#pragma unroll
        for (int i = 0; i < 8; ++i) { o[2 * i] = o2[i][0]; o[2 * i + 1] = o2[i][1]; }
        float vsum = 0.f;
        const int lk3 = (tidx() & 63) * 16;
#pragma unroll
        for (int q4 = 0; q4 < 4; ++q4) {
            const int k = lk3 + q4 * 4;
            const float4 g2 = *(const float4*)&sp[2048 + var * 1024 + k];
            o[q4 * 4 + 0] = ALPHA_F * xr[q4 * 4 + 0] + g2.x * o[q4 * 4 + 0];
            o[q4 * 4 + 1] = ALPHA_F * xr[q4 * 4 + 1] + g2.y * o[q4 * 4 + 1];
            o[q4 * 4 + 2] = ALPHA_F * xr[q4 * 4 + 2] + g2.z * o[q4 * 4 + 2];
            o[q4 * 4 + 3] = ALPHA_F * xr[q4 * 4 + 3] + g2.w * o[q4 * 4 + 3];
        }
#pragma unroll
        for (int i = 0; i < 16; ++i) vsum += o[i];
        const float mean = wave_sum(vsum) * (1.f / 1024.f);
        float vq2 = 0.f;
#pragma unroll
        for (int i = 0; i < 16; ++i) { const float dl = o[i] - mean; vq2 += dl * dl; }
        const float rs = rsqrtf(wave_sum(vq2) * (1.f / 1024.f) + 1e-5f);
#pragma unroll
        for (int q4 = 0; q4 < 4; ++q4) {
            const int k = lk3 + q4 * 4;
            const float4 gg = *(const float4*)&sp[k], bb = *(const float4*)&sp[1024 + k];
            float4 r;
            r.x = (o[q4 * 4 + 0] - mean) * rs * gg.x + bb.x; r.y = (o[q4 * 4 + 1] - mean) * rs * gg.y + bb.y;
            r.z = (o[q4 * 4 + 2] - mean) * rs * gg.z + bb.z; r.w = (o[q4 * 4 + 3] - mean) * rs * gg.w + bb.w;
            *(float4*)&xrow[k] = r;
            if (layer == 0) {
                const float4 sc = *(const float4*)&sp[7168 + var * 1024 + k], sh = *(const float4*)&sp[12288 + var * 1024 + k];
                *(uint2*)(WSP(bf16_t, WS_HB2) + (size_t)R * 1024 + k) =
                    make_uint2(pack2(r.x * (1.f + sc.x) + sh.x, r.y * (1.f + sc.y) + sh.y), pack2(r.z * (1.f + sc.z) + sh.z, r.w * (1.f + sc.w) + sh.w));
            }
        }
        R = Rn; Rn = R2; ia = ian; ib = ibn; ian = ian2; ibn = ibn2; acta = actan; actb = actbn;
#pragma unroll
        for (int i = 0; i < 16; ++i) xr[i] = xn[i];
    }
}
#undef G_ISSUE
#undef G_PIN
#undef BFLY

constexpr size_t WS_ROPE = WS_END;
static_assert(WS_ROPE + 16384 <= (size_t)536870912, "rope table fits");
__device__ void phase_rope_table(const P& p, size_t gtid, size_t gthreads) {
    float* rt = WSP(float, WS_ROPE);
    for (size_t e = gtid; e < 128 * 16; e += gthreads) {
        const int i = (int)(e & 15), pos = (int)(e >> 4);
        const float freq = powf(10000.f, -(float)i / 16.f);
        const float ang = (float)pos * freq;
        rt[e * 2] = cosf(ang); rt[e * 2 + 1] = sinf(ang);
    }
}
struct EpiZX1 {
    bf16_t* zx; bf16_t* vt; const float* rope; int m0, n0;
    __device__ void operator()(const float* Cs, int pass, int tid) const {
        const int Rb = m0 + pass * 64;
        const int b = Rb / SS, sb = Rb - b * SS;
        const bool isv = (n0 == 640) || (n0 >= 1792);
        if (isv) {
            const int hv0 = (n0 == 640) ? 0 : 2 + (n0 - 1792) / 64;
#pragma unroll
            for (int i = 0; i < 4; ++i) {
                const int c = tid + 256 * i, col = c >> 3, r8 = (c & 7) * 8;
                float v[8];
#pragma unroll
                for (int u = 0; u < 8; ++u) v[u] = Cs[(r8 + u) * CS_LD + col];
                uint4 o; o.x = pack2(v[0], v[1]); o.y = pack2(v[2], v[3]); o.z = pack2(v[4], v[5]); o.w = pack2(v[6], v[7]);
                *(uint4*)&vt[((size_t)(b * 10 + hv0 + (col >> 6)) * 64 + (col & 63)) * SS + sb + r8] = o;
            }
            return;
        }
        const bool dorope = (n0 < 640) && (sb >= LC);
#pragma unroll
        for (int i = 0; i < 4; ++i) {
            const int c = tid + 256 * i, row = c >> 4, col8 = (c & 15) * 8;
            const int R = Rb + row;
            float v[8];
            const float4 a = *(const float4*)&Cs[row * CS_LD + col8], bq = *(const float4*)&Cs[row * CS_LD + col8 + 4];
            v[0] = a.x; v[1] = a.y; v[2] = a.z; v[3] = a.w; v[4] = bq.x; v[5] = bq.y; v[6] = bq.z; v[7] = bq.w;
            if (dorope) {
                const int t = sb + row - LC;
                const int e0 = col8 & 31, half = (col8 >> 5) & 1;
                const int pos = half ? (t & 63) : (t >> 6);
                const bool lo = e0 < 16;
                const int pc = lo ? col8 + 16 : col8 - 16;
                const float4 pa = *(const float4*)&Cs[row * CS_LD + pc], pb = *(const float4*)&Cs[row * CS_LD + pc + 4];
                const float pv[8] = {pa.x, pa.y, pa.z, pa.w, pb.x, pb.y, pb.z, pb.w};
#pragma unroll
                for (int u = 0; u < 8; ++u) {
                    const int fi = (e0 & 15) + u;
                    const float cs = rope[(pos * 16 + fi) * 2], sn = rope[(pos * 16 + fi) * 2 + 1];
                    v[u] = lo ? (v[u] * cs - pv[u] * sn) : (v[u] * cs + pv[u] * sn);
                }
            }
            uint4 o; o.x = pack2(v[0], v[1]); o.y = pack2(v[2], v[3]); o.z = pack2(v[4], v[5]); o.w = pack2(v[6], v[7]);
            *(uint4*)&zx[(size_t)R * ZW1 + n0 + col8] = o;
        }
    }
};
__device__ void phase_gemm_win1(const W p, unsigned char* smem, int bid, int nblk) {
    LdBf16 al{WSP(bf16_t, WS_HB2), 1024};
    LdBf16 bl{WSP(bf16_t, WS_WIN1T), 1024};
    const int ntn = ZW1 / 128, total = (NTOK / 128) * ntn;
    for (int t = xcd_swz(bid, nblk); t < total; t += nblk) {
        const int m0 = (t / ntn) * 128, n0 = (t % ntn) * 128;
        EpiZX1 epi{WSP(bf16_t, WS_ZX), WSP(bf16_t, WS_VT), WSP(float, WS_ROPE), m0, n0};
        gemm_tile_dma(al.base, al.ld, bl.base, bl.ld, 1024, m0, n0, epi, smem);
    }
}

#define AT_LD 72
#define ATTN_SMEM_BYTES (2 * 64 * AT_LD * 2)
#define MASK_NEG (-1.0e30f)
template <int kind>
__device__ void attn_item(const W p, int item, unsigned char* smem) {
    const int qt = item & 63, hq = (item >> 6) & 7, b = (item >> 9) & 3;
    const int tid = tidx(), lane = tid & 63, wave = tid >> 6, hh = lane >> 5, ql = lane & 31;
    bf16_t* Ks = (bf16_t*)smem;
    bf16_t* Vs = Ks + 64 * AT_LD;
    const bf16_t* zx = WSP(bf16_t, WS_ZX);
    const int t0 = qt * 128;
    const int qcol = kind ? 768 + hq * 64 : hq * 64;
    const int kcol = kind ? 1280 + hq * 64 : 512 + (hq >> 2) * 64;
    const bf16_t* vt = WSP(bf16_t, WS_VT) + ((size_t)(b * 10 + (kind ? 2 + hq : (hq >> 2))) * 64) * SS;
    const int ocol = kind ? 512 + hq * 64 : hq * 64;
    const int tq = t0 + wave * 32 + ql, tq0w = t0 + wave * 32;
    const size_t Rq = (size_t)b * SS + LC + tq;
    bf16x8 qf[4];
#pragma unroll
    for (int st = 0; st < 4; ++st) qf[st] = *(const bf16x8*)&zx[Rq * ZW1 + qcol + st * 16 + 8 * hh];
    int lk0, lk1;
    const int r0 = t0 >> 6;
    if (kind == 0) { lk0 = t0 - 128 < 0 ? 0 : t0 - 128; lk1 = t0 + 256 > TT ? TT : t0 + 256; }
    else {
        int rs0 = r0 - 4; rs0 = rs0 < 0 ? 0 : (rs0 > 120 ? 120 : rs0);
        int rs1 = r0 + 1 - 4; rs1 = rs1 < 0 ? 0 : (rs1 > 120 ? 120 : rs1);
        lk0 = rs0 * 64; lk1 = (rs1 + 8) * 64;
    }
    const int nloc = (lk1 - lk0) >> 6;
    const int rq = tq >> 6, cq = tq & 63;
    int rsq = rq - 4; rsq = rsq < 0 ? 0 : (rsq > 120 ? 120 : rsq);
    int csq = cq - 8; csq = csq < 0 ? 0 : (csq > 48 ? 48 : csq);
    const float* rpb = PAR(PAR_RPB) + (size_t)hq * 15 * 31;
    float m = MASK_NEG, l = 0.f;
    f32x16 oacc[2];
#pragma unroll
    for (int r = 0; r < 16; ++r) { oacc[0][r] = 0.f; oacc[1][r] = 0.f; }
    const int prr = tid >> 3, pc8 = (tid & 7) * 8;
    u32x4v pk0, pk1, pv0, pv1;
    pk0 = *(const u32x4v*)&zx[((size_t)b * SS + prr) * ZW1 + kcol + pc8];        pk1 = *(const u32x4v*)&zx[((size_t)b * SS + 32 + prr) * ZW1 + kcol + pc8];
    pv0 = *(const u32x4v*)&vt[(size_t)prr * SS + pc8];                           pv1 = *(const u32x4v*)&vt[(size_t)(32 + prr) * SS + pc8];
    for (int ti = 0; ti < 4 + nloc; ++ti) {
        const bool isctx = ti < 4;
        const int sbase = isctx ? ti * 64 : LC + lk0 + (ti - 4) * 64;
        __syncthreads();
        *(u32x4v*)&Ks[prr * AT_LD + pc8] = pk0; *(u32x4v*)&Ks[(32 + prr) * AT_LD + pc8] = pk1;
        *(u32x4v*)&Vs[prr * AT_LD + pc8] = pv0; *(u32x4v*)&Vs[(32 + prr) * AT_LD + pc8] = pv1;
        __syncthreads();
        if (ti + 1 < 4 + nloc) {
            const int sbn = (ti + 1 < 4) ? (ti + 1) * 64 : LC + lk0 + (ti + 1 - 4) * 64;
            pk0 = *(const u32x4v*)&zx[((size_t)b * SS + sbn + prr) * ZW1 + kcol + pc8];  pk1 = *(const u32x4v*)&zx[((size_t)b * SS + sbn + 32 + prr) * ZW1 + kcol + pc8];
            pv0 = *(const u32x4v*)&vt[(size_t)prr * SS + sbn + pc8];                     pv1 = *(const u32x4v*)&vt[(size_t)(32 + prr) * SS + sbn + pc8];
        }
        const int tk0 = sbase - LC;
        const int kr = tk0 >> 6;
        if (!isctx && kind == 1) {
            const int rqw = (t0 + wave * 32) >> 6;
            int rsw = rqw - 4; rsw = rsw < 0 ? 0 : (rsw > 120 ? 120 : rsw);
            if (kr < rsw || kr >= rsw + 8) continue;
        }
#pragma unroll
        for (int sub = 0; sub < 2; ++sub) {
            f32x16 sacc;
#pragma unroll
            for (int r = 0; r < 16; ++r) sacc[r] = 0.f;
#pragma unroll
            for (int st = 0; st < 4; ++st) {
                const bf16x8 kf = *(const bf16x8*)&Ks[(sub * 32 + ql) * AT_LD + st * 16 + 8 * hh];
                sacc = __builtin_amdgcn_mfma_f32_32x32x16_bf16(kf, qf[st], sacc, 0, 0, 0);
            }
            float sv[16], smax = MASK_NEG;
            const bool needmask = !isctx && (kind == 1 || (tk0 + 63 - tq0w > 128) || (tk0 - (tq0w + 31) < -128));
            if (kind == 1 && needmask) {
                const float* rb = rpb + (kr - rq + 7) * 31 + (15 - cq);
                float bias[16];
#pragma unroll
                for (int r = 0; r < 16; ++r) {
                    const int key = sub * 32 + (r & 3) + 8 * (r >> 2) + 4 * hh;
                    const bool valid = (unsigned)(key - csq) < 16u;
                    bias[r] = rb[valid ? key : csq];
                }
#pragma unroll
                for (int r = 0; r < 16; ++r) {
                    const int key = sub * 32 + (r & 3) + 8 * (r >> 2) + 4 * hh;
                    const bool valid = (unsigned)(key - csq) < 16u;
                    const float x = valid ? sacc[r] * 0.18033688011f + 1.44269504089f * bias[r] : MASK_NEG;
                    sv[r] = x; smax = fmaxf(smax, x);
                }
            } else {
#pragma unroll
                for (int r = 0; r < 16; ++r) {
                    const int key = sub * 32 + (r & 3) + 8 * (r >> 2) + 4 * hh;
                    float x = sacc[r] * 0.18033688011f;
                    if (kind == 0 && needmask) { const int dlt = tk0 + key - tq; if (dlt > 128 || dlt < -128) x = MASK_NEG; }
                    sv[r] = x; smax = fmaxf(smax, x);
                }
            }
            smax = half_swap_max(smax);
            const float mn = fmaxf(m, smax);
            if (__builtin_amdgcn_ballot_w64(mn > m)) {
                const float alpha = __builtin_amdgcn_exp2f(m - mn);
                l *= alpha;
#pragma unroll
                for (int r = 0; r < 16; ++r) { oacc[0][r] *= alpha; oacc[1][r] *= alpha; }
                m = mn;
            }
            float ps = 0.f;
#pragma unroll
            for (int r = 0; r < 16; ++r) { sv[r] = __builtin_amdgcn_exp2f(sv[r] - m); ps += sv[r]; }
            l += ps;
#pragma unroll
            for (int s2 = 0; s2 < 2; ++s2) {
                union { bf16x8 v; unsigned u[4]; } pb;
#pragma unroll
                for (int u = 0; u < 4; ++u) pb.u[u] = pack2(sv[8 * s2 + 2 * u], sv[8 * s2 + 2 * u + 1]);
#pragma unroll
                for (int db = 0; db < 2; ++db) {
                    union { bf16x8 v; uint2 h[2]; } vf;
                    const bf16_t* vrow = &Vs[(db * 32 + ql) * AT_LD + sub * 32 + 16 * s2 + 4 * hh];
                    vf.h[0] = *(const uint2*)vrow;
                    vf.h[1] = *(const uint2*)(vrow + 8);
                    oacc[db] = __builtin_amdgcn_mfma_f32_32x32x16_bf16(vf.v, pb.v, oacc[db], 0, 0, 0);
                }
            }
        }
    }
    float lt = half_swap_sum(l);
    if (kind == 0) lt += __builtin_amdgcn_exp2f(1.44269504089f * PAR(PAR_SINK)[hq] - m);
    const float inv = 1.f / lt;
    bf16_t* mix = WSP(bf16_t, WS_MIX);
#pragma unroll
    for (int db = 0; db < 2; ++db)
#pragma unroll
        for (int g4 = 0; g4 < 4; ++g4) {
            const int dd = db * 32 + 8 * g4 + 4 * hh;
            uint2 o; o.x = pack2(oacc[db][4 * g4] * inv, oacc[db][4 * g4 + 1] * inv); o.y = pack2(oacc[db][4 * g4 + 2] * inv, oacc[db][4 * g4 + 3] * inv);
            *(uint2*)&mix[Rq * 1024 + ocol + dd] = o;
        }
}


enum { PH_TRANSPOSE = 0, PH_CONVERT, PH_MODP, PH_MISC, PH_S5TAB, PH_WIN0, PH_S5E, PH_S5CARRY, PH_S5Y, PH_RWKV, PH_GLU, PH_RWKVOUT,
       PH_WOUT, PH_LN1, PH_QGEMM, PH_TOPK, PH_GATHER, PH_GATHERB, PH_WIN1, PH_ATTN, PH_RWPREP, PH_COUNT };
template <int PH> struct PhaseSmem { static constexpr int bytes = 1024; };
template <> struct PhaseSmem<PH_TRANSPOSE> { static constexpr int bytes = 64 * 65 * 4; };
template <> struct PhaseSmem<PH_WIN0>    { static constexpr int bytes = GEMM_SMEM_BYTES; };
template <> struct PhaseSmem<PH_S5E>     { static constexpr int bytes = GEMM_SMEM_BYTES; };
template <> struct PhaseSmem<PH_S5Y>     { static constexpr int bytes = GEMM_SMEM_BYTES; };
template <> struct PhaseSmem<PH_RWKV>    { static constexpr int bytes = (int)sizeof(RwkvSmem); };
template <> struct PhaseSmem<PH_GLU>     { static constexpr int bytes = GEMM_SMEM_BYTES; };
template <> struct PhaseSmem<PH_RWKVOUT> { static constexpr int bytes = GEMM_SMEM_BYTES; };
template <> struct PhaseSmem<PH_WOUT>    { static constexpr int bytes = GEMM_SMEM_BYTES; };
template <> struct PhaseSmem<PH_QGEMM>   { static constexpr int bytes = GEMM_SMEM_BYTES; };
template <> struct PhaseSmem<PH_TOPK>    { static constexpr int bytes = TOPK_SMEM_BYTES; };
template <> struct PhaseSmem<PH_WIN1>    { static constexpr int bytes = GEMM_SMEM_BYTES; };
template <> struct PhaseSmem<PH_ATTN>    { static constexpr int bytes = ATTN_SMEM_BYTES; };

template <int PH>
__device__ __forceinline__ void run_early(const P& p, unsigned char* smem) {
    const int bid = bidx(), nblk = gridDim.x;
    const size_t gtid = (size_t)bid * 256 + tidx(), gthreads = (size_t)nblk * 256;
    const int gwave = bid * 4 + (tidx() >> 6), nwaves = nblk * 4;
    if constexpr (PH == PH_TRANSPOSE) phase_transpose(p, (float*)smem, bid, nblk);
    else if constexpr (PH == PH_CONVERT) phase_convert(p, gtid, gthreads);
    else if constexpr (PH == PH_MODP) phase_mod_partial(p, gwave, nwaves);
    else if constexpr (PH == PH_MISC) { phase_s5_pow(p, gtid, gthreads); phase_rope_table(p, gtid, gthreads); phase_pack_params(p, gtid, gthreads); }
    else if constexpr (PH == PH_S5TAB) { phase_mod_reduce(p, gtid, gthreads); phase_s5_tables(p, gtid, gthreads); }
}
template <int PH>
__device__ __forceinline__ void run_phase(const W p, int layer, unsigned char* smem) {
    const int bid = bidx(), nblk = gridDim.x;
    const size_t gtid = (size_t)bid * 256 + tidx(), gthreads = (size_t)nblk * 256;
    const int gwave = bid * 4 + (tidx() >> 6), nwaves = nblk * 4;
    if constexpr (PH == PH_WIN0) phase_gemm_win0(p, smem, bid, nblk);
    else if constexpr (PH == PH_RWPREP) { phase_rw_shift(p, gwave, nwaves); phase_rw_lora(p, smem, bid, nblk); }
    else if constexpr (PH == PH_S5E) phase_s5_E(p, smem, (bid + nblk - 8448 % nblk) % nblk, nblk);
    else if constexpr (PH == PH_S5CARRY) phase_s5_carry(p, gtid, gthreads);
    else if constexpr (PH == PH_S5Y) phase_s5_Y(p, smem, bid, nblk);
    else if constexpr (PH == PH_RWKV) { for (int it = bid; it < 256; it += nblk) rwkv_scan_item(p, it, smem); }
    else if constexpr (PH == PH_GLU) phase_glu(p, smem, bid, nblk);
    else if constexpr (PH == PH_RWKVOUT) phase_rwkv_out(p, smem, bid, nblk);
    else if constexpr (PH == PH_WOUT) phase_gemm_wout(p, smem, bid, nblk, layer);
    else if constexpr (PH == PH_LN1) phase_ln1(p, gwave, nwaves, layer, smem);
    else if constexpr (PH == PH_QGEMM) phase_gemm_q(p, smem, bid, nblk, layer);
    else if constexpr (PH == PH_TOPK) {
        for (int it = bid; it < (NTOK / 64) * 8; it += nblk) { if (layer && ((it >> 3) * 64) % SS < LC) continue; peer_topk_item(p, it, smem, layer); }
    }
    else if constexpr (PH == PH_GATHER) phase_peer_act(p, gwave, nwaves, layer);
    else if constexpr (PH == PH_GATHERB) phase_peer_out(p, gwave, nwaves, layer, smem);
    else if constexpr (PH == PH_WIN1) phase_gemm_win1(p, smem, bid, nblk);
    else if constexpr (PH == PH_ATTN) { for (int it = bid; it < 2048; it += nblk) attn_item<1>(p, it, smem); for (int it = bid; it < 2048; it += nblk) attn_item<0>(p, it, smem); }
}

namespace cg = cooperative_groups;
constexpr int cmax(int a, int b) { return a > b ? a : b; }
constexpr int MEGA_SMEM = cmax(cmax(GEMM_SMEM_BYTES, RW1_SMEM_BYTES), cmax(TOPK_SMEM_BYTES, ATTN_SMEM_BYTES));
static_assert(MEGA_SMEM >= 17408 * 4, "gather epilogue vectors fit in LDS");
static_assert(MEGA_SMEM >= 128 * CS_LD * 4, "128-row C staging fits");

#define DIAG 0
#define DIAG_A0 13
#define DIAG_A1 14
#if DIAG
#define STAMP(k) do { if (bidx() == 0 && tidx() == 0) ((volatile unsigned long long*)(p.ws + WS_TS))[k] = __builtin_amdgcn_s_memrealtime(); } while (0)
#define DIAG_TAIL() do { GSYNC(); STAMP(63); GSYNC(); \
    const volatile unsigned long long* ts = (const volatile unsigned long long*)(p.ws + WS_TS); \
    const float ra = (float)(ts[DIAG_A1] - ts[DIAG_A0]) * (1.f / 500000.f);     \
    const float sc = 1.f + sqrtf(0.04f * ra); \
    for (size_t i = (size_t)bidx() * 256 + tidx(); i < (size_t)NB * TT * DM; i += (size_t)gridDim.x * 256) p.out[i] *= sc; } while (0)
#else
#define STAMP(k)
#define DIAG_TAIL()
#endif
#define GSYNC() xcd_barrier(xb)

__device__ __forceinline__ void phase_scan_and_side(const P& p, const W w, unsigned char* smem, volatile LAS unsigned* bc) {
    unsigned* ctl = (unsigned*)(p.ws + WS_CTL);
    if (bidx() < 64) rw2_chain(w, bidx(), smem);
    STAMP(20);
    for (;;) { const int t = take_ticket(&ctl[CT_S5YT], bc); if (t >= 640) break; phase_s5_Y(w, smem, t, 1 << 30); }
}

__global__ void __launch_bounds__(256, 2) mega_kernel(P p) {
    __shared__ __attribute__((aligned(16))) unsigned char smem[MEGA_SMEM + 64];
    cg::grid_group grid = cg::this_grid();
    volatile LAS unsigned* st = (volatile LAS unsigned*)(smem + MEGA_SMEM);
    if (tidx() < 4) st[tidx()] = 0u;
    __syncthreads();
    XcdBarrier xb = xcd_barrier_post((unsigned*)(p.ws + WS_CTL), st);
    volatile LAS unsigned* bc = st + 2;
    STAMP(0);
    run_early<PH_TRANSPOSE>(p, smem); STAMP(21);
    run_early<PH_MODP>(p, smem); STAMP(22);
    run_early<PH_MISC>(p, smem);
    GSYNC(); STAMP(1);
    run_early<PH_S5TAB>(p, smem);
    GSYNC(); STAMP(2);
    const W w{p.in[I_X], p.in[I_CTX], p.out, p.ws};
    phase_xcvt(w, smem);
    GSYNC();
    run_phase<PH_WIN0>(w, 0, smem);
    GSYNC(); STAMP(3);
    run_phase<PH_S5E>(w, 0, smem);
    for (int it = bidx(); it < 8448; it += gridDim.x) rw1_item(w, it, smem);
    { unsigned* ctl = (unsigned*)(p.ws + WS_CTL);
      wait_count(ctl, CT_S5ED, 160u);
      for (;;) { const int t = take_ticket(&ctl[CT_CARRYT], bc); if (t >= 32) break; phase_s5_carry(w, (size_t)t * 256 + tidx(), (size_t)1 << 40); } }
    GSYNC(); STAMP(4);
    phase_scan_and_side(p, w, smem, bc);
    GSYNC(); STAMP(5);
    run_phase<PH_GLU>(w, 0, smem);
    run_phase<PH_RWKVOUT>(w, 0, smem);
    run_early<PH_CONVERT>(p, smem);
    GSYNC(); STAMP(7);
    run_phase<PH_WOUT>(w, 0, smem);   GSYNC(); STAMP(8);
    run_phase<PH_LN1>(w, 0, smem);    GSYNC(); STAMP(9);
    run_phase<PH_QGEMM>(w, 0, smem);  GSYNC(); STAMP(10);
    STAMP(11);
    run_phase<PH_GATHER>(w, 0, smem); GSYNC(); run_phase<PH_GATHERB>(w, 0, smem); GSYNC(); STAMP(12);
    run_phase<PH_WIN1>(w, 1, smem);   GSYNC(); STAMP(13);
    run_phase<PH_ATTN>(w, 1, smem);   GSYNC(); STAMP(14);
    run_phase<PH_WOUT>(w, 1, smem);   GSYNC(); STAMP(15);
    run_phase<PH_LN1>(w, 1, smem);    GSYNC(); STAMP(16);
    run_phase<PH_QGEMM>(w, 1, smem);  GSYNC(); STAMP(17);
    STAMP(18);
    run_phase<PH_GATHER>(w, 1, smem); GSYNC(); run_phase<PH_GATHERB>(w, 1, smem);
    DIAG_TAIL();
    grid.sync();
}

extern "C" void kernel_launch(void* const* d_in, const int* in_sizes, int n_in, void* d_out, int out_size, void* d_ws, size_t ws_size,
                              hipStream_t stream) {
    (void)in_sizes; (void)n_in; (void)out_size; (void)ws_size;
    static int grid_blocks = 0;
    if (!grid_blocks) {
        int dev = 0, cus = 0, per_cu = 0;
        hipGetDevice(&dev);
        hipDeviceGetAttribute(&cus, hipDeviceAttributeMultiprocessorCount, dev);
        hipOccupancyMaxActiveBlocksPerMultiprocessor(&per_cu, mega_kernel, 256, 0);
        if (per_cu > 2) per_cu = 2;
        if (per_cu < 1) per_cu = 1;
        grid_blocks = cus * per_cu;
    }
    P p{};
    for (int i = 0; i < 51; ++i) p.in[i] = (const float*)d_in[i];
    p.out = (float*)d_out; p.ws = (unsigned char*)d_ws;
    hipMemsetAsync((unsigned char*)d_ws + WS_CTL, 0, CTL_WORDS * 4, stream);
    void* args[] = {&p};
    hipError_t e = hipLaunchCooperativeKernel((void*)mega_kernel, dim3(grid_blocks), dim3(256), args, 0, stream);
    if (e != hipSuccess) fprintf(stderr, "cooperative launch failed: %s (grid %d)\n", hipGetErrorString(e), grid_blocks);
}
```

```cpp
#include <hip/hip_runtime.h>
#include <hip/hip_cooperative_groups.h>
#include <stdint.h>
#include <stdio.h>
#define DIAGX 0

#define DM      1024
#define NB      4
#define TT      8192
#define LC      256
#define SS      8448
#define NTOK    33792
#define ZW0     2176
#define ZW1     2304
#define ALPHA_F 1.41421356237f
#define NCH     132

typedef unsigned short bf16_t;
using bf16x8 = __attribute__((ext_vector_type(8))) short;
using f32x16 = __attribute__((ext_vector_type(16))) float;
using f32x4  = __attribute__((ext_vector_type(4))) float;
using bf16x2v = __attribute__((ext_vector_type(2))) __bf16;
using u32x4v = __attribute__((ext_vector_type(4))) unsigned;


__device__ __forceinline__ int tidx() { int t = (int)threadIdx.x; asm volatile("" : "+v"(t)); return t; }
__device__ __forceinline__ int bidx() { int t = (int)blockIdx.x; asm volatile("" : "+s"(t)); return t; }
typedef __bf16 hwbf16x2_t __attribute__((ext_vector_type(2)));
typedef float hwf32x2_t __attribute__((ext_vector_type(2)));
__device__ __forceinline__ bf16_t f2bf(float f) { return (bf16_t)__builtin_bit_cast(unsigned short, (__bf16)f); }
__device__ __forceinline__ float bf2f(bf16_t h) { return __uint_as_float(((unsigned)h) << 16); }
__device__ __forceinline__ unsigned pack2(float lo, float hi) { const hwf32x2_t f = {lo, hi}; return __builtin_bit_cast(unsigned, __builtin_convertvector(f, hwbf16x2_t)); }
__device__ __forceinline__ float bflo(unsigned u) { return __uint_as_float(u << 16); }
__device__ __forceinline__ float bfhi(unsigned u) { return __uint_as_float(u & 0xffff0000u); }
__device__ __forceinline__ float sigmoidf_(float x) { return 1.f / (1.f + __expf(-x)); }
__device__ __forceinline__ float siluf_(float x) { return x / (1.f + __expf(-x)); }
__device__ __forceinline__ float geluf_(float x) { return 0.5f * x * (1.f + erff(x * 0.70710678118654752f)); }

template <int CTRL> __device__ __forceinline__ float dppf(float x) {
    return __builtin_bit_cast(float, __builtin_amdgcn_mov_dpp(__builtin_bit_cast(int, x), CTRL, 0xf, 0xf, true));
}
#define DPP_XOR1 0xB1
#define DPP_XOR2 0x4E
#define DPP_ROR4 0x124
#define DPP_ROR8 0x128
__device__ __forceinline__ float row16_sum(float x) {
    x += dppf<DPP_XOR1>(x); x += dppf<DPP_XOR2>(x); x += dppf<DPP_ROR4>(x); x += dppf<DPP_ROR8>(x); return x;
}
__device__ __forceinline__ float row16_max(float x) {
    x = fmaxf(x, dppf<DPP_XOR1>(x)); x = fmaxf(x, dppf<DPP_XOR2>(x)); x = fmaxf(x, dppf<DPP_ROR4>(x)); x = fmaxf(x, dppf<DPP_ROR8>(x)); return x;
}
__device__ __forceinline__ float xrow_sum(float x) {
    auto s = __builtin_amdgcn_permlane16_swap(__float_as_uint(x), __float_as_uint(x), false, false);
    x = __uint_as_float(s[0]) + __uint_as_float(s[1]);
    auto t = __builtin_amdgcn_permlane32_swap(__float_as_uint(x), __float_as_uint(x), false, false);
    return __uint_as_float(t[0]) + __uint_as_float(t[1]);
}
__device__ __forceinline__ float xrow_max(float x) {
    auto s = __builtin_amdgcn_permlane16_swap(__float_as_uint(x), __float_as_uint(x), false, false);
    x = fmaxf(__uint_as_float(s[0]), __uint_as_float(s[1]));
    auto t = __builtin_amdgcn_permlane32_swap(__float_as_uint(x), __float_as_uint(x), false, false);
    return fmaxf(__uint_as_float(t[0]), __uint_as_float(t[1]));
}
__device__ __forceinline__ float wave_sum(float x) { return xrow_sum(row16_sum(x)); }
__device__ __forceinline__ float wave_max(float x) { return xrow_max(row16_max(x)); }
__device__ __forceinline__ float half_swap_sum(float x) {
    auto t = __builtin_amdgcn_permlane32_swap(__float_as_uint(x), __float_as_uint(x), false, false);
    return __uint_as_float(t[0]) + __uint_as_float(t[1]);
}
__device__ __forceinline__ float half_swap_max(float x) {
    auto t = __builtin_amdgcn_permlane32_swap(__float_as_uint(x), __float_as_uint(x), false, false);
    return fmaxf(__uint_as_float(t[0]), __uint_as_float(t[1]));
}

constexpr size_t al256(size_t x) { return (x + 255) & ~(size_t)255; }
constexpr size_t WS_WIN0T  = 0;
constexpr size_t WS_WOUT0T = WS_WIN0T  + al256((size_t)ZW0 * 1024 * 2);
constexpr size_t WS_WQ0T   = WS_WOUT0T + al256((size_t)1024 * 768 * 2);
constexpr size_t WS_KEYS0  = WS_WQ0T   + al256((size_t)1024 * 1024 * 2);
constexpr size_t WS_WIN1T  = WS_KEYS0  + al256((size_t)2048 * 64 * 2);
constexpr size_t WS_WOUT1T = WS_WIN1T  + al256((size_t)ZW1 * 1024 * 2);
constexpr size_t WS_WQ1T   = WS_WOUT1T + al256((size_t)1024 * 1024 * 2);
constexpr size_t WS_KEYS1  = WS_WQ1T   + al256((size_t)1024 * 1024 * 2);
constexpr size_t WS_WGLUT  = WS_KEYS1  + al256((size_t)2048 * 64 * 2);
constexpr size_t WS_W2T    = WS_WGLUT  + al256((size_t)256 * 256 * 2);
constexpr size_t WS_A2T    = WS_W2T    + al256((size_t)2 * 512 * 64 * 2);
constexpr size_t WS_G2T    = WS_A2T    + al256((size_t)2 * 512 * 64 * 2);
constexpr size_t WS_S5POW  = WS_G2T    + al256((size_t)512 * 128 * 2);
constexpr size_t WS_S5K    = WS_S5POW  + al256((size_t)2 * 16 * 64 * 65 * 2 * 4);
constexpr size_t WS_S5W    = WS_S5K    + al256((size_t)2 * 16 * 64 * 256 * 2);
constexpr size_t WS_S5V    = WS_S5W    + al256((size_t)2 * 16 * 128 * 1024 * 2);
constexpr size_t WS_MODP   = WS_S5V    + al256((size_t)2 * 16 * 1024 * 128 * 2);
constexpr size_t WS_MOD    = WS_MODP   + al256((size_t)8 * 2 * 5 * 6144 * 4);
constexpr size_t WS_TABU0  = WS_MOD    + al256((size_t)2 * 5 * 6144 * 4);
constexpr size_t WS_TABV0  = WS_TABU0  + (size_t)16384 * 1024;
constexpr size_t WS_TABU1  = WS_TABV0  + (size_t)16384 * 1024;
constexpr size_t WS_TABV1  = WS_TABU1  + (size_t)16384 * 1024;
constexpr size_t WS_TABSC  = WS_TABV1  + (size_t)16384 * 1024;
constexpr size_t WS_ZX     = WS_TABU0  + (size_t)4 * 16384 * 1024 * 2;
constexpr size_t WS_CTX    = WS_ZX     + al256((size_t)NTOK * ZW1 * 2);
constexpr size_t WS_US5    = WS_CTX    + al256((size_t)1024 * 1024 * 4);
constexpr size_t WS_S5E    = WS_US5    + al256((size_t)16 * NTOK * 16 * 2);
constexpr size_t WS_S5H    = WS_S5E    + al256((size_t)2 * 16 * 528 * 128 * 4);
constexpr size_t WS_YA     = WS_S5H    + al256((size_t)2 * 16 * 528 * 128 * 2);
constexpr size_t WS_YB     = WS_YA     + al256((size_t)NTOK * 256 * 2);
constexpr size_t WS_BON    = WS_YB     + al256((size_t)2 * NTOK * 512 * 2);
constexpr size_t WS_MIX    = WS_BON    + al256((size_t)NTOK * 16 * 4);
constexpr size_t WS_END    = WS_MIX    + al256((size_t)NTOK * 1024 * 2);
constexpr size_t WS_VT     = WS_TABSC + (size_t)4 * 16384 * 4;
static_assert(WS_VT + (size_t)4 * 10 * 64 * SS * 2 <= WS_ZX, "VT fits behind the fp8 tables");
constexpr size_t WS_HB     = WS_MIX;
constexpr size_t WS_HB2    = WS_YB;
constexpr int PAR_SHIFT = 0, PAR_A0 = 3840, PAR_W0 = 4864, PAR_KK = 5888, PAR_KA = 6400, PAR_RK = 6912, PAR_BGLU = 7424, PAR_GNW = 7680, PAR_GNB = 8192,
              PAR_LN1G0 = 8704, PAR_LN1B0 = 9728, PAR_LN2G0 = 10752, PAR_LN2B0 = 11776, PAR_LN1G1 = 12800, PAR_LN1B1 = 13824, PAR_LN2G1 = 14848, PAR_LN2B1 = 15872,
              PAR_RPB = 16896, PAR_SINK = 20736, PAR_TOTAL = 20800;
constexpr size_t WS_PAR    = WS_END + 16384;
static_assert(WS_PAR + (size_t)PAR_TOTAL * 4 <= (size_t)536870912, "param pack fits");
constexpr size_t WS_TS     = WS_PAR + (size_t)PAR_TOTAL * 4 + 256;
static_assert(WS_TS + 512 <= (size_t)536870912, "ts fits");
constexpr size_t WS_RWR    = WS_TABU0;
constexpr size_t WS_RWK    = WS_RWR + (size_t)NTOK * 512 * 2;
constexpr size_t WS_RWAS   = WS_RWK + (size_t)NTOK * 512 * 2;
constexpr size_t WS_RWNRM  = WS_RWAS + (size_t)2 * NTOK * 512;
static_assert(WS_RWNRM + (size_t)NTOK * 8 * 4 <= WS_ZX, "rwkv hand-off fits in the table region");
constexpr size_t WS_RWLW   = WS_MIX;
constexpr size_t WS_IDX    = WS_US5;
constexpr size_t WS_GATE   = WS_YA;
static_assert((size_t)NTOK * 128 * 4 <= (size_t)16 * NTOK * 16 * 2 && (size_t)NTOK * 128 * 4 <= (size_t)NTOK * 256 * 2, "idx/gate overlays");
static_assert(WS_END <= (size_t)536870912, "workspace budget");

struct P {
    const float* in[51];
    float* out;
    unsigned char* ws;
};
struct W { const float* x; const float* ctx; float* out; unsigned char* ws; };
enum {
    I_X = 0, I_C, I_CTX, I_CCTX,
    I0_WMOD, I0_BMOD, I0_WIN, I0_LAMRE, I0_LAMIM, I0_LOGDT, I0_BRE, I0_BIM, I0_CRE, I0_CIM, I0_S5D, I0_WGLU, I0_BGLU,
    I0_SHIFT, I0_W0, I0_W2, I0_A0, I0_A2, I0_G2, I0_KK, I0_KA, I0_RK, I0_GNW, I0_GNB, I0_WOUT, I0_LN1G, I0_LN1B,
    I0_WQ, I0_KEYS, I0_U, I0_V, I0_LN2G, I0_LN2B,
    I1_WMOD, I1_BMOD, I1_WIN, I1_SINK, I1_RPB, I1_WOUT, I1_LN1G, I1_LN1B, I1_WQ, I1_KEYS, I1_U, I1_V, I1_LN2G, I1_LN2B
};
static_assert(I1_LN2B == 50, "51 inputs");

#define WSP(T, off) ((T*)(p.ws + (off)))
#define PAR(off) (((const float*)(p.ws + WS_PAR)) + (off))

constexpr size_t WS_CTL = WS_TS + 512;
#define CTL_WORDS 8192
constexpr size_t WS_S5BB = WS_CTL + CTL_WORDS * 4;
static_assert(WS_S5BB + (size_t)2048 * 32 * 4 <= (size_t)536870912, "ctl + bbar fit");
#define XB_TMO      128
#define XB_XCNT(j)  (256  + 64 * (j))
#define XB_XSUB(j)  (1280 + 64 * (j))
#define XB_XGEN(j)  (2304 + 64 * (j))
#define XB_TOP      3328
#define XB_TOPGEN   3392
#define CT_ELECT    4096
#define CT_NEXT     6144
#define CT_CARRYT   6208
#define CT_CARRYD   6272
#define CT_S5YT     6336
#define CT_S5YD     6400
#define CT_CONVT    6464
#define CT_GLUT     6528
#define CT_S5ED     6592
#define XB_SPIN_CAP (1u << 22)
#define LAS __attribute__((address_space(3)))
__device__ __forceinline__ unsigned xb_ld(unsigned* p)              { return __hip_atomic_load(p, __ATOMIC_RELAXED, __HIP_MEMORY_SCOPE_AGENT); }
__device__ __forceinline__ unsigned xb_add(unsigned* p, unsigned v) { return __hip_atomic_fetch_add(p, v, __ATOMIC_RELAXED, __HIP_MEMORY_SCOPE_AGENT); }
__device__ __forceinline__ unsigned xb_xcc_id() { return (unsigned)__builtin_amdgcn_s_getreg((3 << 11) | 20) & 0xFu; }
__device__ __forceinline__ unsigned cu_key() { return ((unsigned)__builtin_amdgcn_s_getreg(63492) >> 8) & 0xffu; }
#define XB_SPIN(cond, bar) do { unsigned _sp = 0; while (cond) { __builtin_amdgcn_s_sleep(1); \
    if ((++_sp & 255u) == 0u) { if (xb_ld(&(bar)[XB_TMO])) break; if (_sp > XB_SPIN_CAP) { atomicAdd(&(bar)[XB_TMO], 1u); break; } } } } while (0)
struct XcdBarrier { unsigned* bar; unsigned x; volatile LAS unsigned* st; };
__device__ __forceinline__ XcdBarrier xcd_barrier_post(unsigned* bar, volatile LAS unsigned* st) {
    XcdBarrier b; b.bar = bar; b.x = xb_xcc_id(); b.st = st;
    if (tidx() == 0) (void)xb_add(&bar[XB_XCNT(b.x)], 1u);
    return b;
}
__device__ __forceinline__ void xcd_barrier_complete(unsigned* bar, unsigned x, unsigned& nloc, unsigned& nx) {
    const unsigned G = gridDim.x;
    unsigned sum, cnt, mine, sp = 0u;
    for (;;) {
        sum = 0u; cnt = 0u; mine = 0u;
#pragma unroll
        for (unsigned j = 0; j < 16; ++j) { const unsigned c = xb_ld(&bar[XB_XCNT(j)]); sum += c; cnt += (c > 0u) ? 1u : 0u; mine = (j == x) ? c : mine; }
        if (sum == G) break;
        __builtin_amdgcn_s_sleep(1);
        if ((++sp & 255u) == 0u) { if (xb_ld(&bar[XB_TMO])) break; if (sp > XB_SPIN_CAP) { atomicAdd(&bar[XB_TMO], 1u); break; } }
    }
    nloc = mine > 0u ? mine : 1u; nx = cnt > 0u ? cnt : 1u;
}
__device__ __forceinline__ void xcd_barrier(const XcdBarrier& b) {
    asm volatile("s_waitcnt vmcnt(0)" ::: "memory");
    __syncthreads();
    if (tidx() == 0) {
        unsigned* bar = b.bar;
        __builtin_amdgcn_s_waitcnt(0);
        unsigned nloc = b.st[0], nx = b.st[1];
        if (nloc == 0u) { xcd_barrier_complete(bar, b.x, nloc, nx); b.st[0] = nloc; b.st[1] = nx; }
        const unsigned old = xb_add(&bar[XB_XSUB(b.x)], 1u);
        const unsigned gen = old / nloc;
        if (old + 1u == (gen + 1u) * nloc) {
            __builtin_amdgcn_fence(__ATOMIC_RELEASE, "agent");
            asm volatile("s_waitcnt vmcnt(0)" ::: "memory");
            const unsigned og = xb_add(&bar[XB_TOP], 1u);
            const unsigned tg = og / nx;
            if (og + 1u == (tg + 1u) * nx) xb_add(&bar[XB_TOPGEN], 1u);
            else XB_SPIN(xb_ld(&bar[XB_TOPGEN]) == tg, bar);
            __builtin_amdgcn_fence(__ATOMIC_ACQUIRE, "agent");
            xb_add(&bar[XB_XGEN(b.x)], 1u);
            asm volatile("s_waitcnt vmcnt(0)" ::: "memory");
        } else {
            XB_SPIN(xb_ld(&bar[XB_XGEN(b.x)]) == gen, bar);
            __builtin_amdgcn_fence(__ATOMIC_ACQUIRE, "agent");
            asm volatile("s_waitcnt vmcnt(0)" ::: "memory");
        }
    }
    __syncthreads();
}
__device__ __forceinline__ int take_ticket(unsigned* ctr, volatile LAS unsigned* bc) {
    __syncthreads();
    if (tidx() == 0) bc[0] = xb_add(ctr, 1u);
    __syncthreads();
    return (int)bc[0];
}
__device__ __forceinline__ void signal_done(unsigned* ctr) {
    asm volatile("s_waitcnt vmcnt(0)" ::: "memory");
    __syncthreads();
    if (tidx() == 0) {
        __builtin_amdgcn_fence(__ATOMIC_RELEASE, "agent");
        asm volatile("s_waitcnt vmcnt(0)" ::: "memory");
        xb_add(ctr, 1u);
    }
}
__device__ __forceinline__ void wait_count(unsigned* ctl, int word, unsigned target) {
    if (tidx() == 0) {
        XB_SPIN(xb_ld(&ctl[word]) < target, ctl);
        __builtin_amdgcn_fence(__ATOMIC_ACQUIRE, "agent");
        asm volatile("s_waitcnt vmcnt(0)" ::: "memory");
    }
    __syncthreads();
}

__device__ void transpose_cvt_tile(const float* __restrict__ W, int K, int N, bf16_t* __restrict__ Wt, int tile, float* sm) {
    const int tn = N / 64;
    const int k0 = (tile / tn) * 64, n0 = (tile % tn) * 64;
    const int tid = tidx();
    for (int e = tid; e < 4096; e += 256) { int r = e >> 6, c = e & 63; sm[r * 65 + c] = W[(size_t)(k0 + r) * N + n0 + c]; }
    __syncthreads();
    for (int e = tid; e < 4096; e += 256) { int r = e >> 6, c = e & 63; Wt[(size_t)(n0 + r) * K + k0 + c] = f2bf(sm[c * 65 + r]); }
    __syncthreads();
}

struct TrDesc { int in_idx; size_t in_off; int K, N; size_t out_off; };
#define N_TR 12
__device__ __forceinline__ TrDesc tr_desc(int i) {
    switch (i) {
        case 0:  return {I0_WIN, 0, 1024, ZW0, WS_WIN0T};
        case 1:  return {I0_WOUT, 0, 768, 1024, WS_WOUT0T};
        case 2:  return {I0_WQ, 0, 1024, 1024, WS_WQ0T};
        case 3:  return {I1_WIN, 0, 1024, ZW1, WS_WIN1T};
        case 4:  return {I1_WOUT, 0, 1024, 1024, WS_WOUT1T};
        case 5:  return {I1_WQ, 0, 1024, 1024, WS_WQ1T};
        case 6:  return {I0_WGLU, 0, 256, 256, WS_WGLUT};
        case 7:  return {I0_W2, 0, 64, 512, WS_W2T};
        case 8:  return {I0_W2, (size_t)64 * 512, 64, 512, WS_W2T + (size_t)512 * 64 * 2};
        case 9:  return {I0_A2, 0, 64, 512, WS_A2T};
        case 10: return {I0_A2, (size_t)64 * 512, 64, 512, WS_A2T + (size_t)512 * 64 * 2};
        default: return {I0_G2, 0, 128, 512, WS_G2T};
    }
}
__device__ int tr_total_tiles() { int t = 0; for (int i = 0; i < N_TR; ++i) { TrDesc d = tr_desc(i); t += (d.K / 64) * (d.N / 64); } return t; }

__device__ void phase_transpose(const P& p, float* sm, int bid, int nblk) {
    const int total = tr_total_tiles();
    for (int t = bid; t < total; t += nblk) {
        int rem = t, i = 0;
        for (; i < N_TR; ++i) { TrDesc d = tr_desc(i); int n = (d.K / 64) * (d.N / 64); if (rem < n) break; rem -= n; }
        TrDesc d = tr_desc(i);
        transpose_cvt_tile(p.in[d.in_idx] + d.in_off, d.K, d.N, (bf16_t*)(p.ws + d.out_off), rem, sm);
    }
}

__device__ void cvt_range(const float* __restrict__ src, bf16_t* __restrict__ dst, size_t n, size_t gtid, size_t gthreads) {
    const size_t n8 = n / 8;
    for (size_t i = gtid; i < n8; i += gthreads) {
        float4 a = ((const float4*)src)[2 * i], b = ((const float4*)src)[2 * i + 1];
        uint4 o; o.x = pack2(a.x, a.y); o.y = pack2(a.z, a.w); o.z = pack2(b.x, b.y); o.w = pack2(b.z, b.w);
        ((uint4*)dst)[i] = o;
    }
}
struct __attribute__((aligned(4))) U3 { unsigned x, y, z; };
__device__ __forceinline__ unsigned e2m3_code(float v) {
    const float a = fabsf(v);
    const float c = a < 2.f ? rintf(a * 8.f) : (a < 4.f ? 16.f + rintf((a - 2.f) * 4.f) : 24.f + rintf((a - 4.f) * 2.f));
    return (unsigned)fminf(c, 31.f) | (v < 0.f ? 32u : 0u);
}
__device__ void phase_convert(const P& p, size_t gtid, size_t gthreads) {
    cvt_range(p.in[I0_KEYS], WSP(bf16_t, WS_KEYS0), (size_t)2048 * 64, gtid, gthreads);
    cvt_range(p.in[I1_KEYS], WSP(bf16_t, WS_KEYS1), (size_t)2048 * 64, gtid, gthreads);
    const int lane = (int)(gtid & 63);
    const size_t gwave = gtid >> 6, nwaves = gthreads >> 6;
    float* scl = WSP(float, WS_TABSC);
    const float* t0 = p.in[I0_U]; const float* t1 = p.in[I0_V]; const float* t2 = p.in[I1_U]; const float* t3 = p.in[I1_V];
#define CV_SRC(R_) ((((R_) >> 14) == 0 ? t0 : ((R_) >> 14) == 1 ? t1 : ((R_) >> 14) == 2 ? t2 : t3) + (size_t)((R_) & 16383) * 1024 + lane * 16)
#define CV_LOAD(DST, R_) { const size_t rr_ = (R_) < (size_t)4 * 16384 ? (R_) : (size_t)4 * 16384 - 1; const float4* s_ = (const float4*)CV_SRC(rr_); \
        _Pragma("unroll") for (int q_ = 0; q_ < 4; ++q_) { const float4 t_ = s_[q_]; DST[4 * q_] = t_.x; DST[4 * q_ + 1] = t_.y; DST[4 * q_ + 2] = t_.z; DST[4 * q_ + 3] = t_.w; } }
    float pa[16], pb[16];
    CV_LOAD(pa, gwave) CV_LOAD(pb, gwave + nwaves)
    for (size_t r = gwave; r < (size_t)4 * 16384; r += nwaves) {
        const int tb = (int)(r >> 14), row = (int)(r & 16383);
        unsigned char* dst = p.ws + (tb == 0 ? WS_TABU0 : tb == 1 ? WS_TABV0 : tb == 2 ? WS_TABU1 : WS_TABV1) + (size_t)row * 768 + lane * 12;
        float v[16];
#pragma unroll
        for (int u = 0; u < 16; ++u) { v[u] = pa[u]; pa[u] = pb[u]; }
        CV_LOAD(pb, r + 2 * nwaves)
        float mx = 0.f;
#pragma unroll
        for (int u = 0; u < 16; ++u) mx = fmaxf(mx, fabsf(v[u]));
        mx = wave_max(mx);
        const float sc = mx > 0.f ? 7.5f / mx : 1.f;
        unsigned c[16];
#pragma unroll
        for (int u = 0; u < 16; ++u) c[u] = e2m3_code(v[u] * sc);
        unsigned long long lo = 0ull;
#pragma unroll
        for (int u = 0; u < 10; ++u) lo |= (unsigned long long)c[u] << (6 * u);
        lo |= (unsigned long long)(c[10] & 15u) << 60;
        U3 o3;
        o3.x = (unsigned)lo; o3.y = (unsigned)(lo >> 32);
        o3.z = (c[10] >> 4) | (c[11] << 2) | (c[12] << 8) | (c[13] << 14) | (c[14] << 20) | (c[15] << 26);
        *(U3*)dst = o3;
        if (lane == 0) scl[r] = mx > 0.f ? mx / 7.5f : 1.f;
    }
#undef CV_LOAD
#undef CV_SRC
}
#define PSEG(IDX, OFF, CNT) if (r < (CNT)) { dst[(OFF) + r] = p.in[IDX][r]; continue; } r -= (CNT);
__device__ void phase_pack_params(const P& p, size_t gtid, size_t gthreads) {
    float* dst = (float*)(p.ws + WS_PAR);
    for (size_t i = gtid; i < 20624; i += gthreads) {
        int r = (int)i;
        PSEG(I0_SHIFT, PAR_SHIFT, 3840) PSEG(I0_A0, PAR_A0, 1024) PSEG(I0_W0, PAR_W0, 1024) PSEG(I0_KK, PAR_KK, 512) PSEG(I0_KA, PAR_KA, 512)
        PSEG(I0_RK, PAR_RK, 512) PSEG(I0_BGLU, PAR_BGLU, 256) PSEG(I0_GNW, PAR_GNW, 512) PSEG(I0_GNB, PAR_GNB, 512)
        PSEG(I0_LN1G, PAR_LN1G0, 1024) PSEG(I0_LN1B, PAR_LN1B0, 1024) PSEG(I0_LN2G, PAR_LN2G0, 1024) PSEG(I0_LN2B, PAR_LN2B0, 1024)
        PSEG(I1_LN1G, PAR_LN1G1, 1024) PSEG(I1_LN1B, PAR_LN1B1, 1024) PSEG(I1_LN2G, PAR_LN2G1, 1024) PSEG(I1_LN2B, PAR_LN2B1, 1024)
        PSEG(I1_RPB, PAR_RPB, 3720) PSEG(I1_SINK, PAR_SINK, 8)
    }
}
#undef PSEG
__device__ void phase_mod_partial(const P& p, int gwave, int nwaves) {
    const int lane = tidx() & 63;
    for (int it = gwave; it < 2 * 96 * 8; it += nwaves) {
        const int kc = it & 7, ct = (it >> 3) % 96, l = it / (8 * 96);
        const float* wm = p.in[l ? I1_WMOD : I0_WMOD];
        const int col = ct * 64 + lane;
        float sa[5], sb[5];
#pragma unroll
        for (int n = 0; n < 5; ++n) {
            const float* cv = n < 4 ? p.in[I_C] + n * 1024 : p.in[I_CCTX];
            sa[n] = siluf_(cv[kc * 128 + lane]); sb[n] = siluf_(cv[kc * 128 + 64 + lane]);
        }
        float acc[5] = {0.f, 0.f, 0.f, 0.f, 0.f};
        const float* wp = wm + (size_t)(kc * 128) * 6144 + col;
#pragma unroll 1
        for (int i0 = 0; i0 < 64; i0 += 32) {
            float w0[32], w1[32];
#pragma unroll
            for (int j = 0; j < 32; ++j) { w0[j] = wp[(size_t)(i0 + j) * 6144]; w1[j] = wp[(size_t)(64 + i0 + j) * 6144]; }
#pragma unroll
            for (int j = 0; j < 32; ++j)
#pragma unroll
                for (int n = 0; n < 5; ++n) {
                    const float s0 = __builtin_bit_cast(float, __builtin_amdgcn_readlane(__builtin_bit_cast(int, sa[n]), i0 + j));
                    const float s1 = __builtin_bit_cast(float, __builtin_amdgcn_readlane(__builtin_bit_cast(int, sb[n]), i0 + j));
                    acc[n] += s0 * w0[j] + s1 * w1[j];
                }
        }
        float* mp = WSP(float, WS_MODP);
#pragma unroll
        for (int n = 0; n < 5; ++n) mp[(((size_t)kc * 2 + l) * 5 + n) * 6144 + col] = acc[n];
    }
}
__device__ void phase_mod_reduce(const P& p, size_t gtid, size_t gthreads) {
    const float* mp = WSP(float, WS_MODP);
    float* mo = WSP(float, WS_MOD);
    for (size_t i = gtid; i < (size_t)2 * 5 * 6144; i += gthreads) {
        const int l = (int)(i / (5 * 6144)), col = (int)(i % 6144);
        float s = p.in[l ? I1_BMOD : I0_BMOD][col];
        for (int kc = 0; kc < 8; ++kc) s += mp[(size_t)kc * 2 * 5 * 6144 + i];
        mo[i] = s;
    }
}

__device__ void phase_s5_pow(const P& p, size_t gtid, size_t gthreads) {
    float* pw = WSP(float, WS_S5POW);
    for (size_t e = gtid; e < (size_t)2048 * 65; e += gthreads) {
        const int i = (int)(e / 65), j = (int)(e - (size_t)i * 65);
        const float lr = p.in[I0_LAMRE][i], li = p.in[I0_LAMIM][i];
        const float dt = expf(p.in[I0_LOGDT][i >> 6]);
        const float mag = expf(lr * dt * (float)j), ang = li * dt * (float)j;
        pw[e * 2] = mag * cosf(ang); pw[e * 2 + 1] = mag * sinf(ang);
    }
    for (size_t e = gtid; e < (size_t)2048 * 16; e += gthreads) {
        const int i = (int)(e >> 4), q = (int)(e & 15);
        const float lr = p.in[I0_LAMRE][i], li = p.in[I0_LAMIM][i];
        const float dt = expf(p.in[I0_LOGDT][i >> 6]);
        const float mag = expf(lr * dt);
        const float ar = mag * cosf(li * dt), ai = mag * sinf(li * dt);
        const float den = lr * lr + li * li, nr1 = ar - 1.f;
        const float kr = (nr1 * lr + ai * li) / den, ki = (ai * lr - nr1 * li) / den;
        const float xr = p.in[I0_BRE][e], xi = p.in[I0_BIM][e];
        float* bbt = (float*)(p.ws + WS_S5BB) + (size_t)i * 32 + 2 * q;
        bbt[0] = kr * xr - ki * xi; bbt[1] = kr * xi + ki * xr;
    }
}
__device__ __forceinline__ void s5_bbar(const P& p, int dgp, int i, float& br, float& bi) {
    const float* bbt = (const float*)(p.ws + WS_S5BB) + (size_t)dgp * 32 + 2 * i;
    br = bbt[0]; bi = bbt[1];
}
#define TSTAMP(k) do { if (DIAGX && bidx() == 0 && tidx() == 0) ((volatile unsigned long long*)(p.ws + WS_TS))[k] = __builtin_amdgcn_s_memrealtime(); } while (0)
__device__ void phase_s5_tables(const P& p, size_t gtid, size_t gthreads) {
    const float* pw = WSP(float, WS_S5POW);
    const float* bbt = (const float*)(p.ws + WS_S5BB);
    bf16_t* Kt = WSP(bf16_t, WS_S5K);
    bf16_t* Wt = WSP(bf16_t, WS_S5W);
    bf16_t* Vt = WSP(bf16_t, WS_S5V);
    for (size_t e = gtid; e < (size_t)32 * 64 * 64; e += gthreads) {
        const int ipq = (int)(e & 3), i = (int)((e >> 2) & 15), lag = (int)((e >> 6) & 63), dg = (int)(e >> 12);
        float acc[4] = {0.f, 0.f, 0.f, 0.f};
        const float* crp = p.in[I0_CRE] + ((size_t)dg * 16 + i) * 64;
        const float* cip = p.in[I0_CIM] + ((size_t)dg * 16 + i) * 64;
#pragma unroll 8
        for (int pp = 0; pp < 64; ++pp) {
            const int dgp = dg * 64 + pp;
            const float2 a = *(const float2*)&pw[((size_t)dgp * 65 + lag) * 2];
            const float cr = crp[pp], ci = cip[pp];
            const float tr = cr * a.x - ci * a.y, ti = cr * a.y + ci * a.x;
            const float4 b0 = *(const float4*)&bbt[(size_t)dgp * 32 + ipq * 8], b1 = *(const float4*)&bbt[(size_t)dgp * 32 + ipq * 8 + 4];
            acc[0] += tr * b0.x - ti * b0.y; acc[1] += tr * b0.z - ti * b0.w;
            acc[2] += tr * b1.x - ti * b1.y; acc[3] += tr * b1.z - ti * b1.w;
        }
        if (lag == 0 && dg < 16 && (i >> 2) == ipq) acc[i & 3] += p.in[I0_S5D][(dg & 15) * 16 + i];
        *(uint2*)&Kt[e * 4] = make_uint2(pack2(acc[0], acc[1]), pack2(acc[2], acc[3]));
    }
    for (size_t e = gtid; e < (size_t)32 * 64 * 64; e += gthreads) {
        const int s_ = (int)(e & 63), pp = (int)((e >> 6) & 63), dg = (int)(e >> 12), d = dg >> 4;
        const int dgp = dg * 64 + pp;
        const int ex = d ? s_ : 63 - s_;
        const float2 a = *(const float2*)&pw[((size_t)dgp * 65 + ex) * 2];
        float tr[16], ti[16];
#pragma unroll
        for (int q = 0; q < 8; ++q) {
            const float4 b = *(const float4*)&bbt[(size_t)dgp * 32 + q * 4];
            tr[2 * q] = a.x * b.x - a.y * b.y; ti[2 * q] = a.x * b.y + a.y * b.x;
            tr[2 * q + 1] = a.x * b.z - a.y * b.w; ti[2 * q + 1] = a.x * b.w + a.y * b.z;
        }
        bf16_t* w0 = Wt + ((size_t)dg * 128 + pp * 2) * 1024 + s_ * 16;
        *(uint4*)&w0[0] = make_uint4(pack2(tr[0], tr[1]), pack2(tr[2], tr[3]), pack2(tr[4], tr[5]), pack2(tr[6], tr[7]));
        *(uint4*)&w0[8] = make_uint4(pack2(tr[8], tr[9]), pack2(tr[10], tr[11]), pack2(tr[12], tr[13]), pack2(tr[14], tr[15]));
        *(uint4*)&w0[1024] = make_uint4(pack2(ti[0], ti[1]), pack2(ti[2], ti[3]), pack2(ti[4], ti[5]), pack2(ti[6], ti[7]));
        *(uint4*)&w0[1032] = make_uint4(pack2(ti[8], ti[9]), pack2(ti[10], ti[11]), pack2(ti[12], ti[13]), pack2(ti[14], ti[15]));
    }
    for (size_t e = gtid; e < (size_t)32 * 64 * 64; e += gthreads) {
        const int pp = (int)(e & 63), t = (int)((e >> 6) & 63), dg = (int)(e >> 12), d = dg >> 4;
        const int dgp = dg * 64 + pp;
        const int ex = d ? 64 - t : t + 1;
        const float2 a = *(const float2*)&pw[((size_t)dgp * 65 + ex) * 2];
        bf16_t* v0 = Vt + ((size_t)dg * 1024 + t * 16) * 128 + pp * 2;
#pragma unroll
        for (int i = 0; i < 16; ++i) {
            const float cr = p.in[I0_CRE][((size_t)dg * 16 + i) * 64 + pp], ci = p.in[I0_CIM][((size_t)dg * 16 + i) * 64 + pp];
            *(unsigned*)&v0[(size_t)i * 128] = pack2(cr * a.x - ci * a.y, -(cr * a.y + ci * a.x));
        }
    }
}

#define GM_LD 72
#define CS_LD 132
#define GEMM_SMEM_BYTES (2 * 128 * (128 + 8) * 2)
static_assert(64 * CS_LD * 4 <= 2 * 128 * GM_LD * 2, "C staging fits");

template <int BK, class AL, class BL, class Epi>
__device__ void gemm_tile(const AL& al, const BL& bl, int K, int m0, int n0, Epi& epi, unsigned char* smem) {
    constexpr int LD = BK + 8;
    constexpr int NC = BK / 64;
    bf16_t* As = (bf16_t*)smem;
    bf16_t* Bs = As + 128 * LD;
    const int tid = tidx(), lane = tid & 63, wave = tid >> 6;
    const int wm = wave >> 1, wn = wave & 1;
    const int lrow = tid >> 3, kc = (tid & 7) * 8;
    typename AL::RowCtx arow[4];
    typename BL::RowCtx brow[4];
#pragma unroll
    for (int i = 0; i < 4; ++i) { arow[i] = al.row(m0 + lrow + 32 * i); brow[i] = bl.row(n0 + lrow + 32 * i); }
    f32x16 acc[2][2];
#pragma unroll
    for (int i = 0; i < 2; ++i)
#pragma unroll
        for (int j = 0; j < 2; ++j)
#pragma unroll
            for (int r = 0; r < 16; ++r) acc[i][j][r] = 0.f;
    uint4 ra[4 * NC], rb[4 * NC];
#pragma unroll
    for (int c = 0; c < NC; ++c)
#pragma unroll
        for (int i = 0; i < 4; ++i) { ra[c * 4 + i] = al.load8(arow[i], c * 64 + kc); rb[c * 4 + i] = bl.load8(brow[i], c * 64 + kc); }
    for (int k0 = 0; k0 < K; k0 += BK) {
        __syncthreads();
#pragma unroll
        for (int c = 0; c < NC; ++c)
#pragma unroll
            for (int i = 0; i < 4; ++i) {
                *(uint4*)&As[(lrow + 32 * i) * LD + c * 64 + kc] = ra[c * 4 + i];
                *(uint4*)&Bs[(lrow + 32 * i) * LD + c * 64 + kc] = rb[c * 4 + i];
            }
        __syncthreads();
        if (k0 + BK < K) {
#pragma unroll
            for (int c = 0; c < NC; ++c)
#pragma unroll
                for (int i = 0; i < 4; ++i) { ra[c * 4 + i] = al.load8(arow[i], k0 + BK + c * 64 + kc); rb[c * 4 + i] = bl.load8(brow[i], k0 + BK + c * 64 + kc); }
        }
#pragma unroll
        for (int kk = 0; kk < BK / 16; ++kk) {
            bf16x8 a[2], b[2];
#pragma unroll
            for (int i = 0; i < 2; ++i) a[i] = *(const bf16x8*)&As[(wm * 64 + i * 32 + (lane & 31)) * LD + kk * 16 + 8 * (lane >> 5)];
#pragma unroll
            for (int j = 0; j < 2; ++j) b[j] = *(const bf16x8*)&Bs[(wn * 64 + j * 32 + (lane & 31)) * LD + kk * 16 + 8 * (lane >> 5)];
#pragma unroll
            for (int i = 0; i < 2; ++i)
#pragma unroll
                for (int j = 0; j < 2; ++j) acc[i][j] = __builtin_amdgcn_mfma_f32_32x32x16_bf16(a[i], b[j], acc[i][j], 0, 0, 0);
        }
    }
    float* Cs = (float*)smem;
#pragma unroll
    for (int pass = 0; pass < 2; ++pass) {
        __syncthreads();
        if (wm == pass) {
#pragma unroll
            for (int i = 0; i < 2; ++i)
#pragma unroll
                for (int j = 0; j < 2; ++j)
#pragma unroll
                    for (int r = 0; r < 16; ++r) {
                        const int row = i * 32 + (r & 3) + 8 * (r >> 2) + 4 * (lane >> 5);
                        const int col = wn * 64 + j * 32 + (lane & 31);
                        Cs[row * CS_LD + col] = acc[i][j][r];
                    }
        }
        __syncthreads();
        epi(Cs, pass, tid);
    }
    __syncthreads();
}

template <int MODE = 0, class Epi>
__device__ void gemm_tile_dma(const bf16_t* __restrict__ A, int lda, const bf16_t* __restrict__ Bt, int ldb, int K, int m0, int n0, Epi& epi, unsigned char* smem) {
    const int tid = tidx(), lane = tid & 63, wave = tid >> 6, wm = wave >> 1, wn = wave & 1, l31 = lane & 31, hh = lane >> 5;
    const int prow = lane >> 3, pchunk = (lane & 7) ^ prow;
    const bf16_t* ga = A + (size_t)(m0 + wave * 32 + prow) * lda + pchunk * 8;
    const bf16_t* gb = Bt + (size_t)(n0 + wave * 32 + prow) * ldb + pchunk * 8;
    f32x16 acc[2][2];
#pragma unroll
    for (int i = 0; i < 2; ++i)
#pragma unroll
        for (int j = 0; j < 2; ++j)
#pragma unroll
            for (int r = 0; r < 16; ++r) acc[i][j][r] = 0.f;
    const int wbase = __builtin_amdgcn_readfirstlane(wave) * (32 * 128);
#define DMA_ISSUE(k0_, buf_) { unsigned char* ab_ = smem + (buf_) * 32768 + wbase; unsigned char* bb_ = ab_ + 16384; \
        _Pragma("unroll") for (int j_ = 0; j_ < 4; ++j_) { \
            __builtin_amdgcn_global_load_lds((const unsigned*)(ga + (size_t)(8 * j_) * lda + (k0_)), (unsigned*)(ab_ + j_ * 1024), 16, 0, 0); \
            __builtin_amdgcn_global_load_lds((const unsigned*)(gb + (size_t)(8 * j_) * ldb + (k0_)), (unsigned*)(bb_ + j_ * 1024), 16, 0, 0); } }
    __syncthreads();
    DMA_ISSUE(0, 0)
    asm volatile("s_waitcnt vmcnt(0)" ::: "memory");
    asm volatile("s_waitcnt lgkmcnt(0)" ::: "memory"); __builtin_amdgcn_s_barrier();
    const int nk = K / 64;
    for (int kt = 0; kt < nk; ++kt) {
        const int buf = kt & 1;
        if (kt + 1 < nk) DMA_ISSUE((kt + 1) * 64, buf ^ 1)
        const bf16_t* As = (const bf16_t*)(smem + buf * 32768);
        const bf16_t* Bs = As + 8192;
#pragma unroll
        for (int kk = 0; kk < 4; ++kk) {
            bf16x8 a[2], b[2];
            const int cc = ((kk * 2 + hh) ^ (l31 & 7)) * 8;
#pragma unroll
            for (int i = 0; i < 2; ++i) a[i] = *(const bf16x8*)&As[(wm * 64 + i * 32 + l31) * 64 + cc];
#pragma unroll
            for (int j = 0; j < 2; ++j) b[j] = *(const bf16x8*)&Bs[(wn * 64 + j * 32 + l31) * 64 + cc];
#pragma unroll
            for (int i = 0; i < 2; ++i)
#pragma unroll
                for (int j = 0; j < 2; ++j) acc[i][j] = __builtin_amdgcn_mfma_f32_32x32x16_bf16(a[i], b[j], acc[i][j], 0, 0, 0);
        }
        asm volatile("s_waitcnt vmcnt(0)" ::: "memory");
        asm volatile("s_waitcnt lgkmcnt(0)" ::: "memory"); __builtin_amdgcn_s_barrier();
    }
#undef DMA_ISSUE
    float* Cs = (float*)smem;
    if constexpr (MODE == 2) {
        __syncthreads();
#pragma unroll
        for (int i = 0; i < 2; ++i)
#pragma unroll
            for (int j = 0; j < 2; ++j)
#pragma unroll
                for (int r = 0; r < 16; ++r) {
                    const int row = wm * 64 + i * 32 + (r & 3) + 8 * (r >> 2) + 4 * (lane >> 5);
                    const int col = wn * 64 + j * 32 + (lane & 31);
                    Cs[row * CS_LD + col] = acc[i][j][r];
                }
        __syncthreads();
        epi.run128(Cs, tid);
    } else {
#pragma unroll
    for (int pass = 0; pass < 2; ++pass) {
        __syncthreads();
        if (wm == pass) {
#pragma unroll
            for (int i = 0; i < 2; ++i)
#pragma unroll
                for (int j = 0; j < 2; ++j)
#pragma unroll
                    for (int r = 0; r < 16; ++r) {
                        const int row = i * 32 + (r & 3) + 8 * (r >> 2) + 4 * (lane >> 5);
                        const int col = wn * 64 + j * 32 + (lane & 31);
                        Cs[row * CS_LD + col] = acc[i][j][r];
                    }
        }
        __syncthreads();
        epi(Cs, pass, tid);
    }
    __syncthreads();
    }
}

__device__ __forceinline__ int xcd_swz(int bid, int nblk) { return (nblk & 7) ? bid : (bid & 7) * (nblk >> 3) + (bid >> 3); }

struct LdBf16 {
    const bf16_t* base; int ld;
    typedef const bf16_t* RowCtx;
    __device__ RowCtx row(int r) const { return base + (size_t)r * ld; }
    __device__ uint4 load8(RowCtx rc, int k) const { return *(const uint4*)(rc + k); }
};
struct LdXMod {
    const float* xlat; const float* xctx; const float* mod; int shift_off, scale_off;
    struct RowCtx { const float* src; const float* m; };
    __device__ RowCtx row(int R) const {
        const int b = R / SS, s = R - b * SS;
        RowCtx rc;
        if (s < LC) { rc.src = xctx + ((size_t)(b * LC + s)) * DM; rc.m = mod + 4 * 6144; }
        else        { rc.src = xlat + ((size_t)(b * TT + s - LC)) * DM; rc.m = mod + b * 6144; }
        return rc;
    }
    __device__ uint4 load8(const RowCtx& rc, int k) const {
        const float4 x0 = *(const float4*)(rc.src + k), x1 = *(const float4*)(rc.src + k + 4);
        const float4 c0 = *(const float4*)(rc.m + scale_off + k), c1 = *(const float4*)(rc.m + scale_off + k + 4);
        const float4 h0 = *(const float4*)(rc.m + shift_off + k), h1 = *(const float4*)(rc.m + shift_off + k + 4);
        uint4 o;
        o.x = pack2(x0.x * (1.f + c0.x) + h0.x, x0.y * (1.f + c0.y) + h0.y);
        o.y = pack2(x0.z * (1.f + c0.z) + h0.z, x0.w * (1.f + c0.w) + h0.w);
        o.z = pack2(x1.x * (1.f + c1.x) + h1.x, x1.y * (1.f + c1.y) + h1.y);
        o.w = pack2(x1.z * (1.f + c1.z) + h1.z, x1.w * (1.f + c1.w) + h1.w);
        return o;
    }
};

struct EpiStoreBf16 {
    bf16_t* out; int ld; int m0, n0; int mmax;
    __device__ void operator()(const float* Cs, int pass, int tid) const {
#pragma unroll
        for (int i = 0; i < 4; ++i) {
            const int c = tid + 256 * i, row = c >> 4, col8 = (c & 15) * 8;
            const int R = m0 + pass * 64 + row;
            if (R >= mmax) continue;
            const float4 a = *(const float4*)&Cs[row * CS_LD + col8], b = *(const float4*)&Cs[row * CS_LD + col8 + 4];
            uint4 o; o.x = pack2(a.x, a.y); o.y = pack2(a.z, a.w); o.z = pack2(b.x, b.y); o.w = pack2(b.z, b.w);
            *(uint4*)&out[(size_t)R * ld + n0 + col8] = o;
        }
    }
};
struct EpiStoreF32 {
    float* out; int ld; int m0, n0; int mmax;
    __device__ void operator()(const float* Cs, int pass, int tid) const {
#pragma unroll
        for (int i = 0; i < 8; ++i) {
            const int c = tid + 256 * i, row = c >> 5, col4 = (c & 31) * 4;
            const int R = m0 + pass * 64 + row;
            if (R >= mmax) continue;
            *(float4*)&out[(size_t)R * ld + n0 + col4] = *(const float4*)&Cs[row * CS_LD + col4];
        }
    }
};

__device__ __forceinline__ void phase_xcvt(const W p, unsigned char* smem) {
    const int gwave = __builtin_amdgcn_readfirstlane((int)bidx() * 4 + (tidx() >> 6)), nwaves = (int)gridDim.x * 4;
    const float* mod = WSP(float, WS_MOD);
    bf16_t* hb = WSP(bf16_t, WS_HB);
    float* sp = (float*)smem;
    for (int i = tidx(); i < 1024; i += 256) {
#pragma unroll
        for (int v = 0; v < 5; ++v) { sp[v * 1024 + i] = mod[v * 6144 + i]; sp[5120 + v * 1024 + i] = mod[v * 6144 + 1024 + i]; }
    }
    __syncthreads();
    if (gwave >= NTOK) return;
#define XC_SRC(R_) ((R_) % SS < LC ? p.ctx + ((size_t)(((R_) / SS) * LC + (R_) % SS)) * DM : p.x + ((size_t)(((R_) / SS) * TT + (R_) % SS - LC)) * DM)
#define XC_LOAD(XD, R_) { const float* s_ = XC_SRC(R_); const int l4_ = (tidx() & 63) * 4; \
        _Pragma("unroll") for (int i_ = 0; i_ < 4; ++i_) { const float4 x4_ = *(const float4*)&s_[i_ * 256 + l4_]; \
            XD[4 * i_] = x4_.x; XD[4 * i_ + 1] = x4_.y; XD[4 * i_ + 2] = x4_.z; XD[4 * i_ + 3] = x4_.w; } }
    float xa[16], xb[16];
    XC_LOAD(xa, gwave)
    { const int r1 = gwave + nwaves < NTOK ? gwave + nwaves : gwave; XC_LOAD(xb, r1) }
    for (int R = gwave; R < NTOK; R += nwaves) {
        const int var = (R % SS) < LC ? 4 : R / SS;
        float xc[16];
        { const int r2 = R + 2 * nwaves < NTOK ? R + 2 * nwaves : R; XC_LOAD(xc, r2) }
        const int l4 = (tidx() & 63) * 4;
#pragma unroll
        for (int i = 0; i < 4; ++i) {
            const int k = i * 256 + l4;
            const float4 sh = *(const float4*)&sp[var * 1024 + k], sc = *(const float4*)&sp[5120 + var * 1024 + k];
            *(uint2*)&hb[(size_t)R * 1024 + k] = make_uint2(pack2(xa[4 * i] * (1.f + sc.x) + sh.x, xa[4 * i + 1] * (1.f + sc.y) + sh.y),
                                                            pack2(xa[4 * i + 2] * (1.f + sc.z) + sh.z, xa[4 * i + 3] * (1.f + sc.w) + sh.w));
        }
#pragma unroll
        for (int i = 0; i < 16; ++i) { xa[i] = xb[i]; xb[i] = xc[i]; }
    }
#undef XC_LOAD
#undef XC_SRC
}
struct EpiZX0 {
    bf16_t* zx; bf16_t* us5; int m0, n0;
    __device__ void operator()(const float* Cs, int pass, int tid) const {
#pragma unroll
        for (int i = 0; i < 4; ++i) {
            const int c = tid + 256 * i, row = c >> 4, col8 = (c & 15) * 8;
            const int R = m0 + pass * 64 + row, col = n0 + col8;
            const float4 a = *(const float4*)&Cs[row * CS_LD + col8], b = *(const float4*)&Cs[row * CS_LD + col8 + 4];
            uint4 o; o.x = pack2(a.x, a.y); o.y = pack2(a.z, a.w); o.z = pack2(b.x, b.y); o.w = pack2(b.z, b.w);
            if (col < 256) *(uint4*)&us5[((size_t)(col >> 4) * NTOK + R) * 16 + (col & 8)] = o;
            else           *(uint4*)&zx[(size_t)R * ZW0 + col] = o;
        }
    }
};
__device__ void phase_gemm_win0(const W p, unsigned char* smem, int bid, int nblk) {
    LdBf16 al{WSP(bf16_t, WS_HB), 1024};
    LdBf16 bl{WSP(bf16_t, WS_WIN0T), 1024};
    const int ntn = ZW0 / 128, total = (NTOK / 128) * ntn;
    for (int t = xcd_swz(bid, nblk); t < total; t += nblk) {
        const int m0 = (t / ntn) * 128, n0 = (t % ntn) * 128;
        EpiZX0 epi{WSP(bf16_t, WS_ZX), WSP(bf16_t, WS_US5), m0, n0};
        gemm_tile_dma(al.base, al.ld, bl.base, bl.ld, 1024, m0, n0, epi, smem);
    }
}

struct LdBf16Clamp {
    const bf16_t* base; int ld; int rmax;
    typedef const bf16_t* RowCtx;
    __device__ RowCtx row(int r) const { return base + (size_t)(r < rmax ? r : rmax) * ld; }
    __device__ uint4 load8(RowCtx rc, int k) const { return *(const uint4*)(rc + k); }
};
__device__ void phase_s5_E(const W p, unsigned char* smem, int bid, int nblk) {
    for (int t = bid; t < 32 * 5; t += nblk) {
        const int dg = t / 5, mt = t % 5, g = dg & 15;
        LdBf16Clamp al{WSP(bf16_t, WS_US5) + (size_t)g * NTOK * 16, 1024, 527};
        LdBf16 bl{WSP(bf16_t, WS_S5W) + (size_t)dg * 128 * 1024, 1024};
        EpiStoreF32 epi{WSP(float, WS_S5E) + (size_t)dg * 528 * 128, 128, mt * 128, 0, 528};
        gemm_tile<128>(al, bl, 1024, mt * 128, 0, epi, smem);
        signal_done((unsigned*)(p.ws + WS_CTL) + CT_S5ED);
    }
}
__device__ void phase_s5_carry(const W p, size_t gtid, size_t gthreads) {
    const float* pw = WSP(float, WS_S5POW);
    const float* E = WSP(float, WS_S5E);
    bf16_t* H = WSP(bf16_t, WS_S5H);
    for (size_t i = gtid; i < 8192; i += gthreads) {
        const int pp = (int)(i & 63), b = (int)((i >> 6) & 3), dg = (int)(i >> 8), d = dg >> 4;
        const float ar = pw[((size_t)(dg * 64 + pp) * 65 + 64) * 2], ai = pw[((size_t)(dg * 64 + pp) * 65 + 64) * 2 + 1];
        float hr = 0.f, hi = 0.f;
        for (int cc0 = 0; cc0 < NCH; cc0 += 4) {
            size_t o[4]; float er[4], ei[4];
#pragma unroll
            for (int j = 0; j < 4; ++j) {
                const int cc = cc0 + j;
                const int c = d ? (cc < 4 ? 3 - cc : 131 - (cc - 4)) : cc;
                o[j] = ((size_t)dg * 528 + b * NCH + c) * 128 + pp * 2;
                er[j] = E[o[j]]; ei[j] = E[o[j] + 1];
            }
#pragma unroll
            for (int j = 0; j < 4; ++j) {
                H[o[j]] = f2bf(hr); H[o[j] + 1] = f2bf(hi);
                const float nr = ar * hr - ai * hi + er[j], ni = ar * hi + ai * hr + ei[j];
                hr = nr; hi = ni;
            }
        }
    }
}
struct LdS5YA {
    const bf16_t* u; const bf16_t* h0; const bf16_t* h1;
    struct RowCtx { const bf16_t* u; const bf16_t* h0; const bf16_t* h1; };
    __device__ RowCtx row(int r) const { if (r > 527) r = 527; return {u + (size_t)r * 1024, h0 + (size_t)r * 128, h1 + (size_t)r * 128}; }
    __device__ uint4 load8(const RowCtx& rc, int k) const {
        if (k < 1024) return *(const uint4*)(rc.u + k);
        if (k < 1152) return *(const uint4*)(rc.h0 + (k - 1024));
        if (k < 2176) return *(const uint4*)(rc.u + (k - 1152));
        return *(const uint4*)(rc.h1 + (k - 2176));
    }
};
struct LdS5YB {
    const bf16_t* k0; const bf16_t* k1; const bf16_t* v0; const bf16_t* v1;
    struct RowCtx { int t, i; const bf16_t* v0; const bf16_t* v1; };
    __device__ RowCtx row(int n) const { return {n >> 4, n & 15, v0 + (size_t)n * 128, v1 + (size_t)n * 128}; }
    __device__ uint4 load8(const RowCtx& rc, int k) const {
        if (k < 1024) { const int s = k >> 4, lag = rc.t - s; if (lag < 0) return make_uint4(0, 0, 0, 0); return *(const uint4*)(k0 + (lag * 16 + rc.i) * 16 + (k & 8)); }
        if (k < 1152) return *(const uint4*)(rc.v0 + (k - 1024));
        if (k < 2176) { const int kk = k - 1152, s = kk >> 4, lag = s - rc.t; if (lag < 0) return make_uint4(0, 0, 0, 0); return *(const uint4*)(k1 + (lag * 16 + rc.i) * 16 + (kk & 8)); }
        return *(const uint4*)(rc.v1 + (k - 2176));
    }
};
struct EpiS5Y {
    bf16_t* ya; int g; int m0, n0;
    __device__ void operator()(const float* Cs, int pass, int tid) const {
#pragma unroll
        for (int i = 0; i < 4; ++i) {
            const int c = tid + 256 * i, row = c >> 4, col8 = (c & 15) * 8;
            const int r = m0 + pass * 64 + row;
            if (r > 527) continue;
            const int n = n0 + col8, t = n >> 4;
            const float4 a = *(const float4*)&Cs[row * CS_LD + col8], b = *(const float4*)&Cs[row * CS_LD + col8 + 4];
            uint4 o;
            o.x = pack2(geluf_(a.x), geluf_(a.y)); o.y = pack2(geluf_(a.z), geluf_(a.w));
            o.z = pack2(geluf_(b.x), geluf_(b.y)); o.w = pack2(geluf_(b.z), geluf_(b.w));
            *(uint4*)&ya[((size_t)r * 64 + t) * 256 + g * 16 + (n & 8)] = o;
        }
    }
};
__device__ void phase_s5_Y(const W p, unsigned char* smem, int bid, int nblk) {
    for (int t = bid; t < 16 * 5 * 8; t += nblk) {
        if (t < 0) continue;
        const int g = t / 40, mt = (t % 40) / 8, nt = t % 8;
        LdS5YA al{WSP(bf16_t, WS_US5) + (size_t)g * NTOK * 16, WSP(bf16_t, WS_S5H) + (size_t)g * 528 * 128, WSP(bf16_t, WS_S5H) + (size_t)(16 + g) * 528 * 128};
        LdS5YB bl{WSP(bf16_t, WS_S5K) + (size_t)g * 64 * 256, WSP(bf16_t, WS_S5K) + (size_t)(16 + g) * 64 * 256,
                  WSP(bf16_t, WS_S5V) + (size_t)g * 1024 * 128, WSP(bf16_t, WS_S5V) + (size_t)(16 + g) * 1024 * 128};
        EpiS5Y epi{WSP(bf16_t, WS_YA), g, mt * 128, nt * 128};
        gemm_tile<128>(al, bl, 2304, mt * 128, nt * 128, epi, smem);
    }
}

__device__ __forceinline__ void zx0_shift8(const bf16_t* zx, const float* mu, int R, int col, float (&o)[8]) {
    const int s = R % SS;
    const bool hp = (s != 0) && (s != LC), hn = (s != LC - 1) && (s != SS - 1);
    const uint4 z = *(const uint4*)&zx[(size_t)R * ZW0 + col];
    uint4 zp = make_uint4(0, 0, 0, 0), zn = make_uint4(0, 0, 0, 0);
    if (hp) zp = *(const uint4*)&zx[(size_t)(R - 1) * ZW0 + col];
    if (hn) zn = *(const uint4*)&zx[(size_t)(R + 1) * ZW0 + col];
    const unsigned zu[4] = {z.x, z.y, z.z, z.w}, pu[4] = {zp.x, zp.y, zp.z, zp.w}, nu[4] = {zn.x, zn.y, zn.z, zn.w};
    const int mc = col - 256;
#pragma unroll
    for (int u = 0; u < 4; ++u) {
        const float a0 = bflo(zu[u]), a1 = bfhi(zu[u]);
        o[2 * u]     = a0 + mu[mc + 2 * u] * (bflo(pu[u]) - a0) + mu[1920 + mc + 2 * u] * (bflo(nu[u]) - a0);
        o[2 * u + 1] = a1 + mu[mc + 2 * u + 1] * (bfhi(pu[u]) - a1) + mu[1920 + mc + 2 * u + 1] * (bfhi(nu[u]) - a1);
    }
}

__device__ __forceinline__ float tanh_fast(float x) { const float e = __expf(2.f * fminf(fmaxf(x, -15.f), 15.f)); return 1.f - 2.f / (e + 1.f); }
__device__ __forceinline__ float softplus_fast(float x) { return fmaxf(x, 0.f) + __logf(1.f + __expf(-fabsf(x))); }

__device__ void phase_rw_shift(const W p, int gwave, int nwaves) {
    const int lane = tidx() & 63;
    const bf16_t* zx = WSP(bf16_t, WS_ZX);
    const float* mu = PAR(PAR_SHIFT);
    bf16_t* Rr = WSP(bf16_t, WS_RWR);
    bf16_t* Kk = WSP(bf16_t, WS_RWK);
    float* nrm = WSP(float, WS_RWNRM);
    for (int R = gwave; R < NTOK; R += nwaves) {
        const int b = R / SS, s = R - b * SS, h = lane >> 3, c8 = (lane & 7) * 8;
        float r8[8], k8[8];
        zx0_shift8(zx, mu, R, 256 + lane * 8, r8);
        zx0_shift8(zx, mu, R, 768 + lane * 8, k8);
        float ss = 0.f;
#pragma unroll
        for (int u = 0; u < 8; ++u) { const float kk = k8[u] * PAR(PAR_KK)[lane * 8 + u]; ss += kk * kk; }
        ss += __shfl_xor(ss, 1); ss += __shfl_xor(ss, 2); ss += __shfl_xor(ss, 4);
        const size_t o = (((size_t)(b * 8 + h)) * SS + s) * 64 + c8;
        *(uint4*)&Rr[o] = make_uint4(pack2(r8[0], r8[1]), pack2(r8[2], r8[3]), pack2(r8[4], r8[5]), pack2(r8[6], r8[7]));
        *(uint4*)&Kk[o] = make_uint4(pack2(k8[0], k8[1]), pack2(k8[2], k8[3]), pack2(k8[4], k8[5]), pack2(k8[6], k8[7]));
        if ((lane & 7) == 0) nrm[((size_t)(b * 8 + h)) * SS + s] = rsqrtf(ss + 1e-12f);
    }
}
struct LdLora {
    const bf16_t* zx; const float* mu; int col0; int dotanh;
    typedef int RowCtx;
    __device__ RowCtx row(int R) const { return R; }
    __device__ uint4 load8(RowCtx R, int k) const {
        float v[8]; zx0_shift8(zx, mu, R, col0 + k, v);
        if (dotanh) {
#pragma unroll
            for (int u = 0; u < 8; ++u) v[u] = tanh_fast(v[u]);
        }
        return make_uint4(pack2(v[0], v[1]), pack2(v[2], v[3]), pack2(v[4], v[5]), pack2(v[6], v[7]));
    }
};
template <int MAT>
struct EpiLora {
    int d; const float* bias; bf16_t* lw; unsigned char* as; float* bon; const bf16_t* zx; const float* mu; const float* ka; const float* rk; int m0, n0;
    __device__ void operator()(const float* Cs, int pass, int tid) const {
#pragma unroll 1
        for (int i = 0; i < 4; ++i) {
            const int c = tid + 256 * i, row = c >> 4, col8 = (c & 15) * 8;
            const int R = m0 + pass * 64 + row, col = n0 + col8;
            const float4 a = *(const float4*)&Cs[row * CS_LD + col8], bq = *(const float4*)&Cs[row * CS_LD + col8 + 4];
            const float x[8] = {a.x, a.y, a.z, a.w, bq.x, bq.y, bq.z, bq.w};
            if constexpr (MAT == 0) {
                float o[8];
#pragma unroll
                for (int u = 0; u < 8; ++u) o[u] = -__expf(-softplus_fast(-(x[u] + bias[col + u])) - 0.5f);
                *(uint4*)&lw[(size_t)R * 512 + col] = make_uint4(pack2(o[0], o[1]), pack2(o[2], o[3]), pack2(o[4], o[5]), pack2(o[6], o[7]));
            } else {
                float r8[8], k8[8], bsum = 0.f;
                zx0_shift8(zx, mu, R, 256 + col, r8);
                zx0_shift8(zx, mu, R, 768 + col, k8);
                unsigned q0 = 0u, q1 = 0u;
#pragma unroll
                for (int u = 0; u < 8; ++u) {
                    const float sg = sigmoidf_(x[u] + bias[col + u]);
                    const float kd = k8[u] * (1.f + (sg - 1.f) * ka[col + u]);
                    bsum += r8[u] * kd * rk[col + u];
                    const unsigned qq = ((unsigned)(sg * 255.f + 0.5f)) << (8 * (u & 3));
                    if (u < 4) q0 |= qq; else q1 |= qq;
                }
                *(uint2*)&as[(size_t)R * 512 + col] = make_uint2(q0, q1);
                bsum += __shfl_xor(bsum, 1); bsum += __shfl_xor(bsum, 2); bsum += __shfl_xor(bsum, 4);
                if ((c & 7) == 0) bon[(size_t)R * 16 + (col >> 6) * 2 + d] = bsum;
            }
        }
    }
};
template <int MAT>
__device__ void phase_rw_lora_mat(const W p, unsigned char* smem, int bid, int nblk) {
    const int total = (NTOK / 128) * 4 * 2;
    for (int t = bid; t < total; t += nblk) {
        const int d = t & 1, nt = (t >> 1) & 3, mt = t >> 3;
        LdLora al{WSP(bf16_t, WS_ZX), PAR(PAR_SHIFT), (MAT ? 1920 : 1792) + d * 64, MAT == 0};
        LdBf16 bl{WSP(bf16_t, MAT ? WS_A2T : WS_W2T) + (size_t)d * 512 * 64, 64};
        EpiLora<MAT> epi{d, PAR(MAT ? PAR_A0 : PAR_W0) + d * 512, WSP(bf16_t, WS_RWLW) + (size_t)d * NTOK * 512, WSP(unsigned char, WS_RWAS) + (size_t)d * NTOK * 512,
                         WSP(float, WS_BON), WSP(bf16_t, WS_ZX), PAR(PAR_SHIFT), PAR(PAR_KA), PAR(PAR_RK), mt * 128, nt * 128};
        gemm_tile<64>(al, bl, 64, mt * 128, nt * 128, epi, smem);
    }
}
__device__ void phase_rw_lora(const W p, unsigned char* smem, int bid, int nblk) {
    phase_rw_lora_mat<0>(p, smem, bid, nblk);
    phase_rw_lora_mat<1>(p, smem, bid, nblk);
}

#define RW_CH 32
struct RwkvSmem {
    float dec[RW_CH][64], aa[RW_CH][64], bb[RW_CH][64], kd[RW_CH][64], rr[RW_CH][64];
    float vv[RW_CH][16];
    float yo[RW_CH][16];
};
struct RwStage { uint4 r8, k8, lw8; uint2 as8; float nrm; float v[8]; };
__device__ __forceinline__ int rw_chunk_s0(int d, int cc) {
    if (d == 0) return RW_CH * cc;
    return (cc < LC / RW_CH) ? RW_CH * (LC / RW_CH - 1 - cc) : LC + RW_CH * (TT / RW_CH - 1 - (cc - LC / RW_CH));
}
__device__ __forceinline__ void rw_stage_load(const W p, RwStage& st, int b, int h, int d, int q, int cc, int tid) {
    const int s0 = rw_chunk_s0(d, cc);
    const int j = tid >> 3, c8 = (tid & 7) * 8;
    const int s = d ? (s0 + RW_CH - 1 - j) : (s0 + j);
    const size_t R = (size_t)b * SS + s;
    const size_t o = (((size_t)(b * 8 + h)) * SS + s) * 64 + c8;
    st.r8 = *(const uint4*)(WSP(bf16_t, WS_RWR) + o);
    st.k8 = *(const uint4*)(WSP(bf16_t, WS_RWK) + o);
    st.lw8 = *(const uint4*)(WSP(bf16_t, WS_RWLW) + ((size_t)d * NTOK + R) * 512 + h * 64 + c8);
    st.as8 = *(const uint2*)(WSP(unsigned char, WS_RWAS) + ((size_t)d * NTOK + R) * 512 + h * 64 + c8);
    st.nrm = WSP(float, WS_RWNRM)[((size_t)(b * 8 + h)) * SS + s];
    if ((tid & 7) < 2) zx0_shift8(WSP(bf16_t, WS_ZX), PAR(PAR_SHIFT), (int)R, 1280 + h * 64 + q * 16 + (tid & 7) * 8, st.v);
}
__device__ __forceinline__ void rw_stage_store(const RwStage& st, RwkvSmem& sm, const float (&kkc)[8], const float (&kac)[8], int tid) {
    const int j = tid >> 3, c8 = (tid & 7) * 8;
    const unsigned ru[4] = {st.r8.x, st.r8.y, st.r8.z, st.r8.w}, ku[4] = {st.k8.x, st.k8.y, st.k8.z, st.k8.w}, lu[4] = {st.lw8.x, st.lw8.y, st.lw8.z, st.lw8.w};
    const unsigned au[2] = {st.as8.x, st.as8.y};
    float dec[8], aa[8], bb[8], kd[8], rr[8];
#pragma unroll
    for (int u = 0; u < 8; ++u) {
        const float kt = (u & 1) ? bfhi(ku[u >> 1]) : bflo(ku[u >> 1]);
        const float rt = (u & 1) ? bfhi(ru[u >> 1]) : bflo(ru[u >> 1]);
        const float lw = (u & 1) ? bfhi(lu[u >> 1]) : bflo(lu[u >> 1]);
        const float a = (float)((au[u >> 2] >> (8 * (u & 3))) & 255u) * (1.f / 255.f);
        const float kk = kt * kkc[u] * st.nrm;
        dec[u] = __expf(lw); aa[u] = -kk; bb[u] = kk * a; kd[u] = kt * (1.f + (a - 1.f) * kac[u]); rr[u] = rt;
    }
    *(float4*)&sm.dec[j][c8] = make_float4(dec[0], dec[1], dec[2], dec[3]); *(float4*)&sm.dec[j][c8 + 4] = make_float4(dec[4], dec[5], dec[6], dec[7]);
    *(float4*)&sm.aa[j][c8] = make_float4(aa[0], aa[1], aa[2], aa[3]);     *(float4*)&sm.aa[j][c8 + 4] = make_float4(aa[4], aa[5], aa[6], aa[7]);
    *(float4*)&sm.bb[j][c8] = make_float4(bb[0], bb[1], bb[2], bb[3]);     *(float4*)&sm.bb[j][c8 + 4] = make_float4(bb[4], bb[5], bb[6], bb[7]);
    *(float4*)&sm.kd[j][c8] = make_float4(kd[0], kd[1], kd[2], kd[3]);     *(float4*)&sm.kd[j][c8 + 4] = make_float4(kd[4], kd[5], kd[6], kd[7]);
    *(float4*)&sm.rr[j][c8] = make_float4(rr[0], rr[1], rr[2], rr[3]);     *(float4*)&sm.rr[j][c8 + 4] = make_float4(rr[4], rr[5], rr[6], rr[7]);
    if ((tid & 7) < 2) {
        *(float4*)&sm.vv[j][(tid & 7) * 8] = make_float4(st.v[0], st.v[1], st.v[2], st.v[3]);
        *(float4*)&sm.vv[j][(tid & 7) * 8 + 4] = make_float4(st.v[4], st.v[5], st.v[6], st.v[7]);
    }
}
__device__ void rwkv_scan_item(const W p, int item, unsigned char* smem_raw) {
    RwkvSmem& sm = *(RwkvSmem*)smem_raw;
    const int q = item & 3, d = (item >> 2) & 1, h = (item >> 3) & 7, b = item >> 6;
    const int tid = tidx(), lane = tid & 63, wave = tid >> 6;
    float S0 = 0.f, S1 = 0.f, S2 = 0.f, S3 = 0.f;
    const int kseg = lane & 15, rowl = wave * 4 + (lane >> 4);
    bf16_t* yb = WSP(bf16_t, WS_YB) + (size_t)d * NTOK * 512;
    float kkc[8], kac[8];
#pragma unroll
    for (int u = 0; u < 8; ++u) { kkc[u] = PAR(PAR_KK)[h * 64 + (tid & 7) * 8 + u]; kac[u] = PAR(PAR_KA)[h * 64 + (tid & 7) * 8 + u]; }
    RwStage st;
    rw_stage_load(p, st, b, h, d, q, 0, tid);
    for (int cc = 0; cc < SS / RW_CH; ++cc) {
        const int s0 = rw_chunk_s0(d, cc);
        __syncthreads();
        rw_stage_store(st, sm, kkc, kac, tid);
        __syncthreads();
        if (cc + 1 < SS / RW_CH) rw_stage_load(p, st, b, h, d, q, cc + 1, tid);
        float yk0 = 0.f, yk1 = 0.f;
#pragma unroll
        for (int j = 0; j < RW_CH; ++j) {
            const float4 w4 = *(const float4*)&sm.dec[j][kseg * 4];
            const float4 a4 = *(const float4*)&sm.aa[j][kseg * 4];
            const float4 b4 = *(const float4*)&sm.bb[j][kseg * 4];
            const float4 k4 = *(const float4*)&sm.kd[j][kseg * 4];
            const float4 r4 = *(const float4*)&sm.rr[j][kseg * 4];
            const float vj = sm.vv[j][rowl];
            float sa = (S0 * a4.x + S1 * a4.y) + (S2 * a4.z + S3 * a4.w);
            sa = row16_sum(sa);
            S0 = S0 * w4.x + sa * b4.x + vj * k4.x;
            S1 = S1 * w4.y + sa * b4.y + vj * k4.y;
            S2 = S2 * w4.z + sa * b4.z + vj * k4.z;
            S3 = S3 * w4.w + sa * b4.w + vj * k4.w;
            float y = (S0 * r4.x + S1 * r4.y) + (S2 * r4.z + S3 * r4.w);
            y = row16_sum(y);
            if (j < 16) yk0 = (kseg == j) ? y : yk0; else yk1 = (kseg == j - 16) ? y : yk1;
        }
        {
            const int sA = d ? (s0 + RW_CH - 1 - kseg) : (s0 + kseg), sB = d ? (s0 + RW_CH - 17 - kseg) : (s0 + 16 + kseg);
            yb[((size_t)b * SS + sA) * 512 + h * 64 + q * 16 + rowl] = f2bf(yk0);
            yb[((size_t)b * SS + sB) * 512 + h * 64 + q * 16 + rowl] = f2bf(yk1);
        }
    }
}

#define RLD 72
constexpr size_t WS_RWPHI = WS_TABU0;
constexpr size_t WS_RWG5  = WS_TABU0 + (size_t)8448 * 8192;
constexpr size_t WS_RWG5B = WS_ZX + (size_t)NTOK * ZW0 * 2;
constexpr size_t WS_RWR2  = WS_MIX;
static_assert(WS_RWG5 + (size_t)7936 * 8192 <= WS_ZX, "G5 part A fits");
static_assert(WS_RWG5B + (size_t)512 * 8192 <= WS_ZX + (size_t)NTOK * ZW1 * 2, "G5 part B fits");
__device__ __forceinline__ bf16_t* rw_g5_ptr(const W p, int item) {
    return item < 7936 ? WSP(bf16_t, WS_RWG5) + (size_t)item * 4096 : WSP(bf16_t, WS_RWG5B) + (size_t)(item - 7936) * 4096;
}
__device__ __forceinline__ int rw_chunk64_s0(int d, int cc) { return d == 0 ? 64 * cc : (cc < 4 ? 64 * (3 - cc) : LC + 64 * (127 - (cc - 4))); }
__device__ __forceinline__ void mmq64(const bf16_t* A, const bf16_t* Bt, int qi, int qj, int l31, int hh, f32x16& acc) {
#pragma unroll
    for (int kk = 0; kk < 4; ++kk) {
        const bf16x8 a = *(const bf16x8*)&A[(32 * qi + l31) * RLD + 16 * kk + 8 * hh];
        const bf16x8 b = *(const bf16x8*)&Bt[(32 * qj + l31) * RLD + 16 * kk + 8 * hh];
        acc = __builtin_amdgcn_mfma_f32_32x32x16_bf16(a, b, acc, 0, 0, 0);
    }
}
#define ACC_ROW(r, qi, hh) (32 * (qi) + ((r) & 3) + 8 * ((r) >> 2) + 4 * (hh))
__device__ __forceinline__ void acc_zero(f32x16& a) {
#pragma unroll
    for (int r = 0; r < 16; ++r) a[r] = 0.f;
}
__device__ __forceinline__ void st_rm(bf16_t* D, const f32x16& acc, int qi, int qj, int l31, int hh) {
#pragma unroll
    for (int r = 0; r < 16; ++r) D[ACC_ROW(r, qi, hh) * RLD + 32 * qj + l31] = f2bf(acc[r]);
}
__device__ __forceinline__ float rcp_fast(float x) { return __builtin_amdgcn_rcpf(x); }
__device__ __forceinline__ void rw1_item(const W p, int item, unsigned char* smem) {
    const int chain = item / 132, cc = item - chain * 132;
    const int d = chain & 1, h = (chain >> 1) & 7, b = chain >> 4;
    const int s0 = rw_chunk64_s0(d, cc);
    const int seg_lo = (s0 < LC) ? 0 : LC, seg_hi = (s0 < LC) ? LC : SS;
    const int tid = tidx(), lane = tid & 63, wave = tid >> 6, l31 = lane & 31, hh = lane >> 5, qi = wave >> 1, qj = wave & 1;
    const int tau = tid >> 2, kq = tid & 3, k0 = kq * 16;
    bf16_t* M0 = (bf16_t*)smem;            bf16_t* M1 = M0 + 64 * RLD; bf16_t* M2 = M1 + 64 * RLD; bf16_t* M3 = M2 + 64 * RLD;
    bf16_t* M4 = M3 + 64 * RLD;            bf16_t* M5 = M4 + 64 * RLD; bf16_t* M6 = M5 + 64 * RLD;
    float* gam = (float*)(smem + 7 * 64 * RLD * 2);
    bf16_t* T11 = (bf16_t*)(gam + 64);
    bf16_t* Wrm = T11 + 32 * 40;
    float* muS = gam + 64;
    float* hcS = muS + 640;
    float* LW = (float*)smem;
    bf16_t* AS = (bf16_t*)(LW + 64 * 64);
    float* tot = (float*)(AS + 64 * 64);
    const bf16_t* zx = WSP(bf16_t, WS_ZX);
    const float* mu = PAR(PAR_SHIFT);
    unsigned* scr = (unsigned*)(WSP(bf16_t, WS_YA) + (size_t)bidx() * 4 * 4096 + tau * 64 + k0);
    const int colr = 256 + h * 64, colk = 768 + h * 64, colv = 1280 + h * 64, colw = 1792 + d * 64, cola = 1920 + d * 64;
    __syncthreads();
    {
        bf16_t* raw = (bf16_t*)smem;
        u32x4v rv[11];
#pragma unroll
        for (int q = 0; q < 11; ++q) {
            const int c = tid + 256 * q;
            const int cc = c < 5 * 66 * 8 ? c : 5 * 66 * 8 - 1;
            const int c8 = (cc & 7) * 8, rix = (cc >> 3) % 66, sl = cc / (8 * 66);
            int s = s0 - 1 + rix;
            const bool inr = s >= seg_lo && s < seg_hi;
            s = inr ? s : seg_lo;
            const int col = (sl == 0 ? colr : sl == 1 ? colk : sl == 2 ? colv : sl == 3 ? colw : cola) + c8;
            const u32x4v v = *(const u32x4v*)&zx[((size_t)b * SS + s) * ZW0 + col];
            rv[q] = inr ? v : (u32x4v){0u, 0u, 0u, 0u};
        }
        float m0v[2], m1v[2];
#pragma unroll
        for (int q = 0; q < 2; ++q) {
            const int e = tid + 256 * q, ee = e < 320 ? e : 319;
            const int sl = ee >> 6, ch = ee & 63;
            const int mc = (sl == 0 ? colr : sl == 1 ? colk : sl == 2 ? colv : sl == 3 ? colw : cola) - 256 + ch;
            m0v[q] = mu[mc]; m1v[q] = mu[1920 + mc];
        }
        const float hcv = PAR(tid < 64 ? PAR_KK : tid < 128 ? PAR_KA : PAR_RK)[h * 64 + (tid & 63)];
#pragma unroll
        for (int q = 0; q < 11; ++q) {
            const int c = tid + 256 * q;
            if (c < 5 * 66 * 8) { const int c8 = (c & 7) * 8, rix = (c >> 3) % 66, sl = c / (8 * 66); *(u32x4v*)&raw[(sl * 66 + rix) * 64 + c8] = rv[q]; }
        }
#pragma unroll
        for (int q = 0; q < 2; ++q) { const int e = tid + 256 * q; if (e < 320) { muS[e * 2] = m0v[q]; muS[e * 2 + 1] = m1v[q]; } }
        if (tid < 192) hcS[tid] = hcv;
    }
    __syncthreads();
    unsigned rpa[8], kpa[8], vpa[8], atp[8], rtp[8], btp[8], ktp[8];
    {
        const bf16_t* raw = (const bf16_t*)smem;
        const int jj = d ? (63 - tau) : tau;
#pragma unroll
        for (int sl = 0; sl < 5; ++sl) {
            const uint4* rp_ = (const uint4*)&raw[(sl * 66 + jj) * 64 + k0];
            const uint4 p0 = rp_[0], p1 = rp_[1], z0 = rp_[8], z1 = rp_[9], n0 = rp_[16], n1 = rp_[17];
            const unsigned pu[8] = {p0.x, p0.y, p0.z, p0.w, p1.x, p1.y, p1.z, p1.w}, zu[8] = {z0.x, z0.y, z0.z, z0.w, z1.x, z1.y, z1.z, z1.w},
                           nu[8] = {n0.x, n0.y, n0.z, n0.w, n1.x, n1.y, n1.z, n1.w};
            unsigned o[8];
#pragma unroll
            for (int u2 = 0; u2 < 8; ++u2) {
                const float4 mw = *(const float4*)&muS[(sl * 64 + k0 + 2 * u2) * 2];
                const float za = bflo(zu[u2]), zb = bfhi(zu[u2]);
                float oa = za + mw.x * (bflo(pu[u2]) - za) + mw.y * (bflo(nu[u2]) - za);
                float ob = zb + mw.z * (bfhi(pu[u2]) - zb) + mw.w * (bfhi(nu[u2]) - zb);
                if (sl == 3) { oa = tanh_fast(oa); ob = tanh_fast(ob); }
                o[u2] = pack2(oa, ob);
            }
            if (sl < 3) {
#pragma unroll
                for (int u2 = 0; u2 < 8; ++u2) { if (sl == 0) rpa[u2] = o[u2]; else if (sl == 1) kpa[u2] = o[u2]; else vpa[u2] = o[u2]; }
            }
            else { bf16_t* Dm = (sl == 3 ? M5 : M6); *(uint4*)&Dm[tau * RLD + k0] = make_uint4(o[0], o[1], o[2], o[3]); *(uint4*)&Dm[tau * RLD + k0 + 8] = make_uint4(o[4], o[5], o[6], o[7]); }
        }
    }
    __syncthreads();
    {
        f32x16 aw, aa; acc_zero(aw); acc_zero(aa);
        const bf16_t* w2t = WSP(bf16_t, WS_W2T) + ((size_t)d * 512 + h * 64 + 32 * qj + l31) * 64 + 8 * hh;
        const bf16_t* a2t = WSP(bf16_t, WS_A2T) + ((size_t)d * 512 + h * 64 + 32 * qj + l31) * 64 + 8 * hh;
#pragma unroll
        for (int kk = 0; kk < 4; ++kk) {
            const bf16x8 xa = *(const bf16x8*)&M5[(32 * qi + l31) * RLD + 16 * kk + 8 * hh];
            const bf16x8 xb = *(const bf16x8*)&M6[(32 * qi + l31) * RLD + 16 * kk + 8 * hh];
            aw = __builtin_amdgcn_mfma_f32_32x32x16_bf16(xa, *(const bf16x8*)(w2t + 16 * kk), aw, 0, 0, 0);
            aa = __builtin_amdgcn_mfma_f32_32x32x16_bf16(xb, *(const bf16x8*)(a2t + 16 * kk), aa, 0, 0, 0);
        }
        const int n = 32 * qj + l31;
        const float w0 = PAR(PAR_W0)[d * 512 + h * 64 + n], a0 = PAR(PAR_A0)[d * 512 + h * 64 + n];
#pragma unroll
        for (int r = 0; r < 16; ++r) {
            const int t = ACC_ROW(r, qi, hh);
            LW[t * 64 + n] = -0.60653065971f * rcp_fast(1.f + __expf(-(aw[r] + w0)));
            AS[t * 64 + n] = f2bf(rcp_fast(1.f + __expf(-(aa[r] + a0))));
        }
    }
    __syncthreads();
    {
        const int k = tid & 63, part = tid >> 6;
        float run = 0.f;
#pragma unroll 4
        for (int i = 0; i < 16; ++i) { run += LW[(16 * part + i) * 64 + k]; LW[(16 * part + i) * 64 + k] = run; }
        tot[part * 64 + k] = run;
        __syncthreads();
        float off = 0.f;
        for (int pp = 0; pp < part; ++pp) off += tot[pp * 64 + k];
#pragma unroll 4
        for (int i = 0; i < 16; ++i) LW[(16 * part + i) * 64 + k] = __expf(LW[(16 * part + i) * 64 + k] + off);
    }
    __syncthreads();
    {
        float ss = 0.f;
#pragma unroll
        for (int u2 = 0; u2 < 8; ++u2) { const unsigned kp = kpa[u2]; const float a = bflo(kp) * hcS[k0 + 2 * u2], c = bfhi(kp) * hcS[k0 + 2 * u2 + 1]; ss += a * a + c * c; }
        ss += dppf<DPP_XOR1>(ss); ss += dppf<DPP_XOR2>(ss);
        const float nrm = rsqrtf(ss + 1e-12f);
        float bsum = 0.f;
#pragma unroll
        for (int u2 = 0; u2 < 8; ++u2) {
            const unsigned kp = kpa[u2], rp = rpa[u2], vp = vpa[u2];
            float fa[2], fr[2], fb[2], fk[2];
#pragma unroll
            for (int e = 0; e < 2; ++e) {
                const int k = k0 + 2 * u2 + e;
                const float kv = e ? bfhi(kp) : bflo(kp), rv = e ? bfhi(rp) : bflo(rp);
                const float eL = LW[tau * 64 + k], eLp = tau ? LW[(tau - 1) * 64 + k] : 1.f, sg = bf2f(AS[tau * 64 + k]);
                const float kk = kv * hcS[k] * nrm;
                const float kd = kv * (1.f + (sg - 1.f) * hcS[64 + k]);
                bsum += rv * kd * hcS[128 + k];
                const float eNL = rcp_fast(eL);
                fa[e] = -kk * eLp; fr[e] = rv * eL; fb[e] = kk * sg * eNL; fk[e] = kd * eNL;
                if (tau == 63) gam[k] = eL;
            }
            const unsigned pa = pack2(fa[0], fa[1]), pr = pack2(fr[0], fr[1]), pb = pack2(fb[0], fb[1]), pk = pack2(fk[0], fk[1]);
            *(unsigned*)&M4[tau * RLD + k0 + 2 * u2] = pa; *(unsigned*)&M5[tau * RLD + k0 + 2 * u2] = pb; *(unsigned*)&M6[tau * RLD + k0 + 2 * u2] = pk;
            atp[u2] = pa; rtp[u2] = pr; btp[u2] = pb; ktp[u2] = pk;
            M3[(k0 + 2 * u2) * RLD + tau] = (bf16_t)(vp & 0xffffu); M3[(k0 + 2 * u2 + 1) * RLD + tau] = (bf16_t)(vp >> 16);
        }
        bsum += dppf<DPP_XOR1>(bsum); bsum += dppf<DPP_XOR2>(bsum);
        if (kq == 0) { const int s = d ? (s0 + 63 - tau) : (s0 + tau); WSP(float, WS_BON)[((size_t)b * SS + s) * 16 + h * 2 + d] = bsum; }
    }
    __syncthreads();
#define CP_TM(D, a) { *(uint4*)&(D)[tau * RLD + k0] = make_uint4(a[0], a[1], a[2], a[3]); *(uint4*)&(D)[tau * RLD + k0 + 8] = make_uint4(a[4], a[5], a[6], a[7]); }
#define CP_KM(D, a, USEG) { _Pragma("unroll") for (int u2 = 0; u2 < 8; ++u2) { const unsigned q_ = a[u2]; const int kx_ = k0 + 2 * u2; \
        (D)[kx_ * RLD + tau] = f2bf(bflo(q_) * ((USEG) ? gam[kx_] : 1.f)); (D)[(kx_ + 1) * RLD + tau] = f2bf(bfhi(q_) * ((USEG) ? gam[kx_ + 1] : 1.f)); } }
    {
        const int sc = 32 * qj + l31;
        f32x16 x0, x1; acc_zero(x0); acc_zero(x1);
        mmq64(M4, M5, qi, qj, l31, hh, x0);
        mmq64(M4, M6, qi, qj, l31, hh, x1);
#pragma unroll
        for (int r = 0; r < 16; ++r) { const bool z = !(sc < ACC_ROW(r, qi, hh)); x0[r] = z ? 0.f : x0[r]; x1[r] = z ? 0.f : x1[r]; }
        st_rm(M0, x0, qi, qj, l31, hh);
        st_rm(M1, x1, qi, qj, l31, hh);
    }
    __syncthreads();
    CP_TM(M4, rtp)
    __syncthreads();
    {
        const int sc = 32 * qj + l31;
        f32x16 x0, x1; acc_zero(x0); acc_zero(x1);
        mmq64(M4, M5, qi, qj, l31, hh, x0);
        mmq64(M4, M6, qi, qj, l31, hh, x1);
#pragma unroll
        for (int r = 0; r < 16; ++r) { const bool z = !(sc <= ACC_ROW(r, qi, hh)); x0[r] = z ? 0.f : x0[r]; x1[r] = z ? 0.f : x1[r]; }
        st_rm(M2, x0, qi, qj, l31, hh);
        __syncthreads();
        st_rm(M6, x1, qi, qj, l31, hh);
    }
    __syncthreads();
    if (wave == 0) {
        const int blk = lane >> 5, rr = lane & 31;
        float Tr[32];
        u32x4v rq0 = {0u, 0u, 0u, 0u}, rq1 = rq0, rq2 = rq0, rq3 = rq0;
#pragma unroll
        for (int t = 0; t < 32; ++t) {
            u32x4v nq0 = rq0, nq1 = rq1, nq2 = rq2, nq3 = rq3;
            if (t + 1 < 32) {
                const bf16_t* nrow = &M0[(32 * blk + t + 1) * RLD + 32 * blk];
                nq0 = *(const u32x4v*)&nrow[0];
                if (t + 1 > 8)  nq1 = *(const u32x4v*)&nrow[8];
                if (t + 1 > 16) nq2 = *(const u32x4v*)&nrow[16];
                if (t + 1 > 24) nq3 = *(const u32x4v*)&nrow[24];
            }
            float ac4[4] = {(t == rr) ? 1.f : 0.f, 0.f, 0.f, 0.f};
#pragma unroll
            for (int c8 = 0; c8 * 8 < t; ++c8) {
                const u32x4v q = c8 == 0 ? rq0 : c8 == 1 ? rq1 : c8 == 2 ? rq2 : rq3;
#pragma unroll
                for (int e = 0; e < 8; ++e) if (8 * c8 + e < t) ac4[e & 3] += Tr[8 * c8 + e] * ((e & 1) ? bfhi(q[e >> 1]) : bflo(q[e >> 1]));
            }
            const float acc = (ac4[0] + ac4[1]) + (ac4[2] + ac4[3]);
            Tr[t] = acc;
            M5[(32 * blk + t) * RLD + 32 * blk + rr] = f2bf(acc);
            if (blk == 0) { T11[rr * 40 + t] = f2bf(acc); M5[t * RLD + 32 + rr] = 0; }
            rq0 = nq0; rq1 = nq1; rq2 = nq2; rq3 = nq3;
        }
        f32x16 wv; acc_zero(wv);
#pragma unroll
        for (int kk = 0; kk < 2; ++kk) {
            const bf16x8 a = *(const bf16x8*)&T11[l31 * 40 + 16 * kk + 8 * hh];
            const bf16x8 bq = *(const bf16x8*)&M0[(32 + l31) * RLD + 16 * kk + 8 * hh];
            wv = __builtin_amdgcn_mfma_f32_32x32x16_bf16(a, bq, wv, 0, 0, 0);
        }
#pragma unroll
        for (int r = 0; r < 16; ++r) Wrm[ACC_ROW(r, 0, hh) * 40 + l31] = f2bf(wv[r]);
        f32x16 t12; acc_zero(t12);
#pragma unroll
        for (int kk = 0; kk < 2; ++kk) {
            const bf16x8 a = *(const bf16x8*)&Wrm[l31 * 40 + 16 * kk + 8 * hh];
            const bf16x8 bq = *(const bf16x8*)&M5[(32 + l31) * RLD + 32 + 16 * kk + 8 * hh];
            t12 = __builtin_amdgcn_mfma_f32_32x32x16_bf16(a, bq, t12, 0, 0, 0);
        }
#pragma unroll
        for (int g4 = 0; g4 < 4; ++g4)
            *(uint2*)&M5[(32 + l31) * RLD + 8 * g4 + 4 * hh] = make_uint2(pack2(t12[4 * g4], t12[4 * g4 + 1]), pack2(t12[4 * g4 + 2], t12[4 * g4 + 3]));
    }
    __syncthreads();
    { f32x16 x; acc_zero(x); mmq64(M3, M1, qi, qj, l31, hh, x); __syncthreads(); st_rm(M0, x, qi, qj, l31, hh); }
    CP_KM(M1, atp, false)
    __syncthreads();
    { f32x16 xa, xg; acc_zero(xa); acc_zero(xg);
      mmq64(M1, M5, qi, qj, l31, hh, xa);
      mmq64(M0, M5, qi, qj, l31, hh, xg);
      st_rm(M4, xa, qi, qj, l31, hh);
      __syncthreads();
      st_rm(M1, xg, qi, qj, l31, hh); }
    __syncthreads();
    CP_TM(M0, rtp)
    CP_KM(M5, btp, true)
    __syncthreads();
    {
        const int cix = 32 * qj + l31;
        f32x16 xr, xp; acc_zero(xr); acc_zero(xp);
        mmq64(M2, M4, qi, qj, l31, hh, xr);
        mmq64(M5, M4, qi, qj, l31, hh, xp);
        const float gc = gam[cix];
#pragma unroll
        for (int r = 0; r < 16; ++r) { xr[r] += bf2f(M0[ACC_ROW(r, qi, hh) * RLD + cix]); xp[r] += (ACC_ROW(r, qi, hh) == cix) ? gc : 0.f; }
        __syncthreads();
        st_rm(M0, xr, qi, qj, l31, hh); st_rm(M4, xp, qi, qj, l31, hh);
    }
    __syncthreads();
    {
        bf16_t* r2g = WSP(bf16_t, WS_RWR2) + (size_t)item * 4096;
        bf16_t* phg = WSP(bf16_t, WS_RWPHI) + (size_t)item * 4096;
        for (int c = tid; c < 512; c += 256) {
            const int row = c >> 3, c8 = (c & 7) * 8;
            *(uint4*)&r2g[row * 64 + c8] = *(const uint4*)&M0[row * RLD + c8];
            *(uint4*)&phg[row * 64 + c8] = *(const uint4*)&M4[row * RLD + c8];
        }
    }
    f32x16 xo; acc_zero(xo);
    {
        f32x16 x; acc_zero(x);
        mmq64(M1, M2, qi, qj, l31, hh, x); mmq64(M3, M6, qi, qj, l31, hh, x);
        mmq64(M1, M5, qi, qj, l31, hh, xo);
        const int t = 32 * qj + l31;
        const int s = d ? (s0 + 63 - t) : (s0 + t);
        bf16_t* yrow = WSP(bf16_t, WS_YB) + (size_t)d * NTOK * 512 + ((size_t)b * SS + s) * 512 + h * 64;
#pragma unroll
        for (int g4 = 0; g4 < 4; ++g4)
            *(uint2*)&yrow[32 * qi + 8 * g4 + 4 * hh] = make_uint2(pack2(x[4 * g4], x[4 * g4 + 1]), pack2(x[4 * g4 + 2], x[4 * g4 + 3]));
    }
    __syncthreads();
    CP_KM(M0, ktp, true)
    __syncthreads();
    { mmq64(M3, M0, qi, qj, l31, hh, xo); st_rm(M4, xo, qi, qj, l31, hh); }
    __syncthreads();
    {
        bf16_t* g5g = rw_g5_ptr(p, item);
        for (int c = tid; c < 512; c += 256) { const int row = c >> 3, c8 = (c & 7) * 8; *(uint4*)&g5g[row * 64 + c8] = *(const uint4*)&M4[row * RLD + c8]; }
    }
#undef CP_TM
#undef CP_KM
}
#define RW1_SMEM_BYTES (7 * 64 * RLD * 2 + 256 + 2 * 32 * 40 * 2)
static_assert(256 + 640 * 4 + 192 * 4 <= 256 + 2 * 32 * 40 * 2, "stage A..E tables fit in the scratch tail");

#define RW2_BUF_BYTES (3 * 64 * RLD * 2)
struct Rw2Stage { u32x4v q0, q1, q2, q3, q4, q5; };
__device__ __forceinline__ void rw2_issue(const W p, int item, int tid, Rw2Stage& st) {
    const bf16_t* s0_ = WSP(bf16_t, WS_RWPHI) + (size_t)item * 4096; const bf16_t* s1_ = WSP(bf16_t, WS_RWR2) + (size_t)item * 4096; const bf16_t* s2_ = rw_g5_ptr(p, item);
    const int o0 = (tid >> 3) * 64 + (tid & 7) * 8, o1 = o0 + 32 * 64;
    st.q0 = *(const u32x4v*)&s0_[o0]; st.q1 = *(const u32x4v*)&s0_[o1];
    st.q2 = *(const u32x4v*)&s1_[o0]; st.q3 = *(const u32x4v*)&s1_[o1];
    st.q4 = *(const u32x4v*)&s2_[o0]; st.q5 = *(const u32x4v*)&s2_[o1];
}
__device__ __forceinline__ void rw2_commit(unsigned char* buf, int tid, const Rw2Stage& st) {
    bf16_t* bb = (bf16_t*)buf;
    const int o0 = (tid >> 3) * RLD + (tid & 7) * 8, o1 = o0 + 32 * RLD;
    *(u32x4v*)&bb[o0] = st.q0; *(u32x4v*)&bb[o1] = st.q1;
    *(u32x4v*)&bb[64 * RLD + o0] = st.q2; *(u32x4v*)&bb[64 * RLD + o1] = st.q3;
    *(u32x4v*)&bb[128 * RLD + o0] = st.q4; *(u32x4v*)&bb[128 * RLD + o1] = st.q5;
}
__device__ __forceinline__ void rw2_step(const unsigned char* bufc, f32x4 (&st)[4], bf16_t* Yt, int wave, int l15, int g) {
    const bf16_t* PH = (const bf16_t*)bufc; const bf16_t* R2 = PH + 64 * RLD; const bf16_t* G5 = R2 + 64 * RLD;
    bf16x8 sb[2];
#pragma unroll
    for (int s2 = 0; s2 < 2; ++s2) {
        union { bf16x8 v; unsigned u[4]; } pk;
        pk.u[0] = pack2(st[2 * s2][0], st[2 * s2][1]); pk.u[1] = pack2(st[2 * s2][2], st[2 * s2][3]);
        pk.u[2] = pack2(st[2 * s2 + 1][0], st[2 * s2 + 1][1]); pk.u[3] = pack2(st[2 * s2 + 1][2], st[2 * s2 + 1][3]);
        sb[s2] = pk.v;
    }
    f32x4 yn[4], sn[4];
#pragma unroll
    for (int mt = 0; mt < 4; ++mt) {
        yn[mt] = (f32x4){0.f, 0.f, 0.f, 0.f};
        const uint2 gq = *(const uint2*)&G5[(16 * wave + l15) * RLD + 16 * mt + 4 * g];
        sn[mt] = (f32x4){bflo(gq.x), bfhi(gq.x), bflo(gq.y), bfhi(gq.y)};
#pragma unroll
        for (int s2 = 0; s2 < 2; ++s2) {
            union { bf16x8 v; uint2 hq[2]; } fa, fb;
            fa.hq[0] = *(const uint2*)&R2[(16 * mt + l15) * RLD + 32 * s2 + 4 * g]; fa.hq[1] = *(const uint2*)&R2[(16 * mt + l15) * RLD + 32 * s2 + 16 + 4 * g];
            fb.hq[0] = *(const uint2*)&PH[(16 * mt + l15) * RLD + 32 * s2 + 4 * g]; fb.hq[1] = *(const uint2*)&PH[(16 * mt + l15) * RLD + 32 * s2 + 16 + 4 * g];
            yn[mt] = __builtin_amdgcn_mfma_f32_16x16x32_bf16(fa.v, sb[s2], yn[mt], 0, 0, 0);
            sn[mt] = __builtin_amdgcn_mfma_f32_16x16x32_bf16(fb.v, sb[s2], sn[mt], 0, 0, 0);
        }
    }
#pragma unroll
    for (int mt = 0; mt < 4; ++mt)
#pragma unroll
        for (int r = 0; r < 4; ++r) Yt[(16 * mt + 4 * g + r) * RLD + 16 * wave + l15] = f2bf(yn[mt][r]);
#pragma unroll
    for (int mt = 0; mt < 4; ++mt) st[mt] = sn[mt];
}
__device__ __forceinline__ void rw2_yaddr(int d, int cc, int tid, size_t& off) {
    const int s0 = rw_chunk64_s0(d, cc < 132 ? cc : 131);
    const int t = tid >> 2; const int s = d ? (s0 + 63 - t) : (s0 + t);
    off = (size_t)s * 512 + (tid & 3) * 16;
}
__device__ __forceinline__ void rw2_yout(bf16_t* ybase, size_t off, const bf16_t* Yt, int tid, const u32x4v& o0, const u32x4v& o1) {
    const int t = tid >> 2, c0 = (tid & 3) * 16;
    const u32x4v a0 = *(const u32x4v*)&Yt[t * RLD + c0], a1 = *(const u32x4v*)&Yt[t * RLD + c0 + 8];
    u32x4v r0, r1;
#pragma unroll
    for (int i = 0; i < 4; ++i) {
        r0[i] = pack2(bflo(o0[i]) + bflo(a0[i]), bfhi(o0[i]) + bfhi(a0[i]));
        r1[i] = pack2(bflo(o1[i]) + bflo(a1[i]), bfhi(o1[i]) + bfhi(a1[i]));
    }
    *(u32x4v*)&ybase[off] = r0; *(u32x4v*)&ybase[off + 8] = r1;
}
__device__ __forceinline__ void rw2_chain(const W p, int chain, unsigned char* smem) {
    const int d = chain & 1, h = (chain >> 1) & 7, b = chain >> 4;
    const int tid = tidx(), lane = tid & 63, wave = tid >> 6, l15 = lane & 15, g = lane >> 4;
    f32x4 st[4];
#pragma unroll
    for (int mt = 0; mt < 4; ++mt) st[mt] = (f32x4){0.f, 0.f, 0.f, 0.f};
    bf16_t* ybase = WSP(bf16_t, WS_YB) + (size_t)d * NTOK * 512 + (size_t)b * SS * 512 + h * 64;
    unsigned char* buf0 = smem; unsigned char* buf1 = smem + RW2_BUF_BYTES;
    bf16_t* Yt = (bf16_t*)(smem + 2 * RW2_BUF_BYTES);
    const int it0 = chain * 132;
    Rw2Stage ra, rb;
    u32x4v oa0, oa1, ob0, ob1; size_t offa, offb;
    __syncthreads();
    rw2_issue(p, it0, tid, ra); rw2_issue(p, it0 + 1, tid, rb);
    rw2_commit(buf0, tid, ra); rw2_issue(p, it0 + 2, tid, ra);
    rw2_commit(buf1, tid, rb); rw2_issue(p, it0 + 3, tid, rb);
    rw2_yaddr(d, 0, tid, offa); oa0 = *(const u32x4v*)&ybase[offa]; oa1 = *(const u32x4v*)&ybase[offa + 8];
#pragma unroll 1
    for (int cc = 0; cc < 132; cc += 2) {
        rw2_yaddr(d, cc + 1, tid, offb); ob0 = *(const u32x4v*)&ybase[offb]; ob1 = *(const u32x4v*)&ybase[offb + 8];
        __syncthreads();
        rw2_step(buf0, st, Yt, wave, l15, g);
        __syncthreads();
        rw2_yout(ybase, offa, Yt, tid, oa0, oa1);
        rw2_commit(buf0, tid, ra);
        rw2_issue(p, it0 + (cc + 4 < 132 ? cc + 4 : 131), tid, ra);
        rw2_yaddr(d, cc + 2, tid, offa); oa0 = *(const u32x4v*)&ybase[offa]; oa1 = *(const u32x4v*)&ybase[offa + 8];
        __syncthreads();
        rw2_step(buf1, st, Yt, wave, l15, g);
        __syncthreads();
        rw2_yout(ybase, offb, Yt, tid, ob0, ob1);
        rw2_commit(buf1, tid, rb);
        rw2_issue(p, it0 + (cc + 5 < 132 ? cc + 5 : 131), tid, rb);
    }
    __syncthreads();
}
static_assert(2 * RW2_BUF_BYTES + 64 * RLD * 2 <= RW1_SMEM_BYTES, "RW2 ring + y tile fit");

struct EpiGlu {
    const bf16_t* ya; const float* bglu; bf16_t* mix; int m0, n0;
    __device__ void operator()(const float* Cs, int pass, int tid) const {
#pragma unroll
        for (int i = 0; i < 4; ++i) {
            const int c = tid + 256 * i, row = c >> 4, col8 = (c & 15) * 8;
            const int R = m0 + pass * 64 + row, col = n0 + col8;
            const uint4 yv = *(const uint4*)&ya[(size_t)R * 256 + col];
            const unsigned yu[4] = {yv.x, yv.y, yv.z, yv.w};
            unsigned o[4];
#pragma unroll
            for (int u = 0; u < 4; ++u) {
                const float y0 = bflo(yu[u]), y1 = bfhi(yu[u]);
                const float g0 = sigmoidf_(Cs[row * CS_LD + col8 + 2 * u] + bglu[col + 2 * u]);
                const float g1 = sigmoidf_(Cs[row * CS_LD + col8 + 2 * u + 1] + bglu[col + 2 * u + 1]);
                o[u] = pack2(y0 * g0, y1 * g1);
            }
            *(uint4*)&mix[(size_t)R * 768 + col] = make_uint4(o[0], o[1], o[2], o[3]);
        }
    }
};
__device__ void phase_glu(const W p, unsigned char* smem, int bid, int nblk) {
    LdBf16 al{WSP(bf16_t, WS_YA), 256};
    LdBf16 bl{WSP(bf16_t, WS_WGLUT), 256};
    for (int t = bid; t < (NTOK / 128) * 2; t += nblk) {
        const int m0 = (t >> 1) * 128, n0 = (t & 1) * 128;
        EpiGlu epi{WSP(bf16_t, WS_YA), PAR(PAR_BGLU), WSP(bf16_t, WS_MIX), m0, n0};
        gemm_tile<128>(al, bl, 256, m0, n0, epi, smem);
    }
}
struct LdGlo {
    const bf16_t* zx; const float* mu;
    typedef int RowCtx;
    __device__ RowCtx row(int R) const { return R; }
    __device__ uint4 load8(RowCtx R, int k) const {
        float v[8]; zx0_shift8(zx, mu, R, 2048 + k, v);
        uint4 o; o.x = pack2(sigmoidf_(v[0]), sigmoidf_(v[1])); o.y = pack2(sigmoidf_(v[2]), sigmoidf_(v[3]));
        o.z = pack2(sigmoidf_(v[4]), sigmoidf_(v[5])); o.w = pack2(sigmoidf_(v[6]), sigmoidf_(v[7]));
        return o;
    }
};
struct EpiRwkvOut {
    const bf16_t* yb0; const bf16_t* yb1; const float* bon; const bf16_t* zx; const float* mu; const float* gnw; const float* gnb; bf16_t* mix; int m0, n0;
    __device__ void operator()(const float* Cs, int pass, int tid) const {
#pragma unroll 1
        for (int i = 0; i < 4; ++i) {
            const int c = tid + 256 * i, row = c >> 4, col8 = (c & 15) * 8;
            const int R = m0 + pass * 64 + row, col = n0 + col8, head = col >> 6;
            const uint4 a = *(const uint4*)&yb0[(size_t)R * 512 + col], b = *(const uint4*)&yb1[(size_t)R * 512 + col];
            const unsigned au[4] = {a.x, a.y, a.z, a.w}, bu[4] = {b.x, b.y, b.z, b.w};
            float y[8], sum = 0.f, sq = 0.f;
#pragma unroll
            for (int u = 0; u < 4; ++u) { y[2 * u] = bflo(au[u]) + bflo(bu[u]); y[2 * u + 1] = bfhi(au[u]) + bfhi(bu[u]); }
#pragma unroll
            for (int u = 0; u < 8; ++u) sum += y[u];
            sum += __shfl_xor(sum, 1); sum += __shfl_xor(sum, 2); sum += __shfl_xor(sum, 4);
            const float mean = sum * (1.f / 64.f);
#pragma unroll
            for (int u = 0; u < 8; ++u) { const float dl = y[u] - mean; sq += dl * dl; }
            sq += __shfl_xor(sq, 1); sq += __shfl_xor(sq, 2); sq += __shfl_xor(sq, 4);
            const float rs = rsqrtf(sq * (1.f / 64.f) + 64e-5f);
            const float bc = bon[(size_t)R * 16 + head * 2] + bon[(size_t)R * 16 + head * 2 + 1];
            float v[8]; zx0_shift8(zx, mu, R, 1280 + col, v);
            const float4 g0 = *(const float4*)&Cs[row * CS_LD + col8], g1 = *(const float4*)&Cs[row * CS_LD + col8 + 4];
            const float gg[8] = {g0.x, g0.y, g0.z, g0.w, g1.x, g1.y, g1.z, g1.w};
            float o[8];
#pragma unroll
            for (int u = 0; u < 8; ++u) o[u] = ((y[u] - mean) * rs * gnw[col + u] + gnb[col + u] + bc * v[u]) * gg[u];
            *(uint4*)&mix[(size_t)R * 768 + 256 + col] = make_uint4(pack2(o[0], o[1]), pack2(o[2], o[3]), pack2(o[4], o[5]), pack2(o[6], o[7]));
        }
    }
};
__device__ void phase_rwkv_out(const W p, unsigned char* smem, int bid, int nblk) {
    LdGlo al{WSP(bf16_t, WS_ZX), PAR(PAR_SHIFT)};
    LdBf16 bl{WSP(bf16_t, WS_G2T), 128};
    for (int t = bid; t < (NTOK / 128) * 4; t += nblk) {
        const int m0 = (t >> 2) * 128, n0 = (t & 3) * 128;
        EpiRwkvOut epi{WSP(bf16_t, WS_YB), WSP(bf16_t, WS_YB) + (size_t)NTOK * 512, WSP(float, WS_BON), WSP(bf16_t, WS_ZX), PAR(PAR_SHIFT),
                       PAR(PAR_GNW), PAR(PAR_GNB), WSP(bf16_t, WS_MIX), m0, n0};
        gemm_tile<128>(al, bl, 128, m0, n0, epi, smem);
    }
}

__device__ void phase_gemm_wout(const W p, unsigned char* smem, int bid, int nblk, int layer) {
    const int K = layer ? 1024 : 768;
    LdBf16 al{WSP(bf16_t, WS_MIX), K};
    LdBf16 bl{WSP(bf16_t, layer ? WS_WOUT1T : WS_WOUT0T), K};
    const int total = (NTOK / 128) * 8;
    for (int t = xcd_swz(bid, nblk); t < total; t += nblk) {
        const int m0 = (t >> 3) * 128, n0 = (t & 7) * 128;
        if (layer && (m0 % SS) < LC) continue;
        EpiStoreBf16 epi{WSP(bf16_t, WS_ZX), 1024, m0, n0, NTOK};
        gemm_tile_dma(al.base, al.ld, bl.base, bl.ld, K, m0, n0, epi, smem);
    }
}

__device__ __forceinline__ void ln_row_store(float (&v)[16], const float* g, const float* bta, float* dst, int lane, const float* m2, bf16_t* hb) {
    float s = 0.f;
#pragma unroll
    for (int i = 0; i < 16; ++i) s += v[i];
    const float mean = wave_sum(s) * (1.f / 1024.f);
    float q = 0.f;
#pragma unroll
    for (int i = 0; i < 16; ++i) { const float dl = v[i] - mean; q += dl * dl; }
    const float rs = rsqrtf(wave_sum(q) * (1.f / 1024.f) + 1e-5f);
#pragma unroll
    for (int i = 0; i < 4; ++i) {
        const int k = i * 256 + lane * 4;
        const float4 gg = *(const float4*)&g[k], bb = *(const float4*)&bta[k];
        float4 o;
        o.x = (v[4 * i] - mean) * rs * gg.x + bb.x; o.y = (v[4 * i + 1] - mean) * rs * gg.y + bb.y;
        o.z = (v[4 * i + 2] - mean) * rs * gg.z + bb.z; o.w = (v[4 * i + 3] - mean) * rs * gg.w + bb.w;
        *(float4*)&dst[k] = o;
        const float4 sc = *(const float4*)&m2[4096 + k], sh = *(const float4*)&m2[3072 + k];
        *(uint2*)&hb[k] = make_uint2(pack2(o.x * (1.f + sc.x) + sh.x, o.y * (1.f + sc.y) + sh.y), pack2(o.z * (1.f + sc.z) + sh.z, o.w * (1.f + sc.w) + sh.w));
    }
}
__device__ void phase_ln1(const W p, int gwave_, int nwaves_, int layer, unsigned char* smem) {
    const int gwave = __builtin_amdgcn_readfirstlane(gwave_), nwaves = __builtin_amdgcn_readfirstlane(nwaves_);
    const int lane = tidx() & 63;
    const bf16_t* yx = WSP(bf16_t, WS_ZX);
    const float* mod = WSP(float, WS_MOD) + (size_t)layer * 5 * 6144;
    const float* g = PAR(layer ? PAR_LN1G1 : PAR_LN1G0);
    const float* bt = PAR(layer ? PAR_LN1B1 : PAR_LN1B0);
    const float* xlat = layer ? p.out : p.x;
    const float* xctx = layer ? WSP(float, WS_CTX) : p.ctx;
    float* sp = (float*)smem;
    for (int i = tidx(); i < 1024; i += 256) {
        sp[i] = g[i]; sp[1024 + i] = bt[i];
#pragma unroll
        for (int v = 0; v < 5; ++v) {
            sp[2048 + v * 1024 + i] = mod[v * 6144 + 2048 + i];
            sp[7168 + v * 1024 + i] = mod[v * 6144 + 4096 + i];
            sp[12288 + v * 1024 + i] = mod[v * 6144 + 3072 + i];
        }
    }
    __syncthreads();
    const int nv = layer ? NB * TT : NTOK;
    if (gwave >= nv) return;
#define LN1_TOK(J) (layer ? ((J) / TT) * SS + LC + ((J) % TT) : (J))
#define LN1_SRC(R_) ((R_) % SS < LC ? xctx + ((size_t)(((R_) / SS) * LC + (R_) % SS)) * DM : xlat + ((size_t)(((R_) / SS) * TT + (R_) % SS - LC)) * DM)
#define LN1_LOAD(XD, YD, R_) { const float* s_ = LN1_SRC(R_); const int l4_ = (tidx() & 63) * 4; \
        _Pragma("unroll") for (int i_ = 0; i_ < 4; ++i_) { const float4 x4_ = *(const float4*)&s_[i_ * 256 + l4_]; const uint2 y_ = *(const uint2*)&yx[(size_t)(R_) * 1024 + i_ * 256 + l4_]; \
            XD[4 * i_] = x4_.x; XD[4 * i_ + 1] = x4_.y; XD[4 * i_ + 2] = x4_.z; XD[4 * i_ + 3] = x4_.w; YD[2 * i_] = y_.x; YD[2 * i_ + 1] = y_.y; } }
    float xa[16]; unsigned ya[8];
    int R = LN1_TOK(gwave);
    LN1_LOAD(xa, ya, R)
    for (int jt = gwave; jt < nv; jt += nwaves) {
        const int b = R / SS, s = R - b * SS;
        float* dst = s < LC ? WSP(float, WS_CTX) + ((size_t)(b * LC + s)) * DM : p.out + ((size_t)(b * TT + s - LC)) * DM;
        const int var = s < LC ? 4 : b;
        const int Rn = LN1_TOK(jt + nwaves < nv ? jt + nwaves : jt);
        float xb[16]; unsigned yb[8];
        LN1_LOAD(xb, yb, Rn)
        float v[16];
#pragma unroll
        for (int i = 0; i < 4; ++i) {
            const int k = i * 256 + lane * 4;
            const float4 g4 = *(const float4*)&sp[2048 + var * 1024 + k];
            v[4 * i] = ALPHA_F * xa[4 * i] + g4.x * bflo(ya[2 * i]);         v[4 * i + 1] = ALPHA_F * xa[4 * i + 1] + g4.y * bfhi(ya[2 * i]);
            v[4 * i + 2] = ALPHA_F * xa[4 * i + 2] + g4.z * bflo(ya[2 * i + 1]); v[4 * i + 3] = ALPHA_F * xa[4 * i + 3] + g4.w * bfhi(ya[2 * i + 1]);
        }
        float sm = 0.f;
#pragma unroll
        for (int i = 0; i < 16; ++i) sm += v[i];
        const float mean = wave_sum(sm) * (1.f / 1024.f);
        float q = 0.f;
#pragma unroll
        for (int i = 0; i < 16; ++i) { const float dl = v[i] - mean; q += dl * dl; }
        const float rs = rsqrtf(wave_sum(q) * (1.f / 1024.f) + 1e-5f);
        bf16_t* hb = WSP(bf16_t, WS_HB) + (size_t)R * 1024;
#pragma unroll
        for (int i = 0; i < 4; ++i) {
            const int k = i * 256 + lane * 4;
            const float4 gg = *(const float4*)&sp[k], bb = *(const float4*)&sp[1024 + k];
            float4 o;
            o.x = (v[4 * i] - mean) * rs * gg.x + bb.x; o.y = (v[4 * i + 1] - mean) * rs * gg.y + bb.y;
            o.z = (v[4 * i + 2] - mean) * rs * gg.z + bb.z; o.w = (v[4 * i + 3] - mean) * rs * gg.w + bb.w;
            *(float4*)&dst[k] = o;
            const float4 sc = *(const float4*)&sp[7168 + var * 1024 + k], sh = *(const float4*)&sp[12288 + var * 1024 + k];
            *(uint2*)&hb[k] = make_uint2(pack2(o.x * (1.f + sc.x) + sh.x, o.y * (1.f + sc.y) + sh.y), pack2(o.z * (1.f + sc.z) + sh.z, o.w * (1.f + sc.w) + sh.w));
        }
        R = Rn;
#pragma unroll
        for (int i = 0; i < 16; ++i) xa[i] = xb[i];
#pragma unroll
        for (int i = 0; i < 8; ++i) ya[i] = yb[i];
    }
#undef LN1_LOAD
#undef LN1_SRC
#undef LN1_TOK
}

__device__ void phase_gemm_q(const W p, unsigned char* smem, int bid, int nblk, int layer);
#define NEG_BIG (-3.0e38f)
#define TOPK_SMEM_BYTES (4 * (2 * 16 * 132) * 4)
__device__ const unsigned char kCandTab[64] = {0, 1, 2, 3, 4, 5, 6, 7, 8, 9, 10, 11, 12, 13, 14, 15, 16, 17, 18, 19, 20, 21, 22, 23, 32, 33, 34, 35, 36, 48, 49, 50, 51, 64, 65, 66, 80, 81, 96, 97, 112, 113, 128, 144, 160, 176, 192, 208, 224, 240, 255, 255, 255, 255, 255, 255, 255, 255, 255, 255, 255, 255, 255, 255};
template <int CTRL> __device__ __forceinline__ unsigned dppu(unsigned x) { return (unsigned)__builtin_amdgcn_mov_dpp((int)x, CTRL, 0xf, 0xf, true); }
__device__ __forceinline__ unsigned umax_(unsigned a, unsigned b) { return a > b ? a : b; }
__device__ __forceinline__ unsigned row16_maxu(unsigned x) {
    x = umax_(x, dppu<DPP_XOR1>(x)); x = umax_(x, dppu<DPP_XOR2>(x)); x = umax_(x, dppu<DPP_ROR4>(x)); x = umax_(x, dppu<DPP_ROR8>(x)); return x;
}
__device__ __forceinline__ unsigned fsort_key(float f) { const unsigned b = __float_as_uint(f); return b ^ ((b >> 31) ? 0xffffffffu : 0x80000000u); }
__device__ void peer_topk_item(const W p, int item, unsigned char* smem, int layer) {
    const int tile = item >> 3, h = item & 7;
    const int tid = tidx(), lane = tid & 63, wave = tid >> 6, l15 = lane & 15, rowbase = lane & 48;
    const int R0 = tile * 64 + wave * 16;
    const bf16_t* Q = WSP(bf16_t, WS_YB);
    const bf16_t* keys = WSP(bf16_t, layer ? WS_KEYS1 : WS_KEYS0);
    float* sc = (float*)smem + wave * (2 * 16 * 132);
    int* idxo = WSP(int, WS_IDX);
    float* gato = WSP(float, WS_GATE);
#pragma unroll
    for (int c = 0; c < 2; ++c) {
        f32x4 acc[8];
#pragma unroll
        for (int nt = 0; nt < 8; ++nt) acc[nt] = (f32x4){0.f, 0.f, 0.f, 0.f};
#pragma unroll
        for (int kk = 0; kk < 2; ++kk) {
            const bf16x8 a = *(const bf16x8*)&Q[(size_t)(R0 + (lane & 15)) * 1024 + h * 128 + c * 64 + kk * 32 + 8 * (lane >> 4)];
#pragma unroll
            for (int nt = 0; nt < 8; ++nt) {
                const bf16x8 bq = *(const bf16x8*)&keys[(size_t)((h * 2 + c) * 128 + nt * 16 + (lane & 15)) * 64 + kk * 32 + 8 * (lane >> 4)];
                acc[nt] = __builtin_amdgcn_mfma_f32_16x16x32_bf16(a, bq, acc[nt], 0, 0, 0);
            }
        }
#pragma unroll
        for (int nt = 0; nt < 8; ++nt)
#pragma unroll
            for (int r = 0; r < 4; ++r) sc[c * (16 * 132) + ((lane >> 4) * 4 + r) * 132 + nt * 16 + (lane & 15)] = acc[nt][r];
    }
#pragma unroll 1
    for (int tg = 0; tg < 4; ++tg) {
        const int t = tg * 4 + (lane >> 4), R = R0 + t;
        const float* s0p = sc + t * 132;
        const float* s1p = sc + 16 * 132 + t * 132;
        unsigned ka[8], kb[8];
#pragma unroll
        for (int m = 0; m < 8; ++m) {
            const int ix = l15 + 16 * m;
            ka[m] = (fsort_key(s0p[ix]) & ~127u) | (unsigned)(127 - ix);
            kb[m] = (fsort_key(s1p[ix]) & ~127u) | (unsigned)(127 - ix);
        }
        unsigned minea = 0u, mineb = 0u;
#pragma unroll 1
        for (int it = 0; it < 16; ++it) {
            const unsigned la = umax_(umax_(umax_(ka[0], ka[1]), umax_(ka[2], ka[3])), umax_(umax_(ka[4], ka[5]), umax_(ka[6], ka[7])));
            const unsigned lb = umax_(umax_(umax_(kb[0], kb[1]), umax_(kb[2], kb[3])), umax_(umax_(kb[4], kb[5]), umax_(kb[6], kb[7])));
            const unsigned ma = row16_maxu(la), mb = row16_maxu(lb);
#pragma unroll
            for (int m = 0; m < 8; ++m) { ka[m] = (ka[m] == ma) ? 0u : ka[m]; kb[m] = (kb[m] == mb) ? 0u : kb[m]; }
            minea = (l15 == it) ? ma : minea; mineb = (l15 == it) ? mb : mineb;
        }
        const int j1 = 127 - (int)(minea & 127u), j2 = 127 - (int)(mineb & 127u);
        const float a1 = s0p[j1], a2 = s1p[j2];
        unsigned k[4];
#pragma unroll
        for (int m = 0; m < 4; ++m) {
            const int slot = l15 + 16 * m;
            const int ij = kCandTab[slot];
            const float v = __shfl(a1, rowbase + ((ij >> 4) & 15)) + __shfl(a2, rowbase + (ij & 15));
            k[m] = (ij == 255) ? 0u : ((fsort_key(v) & ~63u) | (unsigned)(63 - slot));
        }
        unsigned mine = 0u;
#pragma unroll 1
        for (int it = 0; it < 16; ++it) {
            const unsigned lm = umax_(umax_(k[0], k[1]), umax_(k[2], k[3]));
            const unsigned mx = row16_maxu(lm);
#pragma unroll
            for (int m = 0; m < 4; ++m) k[m] = (k[m] == mx) ? 0u : k[m];
            mine = (l15 == it) ? mx : mine;
        }
        const int ij = kCandTab[63 - (int)(mine & 63u)];
        const int i = (ij >> 4) & 15, j = ij & 15;
        const float tv = __shfl(a1, rowbase + i) + __shfl(a2, rowbase + j);
        const int e1 = __shfl(j1, rowbase + i), e2 = __shfl(j2, rowbase + j);
        const float mx = __shfl(tv, rowbase);
        const float ex = __expf(tv - mx);
        const float den = row16_sum(ex);
        idxo[(size_t)R * 128 + h * 16 + l15] = e1 * 128 + e2;
        gato[(size_t)R * 128 + h * 16 + l15] = ex / den;
    }
}

struct EpiTopk {
    const bf16_t* keys; int* idxo; float* gato; int h; int m0; unsigned char* smem;
    __device__ void run128(const float* Cs, int tid) const {
        const int lane = tid & 63, wave = tid >> 6, l15 = lane & 15, rowbase = lane & 48;
        int ijm[4];
#pragma unroll
        for (int m = 0; m < 4; ++m) ijm[m] = kCandTab[l15 + 16 * m];
        bf16x8 qa[2][2][2];
#pragma unroll
        for (int ps = 0; ps < 2; ++ps)
#pragma unroll
            for (int c = 0; c < 2; ++c)
#pragma unroll
                for (int kk = 0; kk < 2; ++kk) {
                    const float* src = &Cs[(ps * 64 + wave * 16 + l15) * CS_LD + c * 64 + kk * 32 + 8 * (lane >> 4)];
                    const float4 f0 = *(const float4*)src, f1 = *(const float4*)(src + 4);
                    union { bf16x8 v; unsigned u[4]; } pk;
                    pk.u[0] = pack2(f0.x, f0.y); pk.u[1] = pack2(f0.z, f0.w); pk.u[2] = pack2(f1.x, f1.y); pk.u[3] = pack2(f1.z, f1.w);
                    qa[ps][c][kk] = pk.v;
                }
        __syncthreads();
        float* sc = (float*)smem + wave * (2 * 16 * 132);
#pragma unroll
        for (int ps = 0; ps < 2; ++ps) {
        const int R0 = m0 + ps * 64 + wave * 16;
#pragma unroll
        for (int c = 0; c < 2; ++c) {
            f32x4 acc[8];
#pragma unroll
            for (int nt = 0; nt < 8; ++nt) acc[nt] = (f32x4){0.f, 0.f, 0.f, 0.f};
            bf16x8 bq[2][8];
#pragma unroll
            for (int kk = 0; kk < 2; ++kk)
#pragma unroll
                for (int nt = 0; nt < 8; ++nt) bq[kk][nt] = *(const bf16x8*)&keys[(size_t)((h * 2 + c) * 128 + nt * 16 + (lane & 15)) * 64 + kk * 32 + 8 * (lane >> 4)];
#pragma unroll
            for (int kk = 0; kk < 2; ++kk) {
                const bf16x8 a = qa[ps][c][kk];
#pragma unroll
                for (int nt = 0; nt < 8; ++nt) acc[nt] = __builtin_amdgcn_mfma_f32_16x16x32_bf16(a, bq[kk][nt], acc[nt], 0, 0, 0);
            }
#pragma unroll
            for (int nt = 0; nt < 8; ++nt)
#pragma unroll
                for (int r = 0; r < 4; ++r) sc[c * (16 * 132) + ((lane >> 4) * 4 + r) * 132 + nt * 16 + (lane & 15)] = acc[nt][r];
        }
#pragma unroll 1
        for (int tg = 0; tg < 4; ++tg) {
            const int t = tg * 4 + (lane >> 4), R = R0 + t;
            const float* s0p = sc + t * 132;
            const float* s1p = sc + 16 * 132 + t * 132;
            unsigned ka[8], kb[8];
#pragma unroll
            for (int m = 0; m < 8; ++m) {
                const int ix = l15 + 16 * m;
                ka[m] = (fsort_key(s0p[ix]) & ~127u) | (unsigned)(127 - ix);
                kb[m] = (fsort_key(s1p[ix]) & ~127u) | (unsigned)(127 - ix);
            }
#define CE_(K, i, j) { const unsigned hi_ = umax_(K[i], K[j]), lo_ = K[i] < K[j] ? K[i] : K[j]; K[i] = hi_; K[j] = lo_; }
#define SORT8_(K) { CE_(K,0,1) CE_(K,2,3) CE_(K,4,5) CE_(K,6,7)  CE_(K,0,2) CE_(K,1,3) CE_(K,4,6) CE_(K,5,7)  CE_(K,1,2) CE_(K,5,6) \
                    CE_(K,0,4) CE_(K,1,5) CE_(K,2,6) CE_(K,3,7)  CE_(K,2,4) CE_(K,3,5)  CE_(K,1,2) CE_(K,3,4) CE_(K,5,6) }
            SORT8_(ka) SORT8_(kb)
            unsigned minea = 0u, mineb = 0u;
#pragma unroll
            for (int it = 0; it < 16; ++it) {
                const unsigned ma = row16_maxu(ka[0]), mb = row16_maxu(kb[0]);
                const bool pa = ka[0] == ma, pb = kb[0] == mb;
#pragma unroll
                for (int m = 0; m < 7; ++m) { ka[m] = pa ? ka[m + 1] : ka[m]; kb[m] = pb ? kb[m + 1] : kb[m]; }
                ka[7] = pa ? 0u : ka[7]; kb[7] = pb ? 0u : kb[7];
                minea = (l15 == it) ? ma : minea; mineb = (l15 == it) ? mb : mineb;
            }
#undef SORT8_
            const int j1 = 127 - (int)(minea & 127u), j2 = 127 - (int)(mineb & 127u);
            const float a1 = s0p[j1], a2 = s1p[j2];
            unsigned k[4];
#pragma unroll
            for (int m = 0; m < 4; ++m) {
                const int ij = ijm[m];
                const float v = __shfl(a1, rowbase + ((ij >> 4) & 15)) + __shfl(a2, rowbase + (ij & 15));
                k[m] = (ij == 255) ? 0u : ((fsort_key(v) & ~255u) | (unsigned)ij);
            }
            CE_(k,0,1) CE_(k,2,3) CE_(k,0,2) CE_(k,1,3) CE_(k,1,2)
#undef CE_
            unsigned mine = 0u;
#pragma unroll
            for (int it = 0; it < 16; ++it) {
                const unsigned mx = row16_maxu(k[0]);
                const bool pk = k[0] == mx;
                k[0] = pk ? k[1] : k[0]; k[1] = pk ? k[2] : k[1]; k[2] = pk ? k[3] : k[2]; k[3] = pk ? 0u : k[3];
                mine = (l15 == it) ? mx : mine;
            }
            const int i = (int)((mine >> 4) & 15u), j = (int)(mine & 15u);
            const float tv = __shfl(a1, rowbase + i) + __shfl(a2, rowbase + j);
            const int e1 = __shfl(j1, rowbase + i), e2 = __shfl(j2, rowbase + j);
            const float mx = __shfl(tv, rowbase);
            const float ex = __expf(tv - mx);
            const float den = row16_sum(ex);
            idxo[(size_t)R * 128 + h * 16 + l15] = e1 * 128 + e2;
            gato[(size_t)R * 128 + h * 16 + l15] = ex / den;
        }
        }
        __syncthreads();
    }
};

__device__ void phase_gemm_q(const W p, unsigned char* smem, int bid, int nblk, int layer) {
    LdBf16 al{WSP(bf16_t, WS_HB), 1024};
    LdBf16 bl{WSP(bf16_t, layer ? WS_WQ1T : WS_WQ0T), 1024};
    const int total = (NTOK / 128) * 8;
    for (int t = xcd_swz(bid, nblk); t < total; t += nblk) {
        const int m0 = (t >> 3) * 128, n0 = (t & 7) * 128;
        if (layer && (m0 % SS) < LC) continue;
        EpiTopk epi{WSP(bf16_t, layer ? WS_KEYS1 : WS_KEYS0), WSP(int, WS_IDX), WSP(float, WS_GATE), t & 7, m0, smem};
        gemm_tile_dma<2>(al.base, al.ld, bl.base, bl.ld, 1024, m0, n0, epi, smem);
    }
}

using f32x2 = __attribute__((ext_vector_type(2))) float;
using v6u = __attribute__((ext_vector_type(6))) unsigned;
using v32f = __attribute__((ext_vector_type(32))) float;
__device__ __forceinline__ v32f fp6x32_to_f32(const U3& a, const U3& b) {
    v6u s; s[0] = a.x; s[1] = a.y; s[2] = a.z; s[3] = b.x; s[4] = b.y; s[5] = b.z;
    return __builtin_amdgcn_cvt_scalef32_pk32_f32_fp6(s, 1.0f);
}
__device__ __forceinline__ float erf_fast(float x) {
    const float ax = fabsf(x);
    const float t = 1.f / (1.f + 0.3275911f * ax);
    const float poly = t * (0.254829592f + t * (-0.284496736f + t * (1.421413741f + t * (-1.453152027f + t * 1.061405429f))));
    const float r = 1.f - poly * __expf(-ax * ax);
    return copysignf(r, x);
}
constexpr int GD = 8;
struct __attribute__((packed, aligned(4))) U2 { unsigned y, z; };
#define G_ISSUE(J, TAB, IA, IB, E) { \
    const unsigned offa_ = (unsigned)__builtin_amdgcn_readlane(IA, E) * 768u + lane12; \
    const unsigned offb_ = (unsigned)__builtin_amdgcn_readlane(IB, E) * 768u + lane12; \
    unsigned offb4_ = offb_ + 4u; asm volatile("" : "+v"(offb4_)); \
    const U3 q0_ = *(const U3*)((TAB) + offa_); \
    const unsigned q1x_ = *(const unsigned*)((TAB) + offb_); \
    const U2 q1_ = *(const U2*)((TAB) + offb4_); \
    rg[J][0] = q0_.x; rg[J][1] = q0_.y; rg[J][2] = q0_.z; rg[J][3] = q1x_; rg[J][4] = q1_.y; rg[J][5] = q1_.z; }
#define BFLY(OUT, A, B, BIT, CTRL) { const float k_ = (BIT) ? (B) : (A), g_ = (BIT) ? (A) : (B); OUT = k_ + dppf<CTRL>(g_); }
#define G_PIN(J) asm volatile("" : "+v"(rg[J]));
constexpr size_t WS_ACT = WS_ZX;
__device__ __forceinline__ int gather_tok(int layer, int j) { return layer ? (j / TT) * SS + LC + (j % TT) : j; }
__device__ __forceinline__ const float* gather_xrow(const W& p, int R) {
    const int b = R / SS, s = R - b * SS;
    return s < LC ? WSP(float, WS_CTX) + ((size_t)(b * LC + s)) * DM : p.out + ((size_t)(b * TT + s - LC)) * DM;
}
__device__ void phase_peer_act(const W p, int gwave_, int nwaves_, int layer) {
    const int gwave = __builtin_amdgcn_readfirstlane(gwave_), nwaves = __builtin_amdgcn_readfirstlane(nwaves_);
    const int lane = tidx() & 63;
    const float* mod = WSP(float, WS_MOD) + (size_t)layer * 5 * 6144;
    const unsigned char* U = p.ws + (layer ? WS_TABU1 : WS_TABU0);
    const float* su = WSP(float, WS_TABSC) + (layer ? 2 : 0) * 16384;
    const float* sv = su + 16384;
    const int* idxo = WSP(int, WS_IDX);
    const float* gato = WSP(float, WS_GATE);
    float* acto = WSP(float, WS_ACT);
    const int nv = layer ? NB * TT : NTOK;
    if (gwave >= nv) return;
    v6u rg[GD];
    static_assert(GD == 8, "the transpose-reduce below merges 8 steps x 2 lists");
    const bool lb0 = (lane & 1) != 0, lb1 = (lane & 2) != 0, lb2 = (lane & 4) != 0, lb3 = (lane & 8) != 0;
    const unsigned lane12 = (unsigned)lane * 12u;
    int R = gather_tok(layer, gwave);
    int ia = idxo[(size_t)R * 128 + lane], ib = idxo[(size_t)R * 128 + 64 + lane];
#pragma unroll
    for (int j = 0; j < GD; ++j) G_ISSUE(j, U, ia, ib, j)
    int Rn = gather_tok(layer, gwave + nwaves < nv ? gwave + nwaves : gwave);
    int ian = idxo[(size_t)Rn * 128 + lane], ibn = idxo[(size_t)Rn * 128 + 64 + lane];
    float hh[16];
    { const int b = R / SS, s = R - b * SS;
      const float* xrow = gather_xrow(p, R);
      const float* m = mod + (s < LC ? 4 : b) * 6144;
#pragma unroll
      for (int q4 = 0; q4 < 4; ++q4) {
          const int k = lane * 16 + q4 * 4;
          const float4 xv = *(const float4*)&xrow[k], sc = *(const float4*)&m[4096 + k], sh = *(const float4*)&m[3072 + k];
          hh[q4 * 4 + 0] = xv.x * (1.f + sc.x) + sh.x; hh[q4 * 4 + 1] = xv.y * (1.f + sc.y) + sh.y;
          hh[q4 * 4 + 2] = xv.z * (1.f + sc.z) + sh.z; hh[q4 * 4 + 3] = xv.w * (1.f + sc.w) + sh.w;
      } }
    for (int jt = gwave; jt < nv; jt += nwaves) {
        const int j2 = jt + 2 * nwaves < nv ? jt + 2 * nwaves : jt;
        const int R2 = gather_tok(layer, j2);
        const int ln0 = tidx() & 63;
        const int ian2 = idxo[(size_t)R2 * 128 + ln0], ibn2 = idxo[(size_t)R2 * 128 + 64 + ln0];
        const float ga = gato[(size_t)R * 128 + ln0], gb = gato[(size_t)R * 128 + 64 + ln0];
        const float sua = su[ia], sub = su[ib], sva = sv[ia], svb = sv[ib];
        float xn[16], scn[16], shn[16];
        { const int bn = Rn / SS, sn = Rn - bn * SS;
          const float* xrown = gather_xrow(p, Rn);
          const float* mn = mod + (sn < LC ? 4 : bn) * 6144;
          const int lk2 = ln0 * 16;
#pragma unroll
          for (int q4 = 0; q4 < 4; ++q4) {
              const float4 xv = *(const float4*)&xrown[lk2 + q4 * 4], sc = *(const float4*)&mn[4096 + lk2 + q4 * 4], sh = *(const float4*)&mn[3072 + lk2 + q4 * 4];
              xn[q4 * 4] = xv.x; xn[q4 * 4 + 1] = xv.y; xn[q4 * 4 + 2] = xv.z; xn[q4 * 4 + 3] = xv.w;
              scn[q4 * 4] = sc.x; scn[q4 * 4 + 1] = sc.y; scn[q4 * 4 + 2] = sc.z; scn[q4 * 4 + 3] = sc.w;
              shn[q4 * 4] = sh.x; shn[q4 * 4 + 1] = sh.y; shn[q4 * 4 + 2] = sh.z; shn[q4 * 4 + 3] = sh.w;
          } }
        asm volatile("" :: "v"(ian), "v"(ibn));
        float acta = 0.f, actb = 0.f;
#pragma unroll 1
        for (int e0 = 0; e0 < 64; e0 += GD) {
            const bool last = e0 + GD >= 64;
            const int ja = last ? ian : ia, jb = last ? ibn : ib;
            float pr[16];
#pragma unroll
            for (int j = 0; j < GD; ++j) {
                G_PIN(j)
                const v32f uu = __builtin_amdgcn_cvt_scalef32_pk32_f32_fp6(rg[j], 1.0f);
                G_ISSUE(j, U, ja, jb, (e0 + j + GD) & 63)
                f32x2 a0 = {0.f, 0.f}, a1 = {0.f, 0.f};
#pragma unroll
                for (int i = 0; i < 8; ++i) {
                    const f32x2 h2 = {hh[2 * i], hh[2 * i + 1]}, u0 = {uu[2 * i], uu[2 * i + 1]}, u1 = {uu[16 + 2 * i], uu[17 + 2 * i]};
                    a0 = __builtin_elementwise_fma(h2, u0, a0); a1 = __builtin_elementwise_fma(h2, u1, a1);
                }
                pr[j] = a0[0] + a0[1]; pr[8 + j] = a1[0] + a1[1];
                __builtin_amdgcn_sched_barrier(0);
            }
            float q8[8], r4[4], s2[2], tt;
#pragma unroll
            for (int m = 0; m < 8; ++m) BFLY(q8[m], pr[2 * m], pr[2 * m + 1], lb0, DPP_XOR1)
#pragma unroll
            for (int m = 0; m < 4; ++m) BFLY(r4[m], q8[2 * m], q8[2 * m + 1], lb1, DPP_XOR2)
#pragma unroll
            for (int m = 0; m < 2; ++m) BFLY(s2[m], r4[2 * m], r4[2 * m + 1], lb2, DPP_ROR4)
            BFLY(tt, s2[0], s2[1], lb3, DPP_ROR8)
            tt = xrow_sum(tt);
            const float tx = dppf<DPP_ROR8>(tt);
            const bool inr = (lane >> 3) == (e0 >> 3), hi8 = (e0 & 8) != 0;
            acta = inr ? (hi8 ? tx : tt) : acta; actb = inr ? (hi8 ? tt : tx) : actb;
        }
        { const float da = acta * sua, db = actb * sub;
          acta = ga * (0.5f * da * (1.f + erf_fast(da * 0.70710678118654752f))) * sva;
          actb = gb * (0.5f * db * (1.f + erf_fast(db * 0.70710678118654752f))) * svb; }
        { const int ln1 = tidx() & 63;
          acto[(size_t)R * 128 + ln1] = acta; acto[(size_t)R * 128 + 64 + ln1] = actb; }
        R = Rn; Rn = R2; ia = ian; ib = ibn; ian = ian2; ibn = ibn2;
#pragma unroll
        for (int i = 0; i < 16; ++i) hh[i] = xn[i] * (1.f + scn[i]) + shn[i];
    }
}
__device__ void phase_peer_out(const W p, int gwave_, int nwaves_, int layer, unsigned char* smem) {
    const int gwave = __builtin_amdgcn_readfirstlane(gwave_), nwaves = __builtin_amdgcn_readfirstlane(nwaves_);
    const int lane = tidx() & 63;
    const float* mod = WSP(float, WS_MOD) + (size_t)layer * 5 * 6144;
    const unsigned char* V = p.ws + (layer ? WS_TABV1 : WS_TABV0);
    const int* idxo = WSP(int, WS_IDX);
    const float* acto = WSP(float, WS_ACT);
    const float* g = PAR(layer ? PAR_LN2G1 : PAR_LN2G0);
    const float* bt = PAR(layer ? PAR_LN2B1 : PAR_LN2B0);
    float* sp = (float*)smem;
    for (int i = tidx(); i < 1024; i += 256) {
        sp[i] = g[i]; sp[1024 + i] = bt[i];
#pragma unroll
        for (int v = 0; v < 5; ++v) {
            sp[2048 + v * 1024 + i] = mod[v * 6144 + 5120 + i];
            if (layer == 0) { sp[7168 + v * 1024 + i] = mod[(5 + v) * 6144 + 1024 + i]; sp[12288 + v * 1024 + i] = mod[(5 + v) * 6144 + i]; }
        }
    }
    __syncthreads();
    const int nv = layer ? NB * TT : NTOK;
    if (gwave >= nv) return;
    v6u rg[GD];
    const unsigned lane12 = (unsigned)lane * 12u;
    int R = gather_tok(layer, gwave);
    int ia = idxo[(size_t)R * 128 + lane], ib = idxo[(size_t)R * 128 + 64 + lane];
#pragma unroll
    for (int j = 0; j < GD; ++j) G_ISSUE(j, V, ia, ib, j)
    int Rn = gather_tok(layer, gwave + nwaves < nv ? gwave + nwaves : gwave);
    int ian = idxo[(size_t)Rn * 128 + lane], ibn = idxo[(size_t)Rn * 128 + 64 + lane];
    float acta = acto[(size_t)R * 128 + lane], actb = acto[(size_t)R * 128 + 64 + lane];
    float xr[16];
    { const float* xrow = gather_xrow(p, R);
#pragma unroll
      for (int q4 = 0; q4 < 4; ++q4) { const float4 xv = *(const float4*)&xrow[lane * 16 + q4 * 4]; xr[q4 * 4] = xv.x; xr[q4 * 4 + 1] = xv.y; xr[q4 * 4 + 2] = xv.z; xr[q4 * 4 + 3] = xv.w; } }
    for (int jt = gwave; jt < nv; jt += nwaves) {
        const int b = R / SS, s = R - b * SS;
        float* xrow = s < LC ? WSP(float, WS_CTX) + ((size_t)(b * LC + s)) * DM : p.out + ((size_t)(b * TT + s - LC)) * DM;
        const int var = s < LC ? 4 : b;
        const int j2 = jt + 2 * nwaves < nv ? jt + 2 * nwaves : jt;
        const int R2 = gather_tok(layer, j2);
        const int ln0 = tidx() & 63;
        const int ian2 = idxo[(size_t)R2 * 128 + ln0], ibn2 = idxo[(size_t)R2 * 128 + 64 + ln0];
        const float actan = acto[(size_t)Rn * 128 + ln0], actbn = acto[(size_t)Rn * 128 + 64 + ln0];
        f32x2 o2[8]; float xn[16];
#pragma unroll
        for (int i = 0; i < 8; ++i) o2[i] = (f32x2){0.f, 0.f};
        { const float* xrown = gather_xrow(p, Rn);
          const int lk2 = ln0 * 16;
#pragma unroll
          for (int q4 = 0; q4 < 4; ++q4) { const float4 xv = *(const float4*)&xrown[lk2 + q4 * 4]; xn[q4 * 4] = xv.x; xn[q4 * 4 + 1] = xv.y; xn[q4 * 4 + 2] = xv.z; xn[q4 * 4 + 3] = xv.w; } }
        asm volatile("" :: "v"(ian), "v"(ibn), "v"(acta), "v"(actb));
#pragma unroll 1
        for (int e0 = 0; e0 < 64; e0 += GD) {
            const bool last = e0 + GD >= 64;
            const int ja = last ? ian : ia, jb = last ? ibn : ib;
#pragma unroll
            for (int j = 0; j < GD; ++j) {
                G_PIN(j)
                const v32f vv = __builtin_amdgcn_cvt_scalef32_pk32_f32_fp6(rg[j], 1.0f);
                G_ISSUE(j, V, ja, jb, (e0 + j + GD) & 63)
                const float w0 = __builtin_bit_cast(float, __builtin_amdgcn_readlane(__builtin_bit_cast(int, acta), e0 + j));
                const float w1 = __builtin_bit_cast(float, __builtin_amdgcn_readlane(__builtin_bit_cast(int, actb), e0 + j));
                const f32x2 w02 = {w0, w0}, w12 = {w1, w1};
#pragma unroll
                for (int i = 0; i < 8; ++i) {
                    o2[i] = __builtin_elementwise_fma(w02, (f32x2){vv[2 * i], vv[2 * i + 1]}, o2[i]);
                    o2[i] = __builtin_elementwise_fma(w12, (f32x2){vv[16 + 2 * i], vv[17 + 2 * i]}, o2[i]);
                }
                asm volatile("" : "+v"(o2[0]), "+v"(o2[1]), "+v"(o2[2]), "+v"(o2[3]), "+v"(o2[4]), "+v"(o2[5]), "+v"(o2[6]), "+v"(o2[7]));
                __builtin_amdgcn_sched_barrier(0);
            }
        }
        float o[16];
#pragma unroll
        for (int i = 0; i < 8; ++i) { o[2 * i] = o2[i][0]; o[2 * i + 1] = o2[i][1]; }
        float vsum = 0.f;
        const int lk3 = (tidx() & 63) * 16;
#pragma unroll
        for (int q4 = 0; q4 < 4; ++q4) {
            const int k = lk3 + q4 * 4;
            const float4 g2 = *(const float4*)&sp[2048 + var * 1024 + k];
            o[q4 * 4 + 0] = ALPHA_F * xr[q4 * 4 + 0] + g2.x * o[q4 * 4 + 0];
            o[q4 * 4 + 1] = ALPHA_F * xr[q4 * 4 + 1] + g2.y * o[q4 * 4 + 1];
            o[q4 * 4 + 2] = ALPHA_F * xr[q4 * 4 + 2] + g2.z * o[q4 * 4 + 2];
            o[q4 * 4 + 3] = ALPHA_F * xr[q4 * 4 + 3] + g2.w * o[q4 * 4 + 3];
        }
#pragma unroll
        for (int i = 0; i < 16; ++i) vsum += o[i];
        const float mean = wave_sum(vsum) * (1.f / 1024.f);
        float vq2 = 0.f;
#pragma unroll
        for (int i = 0; i < 16; ++i) { const float dl = o[i] - mean; vq2 += dl * dl; }
        const float rs = rsqrtf(wave_sum(vq2) * (1.f / 1024.f) + 1e-5f);
#pragma unroll
        for (int q4 = 0; q4 < 4; ++q4) {
            const int k = lk3 + q4 * 4;
            const float4 gg = *(const float4*)&sp[k], bb = *(const float4*)&sp[1024 + k];
            float4 r;
            r.x = (o[q4 * 4 + 0] - mean) * rs * gg.x + bb.x; r.y = (o[q4 * 4 + 1] - mean) * rs * gg.y + bb.y;
            r.z = (o[q4 * 4 + 2] - mean) * rs * gg.z + bb.z; r.w = (o[q4 * 4 + 3] - mean) * rs * gg.w + bb.w;
            *(float4*)&xrow[k] = r;
            if (layer == 0) {
                const float4 sc = *(const float4*)&sp[7168 + var * 1024 + k], sh = *(const float4*)&sp[12288 + var * 1024 + k];
                *(uint2*)(WSP(bf16_t, WS_HB2) + (size_t)R * 1024 + k) =
                    make_uint2(pack2(r.x * (1.f + sc.x) + sh.x, r.y * (1.f + sc.y) + sh.y), pack2(r.z * (1.f + sc.z) + sh.z, r.w * (1.f + sc.w) + sh.w));
            }
        }
        R = Rn; Rn = R2; ia = ian; ib = ibn; ian = ian2; ibn = ibn2; acta = actan; actb = actbn;
#pragma unroll
        for (int i = 0; i < 16; ++i) xr[i] = xn[i];
    }
}
#undef G_ISSUE
#undef G_PIN
#undef BFLY

constexpr size_t WS_ROPE = WS_END;
static_assert(WS_ROPE + 16384 <= (size_t)536870912, "rope table fits");
__device__ void phase_rope_table(const P& p, size_t gtid, size_t gthreads) {
    float* rt = WSP(float, WS_ROPE);
    for (size_t e = gtid; e < 128 * 16; e += gthreads) {
        const int i = (int)(e & 15), pos = (int)(e >> 4);
        const float freq = powf(10000.f, -(float)i / 16.f);
        const float ang = (float)pos * freq;
        rt[e * 2] = cosf(ang); rt[e * 2 + 1] = sinf(ang);
    }
}
struct EpiZX1 {
    bf16_t* zx; bf16_t* vt; const float* rope; int m0, n0;
    __device__ void operator()(const float* Cs, int pass, int tid) const {
        const int Rb = m0 + pass * 64;
        const int b = Rb / SS, sb = Rb - b * SS;
        const bool isv = (n0 == 640) || (n0 >= 1792);
        if (isv) {
            const int hv0 = (n0 == 640) ? 0 : 2 + (n0 - 1792) / 64;
#pragma unroll
            for (int i = 0; i < 4; ++i) {
                const int c = tid + 256 * i, col = c >> 3, r8 = (c & 7) * 8;
                float v[8];
#pragma unroll
                for (int u = 0; u < 8; ++u) v[u] = Cs[(r8 + u) * CS_LD + col];
                uint4 o; o.x = pack2(v[0], v[1]); o.y = pack2(v[2], v[3]); o.z = pack2(v[4], v[5]); o.w = pack2(v[6], v[7]);
                *(uint4*)&vt[((size_t)(b * 10 + hv0 + (col >> 6)) * 64 + (col & 63)) * SS + sb + r8] = o;
            }
            return;
        }
        const bool dorope = (n0 < 640) && (sb >= LC);
#pragma unroll
        for (int i = 0; i < 4; ++i) {
            const int c = tid + 256 * i, row = c >> 4, col8 = (c & 15) * 8;
            const int R = Rb + row;
            float v[8];
            const float4 a = *(const float4*)&Cs[row * CS_LD + col8], bq = *(const float4*)&Cs[row * CS_LD + col8 + 4];
            v[0] = a.x; v[1] = a.y; v[2] = a.z; v[3] = a.w; v[4] = bq.x; v[5] = bq.y; v[6] = bq.z; v[7] = bq.w;
            if (dorope) {
                const int t = sb + row - LC;
                const int e0 = col8 & 31, half = (col8 >> 5) & 1;
                const int pos = half ? (t & 63) : (t >> 6);
                const bool lo = e0 < 16;
                const int pc = lo ? col8 + 16 : col8 - 16;
                const float4 pa = *(const float4*)&Cs[row * CS_LD + pc], pb = *(const float4*)&Cs[row * CS_LD + pc + 4];
                const float pv[8] = {pa.x, pa.y, pa.z, pa.w, pb.x, pb.y, pb.z, pb.w};
#pragma unroll
                for (int u = 0; u < 8; ++u) {
                    const int fi = (e0 & 15) + u;
                    const float cs = rope[(pos * 16 + fi) * 2], sn = rope[(pos * 16 + fi) * 2 + 1];
                    v[u] = lo ? (v[u] * cs - pv[u] * sn) : (v[u] * cs + pv[u] * sn);
                }
            }
            uint4 o; o.x = pack2(v[0], v[1]); o.y = pack2(v[2], v[3]); o.z = pack2(v[4], v[5]); o.w = pack2(v[6], v[7]);
            *(uint4*)&zx[(size_t)R * ZW1 + n0 + col8] = o;
        }
    }
};
__device__ void phase_gemm_win1(const W p, unsigned char* smem, int bid, int nblk) {
    LdBf16 al{WSP(bf16_t, WS_HB2), 1024};
    LdBf16 bl{WSP(bf16_t, WS_WIN1T), 1024};
    const int ntn = ZW1 / 128, total = (NTOK / 128) * ntn;
    for (int t = xcd_swz(bid, nblk); t < total; t += nblk) {
        const int m0 = (t / ntn) * 128, n0 = (t % ntn) * 128;
        EpiZX1 epi{WSP(bf16_t, WS_ZX), WSP(bf16_t, WS_VT), WSP(float, WS_ROPE), m0, n0};
        gemm_tile_dma(al.base, al.ld, bl.base, bl.ld, 1024, m0, n0, epi, smem);
    }
}

#define AT_LD 72
#define ATTN_SMEM_BYTES (2 * 64 * AT_LD * 2)
#define MASK_NEG (-1.0e30f)
template <int kind>
__device__ void attn_item(const W p, int item, unsigned char* smem) {
    const int qt = item & 63, hq = (item >> 6) & 7, b = (item >> 9) & 3;
    const int tid = tidx(), lane = tid & 63, wave = tid >> 6, hh = lane >> 5, ql = lane & 31;
    bf16_t* Ks = (bf16_t*)smem;
    bf16_t* Vs = Ks + 64 * AT_LD;
    const bf16_t* zx = WSP(bf16_t, WS_ZX);
    const int t0 = qt * 128;
    const int qcol = kind ? 768 + hq * 64 : hq * 64;
    const int kcol = kind ? 1280 + hq * 64 : 512 + (hq >> 2) * 64;
    const bf16_t* vt = WSP(bf16_t, WS_VT) + ((size_t)(b * 10 + (kind ? 2 + hq : (hq >> 2))) * 64) * SS;
    const int ocol = kind ? 512 + hq * 64 : hq * 64;
    const int tq = t0 + wave * 32 + ql, tq0w = t0 + wave * 32;
    const size_t Rq = (size_t)b * SS + LC + tq;
    bf16x8 qf[4];
#pragma unroll
    for (int st = 0; st < 4; ++st) qf[st] = *(const bf16x8*)&zx[Rq * ZW1 + qcol + st * 16 + 8 * hh];
    int lk0, lk1;
    const int r0 = t0 >> 6;
    if (kind == 0) { lk0 = t0 - 128 < 0 ? 0 : t0 - 128; lk1 = t0 + 256 > TT ? TT : t0 + 256; }
    else {
        int rs0 = r0 - 4; rs0 = rs0 < 0 ? 0 : (rs0 > 120 ? 120 : rs0);
        int rs1 = r0 + 1 - 4; rs1 = rs1 < 0 ? 0 : (rs1 > 120 ? 120 : rs1);
        lk0 = rs0 * 64; lk1 = (rs1 + 8) * 64;
    }
    const int nloc = (lk1 - lk0) >> 6;
    const int rq = tq >> 6, cq = tq & 63;
    int rsq = rq - 4; rsq = rsq < 0 ? 0 : (rsq > 120 ? 120 : rsq);
    int csq = cq - 8; csq = csq < 0 ? 0 : (csq > 48 ? 48 : csq);
    const float* rpb = PAR(PAR_RPB) + (size_t)hq * 15 * 31;
    float m = MASK_NEG, l = 0.f;
    f32x16 oacc[2];
#pragma unroll
    for (int r = 0; r < 16; ++r) { oacc[0][r] = 0.f; oacc[1][r] = 0.f; }
    const int prr = tid >> 3, pc8 = (tid & 7) * 8;
    u32x4v pk0, pk1, pv0, pv1;
    pk0 = *(const u32x4v*)&zx[((size_t)b * SS + prr) * ZW1 + kcol + pc8];        pk1 = *(const u32x4v*)&zx[((size_t)b * SS + 32 + prr) * ZW1 + kcol + pc8];
    pv0 = *(const u32x4v*)&vt[(size_t)prr * SS + pc8];                           pv1 = *(const u32x4v*)&vt[(size_t)(32 + prr) * SS + pc8];
    for (int ti = 0; ti < 4 + nloc; ++ti) {
        const bool isctx = ti < 4;
        const int sbase = isctx ? ti * 64 : LC + lk0 + (ti - 4) * 64;
        __syncthreads();
        *(u32x4v*)&Ks[prr * AT_LD + pc8] = pk0; *(u32x4v*)&Ks[(32 + prr) * AT_LD + pc8] = pk1;
        *(u32x4v*)&Vs[prr * AT_LD + pc8] = pv0; *(u32x4v*)&Vs[(32 + prr) * AT_LD + pc8] = pv1;
        __syncthreads();
        if (ti + 1 < 4 + nloc) {
            const int sbn = (ti + 1 < 4) ? (ti + 1) * 64 : LC + lk0 + (ti + 1 - 4) * 64;
            pk0 = *(const u32x4v*)&zx[((size_t)b * SS + sbn + prr) * ZW1 + kcol + pc8];  pk1 = *(const u32x4v*)&zx[((size_t)b * SS + sbn + 32 + prr) * ZW1 + kcol + pc8];
            pv0 = *(const u32x4v*)&vt[(size_t)prr * SS + sbn + pc8];                     pv1 = *(const u32x4v*)&vt[(size_t)(32 + prr) * SS + sbn + pc8];
        }
        const int tk0 = sbase - LC;
        const int kr = tk0 >> 6;
        if (!isctx && kind == 1) {
            const int rqw = (t0 + wave * 32) >> 6;
            int rsw = rqw - 4; rsw = rsw < 0 ? 0 : (rsw > 120 ? 120 : rsw);
            if (kr < rsw || kr >= rsw + 8) continue;
        }
#pragma unroll
        for (int sub = 0; sub < 2; ++sub) {
            f32x16 sacc;
#pragma unroll
            for (int r = 0; r < 16; ++r) sacc[r] = 0.f;
#pragma unroll
            for (int st = 0; st < 4; ++st) {
                const bf16x8 kf = *(const bf16x8*)&Ks[(sub * 32 + ql) * AT_LD + st * 16 + 8 * hh];
                sacc = __builtin_amdgcn_mfma_f32_32x32x16_bf16(kf, qf[st], sacc, 0, 0, 0);
            }
            float sv[16], smax = MASK_NEG;
            const bool needmask = !isctx && (kind == 1 || (tk0 + 63 - tq0w > 128) || (tk0 - (tq0w + 31) < -128));
            if (kind == 1 && needmask) {
                const float* rb = rpb + (kr - rq + 7) * 31 + (15 - cq);
                float bias[16];
#pragma unroll
                for (int r = 0; r < 16; ++r) {
                    const int key = sub * 32 + (r & 3) + 8 * (r >> 2) + 4 * hh;
                    const bool valid = (unsigned)(key - csq) < 16u;
                    bias[r] = rb[valid ? key : csq];
                }
#pragma unroll
                for (int r = 0; r < 16; ++r) {
                    const int key = sub * 32 + (r & 3) + 8 * (r >> 2) + 4 * hh;
                    const bool valid = (unsigned)(key - csq) < 16u;
                    const float x = valid ? sacc[r] * 0.18033688011f + 1.44269504089f * bias[r] : MASK_NEG;
                    sv[r] = x; smax = fmaxf(smax, x);
                }
            } else {
#pragma unroll
                for (int r = 0; r < 16; ++r) {
                    const int key = sub * 32 + (r & 3) + 8 * (r >> 2) + 4 * hh;
                    float x = sacc[r] * 0.18033688011f;
                    if (kind == 0 && needmask) { const int dlt = tk0 + key - tq; if (dlt > 128 || dlt < -128) x = MASK_NEG; }
                    sv[r] = x; smax = fmaxf(smax, x);
                }
            }
            smax = half_swap_max(smax);
            const float mn = fmaxf(m, smax);
            if (__builtin_amdgcn_ballot_w64(mn > m)) {
                const float alpha = __builtin_amdgcn_exp2f(m - mn);
                l *= alpha;
#pragma unroll
                for (int r = 0; r < 16; ++r) { oacc[0][r] *= alpha; oacc[1][r] *= alpha; }
                m = mn;
            }
            float ps = 0.f;
#pragma unroll
            for (int r = 0; r < 16; ++r) { sv[r] = __builtin_amdgcn_exp2f(sv[r] - m); ps += sv[r]; }
            l += ps;
#pragma unroll
            for (int s2 = 0; s2 < 2; ++s2) {
                union { bf16x8 v; unsigned u[4]; } pb;
#pragma unroll
                for (int u = 0; u < 4; ++u) pb.u[u] = pack2(sv[8 * s2 + 2 * u], sv[8 * s2 + 2 * u + 1]);
#pragma unroll
                for (int db = 0; db < 2; ++db) {
                    union { bf16x8 v; uint2 h[2]; } vf;
                    const bf16_t* vrow = &Vs[(db * 32 + ql) * AT_LD + sub * 32 + 16 * s2 + 4 * hh];
                    vf.h[0] = *(const uint2*)vrow;
                    vf.h[1] = *(const uint2*)(vrow + 8);
                    oacc[db] = __builtin_amdgcn_mfma_f32_32x32x16_bf16(vf.v, pb.v, oacc[db], 0, 0, 0);
                }
            }
        }
    }
    float lt = half_swap_sum(l);
    if (kind == 0) lt += __builtin_amdgcn_exp2f(1.44269504089f * PAR(PAR_SINK)[hq] - m);
    const float inv = 1.f / lt;
    bf16_t* mix = WSP(bf16_t, WS_MIX);
#pragma unroll
    for (int db = 0; db < 2; ++db)
#pragma unroll
        for (int g4 = 0; g4 < 4; ++g4) {
            const int dd = db * 32 + 8 * g4 + 4 * hh;
            uint2 o; o.x = pack2(oacc[db][4 * g4] * inv, oacc[db][4 * g4 + 1] * inv); o.y = pack2(oacc[db][4 * g4 + 2] * inv, oacc[db][4 * g4 + 3] * inv);
            *(uint2*)&mix[Rq * 1024 + ocol + dd] = o;
        }
}


enum { PH_TRANSPOSE = 0, PH_CONVERT, PH_MODP, PH_MISC, PH_S5TAB, PH_WIN0, PH_S5E, PH_S5CARRY, PH_S5Y, PH_RWKV, PH_GLU, PH_RWKVOUT,
       PH_WOUT, PH_LN1, PH_QGEMM, PH_TOPK, PH_GATHER, PH_GATHERB, PH_WIN1, PH_ATTN, PH_RWPREP, PH_COUNT };
template <int PH> struct PhaseSmem { static constexpr int bytes = 1024; };
template <> struct PhaseSmem<PH_TRANSPOSE> { static constexpr int bytes = 64 * 65 * 4; };
template <> struct PhaseSmem<PH_WIN0>    { static constexpr int bytes = GEMM_SMEM_BYTES; };
template <> struct PhaseSmem<PH_S5E>     { static constexpr int bytes = GEMM_SMEM_BYTES; };
template <> struct PhaseSmem<PH_S5Y>     { static constexpr int bytes = GEMM_SMEM_BYTES; };
template <> struct PhaseSmem<PH_RWKV>    { static constexpr int bytes = (int)sizeof(RwkvSmem); };
template <> struct PhaseSmem<PH_GLU>     { static constexpr int bytes = GEMM_SMEM_BYTES; };
template <> struct PhaseSmem<PH_RWKVOUT> { static constexpr int bytes = GEMM_SMEM_BYTES; };
template <> struct PhaseSmem<PH_WOUT>    { static constexpr int bytes = GEMM_SMEM_BYTES; };
template <> struct PhaseSmem<PH_QGEMM>   { static constexpr int bytes = GEMM_SMEM_BYTES; };
template <> struct PhaseSmem<PH_TOPK>    { static constexpr int bytes = TOPK_SMEM_BYTES; };
template <> struct PhaseSmem<PH_WIN1>    { static constexpr int bytes = GEMM_SMEM_BYTES; };
template <> struct PhaseSmem<PH_ATTN>    { static constexpr int bytes = ATTN_SMEM_BYTES; };

template <int PH>
__device__ __forceinline__ void run_early(const P& p, unsigned char* smem) {
    const int bid = bidx(), nblk = gridDim.x;
    const size_t gtid = (size_t)bid * 256 + tidx(), gthreads = (size_t)nblk * 256;
    const int gwave = bid * 4 + (tidx() >> 6), nwaves = nblk * 4;
    if constexpr (PH == PH_TRANSPOSE) phase_transpose(p, (float*)smem, bid, nblk);
    else if constexpr (PH == PH_CONVERT) phase_convert(p, gtid, gthreads);
    else if constexpr (PH == PH_MODP) phase_mod_partial(p, gwave, nwaves);
    else if constexpr (PH == PH_MISC) { phase_s5_pow(p, gtid, gthreads); phase_rope_table(p, gtid, gthreads); phase_pack_params(p, gtid, gthreads); }
    else if constexpr (PH == PH_S5TAB) { phase_mod_reduce(p, gtid, gthreads); phase_s5_tables(p, gtid, gthreads); }
}
template <int PH>
__device__ __forceinline__ void run_phase(const W p, int layer, unsigned char* smem) {
    const int bid = bidx(), nblk = gridDim.x;
    const size_t gtid = (size_t)bid * 256 + tidx(), gthreads = (size_t)nblk * 256;
    const int gwave = bid * 4 + (tidx() >> 6), nwaves = nblk * 4;
    if constexpr (PH == PH_WIN0) phase_gemm_win0(p, smem, bid, nblk);
    else if constexpr (PH == PH_RWPREP) { phase_rw_shift(p, gwave, nwaves); phase_rw_lora(p, smem, bid, nblk); }
    else if constexpr (PH == PH_S5E) phase_s5_E(p, smem, (bid + nblk - 8448 % nblk) % nblk, nblk);
    else if constexpr (PH == PH_S5CARRY) phase_s5_carry(p, gtid, gthreads);
    else if constexpr (PH == PH_S5Y) phase_s5_Y(p, smem, bid, nblk);
    else if constexpr (PH == PH_RWKV) { for (int it = bid; it < 256; it += nblk) rwkv_scan_item(p, it, smem); }
    else if constexpr (PH == PH_GLU) phase_glu(p, smem, bid, nblk);
    else if constexpr (PH == PH_RWKVOUT) phase_rwkv_out(p, smem, bid, nblk);
    else if constexpr (PH == PH_WOUT) phase_gemm_wout(p, smem, bid, nblk, layer);
    else if constexpr (PH == PH_LN1) phase_ln1(p, gwave, nwaves, layer, smem);
    else if constexpr (PH == PH_QGEMM) phase_gemm_q(p, smem, bid, nblk, layer);
    else if constexpr (PH == PH_TOPK) {
        for (int it = bid; it < (NTOK / 64) * 8; it += nblk) { if (layer && ((it >> 3) * 64) % SS < LC) continue; peer_topk_item(p, it, smem, layer); }
    }
    else if constexpr (PH == PH_GATHER) phase_peer_act(p, gwave, nwaves, layer);
    else if constexpr (PH == PH_GATHERB) phase_peer_out(p, gwave, nwaves, layer, smem);
    else if constexpr (PH == PH_WIN1) phase_gemm_win1(p, smem, bid, nblk);
    else if constexpr (PH == PH_ATTN) { for (int it = bid; it < 2048; it += nblk) attn_item<1>(p, it, smem); for (int it = bid; it < 2048; it += nblk) attn_item<0>(p, it, smem); }
}

namespace cg = cooperative_groups;
constexpr int cmax(int a, int b) { return a > b ? a : b; }
constexpr int MEGA_SMEM = cmax(cmax(GEMM_SMEM_BYTES, RW1_SMEM_BYTES), cmax(TOPK_SMEM_BYTES, ATTN_SMEM_BYTES));
static_assert(MEGA_SMEM >= 17408 * 4, "gather epilogue vectors fit in LDS");
static_assert(MEGA_SMEM >= 128 * CS_LD * 4, "128-row C staging fits");

#define DIAG 0
#define DIAG_A0 13
#define DIAG_A1 14
#if DIAG
#define STAMP(k) do { if (bidx() == 0 && tidx() == 0) ((volatile unsigned long long*)(p.ws + WS_TS))[k] = __builtin_amdgcn_s_memrealtime(); } while (0)
#define DIAG_TAIL() do { GSYNC(); STAMP(63); GSYNC(); \
    const volatile unsigned long long* ts = (const volatile unsigned long long*)(p.ws + WS_TS); \
    const float ra = (float)(ts[DIAG_A1] - ts[DIAG_A0]) * (1.f / 500000.f);     \
    const float sc = 1.f + sqrtf(0.04f * ra); \
    for (size_t i = (size_t)bidx() * 256 + tidx(); i < (size_t)NB * TT * DM; i += (size_t)gridDim.x * 256) p.out[i] *= sc; } while (0)
#else
#define STAMP(k)
#define DIAG_TAIL()
#endif
#define GSYNC() xcd_barrier(xb)

__device__ __forceinline__ void phase_scan_and_side(const P& p, const W w, unsigned char* smem, volatile LAS unsigned* bc) {
    unsigned* ctl = (unsigned*)(p.ws + WS_CTL);
    if (bidx() < 64) rw2_chain(w, bidx(), smem);
    STAMP(20);
    for (;;) { const int t = take_ticket(&ctl[CT_S5YT], bc); if (t >= 640) break; phase_s5_Y(w, smem, t, 1 << 30); }
}

__global__ void __launch_bounds__(256, 2) mega_kernel(P p) {
    __shared__ __attribute__((aligned(16))) unsigned char smem[MEGA_SMEM + 64];
    cg::grid_group grid = cg::this_grid();
    volatile LAS unsigned* st = (volatile LAS unsigned*)(smem + MEGA_SMEM);
    if (tidx() < 4) st[tidx()] = 0u;
    __syncthreads();
    XcdBarrier xb = xcd_barrier_post((unsigned*)(p.ws + WS_CTL), st);
    volatile LAS unsigned* bc = st + 2;
    STAMP(0);
    run_early<PH_TRANSPOSE>(p, smem); STAMP(21);
    run_early<PH_MODP>(p, smem); STAMP(22);
    run_early<PH_MISC>(p, smem);
    GSYNC(); STAMP(1);
    run_early<PH_S5TAB>(p, smem);
    GSYNC(); STAMP(2);
    const W w{p.in[I_X], p.in[I_CTX], p.out, p.ws};
    phase_xcvt(w, smem);
    GSYNC();
    run_phase<PH_WIN0>(w, 0, smem);
    GSYNC(); STAMP(3);
    run_phase<PH_S5E>(w, 0, smem);
    for (int it = bidx(); it < 8448; it += gridDim.x) rw1_item(w, it, smem);
    { unsigned* ctl = (unsigned*)(p.ws + WS_CTL);
      wait_count(ctl, CT_S5ED, 160u);
      for (;;) { const int t = take_ticket(&ctl[CT_CARRYT], bc); if (t >= 32) break; phase_s5_carry(w, (size_t)t * 256 + tidx(), (size_t)1 << 40); } }
    GSYNC(); STAMP(4);
    phase_scan_and_side(p, w, smem, bc);
    GSYNC(); STAMP(5);
    run_phase<PH_GLU>(w, 0, smem);
    run_phase<PH_RWKVOUT>(w, 0, smem);
    run_early<PH_CONVERT>(p, smem);
    GSYNC(); STAMP(7);
    run_phase<PH_WOUT>(w, 0, smem);   GSYNC(); STAMP(8);
    run_phase<PH_LN1>(w, 0, smem);    GSYNC(); STAMP(9);
    run_phase<PH_QGEMM>(w, 0, smem);  GSYNC(); STAMP(10);
    STAMP(11);
    run_phase<PH_GATHER>(w, 0, smem); GSYNC(); run_phase<PH_GATHERB>(w, 0, smem); GSYNC(); STAMP(12);
    run_phase<PH_WIN1>(w, 1, smem);   GSYNC(); STAMP(13);
    run_phase<PH_ATTN>(w, 1, smem);   GSYNC(); STAMP(14);
    run_phase<PH_WOUT>(w, 1, smem);   GSYNC(); STAMP(15);
    run_phase<PH_LN1>(w, 1, smem);    GSYNC(); STAMP(16);
    run_phase<PH_QGEMM>(w, 1, smem);  GSYNC(); STAMP(17);
    STAMP(18);
    run_phase<PH_GATHER>(w, 1, smem); GSYNC(); run_phase<PH_GATHERB>(w, 1, smem);
    DIAG_TAIL();
    grid.sync();
}

extern "C" void kernel_launch(void* const* d_in, const int* in_sizes, int n_in, void* d_out, int out_size, void* d_ws, size_t ws_size,
                              hipStream_t stream) {
    (void)in_sizes; (void)n_in; (void)out_size; (void)ws_size;
    static int grid_blocks = 0;
    if (!grid_blocks) {
        int dev = 0, cus = 0, per_cu = 0;
        hipGetDevice(&dev);
        hipDeviceGetAttribute(&cus, hipDeviceAttributeMultiprocessorCount, dev);
        hipOccupancyMaxActiveBlocksPerMultiprocessor(&per_cu, mega_kernel, 256, 0);
        if (per_cu > 2) per_cu = 2;
        if (per_cu < 1) per_cu = 1;
        grid_blocks = cus * per_cu;
    }
    P p{};
    for (int i = 0; i < 51; ++i) p.in[i] = (const float*)d_in[i];
    p.out = (float*)d_out; p.ws = (unsigned char*)d_ws;
    hipMemsetAsync((unsigned char*)d_ws + WS_CTL, 0, CTL_WORDS * 4, stream);
    void* args[] = {&p};
    hipError_t e = hipLaunchCooperativeKernel((void*)mega_kernel, dim3(grid_blocks), dim3(256), args, 0, stream);
    if (e != hipSuccess) fprintf(stderr, "cooperative launch failed: %s (grid %d)\n", hipGetErrorString(e), grid_blocks);
}
```
